# Optimizing an MI355X kernel written in HIP

```python
import math
import jax, jax.numpy as jnp
from jax import lax
import numpy as np

D_MODEL = 1024
BATCH = 1
SEQ = 16384
DEPTH = 1
DEC_BATCH = 32
DEC_SEQ = 64
PAST_LEN = 2048

CHUNK = 64
GDN_HEADS = 8
GDN_DK = 128
GDN_DV = 128
CONV_W = 4
CONV_DIM = GDN_HEADS * (2 * GDN_DK + GDN_DV)
SWA_HEADS = 16
SWA_KV_HEADS = 2
SWA_GROUP = SWA_HEADS // SWA_KV_HEADS
SWA_HD = 64
WINDOW = 128
NUM_BUCKETS = 32
MAX_DISTANCE = 128
D_FF = 2816
N_MOD = 9
EPS = 1e-6
IN_SPLITS = (CONV_DIM, GDN_HEADS * GDN_DV, GDN_HEADS, GDN_HEADS,
             SWA_HEADS * SWA_HD, SWA_KV_HEADS * SWA_HD, SWA_KV_HEADS * SWA_HD,
             D_MODEL, D_MODEL)
IN_COLS = sum(IN_SPLITS)

kernel_name = 'hybrid_gdn_swa_macaron_adaln_step'


def rmsnorm(x, g):
    x32 = x.astype(jnp.float32)
    y = x32 * lax.rsqrt(jnp.mean(x32 * x32, axis=-1, keepdims=True) + EPS)
    return (y * g.astype(jnp.float32)).astype(x.dtype)


def l2norm(x):
    return x * lax.rsqrt(jnp.sum(x * x, axis=-1, keepdims=True) + EPS)


def swiglu(h, w_in, w_out):
    gate, up = jnp.split(h @ w_in, 2, axis=-1)
    return (jax.nn.silu(gate) * up) @ w_out


def t5_bucket(rel):
    half = NUM_BUCKETS // 2
    max_exact = half // 2
    n = jnp.abs(rel)
    large = max_exact + (jnp.log(jnp.maximum(n, 1).astype(jnp.float32) / max_exact)
                         / math.log(MAX_DISTANCE / max_exact) * (half - max_exact)).astype(jnp.int32)
    large = jnp.minimum(large, half - 1)
    return jnp.where(rel > 0, half, 0) + jnp.where(n < max_exact, n, large)


def gated_delta_chunked(q, k, v, g, beta, s0, C):
    B, L, H, DK = k.shape
    DV = v.shape[-1]
    N = L // C

    def chunks(t):
        return t.reshape(B, N, C, H, t.shape[-1]).transpose(1, 0, 3, 2, 4)

    qc, kc, vc = chunks(q), chunks(k), chunks(v)
    gc = jnp.cumsum(chunks(g[..., None])[..., 0], axis=-1)
    bc = chunks(beta[..., None])
    causal = jnp.tril(jnp.ones((C, C), dtype=bool))
    strict = jnp.tril(jnp.ones((C, C), dtype=bool), k=-1)
    diff = gc[..., :, None] - gc[..., None, :]
    decay = jnp.where(causal, jnp.exp(jnp.where(causal, diff, 0.0)), 0.0)
    kb = kc * bc
    a_mat = jnp.where(strict, jnp.einsum('nbhid,nbhjd->nbhij', kb, kc) * decay, 0.0) + jnp.eye(C, dtype=jnp.float32)
    rhs = jnp.concatenate([vc * bc, kb * jnp.exp(gc)[..., None]], axis=-1)
    sol = lax.linalg.triangular_solve(a_mat, rhs, left_side=True, lower=True)
    u, w = sol[..., :DV], sol[..., DV:]
    intra = jnp.where(causal, jnp.einsum('nbhid,nbhjd->nbhij', qc, kc) * decay, 0.0)

    def step(S, xs):
        q_i, k_i, u_i, w_i, g_i, a_i = xs
        v_new = u_i - jnp.einsum('bhcd,bhde->bhce', w_i, S)
        o = (jnp.einsum('bhcd,bhde->bhce', q_i * jnp.exp(g_i)[..., None], S)
             + jnp.einsum('bhij,bhje->bhie', a_i, v_new))
        g_last = g_i[..., -1:]
        S = (S * jnp.exp(g_last)[..., None]
             + jnp.einsum('bhcd,bhce->bhde', k_i * jnp.exp(g_last - g_i)[..., None], v_new))
        return S, o

    s_final, o = lax.scan(step, s0, (qc, kc, u, w, gc, intra))
    return o.transpose(1, 0, 3, 2, 4).reshape(B, L, H, DV), s_final


def gated_deltanet(qkv_pre, z, b_raw, a_raw, conv_hist, s0, conv_w, a_log, dt_bias, norm_w):
    B, L, _ = qkv_pre.shape
    xp = jnp.concatenate([conv_hist.astype(qkv_pre.dtype), qkv_pre], axis=1)
    conv = lax.conv_general_dilated(xp, conv_w[:, None, :].astype(xp.dtype), window_strides=(1,),
                                    padding='VALID', dimension_numbers=('NWC', 'WIO', 'NWC'),
                                    feature_group_count=CONV_DIM)
    qkv = jax.nn.silu(conv.astype(jnp.float32))
    q, k, v = jnp.split(qkv, [GDN_HEADS * GDN_DK, 2 * GDN_HEADS * GDN_DK], axis=-1)
    q = l2norm(q.reshape(B, L, GDN_HEADS, GDN_DK)) * GDN_DK ** -0.5
    k = l2norm(k.reshape(B, L, GDN_HEADS, GDN_DK))
    v = v.reshape(B, L, GDN_HEADS, GDN_DV)
    beta = jax.nn.sigmoid(b_raw.astype(jnp.float32))
    g = -jnp.exp(a_log.astype(jnp.float32)) * jax.nn.softplus(a_raw.astype(jnp.float32) + dt_bias.astype(jnp.float32))
    o, s_new = gated_delta_chunked(q, k, v, g, beta, s0.astype(jnp.float32), min(CHUNK, L))
    zg = jax.nn.silu(z.astype(jnp.float32).reshape(B, L, GDN_HEADS, GDN_DV))
    o = o * lax.rsqrt(jnp.mean(o * o, axis=-1, keepdims=True) + EPS) * norm_w.astype(jnp.float32) * zg
    return o.reshape(B, L, GDN_HEADS * GDN_DV).astype(qkv_pre.dtype), xp[:, L:], s_new.astype(s0.dtype)


def sliding_window_attention(q, k, v, k_hist, v_hist, n_hist_valid, rel_bias, sinks):
    B, L = q.shape[:2]
    win = k_hist.shape[1]
    C = min(CHUNK, L)
    N = L // C
    k = k.reshape(B, L, SWA_KV_HEADS, SWA_HD)
    v = v.reshape(B, L, SWA_KV_HEADS, SWA_HD)
    kf = jnp.concatenate([k_hist.astype(k.dtype), k], axis=1)
    vf = jnp.concatenate([v_hist.astype(v.dtype), v], axis=1)
    idx = (jnp.arange(N) * C)[:, None] + jnp.arange(win + C)[None, :]
    kb = kf[:, idx]
    vb = vf[:, idx]
    qb = q.reshape(B, N, C, SWA_KV_HEADS, SWA_GROUP, SWA_HD)
    logits = jnp.einsum('bnikgd,bnjkd->bnkgij', qb, kb).astype(jnp.float32) * SWA_HD ** -0.5
    rel = jnp.arange(win + C)[None, :] - win - jnp.arange(C)[:, None]
    bias = rel_bias.astype(jnp.float32)[t5_bucket(rel)]
    bias = bias.transpose(2, 0, 1).reshape(SWA_KV_HEADS, SWA_GROUP, C, win + C)
    valid = (idx >= win - n_hist_valid)[None, :, None, None, None, :]
    logits = jnp.where(valid, logits + bias, -jnp.inf)
    sink = sinks.astype(jnp.float32).reshape(SWA_KV_HEADS, SWA_GROUP, 1, 1)
    m = jnp.maximum(jnp.max(logits, axis=-1, keepdims=True), sink)
    p = jnp.exp(logits - m)
    probs = p / (jnp.sum(p, axis=-1, keepdims=True) + jnp.exp(sink - m))
    out = jnp.einsum('bnkgij,bnjkd->bnikgd', probs.astype(v.dtype), vb)
    return out.reshape(B, L, SWA_HEADS * SWA_HD), kf[:, -win:], vf[:, -win:]


def trunk(x, c, conv_hist, s_hist, k_hist, v_hist, n_hist_valid, p):
    B, L, D = x.shape
    splits = np.cumsum(IN_SPLITS)[:-1].tolist()
    new_conv, new_s, new_k, new_v = [], [], [], []
    for l in range(DEPTH):
        mod = (jax.nn.silu(c) @ p['w_ada'][l] + p['b_ada'][l]).reshape(B, N_MOD, 1, D)
        sh1, sc1, ga1, sh2, sc2, ga2, sh3, sc3, ga3 = [mod[:, i] for i in range(N_MOD)]
        h = rmsnorm(x, p['norm_ffn1'][l]) * (1 + sc1) + sh1
        x = x + 0.5 * ga1 * swiglu(h, p['w_ffn1_in'][l], p['w_ffn1_out'][l])
        h = rmsnorm(x, p['norm_mix'][l]) * (1 + sc2) + sh2
        qkv_a, z_a, b_a, a_a, q_b, k_b, v_b, gate_a, gate_b = jnp.split(h @ p['w_in'][l], splits, axis=-1)
        o_a, conv_new, s_new = gated_deltanet(qkv_a, z_a, b_a, a_a, conv_hist[l], s_hist[l], p['gdn_conv_w'][l],
                                              p['gdn_a_log'][l], p['gdn_dt_bias'][l], p['gdn_norm_w'][l])
        o_b, k_new, v_new = sliding_window_attention(q_b, k_b, v_b, k_hist[l], v_hist[l], n_hist_valid,
                                                     p['rel_bias'], p['swa_sinks'][l])
        merged = (jax.nn.sigmoid(gate_a) * (o_a @ p['w_branch_a'][l])
                  + jax.nn.sigmoid(gate_b) * (o_b @ p['w_branch_b'][l]))
        x = x + ga2 * (merged @ p['w_out'][l])
        h = rmsnorm(x, p['norm_ffn2'][l]) * (1 + sc3) + sh3
        x = x + 0.5 * ga3 * swiglu(h, p['w_ffn2_in'][l], p['w_ffn2_out'][l])
        new_conv.append(conv_new)
        new_s.append(s_new)
        new_k.append(k_new)
        new_v.append(v_new)
    y = rmsnorm(x, p['norm_final'])
    return y, jnp.stack(new_conv), jnp.stack(new_s), jnp.stack(new_k), jnp.stack(new_v)


def setup_inputs(seed: int = 0) -> dict:
    key = jax.random.key(seed)
    ks = iter(jax.random.split(key, 40))

    def nrm(shape, scale):
        return scale * jax.random.normal(next(ks), shape, jnp.float32)

    def gain(shape):
        return 1.0 + nrm(shape, 0.02)

    win_rows = min(WINDOW, PAST_LEN)
    dt = jnp.exp(jax.random.uniform(next(ks), (DEPTH, GDN_HEADS), jnp.float32, math.log(1e-3), math.log(1e-1)))
    a_init = jax.random.uniform(next(ks), (DEPTH, GDN_HEADS), jnp.float32, 1.0, 16.0)
    return {
        'x_prompt': nrm((BATCH, SEQ, D_MODEL), 1.0),
        'x_sample': nrm((DEC_BATCH, DEC_SEQ, D_MODEL), 1.0),
        'state_gdn_conv': nrm((DEPTH, DEC_BATCH, CONV_W - 1, CONV_DIM), 1.0),
        'state_gdn_s': nrm((DEPTH, DEC_BATCH, GDN_HEADS, GDN_DK, GDN_DV), 0.1),
        'cache_swa_k': nrm((DEPTH, DEC_BATCH, win_rows, SWA_KV_HEADS, SWA_HD), 1.0),
        'cache_swa_v': nrm((DEPTH, DEC_BATCH, win_rows, SWA_KV_HEADS, SWA_HD), 1.0),
        'c_prompt': nrm((BATCH, D_MODEL), 1.0),
        'c_sample': nrm((DEC_BATCH, D_MODEL), 1.0),
        'norm_ffn1': gain((DEPTH, D_MODEL)),
        'w_ffn1_in': nrm((DEPTH, D_MODEL, 2 * D_FF), D_MODEL ** -0.5),
        'w_ffn1_out': nrm((DEPTH, D_FF, D_MODEL), D_FF ** -0.5),
        'norm_mix': gain((DEPTH, D_MODEL)),
        'w_in': nrm((DEPTH, D_MODEL, IN_COLS), D_MODEL ** -0.5),
        'gdn_conv_w': nrm((DEPTH, CONV_W, CONV_DIM), 0.5),
        'gdn_a_log': jnp.log(a_init),
        'gdn_dt_bias': dt + jnp.log(-jnp.expm1(-dt)),
        'gdn_norm_w': gain((DEPTH, GDN_DV)),
        'swa_sinks': nrm((DEPTH, SWA_HEADS), 1.0),
        'rel_bias': nrm((NUM_BUCKETS, SWA_HEADS), 0.5),
        'w_branch_a': nrm((DEPTH, GDN_HEADS * GDN_DV, D_MODEL), (GDN_HEADS * GDN_DV) ** -0.5),
        'w_branch_b': nrm((DEPTH, SWA_HEADS * SWA_HD, D_MODEL), (SWA_HEADS * SWA_HD) ** -0.5),
        'w_out': nrm((DEPTH, D_MODEL, D_MODEL), D_MODEL ** -0.5),
        'norm_ffn2': gain((DEPTH, D_MODEL)),
        'w_ffn2_in': nrm((DEPTH, D_MODEL, 2 * D_FF), D_MODEL ** -0.5),
        'w_ffn2_out': nrm((DEPTH, D_FF, D_MODEL), D_FF ** -0.5),
        'w_ada': nrm((DEPTH, D_MODEL, N_MOD * D_MODEL), 0.5 * D_MODEL ** -0.5),
        'b_ada': nrm((DEPTH, N_MOD * D_MODEL), 0.02),
        'norm_final': gain((D_MODEL,)),
    }


def reference(x_prompt, x_sample, state_gdn_conv, state_gdn_s, cache_swa_k, cache_swa_v, c_prompt, c_sample,
              norm_ffn1, w_ffn1_in, w_ffn1_out, norm_mix, w_in, gdn_conv_w, gdn_a_log, gdn_dt_bias, gdn_norm_w,
              swa_sinks, rel_bias, w_branch_a, w_branch_b, w_out, norm_ffn2, w_ffn2_in, w_ffn2_out,
              w_ada, b_ada, norm_final):
    params = {
        'norm_ffn1': norm_ffn1, 'w_ffn1_in': w_ffn1_in, 'w_ffn1_out': w_ffn1_out,
        'norm_mix': norm_mix, 'w_in': w_in, 'gdn_conv_w': gdn_conv_w, 'gdn_a_log': gdn_a_log,
        'gdn_dt_bias': gdn_dt_bias, 'gdn_norm_w': gdn_norm_w, 'swa_sinks': swa_sinks, 'rel_bias': rel_bias,
        'w_branch_a': w_branch_a, 'w_branch_b': w_branch_b, 'w_out': w_out,
        'norm_ffn2': norm_ffn2, 'w_ffn2_in': w_ffn2_in, 'w_ffn2_out': w_ffn2_out,
        'w_ada': w_ada, 'b_ada': b_ada, 'norm_final': norm_final,
    }
    bp = x_prompt.shape[0]
    dt = x_prompt.dtype
    zero_conv = jnp.zeros((DEPTH, bp, CONV_W - 1, CONV_DIM), dt)
    zero_s = jnp.zeros((DEPTH, bp, GDN_HEADS, GDN_DK, GDN_DV), state_gdn_s.dtype)
    zero_kv = jnp.zeros((DEPTH, bp, WINDOW, SWA_KV_HEADS, SWA_HD), dt)
    y_prompt, p_conv, p_s, p_k, p_v = trunk(x_prompt, c_prompt, zero_conv, zero_s, zero_kv, zero_kv, 0, params)
    y_sample, s_conv, s_s, s_k, s_v = trunk(x_sample, c_sample, state_gdn_conv, state_gdn_s, cache_swa_k,
                                            cache_swa_v, cache_swa_k.shape[2], params)
    return (y_prompt, y_sample, p_conv, p_s, p_k, p_v, s_conv, s_s, s_k, s_v)
```

```cpp
#include <hip/hip_runtime.h>
#include <cstdio>
#include <cstdint>
namespace pg8 {
#define PG8_LAS __attribute__((address_space(3)))
typedef unsigned short bf16_t;
typedef short bf16x8 __attribute__((ext_vector_type(8)));
typedef float f32x4 __attribute__((ext_vector_type(4)));
typedef unsigned u32x4 __attribute__((ext_vector_type(4)));
constexpr int BM = 256, BK = 64, HALF = 128, HTB = HALF * BK * 2  , STAGE_BYTES = 8 * HTB, NXCD = 8, WGM = 8;

__host__ __device__ __forceinline__ int lds_byte(int r, int c) { const int st = (r >> 4) * 2 + (c >> 5), rr = r & 15, cc = c & 31, ob = rr * 64 + cc * 2; return st * 1024 + (ob ^ (((ob >> 9) & 1) << 5)); }
__host__ __device__ __forceinline__ void stage_rc(int b, int& R, int& C) { const int st = b / 1024, sb = b % 1024, swz = sb ^ (((sb >> 9) & 1) << 5); R = (st >> 1) * 16 + swz / 64; C = (st & 1) * 32 + (swz % 64) / 2; }
__host__ __device__ __forceinline__ int perm32(int rho) { const int n = rho >> 4, i = rho & 15; return 8 * (i >> 2) + 4 * n + (i & 3); }

struct Unit { int pm, pn; };
struct Gemm { const bf16_t* A; const bf16_t* Bt; int M, N, K; };

struct StaticOrder {
    int nM, nN, nwg, G, c;
    __host__ __device__ void init(int M, int N, int G_, int c_) { nM = M / BM; nN = N / BM; nwg = nM * nN; G = G_; c = c_; }
    __host__ __device__ bool next(int i, Unit& u) const {
        const long L = (long)i * G + c; if (L >= nwg) return false;
        int wgid = (int)L; { const int q = nwg / NXCD, r = nwg % NXCD, xcd = wgid % NXCD, off = wgid / NXCD; wgid = (xcd < r ? xcd * (q + 1) : r * (q + 1) + (xcd - r) * q) + off; }
        const int nig = WGM * nN, gid = wgid / nig, fm = gid * WGM, gsz = (nM - fm) < WGM ? (nM - fm) : WGM;
        u.pm = fm + ((wgid % nig) % gsz); u.pn = (wgid % nig) / gsz; return true;
    }
    __device__ __forceinline__ void a_ready(const Unit&) const {}
    __device__ __forceinline__ void done(const Unit&) const {}
};

__device__ __forceinline__ unsigned cvt_pk_bf16(float lo, float hi) { unsigned r; asm volatile("v_cvt_pk_bf16_f32 %0, %1, %2" : "=v"(r) : "v"(lo), "v"(hi)); return r; }

template <class Epi, class Sched, bool ALIGN_EPI = false, bool SP2 = false>
__device__ __forceinline__ void gemm_phase(PG8_LAS unsigned char* lds, const Gemm g, const Sched& S, const Epi& E) {
    const int tid = threadIdx.x, wid = __builtin_amdgcn_readfirstlane(tid >> 6), lane = tid & 63, wr = wid >> 2, wc = wid & 3, fr = lane & 15, fq = lane >> 4;
    const int K = g.K, nt = K / BK;
    unsigned voffA[2], voffB[2];
#pragma unroll
    for (int i = 0; i < 2; ++i) { int R, C; stage_rc(tid * 16 + i * 8192, R, C); const int Rb = Epi::PERM ? ((R & ~31) + perm32(R & 31)) : R;
        voffA[i] = (unsigned)(R * K + C) * 2u; voffB[i] = (unsigned)(Rb * K + C) * 2u; }
    const size_t kstep = (size_t)(BK * 2);
    const size_t hstep = (size_t)HALF * K * 2;
    const size_t tstep = 2 * hstep;
    const unsigned ldsw = (unsigned)wid * 1024u;
    const int aoff = lds_byte(wr * 64 + fr, fq * 8), boff = lds_byte(wc * 32 + fr, fq * 8);
#define PG8_SA(b, h) (((b) * 2 + (h)) * HTB)
#define PG8_SB(b, h) ((4 + (b) * 2 + (h)) * HTB)
#define PG8_STAGE(bufoff, gbase, voff) do { _Pragma("unroll") for (int _i = 0; _i < 2; ++_i) \
        __builtin_amdgcn_global_load_lds((const unsigned*)((const char*)(gbase) + (voff)[_i]), (PG8_LAS unsigned*)(lds + (bufoff) + ldsw + _i * 8192), 16, 0, 0); } while (0)
#define PG8_LDA(dst, b, h) do { _Pragma("unroll") for (int m = 0; m < 4; ++m) _Pragma("unroll") for (int k = 0; k < 2; ++k) dst[m][k] = *(const PG8_LAS bf16x8*)(lds + PG8_SA(b, h) + aoff + m * 2048 + k * 1024); } while (0)
#define PG8_LDB(dst, b, h) do { _Pragma("unroll") for (int n = 0; n < 2; ++n) _Pragma("unroll") for (int k = 0; k < 2; ++k) dst[n][k] = *(const PG8_LAS bf16x8*)(lds + PG8_SB(b, h) + boff + n * 2048 + k * 1024); } while (0)
#define PG8_MMA(ai, bj, At, Bt) do { __builtin_amdgcn_s_setprio(1); _Pragma("unroll") for (int m = 0; m < 4; ++m) _Pragma("unroll") for (int n = 0; n < 2; ++n) _Pragma("unroll") for (int k = 0; k < 2; ++k) \
        acc[ai][bj][m][n] = __builtin_amdgcn_mfma_f32_16x16x32_bf16(Bt[n][k], At[m][k], acc[ai][bj][m][n], 0, 0, 0); __builtin_amdgcn_s_setprio(0); } while (0)
#define PG8_WAIT_V(n) asm volatile("s_waitcnt vmcnt(" #n ")" ::: "memory")
#define PG8_WAIT_L(n) asm volatile("s_waitcnt lgkmcnt(" #n ")" ::: "memory")
#define PG8_BAR __builtin_amdgcn_s_barrier()
#define PG8_SCHED __builtin_amdgcn_sched_barrier(0)
    Unit cur, nxt; int ui = 0;
    if (!S.next(0, cur)) return;
    f32x4 acc[2][2][4][2];
#pragma unroll
    for (int a = 0; a < 2; ++a)
#pragma unroll
        for (int b = 0; b < 2; ++b)
#pragma unroll
            for (int m = 0; m < 4; ++m)
#pragma unroll
                for (int n = 0; n < 2; ++n) acc[a][b][m][n] = (f32x4){0.f, 0.f, 0.f, 0.f};
    bf16x8 At[4][2], B0[2][2], B1[2][2];
    const char* cA = (const char*)g.A + (size_t)cur.pm * tstep; const char* cB = (const char*)g.Bt + (size_t)cur.pn * tstep;
    S.a_ready(cur);
    if constexpr (SP2) {
        PG8_STAGE(PG8_SB(0, 0), cB, voffB); PG8_STAGE(PG8_SB(0, 1), cB + hstep, voffB); PG8_STAGE(PG8_SA(0, 0), cA, voffA); PG8_STAGE(PG8_SA(0, 1), cA + hstep, voffA);
        if (wr == 1) PG8_BAR;
        PG8_WAIT_V(2); PG8_BAR;
        PG8_STAGE(PG8_SB(1, 0), cB + kstep, voffB); PG8_STAGE(PG8_SA(1, 0), cA + kstep, voffA); PG8_STAGE(PG8_SB(1, 1), cB + hstep + kstep, voffB);
        PG8_WAIT_V(6); PG8_BAR;
    } else {
        PG8_STAGE(PG8_SB(0, 0), cB, voffB); PG8_STAGE(PG8_SA(0, 0), cA, voffA); PG8_STAGE(PG8_SB(0, 1), cB + hstep, voffB); PG8_STAGE(PG8_SA(0, 1), cA + hstep, voffA);
        if (wr == 1) PG8_BAR;
        PG8_WAIT_V(4); PG8_BAR;
        PG8_STAGE(PG8_SB(1, 0), cB + kstep, voffB); PG8_STAGE(PG8_SA(1, 0), cA + kstep, voffA); PG8_STAGE(PG8_SB(1, 1), cB + hstep + kstep, voffB);
        PG8_WAIT_V(6); PG8_BAR;
    }
    for (;;) {
        const bool has_next = S.next(ui + 1, nxt);
        const char* nA = has_next ? (const char*)g.A + (size_t)nxt.pm * tstep : cA; const char* nB = has_next ? (const char*)g.Bt + (size_t)nxt.pn * tstep : cB;
        for (int t = 0; t < nt; t += 2) {
            const bool last = (t == nt - 2);
            const char* a1 = cA + (size_t)(t + 1) * kstep;
            const char* a2 = last ? nA : cA + (size_t)(t + 2) * kstep; const char* b2 = last ? nB : cB + (size_t)(t + 2) * kstep;
            const char* a3 = a2 + kstep; const char* b3 = b2 + kstep;
            if (last && has_next) S.a_ready(nxt);
            if constexpr (SP2) {
            PG8_LDB(B0, 0, 0); PG8_LDB(B1, 0, 1); PG8_SCHED; PG8_LDA(At, 0, 0); PG8_STAGE(PG8_SA(1, 1), a1 + hstep, voffA);
            PG8_WAIT_V(8); PG8_WAIT_L(0); PG8_BAR; PG8_MMA(0, 0, At, B0); PG8_MMA(0, 1, At, B1); PG8_BAR; PG8_SCHED;
            PG8_LDA(At, 0, 1); PG8_STAGE(PG8_SB(0, 0), b2, voffB); PG8_STAGE(PG8_SB(0, 1), b2 + hstep, voffB); PG8_STAGE(PG8_SA(0, 0), a2, voffA);
            PG8_WAIT_V(8); PG8_WAIT_L(0); PG8_BAR; PG8_MMA(1, 0, At, B0); PG8_MMA(1, 1, At, B1); PG8_BAR; PG8_SCHED;
            PG8_LDB(B0, 1, 0); PG8_LDB(B1, 1, 1); PG8_SCHED; PG8_LDA(At, 1, 0); PG8_STAGE(PG8_SA(0, 1), a2 + hstep, voffA);
            PG8_WAIT_V(8); PG8_WAIT_L(0); PG8_BAR; PG8_MMA(0, 0, At, B0); PG8_MMA(0, 1, At, B1); PG8_BAR; PG8_SCHED;
            PG8_LDA(At, 1, 1); PG8_STAGE(PG8_SB(1, 0), b3, voffB); PG8_STAGE(PG8_SB(1, 1), b3 + hstep, voffB); PG8_STAGE(PG8_SA(1, 0), a3, voffA);
            PG8_WAIT_V(8); PG8_WAIT_L(0); PG8_BAR; PG8_MMA(1, 0, At, B0); PG8_MMA(1, 1, At, B1); PG8_BAR; PG8_SCHED;
            } else {
            PG8_LDB(B0, 0, 0); PG8_SCHED; PG8_LDA(At, 0, 0); PG8_STAGE(PG8_SA(1, 1), a1 + hstep, voffA);
            PG8_WAIT_L(8); PG8_BAR; PG8_WAIT_L(0); PG8_MMA(0, 0, At, B0); PG8_BAR; PG8_SCHED;
            PG8_LDB(B1, 0, 1); PG8_STAGE(PG8_SB(0, 0), b2, voffB);
            PG8_BAR; PG8_WAIT_L(0); PG8_MMA(0, 1, At, B1); PG8_BAR;
            PG8_LDA(At, 0, 1); PG8_STAGE(PG8_SA(0, 0), a2, voffA);
            PG8_BAR; PG8_WAIT_L(0); PG8_MMA(1, 0, At, B0); PG8_BAR; PG8_SCHED;
            PG8_STAGE(PG8_SB(0, 1), b2 + hstep, voffB);
            PG8_WAIT_V(6); PG8_BAR; PG8_MMA(1, 1, At, B1); PG8_BAR;
            PG8_LDB(B0, 1, 0); PG8_SCHED; PG8_LDA(At, 1, 0); PG8_STAGE(PG8_SA(0, 1), a2 + hstep, voffA);
            PG8_WAIT_L(8); PG8_BAR; PG8_WAIT_L(0); PG8_MMA(0, 0, At, B0); PG8_BAR; PG8_SCHED;
            PG8_LDB(B1, 1, 1); PG8_STAGE(PG8_SB(1, 0), b3, voffB);
            PG8_BAR; PG8_WAIT_L(0); PG8_MMA(0, 1, At, B1); PG8_BAR;
            PG8_LDA(At, 1, 1); PG8_STAGE(PG8_SA(1, 0), a3, voffA);
            PG8_BAR; PG8_WAIT_L(0); PG8_MMA(1, 0, At, B0); PG8_BAR; PG8_SCHED;
            PG8_STAGE(PG8_SB(1, 1), b3 + hstep, voffB);
            PG8_WAIT_V(6); PG8_BAR; PG8_MMA(1, 1, At, B1); PG8_BAR;
            }
        }
        if constexpr (ALIGN_EPI) { if (wr == 0) PG8_BAR; }
        if constexpr (!Epi::AFTER_DRAIN) { E(acc, cur, wr, wc, fr, fq); S.done(cur); }
        if (!has_next) break;
#pragma unroll
        for (int a = 0; a < 2; ++a)
#pragma unroll
            for (int b = 0; b < 2; ++b)
#pragma unroll
                for (int m = 0; m < 4; ++m)
#pragma unroll
                    for (int n = 0; n < 2; ++n) acc[a][b][m][n] = (f32x4){0.f, 0.f, 0.f, 0.f};
        cur = nxt; cA = nA; cB = nB; ++ui;
        if constexpr (ALIGN_EPI) { if (wr == 1) PG8_BAR; }
    }
    PG8_WAIT_V(0);
    if constexpr (!ALIGN_EPI) { if (wr == 0) PG8_BAR; }
    PG8_BAR;
    if constexpr (Epi::AFTER_DRAIN) { E.fused(acc, cur, wr, wc, fr, fq, lds, wid, lane); S.done(cur); }
#undef PG8_SA
#undef PG8_SB
#undef PG8_STAGE
#undef PG8_LDA
#undef PG8_LDB
#undef PG8_MMA
#undef PG8_WAIT_V
#undef PG8_WAIT_L
#undef PG8_BAR
#undef PG8_SCHED
}
}

#ifndef PG8_SP2
#define PG8_SP2 true
#endif
#define GAS __attribute__((address_space(1)))
#define LAS __attribute__((address_space(3)))
typedef unsigned short bf16;
typedef unsigned v4u __attribute__((ext_vector_type(4)));
typedef float f32x4 __attribute__((ext_vector_type(4)));
typedef short bf16x8 __attribute__((ext_vector_type(8)));
typedef GAS unsigned gu32;
typedef GAS unsigned long long gu64;
#define RLX_AGENT __ATOMIC_RELAXED, __HIP_MEMORY_SCOPE_AGENT
#define LDS_WAIT() asm volatile("s_waitcnt lgkmcnt(0)" ::: "memory")
#define VM_WAIT() asm volatile("s_waitcnt vmcnt(0)" ::: "memory")
__device__ __forceinline__ unsigned long long rt() { return __builtin_amdgcn_s_memrealtime(); }
__device__ __forceinline__ unsigned f2bf(float f) { unsigned u = __builtin_bit_cast(unsigned, f); return (u + 0x7fffu + ((u >> 16) & 1u)) >> 16; }
__device__ __forceinline__ unsigned pk2(float lo, float hi) { return f2bf(lo) | (f2bf(hi) << 16); }

#define XB_TMO      128
#define XB_XCNT(j)  (256  + 64 * (j))
#define XB_XSUB(j)  (1280 + 64 * (j))
#define XB_XGEN(j)  (2304 + 64 * (j))
#define XB_TOP      3328
#define XB_TOPGEN   3392
#define XCD_BAR_WORDS 3456
#define XB_SPIN_CAP (1u << 18)

__device__ __forceinline__ unsigned xb_ld(unsigned* p)              { return __hip_atomic_load(p, __ATOMIC_RELAXED, __HIP_MEMORY_SCOPE_AGENT); }
__device__ __forceinline__ unsigned xb_add(unsigned* p, unsigned v) { return __hip_atomic_fetch_add(p, v, __ATOMIC_RELAXED, __HIP_MEMORY_SCOPE_AGENT); }
__device__ __forceinline__ unsigned xb_xcc_id() { return (unsigned)__builtin_amdgcn_s_getreg((3 << 11) | 20) & 0xFu; }
#define XB_SPIN(cond, bar) do { unsigned _sp = 0; while (cond) { __builtin_amdgcn_s_sleep(1); \
    if ((++_sp & 255u) == 0u) { if (xb_ld(&(bar)[XB_TMO])) break; if (_sp > XB_SPIN_CAP) { atomicAdd(&(bar)[XB_TMO], 1u); break; } } } } while (0)

struct XcdBarrier {
    unsigned* bar; unsigned x;
    volatile LAS unsigned* st;
};

__device__ __forceinline__ XcdBarrier xcd_barrier_post(unsigned* bar, volatile LAS unsigned* st) {
    XcdBarrier b; b.bar = bar; b.x = xb_xcc_id(); b.st = st;
    if (threadIdx.x == 0) (void)xb_add(&bar[XB_XCNT(b.x)], 1u);
    return b;
}
__device__ __forceinline__ void xcd_barrier_complete(unsigned* bar, unsigned x, unsigned& nloc, unsigned& nx) {
    const unsigned G = gridDim.x * gridDim.y * gridDim.z;
    unsigned sum, cnt, mine, sp = 0u;
    for (;;) {
        sum = 0u; cnt = 0u; mine = 0u;
#pragma unroll
        for (unsigned j = 0; j < 16; ++j) { const unsigned c = xb_ld(&bar[XB_XCNT(j)]); sum += c; cnt += (c > 0u) ? 1u : 0u; mine = (j == x) ? c : mine; }
        if (sum == G) break;
        __builtin_amdgcn_s_sleep(1);
        if ((++sp & 255u) == 0u) { if (xb_ld(&bar[XB_TMO])) break; if (sp > XB_SPIN_CAP) { atomicAdd(&bar[XB_TMO], 1u); break; } }
    }
    nloc = mine > 0u ? mine : 1u; nx = cnt > 0u ? cnt : 1u;
}

__device__ __forceinline__ void xcd_barrier(const XcdBarrier& b) {
    asm volatile("s_waitcnt vmcnt(0)" ::: "memory");
    __syncthreads();
    if (threadIdx.x == 0) {
        unsigned* bar = b.bar;
        __builtin_amdgcn_s_waitcnt(0);
        unsigned nloc = b.st[0], nx = b.st[1];
        if (nloc == 0u) { xcd_barrier_complete(bar, b.x, nloc, nx); b.st[0] = nloc; b.st[1] = nx; }
        const unsigned old = xb_add(&bar[XB_XSUB(b.x)], 1u);
        const unsigned gen = old / nloc;
        if (old + 1u == (gen + 1u) * nloc) {
            __builtin_amdgcn_fence(__ATOMIC_RELEASE, "agent");
            asm volatile("s_waitcnt vmcnt(0)" ::: "memory");
            const unsigned og = xb_add(&bar[XB_TOP], 1u);
            const unsigned tg = og / nx;
            if (og + 1u == (tg + 1u) * nx) xb_add(&bar[XB_TOPGEN], 1u);
            else XB_SPIN(xb_ld(&bar[XB_TOPGEN]) == tg, bar);
            __builtin_amdgcn_fence(__ATOMIC_ACQUIRE, "agent");
            xb_add(&bar[XB_XGEN(b.x)], 1u);
            asm volatile("s_waitcnt vmcnt(0)" ::: "memory");
        } else {
            XB_SPIN(xb_ld(&bar[XB_XGEN(b.x)]) == gen, bar);
            __builtin_amdgcn_fence(__ATOMIC_ACQUIRE, "agent");
            asm volatile("s_waitcnt vmcnt(0)" ::: "memory");
        }
    }
    __syncthreads();
}
#ifndef PG8_ALIGN
#define PG8_ALIGN true
#endif
constexpr int NWAVES = 8;
#ifndef MK_PER_PHASE
#define MK_PER_PHASE 1
#endif
constexpr int D = 1024, MP = 16384, MSMP = 2048, M = MP + MSMP, NCH = M / 64, DFF = 2816, INCOLS = 7440, NB = 33, ADAW = 9 * D;
constexpr float EPS = 1e-6f;
constexpr size_t OFF_Y = 0, OFF_PCONV = (size_t)M * D, OFF_PS = OFF_PCONV + 3 * 3072, OFF_PK = OFF_PS + 8 * 128 * 128, OFF_PV = OFF_PK + 128 * 128,
                 OFF_SCONV = OFF_PV + 128 * 128, OFF_SS = OFF_SCONV + 32 * 3 * 3072, OFF_SK = OFF_SS + (size_t)32 * 8 * 128 * 128, OFF_SV = OFF_SK + 32 * 128 * 128, OUT_TOTAL = OFF_SV + 32 * 128 * 128;
constexpr size_t MiB = 1u << 20;
constexpr size_t WS_CTL = 0, CTL_ZERO_BYTES = 1 * MiB, WS_ADA = 1 * MiB, WS_BA = 5 * MiB / 2, WS_GL = 4 * MiB, WS_W = 5 * MiB;
constexpr size_t WS_U1 = 26 * MiB, WS_U2 = 62 * MiB, WS_U3 = 98 * MiB, WS_U4 = 134 * MiB, WS_U5 = 170 * MiB, WS_U6 = 206 * MiB;
constexpr size_t WS_INTRA = 206 * MiB, WS_KV = 224 * MiB, WS_TAIL = 233 * MiB, WS_END = 242 * MiB;
static_assert((size_t)M * D * 2 == 36 * MiB && (size_t)NB * ADAW * 4 <= 3 * MiB / 2 && (size_t)M * 16 * 4 <= 3 * MiB / 2, "ws map");
static_assert((size_t)NCH * 8 * 64 * 64 * 2 == 18 * MiB && (size_t)M * 256 * 2 == 9 * MiB && WS_TAIL + (size_t)NCH * 3 * 3072 * 2 <= WS_END && (size_t)M * DFF * 2 <= 108 * MiB, "ws map 2");
constexpr size_t W_FIN = 0, W_FOUT = (size_t)2 * DFF * D;
constexpr size_t W_IN = 0, W_A = (size_t)7424 * D, W_B = W_A + (size_t)D * D, W_O = W_B + (size_t)D * D;
static_assert((W_O + (size_t)D * D) * 2 <= 21 * MiB, "w slot");
constexpr int CW_TMO = 0, CW_BAR = 4096;
constexpr int RING_BYTES = 131072, LDSCTL_OFF = RING_BYTES, MISC_OFF = LDSCTL_OFF + 320, LDS_BYTES = 147456;

struct Frame {
    LAS unsigned char* lds; volatile LAS unsigned* MISC; gu32* ctl;
    int tid, lane, wave, vcu, G;
    const float* const* in; float* out; unsigned char* ws;
};
typedef float f32x2 __attribute__((ext_vector_type(2)));
typedef unsigned u32x2 __attribute__((ext_vector_type(2)));
__device__ __forceinline__ float bflo(unsigned u) { return __builtin_bit_cast(float, u << 16); }
__device__ __forceinline__ float bfhi(unsigned u) { return __builtin_bit_cast(float, u & 0xffff0000u); }
__device__ __forceinline__ float bf2f(bf16 h) { return __builtin_bit_cast(float, (unsigned)h << 16); }
__device__ __forceinline__ float fexp(float x) { return __builtin_amdgcn_exp2f(x * 1.4426950408889634f); }
__device__ __forceinline__ float sigm(float x) { return __builtin_amdgcn_rcpf(1.f + fexp(-x)); }
__device__ __forceinline__ float siluf(float x) { return x * sigm(x); }
__device__ __forceinline__ float wave_sum(float v) {
#pragma unroll
    for (int o = 1; o < 64; o <<= 1) v += __shfl_xor(v, o);
    return v;
}
__device__ __forceinline__ int mod_row(int m) { return m < MP ? 0 : 1 + ((m - MP) >> 6); }

__device__ __forceinline__ void transpose_item(const float* W, int ldw, int c0, int K, bf16* WT, int drow0, LAS float* scr, int k0, int lane) {
#pragma unroll 8
    for (int i = 0; i < 32; ++i) { const int kk = 2 * i + (lane >> 5); scr[kk * 33 + (lane & 31)] = W[(size_t)(k0 + kk) * ldw + c0 + (lane & 31)]; }
    LDS_WAIT(); asm volatile("" ::: "memory");
    const int c = lane & 7;
#pragma unroll
    for (int j = 0; j < 4; ++j) { const int n = (lane >> 3) + 8 * j; const LAS float* s = scr + (8 * c) * 33 + n;
        v4u o; o.x = pk2(s[0 * 33], s[1 * 33]); o.y = pk2(s[2 * 33], s[3 * 33]); o.z = pk2(s[4 * 33], s[5 * 33]); o.w = pk2(s[6 * 33], s[7 * 33]);
        *(GAS v4u*)(WT + (size_t)(drow0 + n) * K + k0 + 8 * c) = o; }
    LDS_WAIT(); asm volatile("" ::: "memory");
}
__device__ __forceinline__ void convert_ffn(Frame& F, const float* w_in, const float* w_out) {
    LAS float* scr = (LAS float*)(F.lds + F.wave * 16384);
    const int gw = F.vcu * NWAVES + F.wave, NGW = F.G * NWAVES;
    constexpr int I_IN = 16 * 176, I_OUT = 44 * 32;
    for (int it = gw; it < I_IN + I_OUT; it += NGW) {
        if (it < I_IN) { const int kb = it / 176, nb = it % 176, c0 = 32 * nb; const int j0 = c0 < DFF ? c0 : c0 - DFF;
            const int drow0 = (j0 >> 7) * 256 + (c0 < DFF ? 0 : 128) + (j0 & 127);
            transpose_item(w_in, 2 * DFF, c0, D, ((bf16*)(F.ws + WS_W)) + W_FIN, drow0, scr, 64 * kb, F.lane); }
        else { const int r = it - I_IN, kb = r / 32, nb = r % 32; transpose_item(w_out, D, 32 * nb, DFF, ((bf16*)(F.ws + WS_W)) + W_FOUT, 32 * nb, scr, 64 * kb, F.lane); }
    }
}
__device__ __forceinline__ void convert_mixer(Frame& F) {
    LAS float* scr = (LAS float*)(F.lds + F.wave * 16384);
    const int gw = F.vcu * NWAVES + F.wave, NGW = F.G * NWAVES;
    constexpr int NBLK = 7424 / 32, I_IN = 16 * NBLK, I_SQ = 16 * 32;
    for (int it = gw; it < I_IN + 3 * I_SQ; it += NGW) {
        if (it < I_IN) { const int kb = it / NBLK, nb = it % NBLK, dr = 32 * nb;
            const int c0 = dr < 3072 ? dr : dr < 4352 ? 4112 + (dr - 3072) : dr < 5376 ? 3072 + (dr - 4352) : 5392 + (dr - 5376);
            transpose_item((F.in[12]), INCOLS, c0, D, ((bf16*)(F.ws + WS_W)) + W_IN, dr, scr, 64 * kb, F.lane); }
        else { int r = it - I_IN; const int which = r / I_SQ; r %= I_SQ; const int kb = r / 32, nb = r % 32;
            const float* src = which == 0 ? (F.in[19]) : which == 1 ? (F.in[20]) : (F.in[21]); bf16* dst = ((bf16*)(F.ws + WS_W)) + (which == 0 ? W_A : which == 1 ? W_B : W_O);
            transpose_item(src, D, 32 * nb, D, dst, 32 * nb, scr, 64 * kb, F.lane); }
    }
}
__device__ __forceinline__ void ada_item(Frame& F, int item) {
    LAS float* sc = (LAS float*)F.lds; LAS float* red = (LAS float*)(F.lds + 49152);
    const int col = item * 64 + F.lane, k0 = F.wave * 128;
    for (int pass = 0; pass < 3; ++pass) {
        for (int idx = F.tid; idx < 11 * 1024; idx += 512) { const int b = pass * 11 + (idx >> 10), k = idx & 1023;
            const float c = (b == 0) ? (F.in[6])[k] : (F.in[7])[(b - 1) * 1024 + k]; sc[idx] = c / (1.f + __expf(-c)); }
        __syncthreads();
        float acc[11];
#pragma unroll
        for (int b = 0; b < 11; ++b) acc[b] = 0.f;
        for (int k4 = 0; k4 < 128; k4 += 4) {
            const float* wp = (F.in[25]) + (size_t)(k0 + k4) * ADAW + col;
            const float w0 = wp[0], w1 = wp[ADAW], w2 = wp[2 * ADAW], w3 = wp[3 * ADAW];
#pragma unroll
            for (int b = 0; b < 11; ++b) { const f32x4 s = *(const LAS f32x4*)(sc + b * 1024 + k0 + k4); acc[b] += (s.x * w0 + s.y * w1) + (s.z * w2 + s.w * w3); }
        }
#pragma unroll
        for (int b = 0; b < 11; ++b) red[(F.wave * 11 + b) * 64 + F.lane] = acc[b];
        __syncthreads();
        for (int idx = F.tid; idx < 11 * 64; idx += 512) { const int b = idx >> 6, l = idx & 63; float s = 0.f;
#pragma unroll
            for (int w = 0; w < 8; ++w) s += red[(w * 11 + b) * 64 + l];
            ((float*)(F.ws + WS_ADA))[(size_t)(pass * 11 + b) * ADAW + item * 64 + l] = s + (F.in[26])[item * 64 + l]; }
        __syncthreads();
    }
}
__device__ __forceinline__ void rmsmod_row(const float* xrow, const float* g, const float* sc, const float* sh, bf16* orow, int lane, f32x4 (&hv)[4]) {
    const GAS f32x4* xr = (const GAS f32x4*)xrow + lane;
    f32x4 v[4]; float s = 0.f;
#pragma unroll
    for (int j = 0; j < 4; ++j) { v[j] = xr[64 * j]; s += (v[j].x * v[j].x + v[j].y * v[j].y) + (v[j].z * v[j].z + v[j].w * v[j].w); }
    const float r = 1.f / sqrtf(wave_sum(s) * (1.f / D) + EPS);
    GAS u32x2* o8 = (GAS u32x2*)orow + lane;
#pragma unroll
    for (int j = 0; j < 4; ++j) { const f32x4 gg = ((const GAS f32x4*)g)[64 * j + lane], s1 = ((const GAS f32x4*)sc)[64 * j + lane], s0 = ((const GAS f32x4*)sh)[64 * j + lane];
        const f32x4 h = (v[j] * r) * gg * (s1 + 1.f) + s0; hv[j] = h;
        u32x2 w; w.x = pk2(h.x, h.y); w.y = pk2(h.z, h.w); o8[64 * j] = w; }
}
template <bool WITH_BA>
__device__ __forceinline__ void rmsmod_rows(Frame& F, const float* src, const float* g, int li, bf16* dst) {
    const int gw = F.vcu * NWAVES + F.wave, NGW = F.G * NWAVES;
    LAS float* wba = (LAS float*)F.lds;
    if (WITH_BA) { for (int idx = F.tid; idx < 16 * 1024; idx += 512) { const int k = idx >> 4, j = idx & 15; wba[j * 1024 + k] = (F.in[12])[(size_t)k * INCOLS + 4096 + j]; } __syncthreads(); }
    for (int m = gw; m < M; m += NGW) {
        const float* xrow = src ? src + (size_t)m * D : (m < MP ? (F.in[0]) + (size_t)m * D : (F.in[1]) + (size_t)(m - MP) * D);
        const float* ad = ((float*)(F.ws + WS_ADA)) + (size_t)mod_row(m) * ADAW + (3 * li) * D;
        f32x4 hv[4]; rmsmod_row(xrow, g, ad + D, ad, dst + (size_t)m * D, F.lane, hv);
        if (WITH_BA) { float mine = 0.f;
#pragma unroll 1
            for (int j = 0; j < 16; ++j) { float s = 0.f;
#pragma unroll
                for (int jj = 0; jj < 4; ++jj) { const f32x4 w = *(const LAS f32x4*)(wba + j * 1024 + 256 * jj + 4 * F.lane); s += (hv[jj].x * w.x + hv[jj].y * w.y) + (hv[jj].z * w.z + hv[jj].w * w.w); }
                s = wave_sum(s); if (F.lane == j) mine = s; }
            if (F.lane < 16) ((float*)(F.ws + WS_BA))[(size_t)m * 16 + F.lane] = mine; }
    }
    if (WITH_BA) __syncthreads();
}
__device__ __forceinline__ void final_norm_rows(Frame& F) {
    const int gw = F.vcu * NWAVES + F.wave, NGW = F.G * NWAVES;
    for (int m = gw; m < M; m += NGW) {
        GAS f32x4* xr = (GAS f32x4*)(F.out + (size_t)m * D) + F.lane; f32x4 v[4]; float s = 0.f;
#pragma unroll
        for (int j = 0; j < 4; ++j) { v[j] = xr[64 * j]; s += (v[j].x * v[j].x + v[j].y * v[j].y) + (v[j].z * v[j].z + v[j].w * v[j].w); }
        const float r = 1.f / sqrtf(wave_sum(s) * (1.f / D) + EPS);
#pragma unroll
        for (int j = 0; j < 4; ++j) xr[64 * j] = (v[j] * r) * ((const GAS f32x4*)(F.in[27]))[64 * j + F.lane];
    }
}
typedef pg8::f32x4 pf4; typedef pg8::u32x4 pu4;
__device__ __forceinline__ pf4 silu4(pf4 v) { pf4 o; o.x = siluf(v.x); o.y = siluf(v.y); o.z = siluf(v.z); o.w = siluf(v.w); return o; }
__device__ __forceinline__ pu4 pack8(pf4 a, pf4 b) { pu4 w; w.x = pg8::cvt_pk_bf16(a.x, a.y); w.y = pg8::cvt_pk_bf16(a.z, a.w); w.z = pg8::cvt_pk_bf16(b.x, b.y); w.w = pg8::cvt_pk_bf16(b.z, b.w); return w; }
struct EpiSwiglu {
    static constexpr bool PERM = true, AFTER_DRAIN = false; bf16* O;
    __device__ __forceinline__ void operator()(const pf4 (&acc)[2][2][4][2], const pg8::Unit& u, int wr, int wc, int fr, int fq) const {
        const int row0 = u.pm * 256 + wr * 64 + fr, col0 = u.pn * 128 + wc * 32 + 8 * fq;
#pragma unroll
        for (int ai = 0; ai < 2; ++ai)
#pragma unroll
            for (int m = 0; m < 4; ++m) { bf16* p = O + (size_t)(row0 + ai * 128 + m * 16) * DFF + col0;
                const pf4 h0 = silu4(acc[ai][0][m][0]) * acc[ai][1][m][0], h1 = silu4(acc[ai][0][m][1]) * acc[ai][1][m][1];
                *(pu4*)p = pack8(h0, h1); }
    }
};
struct EpiResid {
    static constexpr bool PERM = false, AFTER_DRAIN = false; const float* base0; const float* base1; float* out; const float* ada; int gi; float scale;
    __device__ __forceinline__ void operator()(const pf4 (&acc)[2][2][4][2], const pg8::Unit& u, int wr, int wc, int fr, int fq) const {
        const int rowt = u.pm * 256; const char* base = (const char*)(rowt < MP ? base0 + (size_t)rowt * D : base1 + (size_t)(rowt - MP) * D); char* o = (char*)(out + (size_t)rowt * D);
        const int col0 = u.pn * 256 + wc * 32 + 4 * fq;
#pragma unroll
        for (int ai = 0; ai < 2; ++ai) {
            const int b = rowt < MP ? 0 : 1 + ((rowt - MP) >> 6) + ai * 2 + wr; const char* ga = (const char*)(ada + (size_t)b * ADAW + gi * D);
#pragma unroll
            for (int bj = 0; bj < 2; ++bj)
#pragma unroll
                for (int n = 0; n < 2; ++n) { unsigned co = (unsigned)(col0 + bj * 128 + n * 16) * 4u; asm volatile("" : "+v"(co));
                    const pf4 gv = *(const pf4*)(ga + (size_t)co) * scale; unsigned off = co + (unsigned)(ai * 128 + wr * 64 + fr) * (D * 4u);
#pragma unroll
                    for (int m = 0; m < 4; ++m) { const pf4 bs = *(const pf4*)(base + (size_t)off); *(pf4*)(o + (size_t)off) = bs + gv * acc[ai][bj][m][n]; off += 16u * D * 4u; }
                    asm volatile("" ::: "memory"); }
        }
    }
};
struct EpiF1 {
    static constexpr bool PERM = true, AFTER_DRAIN = false; bf16 *U1, *U2, *U3, *U4, *KV, *TAIL; float* out;
    __device__ __forceinline__ void operator()(const pf4 (&acc)[2][2][4][2], const pg8::Unit& u, int wr, int wc, int fr, int fq) const {
        const int pn = u.pn, dcol = wc * 32 + 8 * fq;
        if (pn < 12) {
            char* Ub = (char*)U1 + (size_t)(pn >> 2) * (36u << 20);
#pragma unroll
            for (int ai = 0; ai < 2; ++ai) { const int cn = u.pm * 4 + ai * 2 + wr;
#pragma unroll
                for (int bj = 0; bj < 2; ++bj) { unsigned off = (unsigned)(((cn * 8 + (pn & 3) * 2 + bj) * 64 + fr) * 128 + dcol) * 2u; asm volatile("" : "+v"(off));
#pragma unroll
                    for (int m = 0; m < 4; ++m) { *(pu4*)(Ub + (size_t)off) = pack8(acc[ai][bj][m][0], acc[ai][bj][m][1]); off += 16u * 128u * 2u; }
                    asm volatile("" ::: "memory"); } }
            if (fr >= 13) {
#pragma unroll
                for (int ai = 0; ai < 2; ++ai) { const int cn = u.pm * 4 + ai * 2 + wr;
#pragma unroll
                    for (int bj = 0; bj < 2; ++bj) { const int j = fr - 13, qc = pn * 256 + bj * 128 + dcol; const pf4 v0 = acc[ai][bj][3][0], v1 = acc[ai][bj][3][1];
                        *(pu4*)(TAIL + ((size_t)cn * 3 + j) * 3072 + qc) = pack8(v0, v1);
                        if (cn >= 255) { float* o = out + (cn == 255 ? OFF_PCONV + (size_t)j * 3072 : OFF_SCONV + ((size_t)(cn - 256) * 3 + j) * 3072) + qc; *(pf4*)o = v0; *(pf4*)(o + 4) = v1; } } } }
        } else if (pn < 16) {
#pragma unroll
            for (int ai = 0; ai < 2; ++ai)
#pragma unroll
                for (int bj = 0; bj < 2; ++bj) { unsigned off = (unsigned)((u.pm * 256 + ai * 128 + wr * 64 + fr) * D + (pn - 12) * 256 + bj * 128 + dcol) * 2u; asm volatile("" : "+v"(off));
#pragma unroll
                    for (int m = 0; m < 4; ++m) { *(pu4*)((char*)U4 + (size_t)off) = pack8(acc[ai][bj][m][0], acc[ai][bj][m][1]); off += 16u * D * 2u; }
                    asm volatile("" ::: "memory"); }
        } else {
#pragma unroll
            for (int ai = 0; ai < 2; ++ai) { const int cn = u.pm * 4 + ai * 2 + wr;
#pragma unroll
                for (int bj = 0; bj < 2; ++bj) { unsigned off = (unsigned)((cn * 64 + fr) * 256 + bj * 128 + dcol) * 2u; asm volatile("" : "+v"(off));
#pragma unroll
                    for (int m = 0; m < 4; ++m) { *(pu4*)((char*)KV + (size_t)off) = pack8(acc[ai][bj][m][0], acc[ai][bj][m][1]); off += 16u * 256u * 2u; }
                    asm volatile("" ::: "memory");
                    if (cn >= 254) {
                        float* ob = cn < 256 ? out + (bj == 0 ? OFF_PK : OFF_PV) + (size_t)((cn - 254) * 64 + fr) * 128 + dcol
                                             : out + (bj == 0 ? OFF_SK : OFF_SV) + (size_t)(cn - 256) * 16384 + (size_t)(64 + fr) * 128 + dcol;
#pragma unroll
                        for (int m = 0; m < 4; ++m) { *(pf4*)(ob + m * 16 * 128) = acc[ai][bj][m][0]; *(pf4*)(ob + m * 16 * 128 + 4) = acc[ai][bj][m][1]; }
                        asm volatile("" ::: "memory"); } } }
        }
    }
};
struct EpiF2 {
    static constexpr bool PERM = true, AFTER_DRAIN = false; bf16 *Z, *GA, *GB;
    __device__ __forceinline__ void operator()(const pf4 (&acc)[2][2][4][2], const pg8::Unit& u, int wr, int wc, int fr, int fq) const {
        const int t_ = u.pn >> 2; bf16* Ob = (bf16*)((char*)Z + (size_t)(108 * t_ - 72 * (t_ >> 1)) * (1u << 20)); const int col0 = (u.pn & 3) * 256 + wc * 32 + 8 * fq, row0 = u.pm * 256 + wr * 64 + fr;
#pragma unroll
        for (int ai = 0; ai < 2; ++ai)
#pragma unroll
            for (int m = 0; m < 4; ++m)
#pragma unroll
                for (int bj = 0; bj < 2; ++bj) *(pu4*)(Ob + (size_t)(row0 + ai * 128 + m * 16) * D + col0 + bj * 128) = pack8(acc[ai][bj][m][0], acc[ai][bj][m][1]);
    }
};
template <int MODE> struct EpiGate {
    static constexpr bool PERM = true, AFTER_DRAIN = false; bf16* T; const bf16* G2;
    __device__ __forceinline__ void operator()(const pf4 (&acc)[2][2][4][2], const pg8::Unit& u, int wr, int wc, int fr, int fq) const {
        const int col0 = u.pn * 256 + wc * 32 + 8 * fq, row0 = u.pm * 256 + wr * 64 + fr;
#pragma unroll
        for (int ai = 0; ai < 2; ++ai)
#pragma unroll
            for (int m = 0; m < 4; ++m)
#pragma unroll
                for (int bj = 0; bj < 2; ++bj) { const size_t off = (size_t)(row0 + ai * 128 + m * 16) * D + col0 + bj * 128;
                    const pu4 gv = *(const pu4*)((MODE == 0 ? (const bf16*)T : G2) + off); pu4 tv = (pu4){0u, 0u, 0u, 0u}; if (MODE == 1) tv = *(const pu4*)(T + off);
                    const pf4 a0 = acc[ai][bj][m][0], a1 = acc[ai][bj][m][1]; pf4 o0, o1;
                    o0.x = bflo(tv.x) + sigm(bflo(gv.x)) * a0.x; o0.y = bfhi(tv.x) + sigm(bfhi(gv.x)) * a0.y; o0.z = bflo(tv.y) + sigm(bflo(gv.y)) * a0.z; o0.w = bfhi(tv.y) + sigm(bfhi(gv.y)) * a0.w;
                    o1.x = bflo(tv.z) + sigm(bflo(gv.z)) * a1.x; o1.y = bfhi(tv.z) + sigm(bfhi(gv.z)) * a1.y; o1.z = bflo(tv.w) + sigm(bflo(gv.w)) * a1.z; o1.w = bfhi(tv.w) + sigm(bfhi(gv.w)) * a1.w;
                    *(pu4*)(T + off) = pack8(o0, o1); }
    }
};
typedef short s16x8 __attribute__((ext_vector_type(8)));
constexpr int PR_Y = 0, PR_RHS = 0, PR_QB = 67584, PR_KB = 84992, PR_AM = 102400, PR_SC = 119808;
__device__ __forceinline__ void gdn_prep_unit(Frame& F, int cn, int h) {
    const int tid = F.tid, lane = F.lane, wave = F.wave, c = tid & 127, rq = tid >> 7;
    LAS float* YQ = (LAS float*)(F.lds + PR_Y); LAS float* YK = YQ + 64 * 132; LAS float* RHS = (LAS float*)(F.lds + PR_RHS);
    LAS bf16* QB = (LAS bf16*)(F.lds + PR_QB); LAS bf16* KB = (LAS bf16*)(F.lds + PR_KB); LAS float* AM = (LAS float*)(F.lds + PR_AM);
    LAS float* SC = (LAS float*)(F.lds + PR_SC); LAS float *S_BETA = SC, *S_GC = SC + 64, *S_EG = SC + 128, *S_EK = SC + 192, *S_RQ = SC + 256, *S_RK = SC + 320;
    const size_t blk = (size_t)(cn * 8 + h) * 64 * 128;
    if (wave == 0) { const int row = cn * 64 + lane; const float braw = ((float*)(F.ws + WS_BA))[(size_t)row * 16 + h], araw = ((float*)(F.ws + WS_BA))[(size_t)row * 16 + 8 + h];
        const float beta = 1.f / (1.f + expf(-braw)); const float xx = araw + (F.in[15])[h]; const float sp = xx > 20.f ? xx : log1pf(expf(xx)); const float g = -expf((F.in[14])[h]) * sp;
        float gcs = g;
#pragma unroll
        for (int o = 1; o < 64; o <<= 1) { const float t = __shfl_up(gcs, o); if (lane >= o) gcs += t; }
        const float glast = __shfl(gcs, 63);
        S_BETA[lane] = beta; S_GC[lane] = gcs; S_EG[lane] = expf(gcs); S_EK[lane] = expf(glast - gcs);
        if (lane == 63) ((float*)(F.ws + WS_GL))[cn * 8 + h] = expf(glast); }
    float y[3][16];
#pragma unroll
    for (int t = 0; t < 3; ++t) { const bf16* Ub = (t == 0 ? ((bf16*)(F.ws + WS_U1)) : t == 1 ? ((bf16*)(F.ws + WS_U2)) : ((bf16*)(F.ws + WS_U3))) + blk + c; const int ch = t * 1024 + h * 128 + c;
        const float w0 = (F.in[13])[ch], w1 = (F.in[13])[3072 + ch], w2 = (F.in[13])[2 * 3072 + ch], w3 = (F.in[13])[3 * 3072 + ch];
        float x0, x1, x2;
        if (rq > 0) { x0 = bf2f(Ub[(16 * rq - 3) * 128]); x1 = bf2f(Ub[(16 * rq - 2) * 128]); x2 = bf2f(Ub[(16 * rq - 1) * 128]); }
        else if (cn == 0) { x0 = 0.f; x1 = 0.f; x2 = 0.f; }
        else if (cn < 256) { const bf16* tp = ((bf16*)(F.ws + WS_TAIL)) + (size_t)(cn - 1) * 3 * 3072 + ch; x0 = bf2f(tp[0]); x1 = bf2f(tp[3072]); x2 = bf2f(tp[2 * 3072]); }
        else { const float* sp = (F.in[2]) + (size_t)(cn - 256) * 3 * 3072 + ch; x0 = sp[0]; x1 = sp[3072]; x2 = sp[2 * 3072]; }
#pragma unroll
        for (int r = 0; r < 16; ++r) { const float x3 = bf2f(Ub[(16 * rq + r) * 128]); const float v = (w0 * x0 + w1 * x1) + (w2 * x2 + w3 * x3); y[t][r] = siluf(v); x0 = x1; x1 = x2; x2 = x3; }
        asm volatile("" ::: "memory"); }
    { int o_ = (16 * rq) * 132 + c; asm volatile("" : "+v"(o_));
#pragma unroll
      for (int r = 0; r < 16; ++r) { YQ[o_ + r * 132] = y[0][r]; YK[o_ + r * 132] = y[1][r]; } }
    __syncthreads();
    { const int p = tid >> 2, part = tid & 3, row = p & 63; const LAS float* Y = (p < 64 ? YQ : YK) + row * 132 + part * 32; float s = 0.f;
#pragma unroll
      for (int e = 0; e < 8; ++e) { const f32x4 v = *(const LAS f32x4*)(Y + 4 * e); s += (v.x * v.x + v.y * v.y) + (v.z * v.z + v.w * v.w); }
      s += __shfl_xor(s, 1); s += __shfl_xor(s, 2);
      if (part == 0) { const float ri = 1.f / sqrtf(s + EPS); if (p < 64) S_RQ[row] = ri * 0.08838834764831845f; else S_RK[row] = ri; } }
    __syncthreads();
    { int c2 = c, rq2 = rq; asm volatile("" : "+v"(c2), "+v"(rq2));
      bf16* Q1 = ((bf16*)(F.ws + WS_U1)) + blk + c2; unsigned kp[8];
#pragma unroll
      for (int r = 0; r < 16; ++r) { const int i = 16 * rq2 + r; const float q = y[0][r] * S_RQ[i], k = y[1][r] * S_RK[i], v = y[2][r], be = S_BETA[i], eg = S_EG[i], ek = S_EK[i];
          QB[i * 136 + c2] = (bf16)f2bf(q); KB[i * 136 + c2] = (bf16)f2bf(k);
          Q1[i * 128] = (bf16)f2bf(q * eg);
          const unsigned kb = f2bf(k * ek); if (r & 1) kp[r >> 1] |= kb << 16; else kp[r >> 1] = kb;
          y[2][r] = v * be; y[1][r] = k * be * eg; }
      bf16* K2 = ((bf16*)(F.ws + WS_U2)) + blk + (size_t)c2 * 64 + 16 * rq2;
      *(v4u*)K2 = (v4u){kp[0], kp[1], kp[2], kp[3]}; *(v4u*)(K2 + 8) = (v4u){kp[4], kp[5], kp[6], kp[7]};
#pragma unroll
      for (int r = 0; r < 16; ++r) { const int i = 16 * rq2 + r; RHS[i * 256 + c2] = y[2][r]; RHS[i * 256 + 128 + c2] = y[1][r]; } }
    __syncthreads();
    { const int ti = wave & 3, fr = lane & 15, fq = lane >> 4; const LAS bf16* Ab = (wave < 4 ? KB : QB) + (16 * ti + fr) * 136 + 8 * fq;
      s16x8 a[4];
#pragma unroll
      for (int s = 0; s < 4; ++s) a[s] = *(const LAS s16x8*)(Ab + 32 * s);
      bf16* IO = ((bf16*)(F.ws + WS_INTRA)) + (size_t)(cn * 8 + h) * 4096;
#pragma unroll
      for (int tj = 0; tj < 4; ++tj) { f32x4 acc = (f32x4){0.f, 0.f, 0.f, 0.f}; const LAS bf16* Bb = KB + (16 * tj + fr) * 136 + 8 * fq;
#pragma unroll
          for (int s = 0; s < 4; ++s) { const s16x8 b = *(const LAS s16x8*)(Bb + 32 * s); acc = __builtin_amdgcn_mfma_f32_16x16x32_bf16(a[s], b, acc, 0, 0, 0); }
          const int j = 16 * tj + fr; const float gj = S_GC[j];
#pragma unroll
          for (int r = 0; r < 4; ++r) { const int i = 16 * ti + 4 * fq + r; const float dec = expf(fminf(S_GC[i] - gj, 0.f));
              if (wave < 4) AM[i * 68 + j] = (i > j) ? S_BETA[i] * acc[r] * dec : 0.f;
              else IO[i * 64 + j] = (bf16)f2bf((i >= j) ? acc[r] * dec : 0.f); } } }
    __syncthreads();
    if (tid < 256) { int t2 = tid; asm volatile("" : "+v"(t2)); float x[64]; int zv = 0; asm volatile("" : "+v"(zv)); const LAS float* AMv = AM + zv;
#pragma unroll
        for (int i = 0; i < 64; ++i) { float acc = RHS[i * 256 + t2];
#pragma unroll
            for (int j4 = 0; j4 < (i & ~3); j4 += 4) { const f32x4 a = *(const LAS f32x4*)(AMv + i * 68 + j4); acc -= (a.x * x[j4] + a.y * x[j4 + 1]) + (a.z * x[j4 + 2] + a.w * x[j4 + 3]); }
#pragma unroll
            for (int j = (i & ~3); j < i; ++j) acc -= AMv[i * 68 + j] * x[j];
            x[i] = acc; asm volatile("" ::: "memory"); }
        if (t2 < 128) { bf16* UT = ((bf16*)(F.ws + WS_U3)) + blk + (size_t)t2 * 64;
#pragma unroll
            for (int q = 0; q < 8; ++q) { v4u w; w.x = pk2(x[8 * q], x[8 * q + 1]); w.y = pk2(x[8 * q + 2], x[8 * q + 3]); w.z = pk2(x[8 * q + 4], x[8 * q + 5]); w.w = pk2(x[8 * q + 6], x[8 * q + 7]); *(v4u*)(UT + 8 * q) = w; } }
        else { bf16* WN = ((bf16*)(F.ws + WS_U5)) + blk + (t2 - 128);
#pragma unroll
            for (int i = 0; i < 64; ++i) WN[i * 128] = (bf16)f2bf(-x[i]); } }
    __syncthreads();
}
typedef float f32x16 __attribute__((ext_vector_type(16)));
constexpr int SW_KS = 0, SW_VT = 27648, SW_TB = 53248;
__device__ __forceinline__ int t5_bucket(int rel) { const int n = rel < 0 ? -rel : rel;
    const int b = n < 8 ? n : n < 12 ? 8 : n < 16 ? 9 : n < 23 ? 10 : n < 32 ? 11 : n < 46 ? 12 : n < 64 ? 13 : n < 91 ? 14 : 15; return (rel > 0 ? 16 : 0) + b; }
__device__ __forceinline__ void swa_unit(Frame& F, int cn, int kh) {
    const int tid = F.tid, lane = F.lane, wave = F.wave, r32 = lane & 31, hi = lane >> 5;
    LAS bf16* KS = (LAS bf16*)(F.lds + SW_KS); LAS bf16* VT = (LAS bf16*)(F.lds + SW_VT); LAS float* TB = (LAS float*)(F.lds + SW_TB);
    const bool smp = cn >= 256; const int b = cn - 256;
#pragma unroll
    for (int it = 0; it < 3; ++it) { const int id = tid + 512 * it, row = id >> 3, dq = id & 7;
        v4u kw = (v4u){0u, 0u, 0u, 0u}, vw = kw;
        if (smp && row < 128) { const size_t so = ((size_t)(b * 128 + row) * 2 + kh) * 64 + dq * 8;
            const f32x4 k0 = *(const f32x4*)((F.in[4]) + so), k1 = *(const f32x4*)((F.in[4]) + so + 4), v0 = *(const f32x4*)((F.in[5]) + so), v1 = *(const f32x4*)((F.in[5]) + so + 4);
            kw = (v4u){pk2(k0.x, k0.y), pk2(k0.z, k0.w), pk2(k1.x, k1.y), pk2(k1.z, k1.w)}; vw = (v4u){pk2(v0.x, v0.y), pk2(v0.z, v0.w), pk2(v1.x, v1.y), pk2(v1.z, v1.w)};
            if (row >= 64) { float* ok = F.out + OFF_SK + (size_t)b * 16384 + (size_t)(row - 64) * 128 + kh * 64 + dq * 8; float* ov = F.out + OFF_SV + (size_t)b * 16384 + (size_t)(row - 64) * 128 + kh * 64 + dq * 8;
                *(f32x4*)ok = k0; *(f32x4*)(ok + 4) = k1; *(f32x4*)ov = v0; *(f32x4*)(ov + 4) = v1; } }
        else { const int kp = smp ? (MP + b * 64 + row - 128) : (cn * 64 - 128 + row);
            if (kp >= 0) { const bf16* src = ((bf16*)(F.ws + WS_KV)) + (size_t)kp * 256 + kh * 64 + dq * 8; kw = *(const v4u*)src; vw = *(const v4u*)(src + 128); } }
        *(LAS v4u*)(KS + row * 72 + dq * 8) = kw;
        LAS bf16* vt = VT + (dq * 8) * 200 + row;
        vt[0] = (bf16)(vw.x & 0xffffu); vt[200] = (bf16)(vw.x >> 16); vt[400] = (bf16)(vw.y & 0xffffu); vt[600] = (bf16)(vw.y >> 16);
        vt[800] = (bf16)(vw.z & 0xffffu); vt[1000] = (bf16)(vw.z >> 16); vt[1200] = (bf16)(vw.w & 0xffffu); vt[1400] = (bf16)(vw.w >> 16); }
    for (int id = tid; id < 8 * 256; id += 512) { const int hl = id >> 8, ix = id & 255; TB[id] = ix < 255 ? (F.in[18])[t5_bucket(ix - 191) * 16 + kh * 8 + hl] : 0.f; }
    __syncthreads();
    const int head = kh * 8 + wave; const float sink = (F.in[17])[head];
    bf16* Qg = ((bf16*)(F.ws + WS_U4)) + (size_t)(cn * 64) * D + head * 64;
    const LAS float* tb = TB + wave * 256;
#pragma unroll 1
    for (int qt = 0; qt < 2; ++qt) {
        s16x8 qf[4];
#pragma unroll
        for (int s = 0; s < 4; ++s) qf[s] = *(const s16x8*)(Qg + (size_t)(32 * qt + r32) * D + 16 * s + 8 * hi);
        f32x16 P[6]; const int qi = 32 * qt + r32; float mx = -INFINITY;
#pragma unroll
        for (int kt = 0; kt < 6; ++kt) { f32x16 acc = {};
#pragma unroll
            for (int s = 0; s < 4; ++s) { const s16x8 a = *(const LAS s16x8*)(KS + (32 * kt + r32) * 72 + 16 * s + 8 * hi); acc = __builtin_amdgcn_mfma_f32_32x32x16_bf16(a, qf[s], acc, 0, 0, 0); }
#pragma unroll
            for (int r = 0; r < 16; ++r) { const int j = 32 * kt + (r & 3) + 8 * (r >> 2) + 4 * hi; float l = acc[r] * 0.125f + tb[j - qi + 63];
                if (!smp && cn * 64 + j < 128) l = -INFINITY; acc[r] = l; mx = fmaxf(mx, l); }
            P[kt] = acc; asm volatile("" ::: "memory"); }
        mx = fmaxf(mx, __shfl_xor(mx, 32)); mx = fmaxf(mx, sink);
        float sum = 0.f;
#pragma unroll
        for (int kt = 0; kt < 6; ++kt)
#pragma unroll
            for (int r = 0; r < 16; ++r) { const float p = fexp(P[kt][r] - mx); P[kt][r] = p; sum += p; }
        sum += __shfl_xor(sum, 32);
        const float inv = 1.f / (sum + fexp(sink - mx));
        f32x16 O[2]; O[0] = (f32x16){}; O[1] = (f32x16){};
#pragma unroll
        for (int kt = 0; kt < 6; ++kt) {
#pragma unroll
            for (int s2 = 0; s2 < 2; ++s2) { v4u pw; pw.x = pk2(P[kt][8 * s2] * inv, P[kt][8 * s2 + 1] * inv); pw.y = pk2(P[kt][8 * s2 + 2] * inv, P[kt][8 * s2 + 3] * inv);
                pw.z = pk2(P[kt][8 * s2 + 4] * inv, P[kt][8 * s2 + 5] * inv); pw.w = pk2(P[kt][8 * s2 + 6] * inv, P[kt][8 * s2 + 7] * inv);
                const s16x8 pa = __builtin_bit_cast(s16x8, pw);
#pragma unroll
                for (int dt = 0; dt < 2; ++dt) { const LAS bf16* vp = VT + (32 * dt + r32) * 200 + 32 * kt + 16 * s2 + 4 * hi;
                    const u32x2 lo = *(const LAS u32x2*)vp, hh = *(const LAS u32x2*)(vp + 8);
                    const s16x8 vb = __builtin_bit_cast(s16x8, (v4u){lo.x, lo.y, hh.x, hh.y});
                    O[dt] = __builtin_amdgcn_mfma_f32_32x32x16_bf16(pa, vb, O[dt], 0, 0, 0); } }
            asm volatile("" ::: "memory"); }
#pragma unroll
        for (int dt = 0; dt < 2; ++dt)
#pragma unroll
            for (int r = 0; r < 16; ++r) { const int q = 32 * qt + (r & 3) + 8 * (r >> 2) + 4 * hi; Qg[(size_t)q * D + 32 * dt + r32] = (bf16)f2bf(O[dt][r]); }
    }
    __syncthreads();
}
constexpr int SC_WN = 0, SC_QP = 16384, SC_KPT = 32768, SC_IN = 49152, SC_STAGE = 57344;
template <int C, int NCHUNK> __device__ __forceinline__ void ld_tile(const bf16* src, int lt, v4u (&reg)[NCHUNK]) {
#pragma unroll
    for (int i = 0; i < NCHUNK; ++i) { const int id = lt + 256 * i; reg[i] = *(const v4u*)(src + (size_t)id * 8); }
}
template <int C, int NCHUNK> __device__ __forceinline__ void st_tile(LAS unsigned char* base, int lt, const v4u (&reg)[NCHUNK]) {
#pragma unroll
    for (int i = 0; i < NCHUNK; ++i) { const int id = lt + 256 * i, row = id / (C / 8), q = id % (C / 8), ks = q >> 2, qq = q & 3;
        LAS unsigned char* d0 = base + ((row >> 4) * (C / 32) + ks) * 1024 + ((2 * (qq & 1)) * 16 + (row & 15)) * 16 + (qq >> 1) * 8;
        *(LAS u32x2*)d0 = (u32x2){reg[i].x, reg[i].y}; *(LAS u32x2*)(d0 + 256) = (u32x2){reg[i].z, reg[i].w}; }
}
__device__ __forceinline__ s16x8 pack_b(f32x4 a, f32x4 b) { v4u w; w.x = pk2(a.x, a.y); w.y = pk2(a.z, a.w); w.z = pk2(b.x, b.y); w.w = pk2(b.z, b.w); return __builtin_bit_cast(s16x8, w); }
#define MF16(a, b, c) __builtin_amdgcn_mfma_f32_16x16x32_bf16(a, b, c, 0, 0, 0)
__device__ __forceinline__ void scan_task(Frame& F, int cn0, int nchunk, int h, int hf, const float* s0, float* sout) {
    const int lane = F.lane, wave = F.wave, e = lane & 15, g = lane >> 4;
    LAS unsigned char* ring = F.lds;
    if (wave >= 4) {
#ifndef SCAN_NO_LOADER
        const int lt = F.tid - 256; v4u rw[4], rq[4], rk[4], ri[2];
#define LD_ALL(cn) do { const size_t blk_ = (size_t)((cn) * 8 + h) * 8192; ld_tile<128, 4>(((bf16*)(F.ws + WS_U5)) + blk_, lt, rw); ld_tile<128, 4>(((bf16*)(F.ws + WS_U1)) + blk_, lt, rq); ld_tile<64, 4>(((bf16*)(F.ws + WS_U2)) + blk_, lt, rk); ld_tile<64, 2>(((bf16*)(F.ws + WS_INTRA)) + (size_t)((cn) * 8 + h) * 4096, lt, ri); } while (0)
#define ST_ALL(st) do { LAS unsigned char* b_ = ring + (st) * SC_STAGE; st_tile<128, 4>(b_ + SC_WN, lt, rw); st_tile<128, 4>(b_ + SC_QP, lt, rq); st_tile<64, 4>(b_ + SC_KPT, lt, rk); st_tile<64, 2>(b_ + SC_IN, lt, ri); } while (0)
        LD_ALL(cn0); ST_ALL(0); if (nchunk > 1) LD_ALL(cn0 + 1);
        LDS_WAIT(); __builtin_amdgcn_s_barrier();
#pragma unroll 1
        for (int n = 0; n < nchunk; ++n) {
            if (n + 1 < nchunk) { ST_ALL((n + 1) & 1); if (n + 2 < nchunk) LD_ALL(cn0 + n + 2); }
            LDS_WAIT(); __builtin_amdgcn_s_barrier();
        }
#undef LD_ALL
#undef ST_ALL
#endif
    } else {
#ifndef SCAN_NO_SCAN
        const int e0 = 64 * hf + 16 * wave + e;
        f32x4 S[8];
#pragma unroll
        for (int dt = 0; dt < 8; ++dt) { const float* p = (const float*)((const char*)s0 + (size_t)((unsigned)((16 * dt + 4 * g) * 128 + e0) * 4u)); S[dt] = (f32x4){p[0], p[128], p[256], p[384]}; }
        u32x2 ucur[4], unext[4];
        { const bf16* up = ((bf16*)(F.ws + WS_U3)) + ((size_t)(cn0 * 8 + h) * 128 + e0) * 64 + 4 * g;
#pragma unroll
          for (int mt = 0; mt < 4; ++mt) ucur[mt] = *(const u32x2*)(up + 16 * mt); }
        __builtin_amdgcn_s_barrier();
#pragma unroll 1
        for (int n = 0; n < nchunk; ++n) {
            const int cn = cn0 + n; const LAS unsigned char* st = ring + (n & 1) * SC_STAGE + lane * 16;
            const float gl = ((float*)(F.ws + WS_GL))[cn * 8 + h];
            bf16* op = ((bf16*)(F.ws + WS_U3)) + ((size_t)(cn * 8 + h) * 128 + e0) * 64 + 4 * g;
            if (n + 1 < nchunk) {
#pragma unroll
                for (int mt = 0; mt < 4; ++mt) unext[mt] = *(const u32x2*)(op + 8 * 128 * 64 + 16 * mt); }
            s16x8 Sb[4];
#pragma unroll
            for (int ks = 0; ks < 4; ++ks) Sb[ks] = pack_b(S[2 * ks], S[2 * ks + 1]);
            f32x4 Vn[4], O[4];
#pragma unroll
            for (int mt = 0; mt < 4; ++mt) { Vn[mt] = (f32x4){bflo(ucur[mt].x), bfhi(ucur[mt].x), bflo(ucur[mt].y), bfhi(ucur[mt].y)}; O[mt] = (f32x4){0.f, 0.f, 0.f, 0.f}; }
#pragma unroll
            for (int mt = 0; mt < 4; ++mt)
#pragma unroll
                for (int ks = 0; ks < 4; ++ks) { const s16x8 aw = *(const LAS s16x8*)(st + SC_WN + (mt * 4 + ks) * 1024), aq = *(const LAS s16x8*)(st + SC_QP + (mt * 4 + ks) * 1024);
                    Vn[mt] = MF16(aw, Sb[ks], Vn[mt]); O[mt] = MF16(aq, Sb[ks], O[mt]); if (ks == 3) asm volatile("" ::: "memory"); }
#pragma unroll
            for (int dt = 0; dt < 8; ++dt) S[dt] = S[dt] * gl;
            s16x8 Vb[2];
#pragma unroll
            for (int k2 = 0; k2 < 2; ++k2) Vb[k2] = pack_b(Vn[2 * k2], Vn[2 * k2 + 1]);
#pragma unroll
            for (int mt = 0; mt < 4; ++mt)
#pragma unroll
                for (int k2 = 0; k2 < 2; ++k2) { const s16x8 ai = *(const LAS s16x8*)(st + SC_IN + (mt * 2 + k2) * 1024); O[mt] = MF16(ai, Vb[k2], O[mt]); if (k2 == 1 && (mt & 1)) asm volatile("" ::: "memory"); }
#pragma unroll
            for (int dt = 0; dt < 8; ++dt)
#pragma unroll
                for (int k2 = 0; k2 < 2; ++k2) { const s16x8 ak = *(const LAS s16x8*)(st + SC_KPT + (dt * 2 + k2) * 1024); S[dt] = MF16(ak, Vb[k2], S[dt]); if (k2 == 1 && (dt & 1)) asm volatile("" ::: "memory"); }
#pragma unroll
            for (int mt = 0; mt < 4; ++mt) { u32x2 w; w.x = pk2(O[mt].x, O[mt].y); w.y = pk2(O[mt].z, O[mt].w); *(u32x2*)(op + 16 * mt) = w; ucur[mt] = unext[mt]; }
            LDS_WAIT(); __builtin_amdgcn_s_barrier();
        }
        { unsigned so = (unsigned)((4 * g) * 128 + e0) * 4u; asm volatile("" : "+v"(so));
#pragma unroll
          for (int dt = 0; dt < 8; ++dt) { float* p = (float*)((char*)sout + (size_t)(so + dt * 8192u)); p[0] = S[dt].x; p[128] = S[dt].y; p[256] = S[dt].z; p[384] = S[dt].w; } }
#endif
    }
}
#undef MF16
__device__ __forceinline__ void scan_phase(Frame& F) {
    const int bx = blockIdx.x;
    if (F.G < 32) return;
    if (bx < 16) { const int h = bx >> 1, hf = bx & 1; scan_task(F, 0, 256, h, hf, (const float*)(F.ws + WS_CTL + 512 * 1024), F.out + OFF_PS + (size_t)h * 16384); }
    else { for (int t = bx - 16; t < 512; t += F.G - 16) { const int b = t >> 4, h = (t >> 1) & 7, hf = t & 1;
               scan_task(F, 256 + b, 1, h, hf, (F.in[3]) + (size_t)(b * 8 + h) * 16384, F.out + OFF_SS + (size_t)(b * 8 + h) * 16384); } }
}
__device__ __forceinline__ void normgate_item(Frame& F, int cn, int h) {
    const int tid = F.tid, e = tid & 127, cq = tid >> 7; LAS float* red = (LAS float*)F.lds;
    const bf16* op = ((bf16*)(F.ws + WS_U3)) + ((size_t)(cn * 8 + h) * 128 + e) * 64 + 16 * cq;
    const v4u a = *(const v4u*)op, b = *(const v4u*)(op + 8); float o[16];
    o[0] = bflo(a.x); o[1] = bfhi(a.x); o[2] = bflo(a.y); o[3] = bfhi(a.y); o[4] = bflo(a.z); o[5] = bfhi(a.z); o[6] = bflo(a.w); o[7] = bfhi(a.w);
    o[8] = bflo(b.x); o[9] = bfhi(b.x); o[10] = bflo(b.y); o[11] = bfhi(b.y); o[12] = bflo(b.z); o[13] = bfhi(b.z); o[14] = bflo(b.w); o[15] = bfhi(b.w);
#pragma unroll
    for (int r = 0; r < 16; ++r) { const float s = wave_sum(o[r] * o[r]); if (F.lane == 0) red[F.wave * 16 + r] = s; }
    __syncthreads();
    const float nw = (F.in[16])[e];
#pragma unroll
    for (int r = 0; r < 16; ++r) { const float ss = red[(2 * cq) * 16 + r] + red[(2 * cq + 1) * 16 + r]; const float ri = 1.f / sqrtf(ss * (1.f / 128.f) + EPS);
        const size_t ro = (size_t)(cn * 64 + 16 * cq + r) * D + h * 128 + e; const float z = bf2f(((bf16*)(F.ws + WS_U2))[ro]);
        ((bf16*)(F.ws + WS_U1))[ro] = (bf16)f2bf(o[r] * ri * nw * siluf(z)); }
    __syncthreads();
}
enum Phase { PH_P0 = 0, PH_H1, PH_G1, PH_G2, PH_H2, PH_F1, PH_PREP, PH_SCAN, PH_H2B, PH_F2, PH_NG, PH_G4A, PH_G4B, PH_G5, PH_H3, PH_G6, PH_G7, PH_FIN, PH_COUNT };
struct Args { const float* in[28]; float* out; unsigned char* ws; int ph_lo, ph_hi; };
static_assert(sizeof(Args) == 28 * 8 + 8 + 8 + 8, "Args has no padding");

#ifdef ONLY_PH
#define PHON(x) ((x) == ONLY_PH)
#else
#define PHON(x) true
#endif
template <class Epi> __device__ __forceinline__ void run_gemm(Frame& F, const bf16* A, const bf16* Bt, int N, int K, const Epi& E) {
    pg8::Gemm g{A, Bt, M, N, K}; pg8::StaticOrder S; S.init(M, N, F.G, (int)blockIdx.x);
    pg8::gemm_phase<Epi, pg8::StaticOrder, PG8_ALIGN, PG8_SP2>(F.lds, g, S, E);
}

__global__ void __launch_bounds__(NWAVES * 64, 2) mega_fwd(Args args) {
    extern __shared__ __attribute__((aligned(16))) unsigned char lds[];
    Frame F;
    F.lds = (LAS unsigned char*)lds; F.MISC = (volatile LAS unsigned*)(F.lds + MISC_OFF);
    F.tid = threadIdx.x; F.lane = F.tid & 63; F.wave = __builtin_amdgcn_readfirstlane(F.tid >> 6);
    F.G = gridDim.x; { const int bx = blockIdx.x; F.vcu = (F.G % 8 == 0) ? (bx % 8) * (F.G / 8) + bx / 8 : bx; }
    unsigned char* ws = args.ws; F.ctl = (gu32*)(ws + WS_CTL);
    F.in = args.in; F.out = args.out; F.ws = ws;
    for (int u = F.tid; u < (LDS_BYTES - LDSCTL_OFF) / 4; u += NWAVES * 64) ((LAS unsigned*)(F.lds + LDSCTL_OFF))[u] = 0u;
    __syncthreads();
    XcdBarrier bar; bar.bar = (unsigned*)(F.ctl + CW_BAR); bar.x = 0; bar.st = nullptr;
    const bool multi = args.ph_hi - args.ph_lo > 1;
    if (multi) bar = xcd_barrier_post((unsigned*)(F.ctl + CW_BAR), F.MISC + 8);

    const int lo = args.ph_lo, hi = args.ph_hi;
#define IN(k) (PHON(k) && lo <= (k) && (k) < hi)
#define SEAM(k) do { if (lo <= (k) && (k) + 1 < hi) xcd_barrier(bar); } while (0)
    if (IN(PH_P0)) { { if (F.vcu < 144) ada_item(F, F.vcu); convert_ffn(F, (F.in[9]), (F.in[10])); } }
    SEAM(PH_P0);
    if (IN(PH_H1)) { rmsmod_rows<false>(F, nullptr, (F.in[8]), 0, ((bf16*)(F.ws + WS_U1))); }
    SEAM(PH_H1);
    if (IN(PH_G1)) { run_gemm(F, ((bf16*)(F.ws + WS_U1)), ((bf16*)(F.ws + WS_W)) + W_FIN, 2 * DFF, D, EpiSwiglu{((bf16*)(F.ws + WS_U2))}); }
    SEAM(PH_G1);
    if (IN(PH_G2)) { run_gemm(F, ((bf16*)(F.ws + WS_U2)), ((bf16*)(F.ws + WS_W)) + W_FOUT, D, DFF, EpiResid{(F.in[0]), (F.in[1]), F.out, ((float*)(F.ws + WS_ADA)), 2, 0.5f}); }
    SEAM(PH_G2);
    if (IN(PH_H2)) { { convert_mixer(F); __syncthreads(); rmsmod_rows<true>(F, F.out, (F.in[11]), 1, ((bf16*)(F.ws + WS_U5))); } }
    SEAM(PH_H2);
    if (IN(PH_F1)) { run_gemm(F, ((bf16*)(F.ws + WS_U5)), ((bf16*)(F.ws + WS_W)) + W_IN, 4352, D, EpiF1{((bf16*)(F.ws + WS_U1)), ((bf16*)(F.ws + WS_U2)), ((bf16*)(F.ws + WS_U3)), ((bf16*)(F.ws + WS_U4)), ((bf16*)(F.ws + WS_KV)), ((bf16*)(F.ws + WS_TAIL)), F.out}); }
    SEAM(PH_F1);
    if (IN(PH_PREP)) {
#ifndef NO_PREP
                        for (int it = F.vcu; it < NCH * 8; it += F.G) gdn_prep_unit(F, it >> 3, it & 7);
#endif
#ifndef NO_SWA
                        for (int it = F.vcu; it < NCH * 2; it += F.G) swa_unit(F, it >> 1, it & 1);
#endif
                      }
    SEAM(PH_PREP);
    if (IN(PH_SCAN)) { scan_phase(F); }
    SEAM(PH_SCAN);
    if (IN(PH_H2B)) { rmsmod_rows<false>(F, F.out, (F.in[11]), 1, ((bf16*)(F.ws + WS_U1))); }
    SEAM(PH_H2B);
    if (IN(PH_F2)) { run_gemm(F, ((bf16*)(F.ws + WS_U1)), ((bf16*)(F.ws + WS_W)) + W_IN + (size_t)4352 * D, 3072, D, EpiF2{((bf16*)(F.ws + WS_U2)), ((bf16*)(F.ws + WS_U5)), ((bf16*)(F.ws + WS_U6))}); }
    SEAM(PH_F2);
    if (IN(PH_NG)) { { for (int it = F.vcu; it < NCH * 8; it += F.G) normgate_item(F, it >> 3, it & 7); } }
    SEAM(PH_NG);
    if (IN(PH_G4A)) { run_gemm(F, ((bf16*)(F.ws + WS_U1)), ((bf16*)(F.ws + WS_W)) + W_A, D, D, EpiGate<0>{((bf16*)(F.ws + WS_U5)), nullptr}); }
    SEAM(PH_G4A);
    if (IN(PH_G4B)) { run_gemm(F, ((bf16*)(F.ws + WS_U4)), ((bf16*)(F.ws + WS_W)) + W_B, D, D, EpiGate<1>{((bf16*)(F.ws + WS_U5)), ((bf16*)(F.ws + WS_U6))}); }
    SEAM(PH_G4B);
    if (IN(PH_G5)) { run_gemm(F, ((bf16*)(F.ws + WS_U5)), ((bf16*)(F.ws + WS_W)) + W_O, D, D, EpiResid{F.out, F.out + (size_t)MP * D, F.out, ((float*)(F.ws + WS_ADA)), 5, 1.0f}); }
    SEAM(PH_G5);
    if (IN(PH_H3)) { { convert_ffn(F, (F.in[23]), (F.in[24])); rmsmod_rows<false>(F, F.out, (F.in[22]), 2, ((bf16*)(F.ws + WS_U1))); } }
    SEAM(PH_H3);
    if (IN(PH_G6)) { run_gemm(F, ((bf16*)(F.ws + WS_U1)), ((bf16*)(F.ws + WS_W)) + W_FIN, 2 * DFF, D, EpiSwiglu{((bf16*)(F.ws + WS_U2))}); }
    SEAM(PH_G6);
    if (IN(PH_G7)) { run_gemm(F, ((bf16*)(F.ws + WS_U2)), ((bf16*)(F.ws + WS_W)) + W_FOUT, D, DFF, EpiResid{F.out, F.out + (size_t)MP * D, F.out, ((float*)(F.ws + WS_ADA)), 8, 0.5f}); }
    SEAM(PH_G7);
    if (IN(PH_FIN)) { final_norm_rows(F); }
    SEAM(PH_FIN);
#undef IN
#undef SEAM
}

extern "C" void kernel_launch(void* const* d_in, const int* in_sizes, int n_in, void* d_out, int out_size, void* d_ws, size_t ws_size, hipStream_t stream) {
    static int grid = 0;
    if (grid == 0) {
        if (n_in != 28 || in_sizes[0] != MP * D || (size_t)out_size != OUT_TOTAL || ws_size < WS_END) { fprintf(stderr, "kernel_launch: unexpected shapes (n_in %d, in0 %d, out %d, ws %zu); nothing launched\n", n_in, n_in > 0 ? in_sizes[0] : -1, out_size, ws_size); grid = -1; return; }
        int dev = 0, cus = 0, per_cu = 0;
        if (hipGetDevice(&dev) != hipSuccess || hipDeviceGetAttribute(&cus, hipDeviceAttributeMultiprocessorCount, dev) != hipSuccess) { grid = -1; return; }
        if (hipFuncSetAttribute((const void*)mega_fwd, hipFuncAttributeMaxDynamicSharedMemorySize, LDS_BYTES) != hipSuccess) { fprintf(stderr, "kernel_launch: hipFuncSetAttribute failed\n"); grid = -1; return; }
        if (hipOccupancyMaxActiveBlocksPerMultiprocessor(&per_cu, (const void*)mega_fwd, NWAVES * 64, LDS_BYTES) != hipSuccess || per_cu < 1) fprintf(stderr, "kernel_launch: occupancy query reports %d\n", per_cu);
        (void)hipGetLastError();
        grid = cus;
    }
    if (grid < 0) return;
    if (hipMemsetAsync((char*)d_ws + WS_CTL, 0, CTL_ZERO_BYTES, stream) != hipSuccess) return;
    Args a{};
    for (int i = 0; i < 28; ++i) a.in[i] = (const float*)d_in[i];
    a.out = (float*)d_out; a.ws = (unsigned char*)d_ws;
#if MK_PER_PHASE
    for (int ph = 0; ph < PH_COUNT; ++ph) { a.ph_lo = ph; a.ph_hi = ph + 1; hipLaunchKernelGGL(mega_fwd, dim3(grid), dim3(NWAVES * 64), LDS_BYTES, stream, a); }
#else
    a.ph_lo = 0; a.ph_hi = PH_COUNT; hipLaunchKernelGGL(mega_fwd, dim3(grid), dim3(NWAVES * 64), LDS_BYTES, stream, a);
#endif
    const hipError_t le = hipPeekAtLastError();
    if (le != hipSuccess) fprintf(stderr, "kernel_launch: launch failed: %s\n", hipGetErrorName(le));
}
```

```cpp
#include <hip/hip_runtime.h>
#include <cstdio>
#include <cstdint>
namespace pg8 {
#define PG8_LAS __attribute__((address_space(3)))
typedef unsigned short bf16_t;
typedef short bf16x8 __attribute__((ext_vector_type(8)));
typedef float f32x4 __attribute__((ext_vector_type(4)));
typedef unsigned u32x4 __attribute__((ext_vector_type(4)));
constexpr int BM = 256, BK = 64, HALF = 128, HTB = HALF * BK * 2  , STAGE_BYTES = 8 * HTB, NXCD = 8, WGM = 8;

__host__ __device__ __forceinline__ int lds_byte(int r, int c) { const int st = (r >> 4) * 2 + (c >> 5), rr = r & 15, cc = c & 31, ob = rr * 64 + cc * 2; return st * 1024 + (ob ^ (((ob >> 9) & 1) << 5)); }
__host__ __device__ __forceinline__ void stage_rc(int b, int& R, int& C) { const int st = b / 1024, sb = b % 1024, swz = sb ^ (((sb >> 9) & 1) << 5); R = (st >> 1) * 16 + swz / 64; C = (st & 1) * 32 + (swz % 64) / 2; }
__host__ __device__ __forceinline__ int perm32(int rho) { const int n = rho >> 4, i = rho & 15; return 8 * (i >> 2) + 4 * n + (i & 3); }

struct Unit { int pm, pn, k0, nt, piece, lidx; };
struct Gemm { const bf16_t* A; const bf16_t* Bt; int M, N, K; int lda; };

struct StaticOrder {
    int nM, nN, nwg, G, c, ntf;
    __host__ __device__ void init(int M, int N, int G_, int c_) { nM = M / BM; nN = N / BM; nwg = nM * nN; G = G_; c = c_; }
    __host__ __device__ bool next(int i, Unit& u) const {
        const long L = (long)i * G + c; if (L >= nwg) return false;
        int wgid = (int)L; { const int q = nwg / NXCD, r = nwg % NXCD, xcd = wgid % NXCD, off = wgid / NXCD; wgid = (xcd < r ? xcd * (q + 1) : r * (q + 1) + (xcd - r) * q) + off; }
        const int nig = WGM * nN, gid = wgid / nig, fm = gid * WGM, gsz = (nM - fm) < WGM ? (nM - fm) : WGM;
        u.pm = fm + ((wgid % nig) % gsz); u.pn = (wgid % nig) / gsz; u.k0 = 0; u.nt = ntf; u.piece = 0; u.lidx = 0; return true;
    }
    __device__ __forceinline__ void a_ready(const Unit&) const {}
    __device__ __forceinline__ void done(const Unit&) const {}
};

__device__ __forceinline__ unsigned cvt_pk_bf16(float lo, float hi) { unsigned r; asm volatile("v_cvt_pk_bf16_f32 %0, %1, %2" : "=v"(r) : "v"(lo), "v"(hi)); return r; }

template <class Epi, class Sched, bool ALIGN_EPI = false, bool SP2 = false>
__device__ __forceinline__ void gemm_phase(PG8_LAS unsigned char* lds, const Gemm g, const Sched& S, const Epi& E) {
    const int tid = threadIdx.x, wid = __builtin_amdgcn_readfirstlane(tid >> 6), lane = tid & 63, wr = wid >> 2, wc = wid & 3, fr = lane & 15, fq = lane >> 4;
    const int K = g.K, lda = g.lda ? g.lda : g.K;
    unsigned voffA[2], voffB[2];
#pragma unroll
    for (int i = 0; i < 2; ++i) { int R, C; stage_rc(tid * 16 + i * 8192, R, C); const int Rb = Epi::PERM ? ((R & ~31) + perm32(R & 31)) : R;
        voffA[i] = (unsigned)(R * lda + C) * 2u; voffB[i] = (unsigned)(Rb * K + C) * 2u; }
    const size_t kstep = (size_t)(BK * 2);
    const size_t hstep = (size_t)HALF * K * 2;
    const size_t tstep = 2 * hstep;
    const size_t hstepA = (size_t)HALF * lda * 2, tstepA = 2 * hstepA;
    const unsigned ldsw = (unsigned)wid * 1024u;
    const int aoff = lds_byte(wr * 64 + fr, fq * 8), boff = lds_byte(wc * 32 + fr, fq * 8);
#define PG8_SA(b, h) (((b) * 2 + (h)) * HTB)
#define PG8_SB(b, h) ((4 + (b) * 2 + (h)) * HTB)
#define PG8_STAGE(bufoff, gbase, voff) do { _Pragma("unroll") for (int _i = 0; _i < 2; ++_i) \
        __builtin_amdgcn_global_load_lds((const unsigned*)((const char*)(gbase) + (voff)[_i]), (PG8_LAS unsigned*)(lds + (bufoff) + ldsw + _i * 8192), 16, 0, 0); } while (0)
#define PG8_LDA(dst, b, h) do { _Pragma("unroll") for (int m = 0; m < 4; ++m) _Pragma("unroll") for (int k = 0; k < 2; ++k) dst[m][k] = *(const PG8_LAS bf16x8*)(lds + PG8_SA(b, h) + aoff + m * 2048 + k * 1024); } while (0)
#define PG8_LDB(dst, b, h) do { _Pragma("unroll") for (int n = 0; n < 2; ++n) _Pragma("unroll") for (int k = 0; k < 2; ++k) dst[n][k] = *(const PG8_LAS bf16x8*)(lds + PG8_SB(b, h) + boff + n * 2048 + k * 1024); } while (0)
#define PG8_MMA(ai, bj, At, Bt) do { __builtin_amdgcn_s_setprio(1); _Pragma("unroll") for (int m = 0; m < 4; ++m) _Pragma("unroll") for (int n = 0; n < 2; ++n) _Pragma("unroll") for (int k = 0; k < 2; ++k) \
        acc[ai][bj][m][n] = __builtin_amdgcn_mfma_f32_16x16x32_bf16(Bt[n][k], At[m][k], acc[ai][bj][m][n], 0, 0, 0); __builtin_amdgcn_s_setprio(0); } while (0)
#define PG8_WAIT_V(n) asm volatile("s_waitcnt vmcnt(" #n ")" ::: "memory")
#define PG8_WAIT_L(n) asm volatile("s_waitcnt lgkmcnt(" #n ")" ::: "memory")
#define PG8_BAR __builtin_amdgcn_s_barrier()
#define PG8_SCHED __builtin_amdgcn_sched_barrier(0)
    Unit cur, nxt; int ui = 0;
    if (!S.next(0, cur)) return;
    f32x4 acc[2][2][4][2];
#pragma unroll
    for (int a = 0; a < 2; ++a)
#pragma unroll
        for (int b = 0; b < 2; ++b)
#pragma unroll
            for (int m = 0; m < 4; ++m)
#pragma unroll
                for (int n = 0; n < 2; ++n) acc[a][b][m][n] = (f32x4){0.f, 0.f, 0.f, 0.f};
    bf16x8 At[4][2], B0[2][2], B1[2][2];
    const char* cA = (const char*)g.A + (size_t)cur.pm * tstepA + (size_t)cur.k0 * kstep; const char* cB = (const char*)g.Bt + (size_t)cur.pn * tstep + (size_t)cur.k0 * kstep;
    S.a_ready(cur);
    if constexpr (SP2) {
        PG8_STAGE(PG8_SB(0, 0), cB, voffB); PG8_STAGE(PG8_SB(0, 1), cB + hstep, voffB); PG8_STAGE(PG8_SA(0, 0), cA, voffA); PG8_STAGE(PG8_SA(0, 1), cA + hstepA, voffA);
        if (wr == 1) PG8_BAR;
        PG8_WAIT_V(2); PG8_BAR;
        PG8_STAGE(PG8_SB(1, 0), cB + kstep, voffB); PG8_STAGE(PG8_SA(1, 0), cA + kstep, voffA); PG8_STAGE(PG8_SB(1, 1), cB + hstep + kstep, voffB);
        PG8_WAIT_V(6); PG8_BAR;
    } else {
        PG8_STAGE(PG8_SB(0, 0), cB, voffB); PG8_STAGE(PG8_SA(0, 0), cA, voffA); PG8_STAGE(PG8_SB(0, 1), cB + hstep, voffB); PG8_STAGE(PG8_SA(0, 1), cA + hstepA, voffA);
        if (wr == 1) PG8_BAR;
        PG8_WAIT_V(4); PG8_BAR;
        PG8_STAGE(PG8_SB(1, 0), cB + kstep, voffB); PG8_STAGE(PG8_SA(1, 0), cA + kstep, voffA); PG8_STAGE(PG8_SB(1, 1), cB + hstep + kstep, voffB);
        PG8_WAIT_V(6); PG8_BAR;
    }
    for (;;) {
        const bool has_next = S.next(ui + 1, nxt);
        const char* nA = has_next ? (const char*)g.A + (size_t)nxt.pm * tstepA + (size_t)nxt.k0 * kstep : cA; const char* nB = has_next ? (const char*)g.Bt + (size_t)nxt.pn * tstep + (size_t)nxt.k0 * kstep : cB;
        const int cnt = cur.nt;
        for (int t = 0; t < cnt; t += 2) {
            const bool last = (t == cnt - 2);
            const char* a1 = cA + (size_t)(t + 1) * kstep;
            const char* a2 = last ? nA : cA + (size_t)(t + 2) * kstep; const char* b2 = last ? nB : cB + (size_t)(t + 2) * kstep;
            const char* a3 = a2 + kstep; const char* b3 = b2 + kstep;
            if (last && has_next) S.a_ready(nxt);
            if constexpr (SP2) {
            PG8_LDB(B0, 0, 0); PG8_LDB(B1, 0, 1); PG8_SCHED; PG8_LDA(At, 0, 0); PG8_STAGE(PG8_SA(1, 1), a1 + hstepA, voffA);
            PG8_WAIT_V(8); PG8_WAIT_L(0); PG8_BAR; PG8_MMA(0, 0, At, B0); PG8_MMA(0, 1, At, B1); PG8_BAR; PG8_SCHED;
            PG8_LDA(At, 0, 1); PG8_STAGE(PG8_SB(0, 0), b2, voffB); PG8_STAGE(PG8_SB(0, 1), b2 + hstep, voffB); PG8_STAGE(PG8_SA(0, 0), a2, voffA);
            PG8_WAIT_V(8); PG8_WAIT_L(0); PG8_BAR; PG8_MMA(1, 0, At, B0); PG8_MMA(1, 1, At, B1); PG8_BAR; PG8_SCHED;
            PG8_LDB(B0, 1, 0); PG8_LDB(B1, 1, 1); PG8_SCHED; PG8_LDA(At, 1, 0); PG8_STAGE(PG8_SA(0, 1), a2 + hstepA, voffA);
            PG8_WAIT_V(8); PG8_WAIT_L(0); PG8_BAR; PG8_MMA(0, 0, At, B0); PG8_MMA(0, 1, At, B1); PG8_BAR; PG8_SCHED;
            PG8_LDA(At, 1, 1); PG8_STAGE(PG8_SB(1, 0), b3, voffB); PG8_STAGE(PG8_SB(1, 1), b3 + hstep, voffB); PG8_STAGE(PG8_SA(1, 0), a3, voffA);
            PG8_WAIT_V(8); PG8_WAIT_L(0); PG8_BAR; PG8_MMA(1, 0, At, B0); PG8_MMA(1, 1, At, B1); PG8_BAR; PG8_SCHED;
            } else {
            PG8_LDB(B0, 0, 0); PG8_SCHED; PG8_LDA(At, 0, 0); PG8_STAGE(PG8_SA(1, 1), a1 + hstepA, voffA);
            PG8_WAIT_L(8); PG8_BAR; PG8_WAIT_L(0); PG8_MMA(0, 0, At, B0); PG8_BAR; PG8_SCHED;
            PG8_LDB(B1, 0, 1); PG8_STAGE(PG8_SB(0, 0), b2, voffB);
            PG8_BAR; PG8_WAIT_L(0); PG8_MMA(0, 1, At, B1); PG8_BAR;
            PG8_LDA(At, 0, 1); PG8_STAGE(PG8_SA(0, 0), a2, voffA);
            PG8_BAR; PG8_WAIT_L(0); PG8_MMA(1, 0, At, B0); PG8_BAR; PG8_SCHED;
            PG8_STAGE(PG8_SB(0, 1), b2 + hstep, voffB);
            PG8_WAIT_V(6); PG8_BAR; PG8_MMA(1, 1, At, B1); PG8_BAR;
            PG8_LDB(B0, 1, 0); PG8_SCHED; PG8_LDA(At, 1, 0); PG8_STAGE(PG8_SA(0, 1), a2 + hstepA, voffA);
            PG8_WAIT_L(8); PG8_BAR; PG8_WAIT_L(0); PG8_MMA(0, 0, At, B0); PG8_BAR; PG8_SCHED;
            PG8_LDB(B1, 1, 1); PG8_STAGE(PG8_SB(1, 0), b3, voffB);
            PG8_BAR; PG8_WAIT_L(0); PG8_MMA(0, 1, At, B1); PG8_BAR;
            PG8_LDA(At, 1, 1); PG8_STAGE(PG8_SA(1, 0), a3, voffA);
            PG8_BAR; PG8_WAIT_L(0); PG8_MMA(1, 0, At, B0); PG8_BAR; PG8_SCHED;
            PG8_STAGE(PG8_SB(1, 1), b3 + hstep, voffB);
            PG8_WAIT_V(6); PG8_BAR; PG8_MMA(1, 1, At, B1); PG8_BAR;
            }
        }
        if constexpr (ALIGN_EPI) { if (wr == 0) PG8_BAR; }
        if constexpr (!Epi::AFTER_DRAIN) { E(acc, cur, wr, wc, fr, fq); S.done(cur); }
        if (!has_next) break;
#pragma unroll
        for (int a = 0; a < 2; ++a)
#pragma unroll
            for (int b = 0; b < 2; ++b)
#pragma unroll
                for (int m = 0; m < 4; ++m)
#pragma unroll
                    for (int n = 0; n < 2; ++n) acc[a][b][m][n] = (f32x4){0.f, 0.f, 0.f, 0.f};
        cur = nxt; cA = nA; cB = nB; ++ui;
        if constexpr (ALIGN_EPI) { if (wr == 1) PG8_BAR; }
    }
    PG8_WAIT_V(0);
    if constexpr (!ALIGN_EPI) { if (wr == 0) PG8_BAR; }
    PG8_BAR;
    if constexpr (Epi::AFTER_DRAIN) { E.fused(acc, cur, wr, wc, fr, fq, lds, wid, lane); S.done(cur); }
#undef PG8_SA
#undef PG8_SB
#undef PG8_STAGE
#undef PG8_LDA
#undef PG8_LDB
#undef PG8_MMA
#undef PG8_WAIT_V
#undef PG8_WAIT_L
#undef PG8_BAR
#undef PG8_SCHED
}
}

#ifndef PG8_SP2
#define PG8_SP2 true
#endif
#define GAS __attribute__((address_space(1)))
#define LAS __attribute__((address_space(3)))
typedef unsigned short bf16;
typedef unsigned v4u __attribute__((ext_vector_type(4)));
typedef float f32x4 __attribute__((ext_vector_type(4)));
typedef short bf16x8 __attribute__((ext_vector_type(8)));
typedef GAS unsigned gu32;
typedef GAS unsigned long long gu64;
#define RLX_AGENT __ATOMIC_RELAXED, __HIP_MEMORY_SCOPE_AGENT
#define LDS_WAIT() asm volatile("s_waitcnt lgkmcnt(0)" ::: "memory")
#define VM_WAIT() asm volatile("s_waitcnt vmcnt(0)" ::: "memory")
__device__ __forceinline__ unsigned long long rt() { return __builtin_amdgcn_s_memrealtime(); }
typedef float pkf2_t __attribute__((ext_vector_type(2))); typedef __bf16 pkb2_t __attribute__((ext_vector_type(2)));
__device__ __forceinline__ unsigned pk2(float lo, float hi) { pkf2_t v = {lo, hi}; pkb2_t b = __builtin_convertvector(v, pkb2_t); return __builtin_bit_cast(unsigned, b); }
__device__ __forceinline__ unsigned f2bf(float f) { return pk2(f, 0.f) & 0xffffu; }

#define XB_TMO      128
#define XB_XCNT(j)  (256  + 64 * (j))
#define XB_XSUB(j)  (1280 + 64 * (j))
#define XB_XGEN(j)  (2304 + 64 * (j))
#define XB_TOP      3328
#define XB_TOPGEN   3392
#define XCD_BAR_WORDS 3456
#define XB_SPIN_CAP (1u << 18)

__device__ __forceinline__ unsigned xb_ld(unsigned* p)              { return __hip_atomic_load(p, __ATOMIC_RELAXED, __HIP_MEMORY_SCOPE_AGENT); }
__device__ __forceinline__ unsigned xb_add(unsigned* p, unsigned v) { return __hip_atomic_fetch_add(p, v, __ATOMIC_RELAXED, __HIP_MEMORY_SCOPE_AGENT); }
__device__ __forceinline__ unsigned xb_xcc_id() { return (unsigned)__builtin_amdgcn_s_getreg((3 << 11) | 20) & 0xFu; }
#define XB_SPIN(cond, bar) do { unsigned _sp = 0; while (cond) { __builtin_amdgcn_s_sleep(1); \
    if ((++_sp & 255u) == 0u) { if (xb_ld(&(bar)[XB_TMO])) break; if (_sp > XB_SPIN_CAP) { atomicAdd(&(bar)[XB_TMO], 1u); break; } } } } while (0)

struct XcdBarrier {
    unsigned* bar; unsigned x;
    volatile LAS unsigned* st;
};

__device__ __forceinline__ XcdBarrier xcd_barrier_post(unsigned* bar, volatile LAS unsigned* st) {
    XcdBarrier b; b.bar = bar; b.x = xb_xcc_id(); b.st = st;
    if (threadIdx.x == 0) (void)xb_add(&bar[XB_XCNT(b.x)], 1u);
    return b;
}
__device__ __forceinline__ void xcd_barrier_complete(unsigned* bar, unsigned x, unsigned& nloc, unsigned& nx) {
    const unsigned G = gridDim.x * gridDim.y * gridDim.z;
    unsigned sum, cnt, mine, sp = 0u;
    for (;;) {
        sum = 0u; cnt = 0u; mine = 0u;
#pragma unroll
        for (unsigned j = 0; j < 16; ++j) { const unsigned c = xb_ld(&bar[XB_XCNT(j)]); sum += c; cnt += (c > 0u) ? 1u : 0u; mine = (j == x) ? c : mine; }
        if (sum == G) break;
        __builtin_amdgcn_s_sleep(1);
        if ((++sp & 255u) == 0u) { if (xb_ld(&bar[XB_TMO])) break; if (sp > XB_SPIN_CAP) { atomicAdd(&bar[XB_TMO], 1u); break; } }
    }
    nloc = mine > 0u ? mine : 1u; nx = cnt > 0u ? cnt : 1u;
}

__device__ __forceinline__ void xcd_barrier(const XcdBarrier& b) {
    asm volatile("s_waitcnt vmcnt(0)" ::: "memory");
    __syncthreads();
    if (threadIdx.x == 0) {
        unsigned* bar = b.bar;
        __builtin_amdgcn_s_waitcnt(0);
        unsigned nloc = b.st[0], nx = b.st[1];
        if (nloc == 0u) { xcd_barrier_complete(bar, b.x, nloc, nx); b.st[0] = nloc; b.st[1] = nx; }
        const unsigned old = xb_add(&bar[XB_XSUB(b.x)], 1u);
        const unsigned gen = old / nloc;
        if (old + 1u == (gen + 1u) * nloc) {
            __builtin_amdgcn_fence(__ATOMIC_RELEASE, "agent");
            asm volatile("s_waitcnt vmcnt(0)" ::: "memory");
            const unsigned og = xb_add(&bar[XB_TOP], 1u);
            const unsigned tg = og / nx;
            if (og + 1u == (tg + 1u) * nx) xb_add(&bar[XB_TOPGEN], 1u);
            else XB_SPIN(xb_ld(&bar[XB_TOPGEN]) == tg, bar);
            __builtin_amdgcn_fence(__ATOMIC_ACQUIRE, "agent");
            xb_add(&bar[XB_XGEN(b.x)], 1u);
            asm volatile("s_waitcnt vmcnt(0)" ::: "memory");
        } else {
            XB_SPIN(xb_ld(&bar[XB_XGEN(b.x)]) == gen, bar);
            __builtin_amdgcn_fence(__ATOMIC_ACQUIRE, "agent");
            asm volatile("s_waitcnt vmcnt(0)" ::: "memory");
        }
    }
    __syncthreads();
}
#ifndef PG8_ALIGN
#define PG8_ALIGN true
#endif
constexpr int NWAVES = 8;
#ifndef MK_PER_PHASE
#define MK_PER_PHASE 0
#endif
constexpr int D = 1024, MP = 16384, MSMP = 2048, M = MP + MSMP, NCH = M / 64, DFF = 2816, INCOLS = 7440, NB = 33, ADAW = 9 * D;
constexpr float EPS = 1e-6f;
constexpr size_t OFF_Y = 0, OFF_PCONV = (size_t)M * D, OFF_PS = OFF_PCONV + 3 * 3072, OFF_PK = OFF_PS + 8 * 128 * 128, OFF_PV = OFF_PK + 128 * 128,
                 OFF_SCONV = OFF_PV + 128 * 128, OFF_SS = OFF_SCONV + 32 * 3 * 3072, OFF_SK = OFF_SS + (size_t)32 * 8 * 128 * 128, OFF_SV = OFF_SK + 32 * 128 * 128, OUT_TOTAL = OFF_SV + 32 * 128 * 128;
constexpr size_t MiB = 1u << 20;
constexpr size_t WS_CTL = 0, CTL_ZERO_BYTES = 1 * MiB, WS_ADA = 1 * MiB, WS_BA = 5 * MiB / 2, WS_GL = 4 * MiB, WS_W = 5 * MiB;
constexpr size_t WS_U1 = 26 * MiB, WS_U2 = 62 * MiB, WS_U3 = 98 * MiB, WS_U4 = 134 * MiB, WS_U5 = 170 * MiB, WS_U6 = 206 * MiB;
constexpr size_t WS_INTRA = 206 * MiB, WS_KV = 224 * MiB, WS_TAIL = 233 * MiB, WS_END = 254 * MiB;
static_assert((size_t)M * D * 2 == 36 * MiB && (size_t)NB * ADAW * 4 <= 3 * MiB / 2 && (size_t)M * 16 * 4 <= 3 * MiB / 2, "ws map");
static_assert((size_t)NCH * 8 * 64 * 64 * 2 == 18 * MiB && (size_t)M * 256 * 2 == 9 * MiB && WS_TAIL + (size_t)NCH * 3 * 3072 * 2 <= WS_END && (size_t)M * DFF * 2 <= 108 * MiB, "ws map 2");
constexpr size_t W_FIN = 0, W_FOUT = (size_t)2 * DFF * D;
constexpr size_t W_IN = 0, W_A = (size_t)7424 * D, W_B = W_A + (size_t)D * D, W_O = W_B + (size_t)D * D;
static_assert((W_O + (size_t)D * D) * 2 <= 21 * MiB, "w slot");
constexpr int CW_TMO = 0, CW_BAR = 4096;
constexpr int RING_BYTES = 131072, LDSCTL_OFF = RING_BYTES, MISC_OFF = LDSCTL_OFF + 320, LDS_BYTES = 147456;

struct Frame {
    LAS unsigned char* lds; volatile LAS unsigned* MISC; gu32* ctl;
    int tid, lane, wave, vcu, G;
    const float* const* in; float* out; unsigned char* ws;
};
typedef float f32x2 __attribute__((ext_vector_type(2)));
typedef unsigned u32x2 __attribute__((ext_vector_type(2)));
__device__ __forceinline__ float bflo(unsigned u) { return __builtin_bit_cast(float, u << 16); }
__device__ __forceinline__ float bfhi(unsigned u) { return __builtin_bit_cast(float, u & 0xffff0000u); }
__device__ __forceinline__ float bf2f(bf16 h) { return __builtin_bit_cast(float, (unsigned)h << 16); }
__device__ __forceinline__ float fexp(float x) { return __builtin_amdgcn_exp2f(x * 1.4426950408889634f); }
__device__ __forceinline__ float sigm(float x) { return __builtin_amdgcn_rcpf(1.f + fexp(-x)); }
__device__ __forceinline__ float siluf(float x) { return x * sigm(x); }
__device__ __forceinline__ float wave_sum(float v) {
#pragma unroll
    for (int o = 1; o < 64; o <<= 1) v += __shfl_xor(v, o);
    return v;
}
__device__ __forceinline__ int mod_row(int m) { return m < MP ? 0 : 1 + ((m - MP) >> 6); }

__device__ __forceinline__ void transpose_item(const float* W, int ldw, int c0, int K, bf16* WT, int drow0, LAS float* scr, int k0, int lane) {
    f32x4 wv[8];
#pragma unroll
    for (int i = 0; i < 8; ++i) wv[i] = *(const f32x4*)(W + (size_t)(k0 + 8 * i + (lane >> 3)) * ldw + c0 + 4 * (lane & 7));
#pragma unroll
    for (int i = 0; i < 8; ++i) { LAS float* d = scr + (8 * i + (lane >> 3)) * 33 + 4 * (lane & 7); d[0] = wv[i].x; d[1] = wv[i].y; d[2] = wv[i].z; d[3] = wv[i].w; }
    LDS_WAIT(); asm volatile("" ::: "memory");
    const int c = lane & 7;
#pragma unroll
    for (int j = 0; j < 4; ++j) { const int n = (lane >> 3) + 8 * j; const LAS float* s = scr + (8 * c) * 33 + n;
        v4u o; o.x = pk2(s[0 * 33], s[1 * 33]); o.y = pk2(s[2 * 33], s[3 * 33]); o.z = pk2(s[4 * 33], s[5 * 33]); o.w = pk2(s[6 * 33], s[7 * 33]);
        *(GAS v4u*)(WT + (size_t)(drow0 + n) * K + k0 + 8 * c) = o; }
    LDS_WAIT(); asm volatile("" ::: "memory");
}
__device__ __forceinline__ void transpose_wide(const float* W, int ldw, int c0, int K, bf16* WT, int drow0, LAS unsigned* scr, int k0, int lane) {
    const int half = lane >> 5, nq = lane & 31;
    const float* src = W + (size_t)(k0 + 2 * half) * ldw + c0 + 4 * nq;
    f32x4 ra[2][4], rb[2][4];
#pragma unroll
    for (int b = 0; b < 2; ++b)
#pragma unroll
        for (int i = 0; i < 4; ++i) { const float* s = src + (size_t)(4 * (4 * b + i)) * ldw; ra[b][i] = *(const f32x4*)s; rb[b][i] = *(const f32x4*)(s + ldw); }
#pragma unroll
    for (int b = 0; b < 4; ++b) {
#pragma unroll
        for (int i = 0; i < 4; ++i) { const int kp = 2 * (4 * b + i) + half; const f32x4 x = ra[b & 1][i], y = rb[b & 1][i];
            *(LAS v4u*)(scr + kp * 128 + ((4 * nq) ^ (((kp >> 2) & 7) << 2))) = (v4u){pk2(x.x, y.x), pk2(x.y, y.y), pk2(x.z, y.z), pk2(x.w, y.w)}; }
        if (b + 2 < 4) {
#pragma unroll
            for (int i = 0; i < 4; ++i) { const float* s = src + (size_t)(4 * (4 * (b + 2) + i)) * ldw; ra[b & 1][i] = *(const f32x4*)s; rb[b & 1][i] = *(const f32x4*)(s + ldw); } }
    }
    LDS_WAIT(); asm volatile("" ::: "memory");
    const int kc = lane & 7, r = lane >> 3;
#pragma unroll
    for (int s = 0; s < 16; ++s) { const int n = 8 * s + r; const LAS unsigned* p = scr + (4 * kc) * 128 + (n ^ (kc << 2));
        *(GAS v4u*)(WT + (size_t)(drow0 + n) * K + k0 + 8 * kc) = (v4u){p[0], p[128], p[256], p[384]}; }
    LDS_WAIT(); asm volatile("" ::: "memory");
}
constexpr int FFN_I_IN = 16 * 44, FFN_I_ALL = FFN_I_IN + 44 * 8;
__device__ __forceinline__ void convert_ffn_items(Frame& F, const float* w_in, const float* w_out, bf16* dst_in, bf16* dst_out, int first, int last, int start, int stride) {
    LAS unsigned* scr = (LAS unsigned*)(F.lds + F.wave * 16384);
    for (int it = first + start; it < last; it += stride) {
        if (it < FFN_I_IN) { const int kb = it / 44, nb = it % 44, c0 = 128 * nb; const int j0 = c0 < DFF ? c0 : c0 - DFF;
            transpose_wide(w_in, 2 * DFF, c0, D, dst_in, (j0 >> 7) * 256 + (c0 < DFF ? 0 : 128), scr, 64 * kb, F.lane); }
        else { const int r = it - FFN_I_IN; const int kb = r / 8, nb = r % 8; transpose_wide(w_out, D, 128 * nb, DFF, dst_out, 128 * nb, scr, 64 * kb, F.lane); } }
}
__device__ __forceinline__ void convert_ffn(Frame& F, const float* w_in, const float* w_out, bf16* dst_in, bf16* dst_out, int gw, int NGW) {
    convert_ffn_items(F, w_in, w_out, dst_in, dst_out, dst_in ? 0 : FFN_I_IN, dst_out ? FFN_I_ALL : FFN_I_IN, gw, NGW);
}
__device__ __forceinline__ void convert_mixer(Frame& F, int part, int gw, int NGW) {
    LAS unsigned* scr = (LAS unsigned*)(F.lds + F.wave * 16384);
    constexpr int NB0 = 4352 / 128, NB1 = (7424 - 4352) / 128, I_SQ = 16 * 8;
    const int nb_n = part == 0 ? NB0 : NB1, i_in = 16 * nb_n, i_tot = part == 0 ? i_in : i_in + 3 * I_SQ;
    for (int it = gw; it < i_tot; it += NGW) {
        if (it < i_in) { const int kb = it / nb_n, nb = it % nb_n, dr = 128 * nb + (part == 0 ? 0 : 4352);
            const int c0 = dr < 3072 ? dr : dr < 4352 ? 4112 + (dr - 3072) : dr < 5376 ? 3072 + (dr - 4352) : 5392 + (dr - 5376);
            transpose_wide((F.in[12]), INCOLS, c0, D, ((bf16*)(F.ws + WS_W)) + W_IN, dr, scr, 64 * kb, F.lane); }
        else { int r = it - i_in; const int which = r / I_SQ; r %= I_SQ; const int kb = r / 8, nb = r % 8;
            const float* src = which == 0 ? (F.in[19]) : which == 1 ? (F.in[20]) : (F.in[21]); bf16* dst = ((bf16*)(F.ws + WS_W)) + (which == 0 ? W_A : which == 1 ? W_B : W_O);
            transpose_wide(src, D, 128 * nb, D, dst, 128 * nb, scr, 64 * kb, F.lane); }
    }
}
__device__ __forceinline__ int ada_row_off(int s) { return s < 31 ? s * 4112 : 131584 + (s - 31) * 4112; }
__device__ __forceinline__ void split_bf(float a, float b, unsigned& hi, unsigned& lo) {
    hi = pk2(a, b); lo = pk2(a - __builtin_bit_cast(float, hi << 16), b - __builtin_bit_cast(float, hi & 0xffff0000u)); }
__device__ __forceinline__ void ada_item(Frame& F, int item) {
    for (int idx = F.tid; idx < 33 * 1024; idx += 512) { const int b = idx >> 10, k = idx & 1023;
        const float c = (b == 0) ? (F.in[6])[k] : (F.in[7])[(b - 1) * 1024 + k]; *(LAS float*)(F.lds + ada_row_off(b == 0 ? 32 : b - 1) + 4 * k) = c / (1.f + __expf(-c)); }
    __syncthreads();
    const int i16 = F.lane & 15, kg = F.lane >> 4, k0 = F.wave * 128;
    const float* wp = (F.in[25]) + (size_t)(k0 + 8 * kg) * ADAW + item * 64 + 4 * i16;
    f32x4 acc[3][4], ld[2][8];
#pragma unroll
    for (int mt = 0; mt < 3; ++mt)
#pragma unroll
        for (int t = 0; t < 4; ++t) acc[mt][t] = (f32x4){0.f, 0.f, 0.f, 0.f};
#pragma unroll
    for (int j = 0; j < 8; ++j) ld[0][j] = *(const f32x4*)(wp + (size_t)j * ADAW);
#pragma unroll
    for (int j = 0; j < 8; ++j) ld[1][j] = *(const f32x4*)(wp + (size_t)(32 + j) * ADAW);
#pragma unroll
    for (int ks = 0; ks < 4; ++ks) {
        bf16x8 bh[4], bl[4];
#pragma unroll
        for (int t = 0; t < 4; ++t) { unsigned h0, h1, h2, h3, l0, l1, l2, l3; split_bf(ld[ks & 1][0][t], ld[ks & 1][1][t], h0, l0); split_bf(ld[ks & 1][2][t], ld[ks & 1][3][t], h1, l1);
            split_bf(ld[ks & 1][4][t], ld[ks & 1][5][t], h2, l2); split_bf(ld[ks & 1][6][t], ld[ks & 1][7][t], h3, l3); bh[t] = __builtin_bit_cast(bf16x8, (v4u){h0, h1, h2, h3}); bl[t] = __builtin_bit_cast(bf16x8, (v4u){l0, l1, l2, l3}); }
        if (ks + 2 < 4) {
#pragma unroll
            for (int j = 0; j < 8; ++j) ld[ks & 1][j] = *(const f32x4*)(wp + (size_t)(32 * (ks + 2) + j) * ADAW); }
#pragma unroll
        for (int mt = 0; mt < 3; ++mt) { const LAS float* ap = (const LAS float*)(F.lds + ada_row_off(mt < 2 ? 16 * mt + i16 : 32)) + k0 + 32 * ks + 8 * kg;
            const f32x4 a0 = *(const LAS f32x4*)ap, a1 = *(const LAS f32x4*)(ap + 4); unsigned h0, h1, h2, h3, l0, l1, l2, l3;
            split_bf(a0.x, a0.y, h0, l0); split_bf(a0.z, a0.w, h1, l1); split_bf(a1.x, a1.y, h2, l2); split_bf(a1.z, a1.w, h3, l3);
            const bf16x8 ah = __builtin_bit_cast(bf16x8, (v4u){h0, h1, h2, h3}), al = __builtin_bit_cast(bf16x8, (v4u){l0, l1, l2, l3});
#pragma unroll
            for (int t = 0; t < 4; ++t) { acc[mt][t] = __builtin_amdgcn_mfma_f32_16x16x32_bf16(ah, bh[t], acc[mt][t], 0, 0, 0);
                acc[mt][t] = __builtin_amdgcn_mfma_f32_16x16x32_bf16(ah, bl[t], acc[mt][t], 0, 0, 0); acc[mt][t] = __builtin_amdgcn_mfma_f32_16x16x32_bf16(al, bh[t], acc[mt][t], 0, 0, 0); } }
    }
    __syncthreads();
    LAS float* red = (LAS float*)F.lds;
#pragma unroll
    for (int mt = 0; mt < 2; ++mt)
#pragma unroll
        for (int i = 0; i < 4; ++i) *(LAS f32x4*)(red + (F.wave * 33 + 16 * mt + 4 * kg + i + 1) * 64 + 4 * i16) = (f32x4){acc[mt][0][i], acc[mt][1][i], acc[mt][2][i], acc[mt][3][i]};
    if (kg == 0) *(LAS f32x4*)(red + (F.wave * 33) * 64 + 4 * i16) = (f32x4){acc[2][0][0], acc[2][1][0], acc[2][2][0], acc[2][3][0]};
    __syncthreads();
    for (int idx = F.tid; idx < 33 * 64; idx += 512) { const int b = idx >> 6, l = idx & 63; float s = 0.f;
#pragma unroll
        for (int w = 0; w < 8; ++w) s += red[(w * 33 + b) * 64 + l];
        ((float*)(F.ws + WS_ADA))[(size_t)b * ADAW + item * 64 + l] = s + (F.in[26])[item * 64 + l]; }
    __syncthreads();
}
__device__ __forceinline__ void convert_ffn_range(Frame& F, const float* w_in, const float* w_out, bf16* dst_in, bf16* dst_out, int lo, int hi) {
    convert_ffn_items(F, w_in, w_out, dst_in, dst_out, lo, hi < FFN_I_ALL ? hi : FFN_I_ALL, F.wave, NWAVES);
}
__device__ __forceinline__ int left_index(int pm, int pn) { return pm >= 64 ? (pm - 64) * 4 + pn : -1; }
struct Leftover { const bf16* part; bool base_in; int gi; float scale; };
__device__ __forceinline__ void load_row(Frame& F, int m, bool from_in, const Leftover& LO, f32x4 (&v)[4]) {
    const float* irow = m < MP ? (F.in[0]) + (size_t)m * D : (F.in[1]) + (size_t)(m - MP) * D;
    GAS u32x2* xb = (GAS u32x2*)((bf16*)F.out + (size_t)m * 2048) + F.lane;
#pragma unroll
    for (int j = 0; j < 4; ++j) { const int li = LO.part ? left_index(m >> 8, j) : -1;
        if (li < 0) { if (from_in) v[j] = *((const GAS f32x4*)irow + 64 * j + F.lane); else { const u32x2 w = xb[64 * j]; v[j] = (f32x4){bflo(w.x), bfhi(w.x), bflo(w.y), bfhi(w.y)}; } }
        else { f32x4 bs; if (LO.base_in) bs = *((const GAS f32x4*)irow + 64 * j + F.lane); else { const u32x2 w = xb[64 * j]; bs = (f32x4){bflo(w.x), bfhi(w.x), bflo(w.y), bfhi(w.y)}; }
            const f32x4 gv = *((const GAS f32x4*)(((float*)(F.ws + WS_ADA)) + (size_t)mod_row(m) * ADAW + LO.gi * D) + 64 * j + F.lane);
            const GAS u32x2* pp = (const GAS u32x2*)(LO.part + (size_t)li * 8 * 65536 + (size_t)(m & 255) * 256) + F.lane; f32x4 s = (f32x4){0.f, 0.f, 0.f, 0.f};
#pragma unroll
            for (int p = 0; p < 8; ++p) { const u32x2 w = pp[(size_t)p * 16384]; s += (f32x4){bflo(w.x), bfhi(w.x), bflo(w.y), bfhi(w.y)}; }
            v[j] = bs + gv * s * LO.scale; xb[64 * j] = (u32x2){pk2(v[j].x, v[j].y), pk2(v[j].z, v[j].w)}; } }
}
struct RowBuf { f32x4 x[4], sc[4], sh[4]; };
__device__ __forceinline__ void rmsmod_row(const RowBuf& rb, const f32x4 (&gq)[4], bf16* orow, int lane, f32x4 (&hv)[4]) {
    float s = 0.f;
#pragma unroll
    for (int j = 0; j < 4; ++j) s += (rb.x[j].x * rb.x[j].x + rb.x[j].y * rb.x[j].y) + (rb.x[j].z * rb.x[j].z + rb.x[j].w * rb.x[j].w);
    const float r = __builtin_amdgcn_rsqf(wave_sum(s) * (1.f / D) + EPS);
    GAS u32x2* o8 = (GAS u32x2*)orow + lane;
#pragma unroll
    for (int j = 0; j < 4; ++j) { const f32x4 h = (rb.x[j] * r) * gq[j] * (rb.sc[j] + 1.f) + rb.sh[j]; hv[j] = h;
        u32x2 w; w.x = pk2(h.x, h.y); w.y = pk2(h.z, h.w); o8[64 * j] = w; }
}
template <bool WITH_BA>
__device__ __forceinline__ void rmsmod_rows(Frame& F, bool from_in, const float* g, int li, bf16* dst, const Leftover LO = Leftover{nullptr, false, 0, 0.f}, int dld = D) {
    const int gw = F.vcu * NWAVES + F.wave, NGW = F.G * NWAVES;
    LAS float* wba = (LAS float*)F.lds;
    if (WITH_BA) { for (int idx = F.tid; idx < 16 * 1024; idx += 512) { const int k = idx >> 4, j = idx & 15; wba[j * 1024 + k] = (F.in[12])[(size_t)k * INCOLS + 4096 + j]; } __syncthreads(); }
    f32x4 gq[4];
#pragma unroll
    for (int j = 0; j < 4; ++j) gq[j] = ((const GAS f32x4*)g)[64 * j + F.lane];
    RowBuf cur, nxt;
#define ROW_FETCH(mm, B) do { const float* ad_ = ((float*)(F.ws + WS_ADA)) + (size_t)mod_row(mm) * ADAW + (3 * li) * D; load_row(F, mm, from_in, LO, B.x); \
        _Pragma("unroll") for (int j = 0; j < 4; ++j) { B.sh[j] = ((const GAS f32x4*)ad_)[64 * j + F.lane]; B.sc[j] = ((const GAS f32x4*)(ad_ + D))[64 * j + F.lane]; } } while (0)
    if (gw < M) ROW_FETCH(gw, cur);
    for (int m = gw; m < M; m += NGW) {
        if (m + NGW < M) ROW_FETCH(m + NGW, nxt);
        f32x4 hv[4]; rmsmod_row(cur, gq, dst + (size_t)m * dld, F.lane, hv);
        if (WITH_BA) { float p[16];
#pragma unroll
            for (int j = 0; j < 16; ++j) { float s = 0.f;
#pragma unroll
                for (int jj = 0; jj < 4; ++jj) { const f32x4 w = *(const LAS f32x4*)(wba + j * 1024 + 256 * jj + 4 * F.lane); s += (hv[jj].x * w.x + hv[jj].y * w.y) + (hv[jj].z * w.z + hv[jj].w * w.w); }
                p[j] = s; if ((j & 3) == 3) asm volatile("" ::: "memory"); }
            { const bool up = F.lane & 32;
#pragma unroll
              for (int i = 0; i < 8; ++i) { const float snd = up ? p[i] : p[8 + i]; const float rcv = __shfl_xor(snd, 32); p[i] = (up ? p[8 + i] : p[i]) + rcv; } }
            { const bool up = F.lane & 16;
#pragma unroll
              for (int i = 0; i < 4; ++i) { const float snd = up ? p[i] : p[4 + i]; const float rcv = __shfl_xor(snd, 16); p[i] = (up ? p[4 + i] : p[i]) + rcv; } }
            { const bool up = F.lane & 8;
#pragma unroll
              for (int i = 0; i < 2; ++i) { const float snd = up ? p[i] : p[2 + i]; const float rcv = __shfl_xor(snd, 8); p[i] = (up ? p[2 + i] : p[i]) + rcv; } }
            { const bool up = F.lane & 4; const float snd = up ? p[0] : p[1]; const float rcv = __shfl_xor(snd, 4); p[0] = (up ? p[1] : p[0]) + rcv; }
            p[0] += __shfl_xor(p[0], 2); p[0] += __shfl_xor(p[0], 1);
            if ((F.lane & 3) == 0) ((float*)(F.ws + WS_BA))[(size_t)m * 16 + (((F.lane >> 5) & 1) * 8 + ((F.lane >> 4) & 1) * 4 + ((F.lane >> 3) & 1) * 2 + ((F.lane >> 2) & 1))] = p[0]; }
        cur = nxt;
    }
#undef ROW_FETCH
    if (WITH_BA) __syncthreads();
}
__device__ __forceinline__ void final_norm_rows(Frame& F, const Leftover LO) {
    const int gw = F.vcu * NWAVES + F.wave, NGW = F.G * NWAVES;
    f32x4 gq[4], cur[4], nxt[4];
#pragma unroll
    for (int j = 0; j < 4; ++j) gq[j] = ((const GAS f32x4*)(F.in[27]))[64 * j + F.lane];
    if (gw < M) load_row(F, gw, false, LO, cur);
    for (int m = gw; m < M; m += NGW) {
        if (m + NGW < M) load_row(F, m + NGW, false, LO, nxt);
        GAS f32x4* xr = (GAS f32x4*)(F.out + (size_t)m * D) + F.lane; float s = 0.f;
#pragma unroll
        for (int j = 0; j < 4; ++j) s += (cur[j].x * cur[j].x + cur[j].y * cur[j].y) + (cur[j].z * cur[j].z + cur[j].w * cur[j].w);
        const float r = __builtin_amdgcn_rsqf(wave_sum(s) * (1.f / D) + EPS);
#pragma unroll
        for (int j = 0; j < 4; ++j) { xr[64 * j] = (cur[j] * r) * gq[j]; cur[j] = nxt[j]; }
    }
}
typedef pg8::f32x4 pf4; typedef pg8::u32x4 pu4;
#ifndef WT_STORES
#define WT_STORES 0
#endif
__device__ __forceinline__ void st16(void* p, pu4 v) {
#if WT_STORES
    asm volatile("global_store_dwordx4 %0, %1, off sc1\n\ts_nop 1" :: "v"(p), "v"(v) : "memory");
#else
    *(pu4*)p = v;
#endif
}
__device__ __forceinline__ void st16f(void* p, pf4 v) { st16(p, __builtin_bit_cast(pu4, v)); }
typedef float pf2 __attribute__((ext_vector_type(2)));
__device__ __forceinline__ pf2 silu_mul2(pf2 g, pf2 u) { const pf2 s = g * (-1.4426950408889634f); pf2 e; e.x = __builtin_amdgcn_exp2f(s.x); e.y = __builtin_amdgcn_exp2f(s.y);
    const pf2 d = e + 1.0f; pf2 r; r.x = __builtin_amdgcn_rcpf(d.x); r.y = __builtin_amdgcn_rcpf(d.y); return (g * r) * u; }
__device__ __forceinline__ pf4 silu_mul4(pf4 g, pf4 u) { const pf2 a = silu_mul2((pf2){g.x, g.y}, (pf2){u.x, u.y}), b = silu_mul2((pf2){g.z, g.w}, (pf2){u.z, u.w}); return (pf4){a.x, a.y, b.x, b.y}; }
__device__ __forceinline__ pu4 pack8(pf4 a, pf4 b) { pu4 w; w.x = pg8::cvt_pk_bf16(a.x, a.y); w.y = pg8::cvt_pk_bf16(a.z, a.w); w.z = pg8::cvt_pk_bf16(b.x, b.y); w.w = pg8::cvt_pk_bf16(b.z, b.w); return w; }
struct EpiSwiglu {
    static constexpr bool PERM = true, AFTER_DRAIN = false; bf16* O;
    __device__ __forceinline__ void operator()(const pf4 (&acc)[2][2][4][2], const pg8::Unit& u, int wr, int wc, int fr, int fq) const {
        const int row0 = u.pm * 256 + wr * 64 + fr, col0 = u.pn * 128 + wc * 32 + 8 * fq;
#pragma unroll
        for (int ai = 0; ai < 2; ++ai)
#pragma unroll
            for (int m = 0; m < 4; ++m) { bf16* p = O + (size_t)(row0 + ai * 128 + m * 16) * DFF + col0;
                const pf4 h0 = silu_mul4(acc[ai][0][m][0], acc[ai][1][m][0]), h1 = silu_mul4(acc[ai][0][m][1], acc[ai][1][m][1]);
                st16(p, pack8(h0, h1)); }
    }
};
template <bool BASE_IN> struct EpiResid {
    static constexpr bool PERM = true, AFTER_DRAIN = false; const float* in0; const float* in1; bf16* xb; const float* ada; int gi; float scale; bf16* part;
    __device__ __forceinline__ void operator()(const pf4 (&acc)[2][2][4][2], const pg8::Unit& u, int wr, int wc, int fr, int fq) const {
        if (u.piece) {
            char* pb = (char*)(part + ((size_t)u.lidx * 8 + (u.piece - 1)) * 65536);
#pragma unroll
            for (int ai = 0; ai < 2; ++ai)
#pragma unroll
                for (int bj = 0; bj < 2; ++bj) { unsigned off = (unsigned)((ai * 128 + wr * 64 + fr) * 256 + wc * 32 + 8 * fq + bj * 128) * 2u; asm volatile("" : "+v"(off));
#pragma unroll
                    for (int m = 0; m < 4; ++m) { *(pu4*)(pb + (size_t)off) = pack8(acc[ai][bj][m][0], acc[ai][bj][m][1]); off += 16u * 256u * 2u; }
                    asm volatile("" ::: "memory"); }
            return; }
        const int rowt = u.pm * 256, col0 = u.pn * 256 + wc * 32 + 8 * fq;
        const char* ib = (const char*)(rowt < MP ? in0 + (size_t)rowt * D : in1 + (size_t)(rowt - MP) * D); char* xo = (char*)(xb + (size_t)rowt * 2048);
#pragma unroll
        for (int ai = 0; ai < 2; ++ai) {
            const int b = rowt < MP ? 0 : 1 + ((rowt - MP) >> 6) + ai * 2 + wr; const char* ga = (const char*)(ada + (size_t)b * ADAW + gi * D);
#pragma unroll
            for (int bj = 0; bj < 2; ++bj) { unsigned co = (unsigned)(col0 + bj * 128); asm volatile("" : "+v"(co));
                const pf4 g0 = *(const pf4*)(ga + (size_t)co * 4u) * scale, g1 = *(const pf4*)(ga + (size_t)co * 4u + 16) * scale;
                unsigned r = (unsigned)(ai * 128 + wr * 64 + fr);
#pragma unroll
                for (int m = 0; m < 4; ++m) { pf4 b0, b1;
                    if (BASE_IN) { const char* p = ib + ((size_t)r * D + co) * 4u; b0 = *(const pf4*)p; b1 = *(const pf4*)(p + 16); }
                    else { const pu4 w = *(const pu4*)(xo + ((size_t)r * 2048 + co) * 2u); b0 = (pf4){bflo(w.x), bfhi(w.x), bflo(w.y), bfhi(w.y)}; b1 = (pf4){bflo(w.z), bfhi(w.z), bflo(w.w), bfhi(w.w)}; }
                    *(pu4*)(xo + ((size_t)r * 2048 + co) * 2u) = pack8(b0 + g0 * acc[ai][bj][m][0], b1 + g1 * acc[ai][bj][m][1]); r += 16u; }
                asm volatile("" ::: "memory"); }
        }
    }
};
struct EpiPart {
    static constexpr bool PERM = true, AFTER_DRAIN = false; bf16* part;
    __device__ __forceinline__ void operator()(const pf4 (&acc)[2][2][4][2], const pg8::Unit& u, int wr, int wc, int fr, int fq) const {
        char* pb = (char*)(part + ((size_t)u.lidx * 8 + (u.piece - 1)) * 65536);
#pragma unroll
        for (int ai = 0; ai < 2; ++ai)
#pragma unroll
            for (int bj = 0; bj < 2; ++bj) { unsigned off = (unsigned)((ai * 128 + wr * 64 + fr) * 256 + wc * 32 + 8 * fq + bj * 128) * 2u; asm volatile("" : "+v"(off));
#pragma unroll
                for (int m = 0; m < 4; ++m) { *(pu4*)(pb + (size_t)off) = pack8(acc[ai][bj][m][0], acc[ai][bj][m][1]); off += 16u * 256u * 2u; }
                asm volatile("" ::: "memory"); }
    }
};
struct EpiF1 {
    static constexpr bool PERM = true, AFTER_DRAIN = false; bf16 *U1, *U2, *U3, *U4, *KV, *TAIL; float* out;
    __device__ __forceinline__ void operator()(const pf4 (&acc)[2][2][4][2], const pg8::Unit& u, int wr, int wc, int fr, int fq) const {
        const int pn = u.pn, dcol = wc * 32 + 8 * fq;
        if (pn < 12) {
            char* Ub = (char*)U1 + (size_t)((pn >> 2) == 0 ? 4 : (pn >> 2)) * (36u << 20);
#pragma unroll
            for (int ai = 0; ai < 2; ++ai) { const int cn = u.pm * 4 + ai * 2 + wr;
#pragma unroll
                for (int bj = 0; bj < 2; ++bj) { unsigned off = (unsigned)(((cn * 8 + (pn & 3) * 2 + bj) * 64 + fr) * 128 + dcol) * 2u; asm volatile("" : "+v"(off));
#pragma unroll
                    for (int m = 0; m < 4; ++m) { st16(Ub + (size_t)off, pack8(acc[ai][bj][m][0], acc[ai][bj][m][1])); off += 16u * 128u * 2u; }
                    asm volatile("" ::: "memory"); } }
            if (fr >= 13) {
#pragma unroll
                for (int ai = 0; ai < 2; ++ai) { const int cn = u.pm * 4 + ai * 2 + wr;
#pragma unroll
                    for (int bj = 0; bj < 2; ++bj) { const int j = fr - 13, qc = pn * 256 + bj * 128 + dcol; const pf4 v0 = acc[ai][bj][3][0], v1 = acc[ai][bj][3][1];
                        *(pu4*)(TAIL + ((size_t)cn * 3 + j) * 3072 + qc) = pack8(v0, v1);
                        if (cn >= 255) { float* o = out + (cn == 255 ? OFF_PCONV + (size_t)j * 3072 : OFF_SCONV + ((size_t)(cn - 256) * 3 + j) * 3072) + qc; *(pf4*)o = v0; *(pf4*)(o + 4) = v1; } } } }
        } else if (pn < 16) {
#pragma unroll
            for (int ai = 0; ai < 2; ++ai)
#pragma unroll
                for (int bj = 0; bj < 2; ++bj) { unsigned off = (unsigned)((u.pm * 256 + ai * 128 + wr * 64 + fr) * D + (pn - 12) * 256 + bj * 128 + dcol) * 2u; asm volatile("" : "+v"(off));
#pragma unroll
                    for (int m = 0; m < 4; ++m) { st16((char*)U4 + (size_t)off, pack8(acc[ai][bj][m][0], acc[ai][bj][m][1])); off += 16u * D * 2u; }
                    asm volatile("" ::: "memory"); }
        } else {
#pragma unroll
            for (int ai = 0; ai < 2; ++ai) { const int cn = u.pm * 4 + ai * 2 + wr;
#pragma unroll
                for (int bj = 0; bj < 2; ++bj) { unsigned off = (unsigned)((cn * 64 + fr) * 256 + bj * 128 + dcol) * 2u; asm volatile("" : "+v"(off));
#pragma unroll
                    for (int m = 0; m < 4; ++m) { st16((char*)KV + (size_t)off, pack8(acc[ai][bj][m][0], acc[ai][bj][m][1])); off += 16u * 256u * 2u; }
                    asm volatile("" ::: "memory");
                    if (cn >= 254) {
                        float* ob = cn < 256 ? out + (bj == 0 ? OFF_PK : OFF_PV) + (size_t)((cn - 254) * 64 + fr) * 128 + dcol
                                             : out + (bj == 0 ? OFF_SK : OFF_SV) + (size_t)(cn - 256) * 16384 + (size_t)(64 + fr) * 128 + dcol;
#pragma unroll
                        for (int m = 0; m < 4; ++m) { *(pf4*)(ob + m * 16 * 128) = acc[ai][bj][m][0]; *(pf4*)(ob + m * 16 * 128 + 4) = acc[ai][bj][m][1]; }
                        asm volatile("" ::: "memory"); } } }
        }
    }
};
struct EpiF2 {
    static constexpr bool PERM = true, AFTER_DRAIN = false; bf16 *Z, *GA, *GB;
    __device__ __forceinline__ void operator()(const pf4 (&acc)[2][2][4][2], const pg8::Unit& u, int wr, int wc, int fr, int fq) const {
        const int t_ = u.pn >> 2; bf16* Ob = (bf16*)((char*)Z + (size_t)(108 * t_ - 72 * (t_ >> 1)) * (1u << 20)); const int col0 = (u.pn & 3) * 256 + wc * 32 + 8 * fq, row0 = u.pm * 256 + wr * 64 + fr;
#pragma unroll
        for (int ai = 0; ai < 2; ++ai)
#pragma unroll
            for (int m = 0; m < 4; ++m)
#pragma unroll
                for (int bj = 0; bj < 2; ++bj) st16(Ob + (size_t)(row0 + ai * 128 + m * 16) * D + col0 + bj * 128, pack8(acc[ai][bj][m][0], acc[ai][bj][m][1]));
    }
};
template <int MODE> struct EpiGate {
    static constexpr bool PERM = true, AFTER_DRAIN = false; bf16* T; const bf16* G2;
    __device__ __forceinline__ void operator()(const pf4 (&acc)[2][2][4][2], const pg8::Unit& u, int wr, int wc, int fr, int fq) const {
        const int col0 = u.pn * 256 + wc * 32 + 8 * fq, row0 = u.pm * 256 + wr * 64 + fr;
#pragma unroll
        for (int ai = 0; ai < 2; ++ai)
#pragma unroll
            for (int m = 0; m < 4; ++m)
#pragma unroll
                for (int bj = 0; bj < 2; ++bj) { const size_t off = (size_t)(row0 + ai * 128 + m * 16) * D + col0 + bj * 128;
                    const pu4 gv = *(const pu4*)((MODE == 0 ? (const bf16*)T : G2) + off); pu4 tv = (pu4){0u, 0u, 0u, 0u}; if (MODE == 1) tv = *(const pu4*)(T + off);
                    const pf4 a0 = acc[ai][bj][m][0], a1 = acc[ai][bj][m][1]; pf4 o0, o1;
                    o0.x = bflo(tv.x) + sigm(bflo(gv.x)) * a0.x; o0.y = bfhi(tv.x) + sigm(bfhi(gv.x)) * a0.y; o0.z = bflo(tv.y) + sigm(bflo(gv.y)) * a0.z; o0.w = bfhi(tv.y) + sigm(bfhi(gv.y)) * a0.w;
                    o1.x = bflo(tv.z) + sigm(bflo(gv.z)) * a1.x; o1.y = bfhi(tv.z) + sigm(bfhi(gv.z)) * a1.y; o1.z = bflo(tv.w) + sigm(bflo(gv.w)) * a1.z; o1.w = bfhi(tv.w) + sigm(bfhi(gv.w)) * a1.w;
                    st16(T + off, pack8(o0, o1)); }
    }
};
typedef short s16x8 __attribute__((ext_vector_type(8)));
constexpr int PR_RHST = 0, PR_QB = 69632, PR_KB = 87040, PR_AM = 104448, PR_TB = 121856, PR_SC = 126976, PR_IL = 132096, PR_CW = 141312;
static_assert(PR_IL + 64 * 72 * 2 <= PR_CW && PR_CW + 12 * 128 * 4 <= LDS_BYTES, "prep LDS map (IL, CW)");
static_assert(PR_SC + 2 * 1536 <= RING_BYTES, "prep LDS map");
constexpr size_t WS_GATES = 242 * MiB;
struct PrepRegs { v4u raw[3][5]; float gate; };
__device__ __forceinline__ void prep_fetch(Frame& F, int it, int ch8, int rg, PrepRegs& P) {
    const int cn = it >> 3, h = it & 7; const size_t blk = (size_t)(cn * 8 + h) * 64 * 128;
    P.gate = ((const float*)(F.ws + WS_GATES))[(size_t)it * 256 + ((rg * 16 + ch8) & 255)];
#pragma unroll
    for (int t = 0; t < 3; ++t) { const int ch = t * 1024 + h * 128 + 8 * ch8; const bf16* Ub = (t == 0 ? ((bf16*)(F.ws + WS_U5)) : t == 1 ? ((bf16*)(F.ws + WS_U2)) : ((bf16*)(F.ws + WS_U3))) + blk + 8 * ch8;
#pragma unroll
        for (int j = 0; j < 5; ++j) { const int rr = 2 * rg - 3 + j;
            if (rr >= 0) P.raw[t][j] = *(const v4u*)(Ub + rr * 128);
            else if (cn > 0 && cn < 256) P.raw[t][j] = *(const v4u*)(((bf16*)(F.ws + WS_TAIL)) + ((size_t)(cn - 1) * 3 + (3 + rr)) * 3072 + ch);
            else if (cn == 0) P.raw[t][j] = (v4u){0u, 0u, 0u, 0u};
            else { const float* p = (F.in[2]) + ((size_t)(cn - 256) * 3 + (3 + rr)) * 3072 + ch; const f32x4 a = *(const f32x4*)p, b = *(const f32x4*)(p + 4);
                P.raw[t][j] = (v4u){pk2(a.x, a.y), pk2(a.z, a.w), pk2(b.x, b.y), pk2(b.z, b.w)}; } } }
}
__device__ __forceinline__ void prep_gates(Frame& F, int it, int lane) {
    const int cn = it >> 3, h = it & 7, row = cn * 64 + lane; const float braw = ((float*)(F.ws + WS_BA))[(size_t)row * 16 + h], araw = ((float*)(F.ws + WS_BA))[(size_t)row * 16 + 8 + h];
    const float beta = 1.f / (1.f + expf(-braw)); const float xx = araw + (F.in[15])[h]; const float sp = xx > 20.f ? xx : log1pf(expf(xx)); const float g = -expf((F.in[14])[h]) * sp;
    float gcs = g;
#pragma unroll
    for (int o = 1; o < 64; o <<= 1) { const float t = __shfl_up(gcs, o); if (lane >= o) gcs += t; }
    const float glast = __shfl(gcs, 63);
    float* G = (float*)(F.ws + WS_GATES) + (size_t)it * 256;
    G[lane] = beta; G[64 + lane] = gcs; G[128 + lane] = expf(gcs); G[192 + lane] = expf(glast - gcs);
    if (lane == 63) ((float*)(F.ws + WS_GL))[it] = expf(glast);
}
#if defined(PROBE_PS)
#define PS_MARK(k) do { if (blockIdx.x == 0 && F.tid == 0) { const unsigned long long t_ = __builtin_amdgcn_s_memrealtime(); volatile LAS unsigned long long* a_ = (volatile LAS unsigned long long*)(F.lds + LDSCTL_OFF + 768); a_[(k)] += t_ - a_[15]; a_[15] = t_; } } while (0)
#else
#define PS_MARK(k) do {} while (0)
#endif
template <bool DRY, int SKIP = 0> __device__ __forceinline__ void gdn_prep_unit(Frame& F, int cn, int h, PrepRegs& P, int it_next, int par) {
    const int tid = F.tid, lane = F.lane, wave = F.wave, ch8 = tid & 15, rg = tid >> 4;
    LAS float* RHST = (LAS float*)(F.lds + PR_RHST); LAS bf16* QB = (LAS bf16*)(F.lds + PR_QB); LAS bf16* KB = (LAS bf16*)(F.lds + PR_KB);
    LAS float* AM = (LAS float*)(F.lds + PR_AM); LAS bf16* TB = (LAS bf16*)(F.lds + PR_TB);
    LAS float* SC = (LAS float*)(F.lds + PR_SC + (par ? 1536 : 0)); LAS float *S_BETA = SC, *S_GC = SC + 64, *S_EG = SC + 128, *S_EK = SC + 192;
    const size_t blk = (size_t)(cn * 8 + h) * 64 * 128;
    PS_MARK(0);
    const float gate_rec = P.gate;
    float y[3][2][8]; int ch8v = ch8, rgv = rg; asm volatile("" : "+v"(ch8v), "+v"(rgv));
#pragma unroll
    for (int t = 0; t < 3; ++t) { const int ch = t * 1024 + h * 128 + 8 * ch8v;
        float x[5][8];
#pragma unroll
        for (int j = 0; j < 5; ++j) { const v4u w = P.raw[t][j]; x[j][0] = bflo(w.x); x[j][1] = bfhi(w.x); x[j][2] = bflo(w.y); x[j][3] = bfhi(w.y); x[j][4] = bflo(w.z); x[j][5] = bfhi(w.z); x[j][6] = bflo(w.w); x[j][7] = bfhi(w.w); }
        const LAS float* cw = (const LAS float*)(F.lds + PR_CW) + t * 512 + 8 * ch8v;
#pragma unroll
        for (int hh = 0; hh < 2; ++hh) { const f32x4 w0 = *(const LAS f32x4*)(cw + 4 * hh), w1 = *(const LAS f32x4*)(cw + 128 + 4 * hh), w2 = *(const LAS f32x4*)(cw + 256 + 4 * hh), w3 = *(const LAS f32x4*)(cw + 384 + 4 * hh);
#pragma unroll
            for (int i = 0; i < 4; ++i)
#pragma unroll
                for (int r2 = 0; r2 < 2; ++r2) { const int ii = 4 * hh + i; if (SKIP & 8) y[t][r2][ii] = x[r2 + 3][ii] + w0[i]; else y[t][r2][ii] = siluf((w0[i] * x[r2][ii] + w1[i] * x[r2 + 1][ii]) + (w2[i] * x[r2 + 2][ii] + w3[i] * x[r2 + 3][ii])); } }
        asm volatile("" ::: "memory"); }
    float rn[2][2];
#pragma unroll
    for (int t = 0; t < 2; ++t)
#pragma unroll
        for (int r2 = 0; r2 < 2; ++r2) { float s = 0.f;
#pragma unroll
            for (int i = 0; i < 8; ++i) s += y[t][r2][i] * y[t][r2][i];
            s += __shfl_xor(s, 1); s += __shfl_xor(s, 2); s += __shfl_xor(s, 4); s += __shfl_xor(s, 8);
            rn[t][r2] = __builtin_amdgcn_rsqf(s + EPS) * (t == 0 ? 0.08838834764831845f : 1.f); }
    if (tid < 256) SC[tid] = gate_rec;
    LDS_WAIT(); __builtin_amdgcn_s_barrier();
    PS_MARK(1);
    if (SKIP & 16) { asm volatile("" :: "v"(y[0][0][0]), "v"(y[1][1][7]), "v"(y[2][0][3]), "v"(rn[0][0]), "v"(rn[1][1])); } else
    { int c8 = 8 * ch8, r0 = 2 * rg; asm volatile("" : "+v"(c8), "+v"(r0));
      float be[2], eg[2], ek[2];
#pragma unroll
      for (int r2 = 0; r2 < 2; ++r2) { be[r2] = S_BETA[r0 + r2]; eg[r2] = S_EG[r0 + r2]; ek[r2] = S_EK[r0 + r2]; }
#pragma unroll
      for (int r2 = 0; r2 < 2; ++r2) { float q[8], k[8];
#pragma unroll
          for (int i = 0; i < 8; ++i) { q[i] = y[0][r2][i] * rn[0][r2]; k[i] = y[1][r2][i] * rn[1][r2]; }
          const int row = r0 + r2;
          *(LAS v4u*)(QB + row * 136 + c8) = (v4u){pk2(q[0], q[1]), pk2(q[2], q[3]), pk2(q[4], q[5]), pk2(q[6], q[7])};
          *(LAS v4u*)(KB + row * 136 + c8) = (v4u){pk2(k[0], k[1]), pk2(k[2], k[3]), pk2(k[4], k[5]), pk2(k[6], k[7])};
          if (!DRY) *(v4u*)(((bf16*)(F.ws + WS_U5)) + blk + row * 128 + c8) = (v4u){pk2(q[0] * eg[r2], q[1] * eg[r2]), pk2(q[2] * eg[r2], q[3] * eg[r2]), pk2(q[4] * eg[r2], q[5] * eg[r2]), pk2(q[6] * eg[r2], q[7] * eg[r2])};
#pragma unroll
          for (int i = 0; i < 8; ++i) {
              y[1][r2][i] = k[i] * be[r2] * eg[r2]; y[2][r2][i] = y[2][r2][i] * be[r2]; } }
#pragma unroll
      for (int i = 0; i < 8; ++i) {
          const int rs = (r0 + (c8 >> 1)) & 63;
          *(LAS f32x2*)(RHST + (c8 + i) * 68 + rs) = (f32x2){y[2][0][i], y[2][1][i]};
          *(LAS f32x2*)(RHST + (128 + c8 + i) * 68 + rs) = (f32x2){y[1][0][i], y[1][1][i]}; } }
    LDS_WAIT(); __builtin_amdgcn_s_barrier();
    PS_MARK(2);
    if (!(SKIP & 2)) { int l4 = lane; asm volatile("" : "+v"(l4)); const int ti = wave & 3, fr = l4 & 15, fq = l4 >> 4; const LAS bf16* Ab = (wave < 4 ? KB : QB) + (16 * ti + fr) * 136 + 8 * fq;
      s16x8 a[4];
#pragma unroll
      for (int s = 0; s < 4; ++s) a[s] = *(const LAS s16x8*)(Ab + 32 * s);
      LAS bf16* IL = (LAS bf16*)(F.lds + PR_IL);
#pragma unroll
      for (int tj = 0; tj < 4; ++tj) { if (wave < 4 && tj > ti) continue;
          f32x4 acc = (f32x4){0.f, 0.f, 0.f, 0.f}; const LAS bf16* Bb = KB + (16 * tj + fr) * 136 + 8 * fq;
#pragma unroll
          for (int s = 0; s < 4; ++s) { const s16x8 b = *(const LAS s16x8*)(Bb + 32 * s); acc = __builtin_amdgcn_mfma_f32_16x16x32_bf16(a[s], b, acc, 0, 0, 0); }
          const int j = 16 * tj + fr; const float gj = S_GC[j];
#pragma unroll
          for (int r = 0; r < 4; ++r) { const int i = 16 * ti + 4 * fq + r; const float dec = fexp(fminf(S_GC[i] - gj, 0.f));
              if (wave < 4) AM[i * 68 + j] = (i > j) ? -(S_BETA[i] * acc[r] * dec) : 0.f;
              else { const unsigned iv = f2bf((i >= j) ? acc[r] * dec : 0.f); IL[i * 72 + j] = (bf16)iv; } } }
      if (wave < 4) {
          LDS_WAIT(); asm volatile("" ::: "memory");
          const int j = l4 & 15; int zv = 0; asm volatile("" : "+v"(zv)); const LAS float* Ad = AM + zv + (16 * ti) * 68 + 16 * ti; float t[16];
          f32x4 ar[16][4];
#pragma unroll
          for (int i = 1; i < 16; ++i)
#pragma unroll
              for (int k4 = 0; k4 < (i + 3) / 4; ++k4) ar[i][k4] = *(const LAS f32x4*)(Ad + i * 68 + 4 * k4);
#pragma unroll
          for (int i = 0; i < 16; ++i) { float acc = (i == j) ? 1.f : 0.f;
#pragma unroll
              for (int k = 0; k < i; ++k) acc += ar[i][k >> 2][k & 3] * t[k];
              t[i] = acc; }
          if (l4 < 16) {
#pragma unroll
              for (int i = 0; i < 16; ++i) TB[(16 * ti + i) * 16 + j] = (bf16)f2bf(t[i]); } } }
    LDS_WAIT(); __builtin_amdgcn_s_barrier();
    PS_MARK(3);
    if (!(SKIP & 4)) { int l6 = lane; asm volatile("" : "+v"(l6)); const int n = l6 & 15, g = l6 >> 4; f32x4 R[4][2];
#pragma unroll
      for (int b = 0; b < 4; ++b)
#pragma unroll
          for (int nt = 0; nt < 2; ++nt) { const int col = 32 * wave + 16 * nt + n; R[b][nt] = *(const LAS f32x4*)(RHST + col * 68 + ((16 * b + 4 * g + 4 * ((col >> 3) & 15)) & 63)); }
      LDS_WAIT(); __builtin_amdgcn_s_barrier();
      const LAS bf16* tb = TB + n * 16 + 4 * g; const LAS float* am = AM + n * 68 + 4 * g;
#pragma unroll
      for (int b = 0; b < 4; ++b) {
          const u32x2 tw = *(const LAS u32x2*)(tb + (16 * b) * 16); const s16x8 ta = __builtin_bit_cast(s16x8, (v4u){tw.x, tw.y, 0u, 0u});
          s16x8 xb[2];
#pragma unroll
          for (int nt = 0; nt < 2; ++nt) { const s16x8 rb = __builtin_bit_cast(s16x8, (v4u){pk2(R[b][nt].x, R[b][nt].y), pk2(R[b][nt].z, R[b][nt].w), 0u, 0u});
              R[b][nt] = __builtin_amdgcn_mfma_f32_16x16x32_bf16(ta, rb, (f32x4){0.f, 0.f, 0.f, 0.f}, 0, 0, 0);
              xb[nt] = __builtin_bit_cast(s16x8, (v4u){pk2(R[b][nt].x, R[b][nt].y), pk2(R[b][nt].z, R[b][nt].w), 0u, 0u}); }
#pragma unroll
          for (int b2 = b + 1; b2 < 4; ++b2) { const f32x4 av = *(const LAS f32x4*)(am + (16 * b2) * 68 + 16 * b); const s16x8 aa = __builtin_bit_cast(s16x8, (v4u){pk2(av.x, av.y), pk2(av.z, av.w), 0u, 0u});
              R[b2][0] = __builtin_amdgcn_mfma_f32_16x16x32_bf16(aa, xb[0], R[b2][0], 0, 0, 0); R[b2][1] = __builtin_amdgcn_mfma_f32_16x16x32_bf16(aa, xb[1], R[b2][1], 0, 0, 0); } }
      if (wave < 4) { LAS bf16* UL = (LAS bf16*)(F.lds + PR_RHST) + (32 * wave + n) * 72 + 4 * g;
#pragma unroll
          for (int b = 0; b < 4; ++b)
#pragma unroll
              for (int nt = 0; nt < 2; ++nt) *(LAS u32x2*)(UL + nt * 16 * 72 + 16 * b) = (u32x2){pk2(R[b][nt].x, R[b][nt].y), pk2(R[b][nt].z, R[b][nt].w)}; }
      else { LAS bf16* WL = QB + (4 * g) * 136 + 32 * (wave - 4) + n;
#pragma unroll
          for (int b = 0; b < 4; ++b)
#pragma unroll
              for (int nt = 0; nt < 2; ++nt)
#pragma unroll
                  for (int r = 0; r < 4; ++r) WL[(16 * b + r) * 136 + 16 * nt] = (bf16)f2bf(-R[b][nt][r]); } }
    LDS_WAIT(); __builtin_amdgcn_s_barrier();
    PS_MARK(5);
    if (it_next >= 0) { int c9 = ch8, r9 = rg; asm volatile("" : "+v"(c9), "+v"(r9)); prep_fetch(F, it_next, c9, r9, P); }
    if (!DRY) { int t5 = tid; asm volatile("" : "+v"(t5));
#pragma unroll
        for (int i = 0; i < 2; ++i) { const int id = t5 + 512 * i, row = id >> 4, q = id & 15; *(v4u*)(((bf16*)(F.ws + WS_U1)) + blk + row * 128 + 8 * q) = *(const LAS v4u*)(QB + row * 136 + 8 * q); }
        { const int row = t5 >> 3, q = t5 & 7; *(v4u*)(((bf16*)(F.ws + WS_INTRA)) + (size_t)(cn * 8 + h) * 4096 + row * 64 + 8 * q) = *(const LAS v4u*)((LAS bf16*)(F.lds + PR_IL) + row * 72 + 8 * q); }
#pragma unroll
        for (int i = 0; i < 2; ++i) { const int id = t5 + 512 * i, row = id >> 3, q = id & 7;
            *(v4u*)(((bf16*)(F.ws + WS_U3)) + blk + row * 64 + 8 * q) = *(const LAS v4u*)((LAS bf16*)(F.lds + PR_RHST) + row * 72 + 8 * q);
            float kv[8];
#pragma unroll
            for (int j = 0; j < 8; ++j) kv[j] = bf2f(KB[(8 * q + j) * 136 + row]) * S_EK[8 * q + j];
            *(v4u*)(((bf16*)(F.ws + WS_U2)) + blk + row * 64 + 8 * q) = (v4u){pk2(kv[0], kv[1]), pk2(kv[2], kv[3]), pk2(kv[4], kv[5]), pk2(kv[6], kv[7])}; } }
    PS_MARK(6);
    LDS_WAIT();
}
typedef float f32x16 __attribute__((ext_vector_type(16)));
constexpr int SW_KS = 0, SW_VT = 27648, SW_TB = 53248;
__device__ __forceinline__ int t5_bucket(int rel) { const int n = rel < 0 ? -rel : rel;
    const int b = n < 8 ? n : n < 12 ? 8 : n < 16 ? 9 : n < 23 ? 10 : n < 32 ? 11 : n < 46 ? 12 : n < 64 ? 13 : n < 91 ? 14 : 15; return (rel > 0 ? 16 : 0) + b; }
template <bool DRY> __device__ __forceinline__ void swa_unit(Frame& F, int cn, int kh) {
    const int tid = F.tid, lane = F.lane, wave = F.wave, r32 = lane & 31, hi = lane >> 5;
    LAS bf16* KS = (LAS bf16*)(F.lds + SW_KS); LAS bf16* VT = (LAS bf16*)(F.lds + SW_VT); LAS float* TB = (LAS float*)(F.lds + SW_TB);
    const bool smp = cn >= 256; const int b = cn - 256;
#pragma unroll
    for (int it = 0; it < 3; ++it) { const int id = tid + 512 * it, row = id >> 3, dq = id & 7;
        v4u kw = (v4u){0u, 0u, 0u, 0u}, vw = kw;
        if (smp && row < 128) { const size_t so = ((size_t)(b * 128 + row) * 2 + kh) * 64 + dq * 8;
            const f32x4 k0 = *(const f32x4*)((F.in[4]) + so), k1 = *(const f32x4*)((F.in[4]) + so + 4), v0 = *(const f32x4*)((F.in[5]) + so), v1 = *(const f32x4*)((F.in[5]) + so + 4);
            kw = (v4u){pk2(k0.x, k0.y), pk2(k0.z, k0.w), pk2(k1.x, k1.y), pk2(k1.z, k1.w)}; vw = (v4u){pk2(v0.x, v0.y), pk2(v0.z, v0.w), pk2(v1.x, v1.y), pk2(v1.z, v1.w)};
            if (row >= 64 && !DRY) { float* ok = F.out + OFF_SK + (size_t)b * 16384 + (size_t)(row - 64) * 128 + kh * 64 + dq * 8; float* ov = F.out + OFF_SV + (size_t)b * 16384 + (size_t)(row - 64) * 128 + kh * 64 + dq * 8;
                *(f32x4*)ok = k0; *(f32x4*)(ok + 4) = k1; *(f32x4*)ov = v0; *(f32x4*)(ov + 4) = v1; } }
        else { const int kp = smp ? (MP + b * 64 + row - 128) : (cn * 64 - 128 + row);
            if (kp >= 0) { const bf16* src = ((bf16*)(F.ws + WS_KV)) + (size_t)kp * 256 + kh * 64 + dq * 8; kw = *(const v4u*)src; vw = *(const v4u*)(src + 128); } }
        *(LAS v4u*)(KS + row * 72 + dq * 8) = kw;
        LAS bf16* vt = VT + (dq * 8) * 200 + row;
        vt[0] = (bf16)(vw.x & 0xffffu); vt[200] = (bf16)(vw.x >> 16); vt[400] = (bf16)(vw.y & 0xffffu); vt[600] = (bf16)(vw.y >> 16);
        vt[800] = (bf16)(vw.z & 0xffffu); vt[1000] = (bf16)(vw.z >> 16); vt[1200] = (bf16)(vw.w & 0xffffu); vt[1400] = (bf16)(vw.w >> 16); }
    for (int id = tid; id < 8 * 256; id += 512) { const int hl = id >> 8, ix = id & 255; TB[id] = ix < 255 ? (F.in[18])[t5_bucket(ix - 191) * 16 + kh * 8 + hl] : 0.f; }
    __syncthreads();
    const int head = kh * 8 + wave; const float sink = (F.in[17])[head];
    bf16* Qg = ((bf16*)(F.ws + WS_U4)) + (size_t)(cn * 64) * D + head * 64;
    const LAS float* tb = TB + wave * 256;
#pragma unroll 1
    for (int qt = 0; qt < 2; ++qt) {
        s16x8 qf[4];
#pragma unroll
        for (int s = 0; s < 4; ++s) qf[s] = *(const s16x8*)(Qg + (size_t)(32 * qt + r32) * D + 16 * s + 8 * hi);
        f32x16 P[6]; const int qi = 32 * qt + r32; float mx = -INFINITY;
#pragma unroll
        for (int kt = 0; kt < 6; ++kt) { f32x16 acc = {};
#pragma unroll
            for (int s = 0; s < 4; ++s) { const s16x8 a = *(const LAS s16x8*)(KS + (32 * kt + r32) * 72 + 16 * s + 8 * hi); acc = __builtin_amdgcn_mfma_f32_32x32x16_bf16(a, qf[s], acc, 0, 0, 0); }
#pragma unroll
            for (int r = 0; r < 16; ++r) { const int j = 32 * kt + (r & 3) + 8 * (r >> 2) + 4 * hi; float l = acc[r] * 0.125f + tb[j - qi + 63];
                if (!smp && cn * 64 + j < 128) l = -INFINITY; acc[r] = l; mx = fmaxf(mx, l); }
            P[kt] = acc; asm volatile("" ::: "memory"); }
        mx = fmaxf(mx, __shfl_xor(mx, 32)); mx = fmaxf(mx, sink);
        float sum = 0.f;
#pragma unroll
        for (int kt = 0; kt < 6; ++kt)
#pragma unroll
            for (int r = 0; r < 16; ++r) { const float p = fexp(P[kt][r] - mx); P[kt][r] = p; sum += p; }
        sum += __shfl_xor(sum, 32);
        const float inv = 1.f / (sum + fexp(sink - mx));
        f32x16 O[2]; O[0] = (f32x16){}; O[1] = (f32x16){};
#pragma unroll
        for (int kt = 0; kt < 6; ++kt) {
#pragma unroll
            for (int s2 = 0; s2 < 2; ++s2) { v4u pw; pw.x = pk2(P[kt][8 * s2] * inv, P[kt][8 * s2 + 1] * inv); pw.y = pk2(P[kt][8 * s2 + 2] * inv, P[kt][8 * s2 + 3] * inv);
                pw.z = pk2(P[kt][8 * s2 + 4] * inv, P[kt][8 * s2 + 5] * inv); pw.w = pk2(P[kt][8 * s2 + 6] * inv, P[kt][8 * s2 + 7] * inv);
                const s16x8 pa = __builtin_bit_cast(s16x8, pw);
#pragma unroll
                for (int dt = 0; dt < 2; ++dt) { const LAS bf16* vp = VT + (32 * dt + r32) * 200 + 32 * kt + 16 * s2 + 4 * hi;
                    const u32x2 lo = *(const LAS u32x2*)vp, hh = *(const LAS u32x2*)(vp + 8);
                    const s16x8 vb = __builtin_bit_cast(s16x8, (v4u){lo.x, lo.y, hh.x, hh.y});
                    O[dt] = __builtin_amdgcn_mfma_f32_32x32x16_bf16(pa, vb, O[dt], 0, 0, 0); } }
            asm volatile("" ::: "memory"); }
#pragma unroll
        for (int dt = 0; dt < 2; ++dt)
#pragma unroll
            for (int r = 0; r < 16; ++r) { const int q = 32 * qt + (r & 3) + 8 * (r >> 2) + 4 * hi; const unsigned ov = f2bf(O[dt][r]); if (!DRY) Qg[(size_t)q * D + 32 * dt + r32] = (bf16)ov; else asm volatile("" :: "v"(ov)); }
    }
    __syncthreads();
}
constexpr int SC_WN = 0, SC_QP = 16384, SC_KPT = 32768, SC_IN = 49152, SC_STAGE = 57344;
template <int C, int NCHUNK> __device__ __forceinline__ void tile_rq(int lt, int i, int& row, int& q) {
    const int l = lt & 63, lw = lt >> 6, grp = l >> 4, s = NCHUNK * lw + i;
    const int rb = (C == 128) ? (s >> 1) : s, qb = (C == 128) ? 8 * (s & 1) : 0;
    row = 8 * rb + (l & 7); q = qb + 4 * (grp >> 1) + (grp & 1) + 2 * ((l >> 3) & 1);
}
template <int C, int NCHUNK> __device__ __forceinline__ void ld_tile(const bf16* src, int lt, v4u (&reg)[NCHUNK]) {
#pragma unroll
    for (int i = 0; i < NCHUNK; ++i) { int row, q; tile_rq<C, NCHUNK>(lt, i, row, q); reg[i] = *(const v4u*)(src + (size_t)row * C + 8 * q); }
}
template <int C, int NCHUNK> __device__ __forceinline__ void st_tile(LAS unsigned char* base, int lt, const v4u (&reg)[NCHUNK]) {
#pragma unroll
    for (int i = 0; i < NCHUNK; ++i) { int row, q; tile_rq<C, NCHUNK>(lt, i, row, q); const int ks = q >> 2, qq = q & 3;
        LAS unsigned char* d0 = base + ((row >> 4) * (C / 32) + ks) * 1024 + ((2 * (qq & 1)) * 16 + (row & 15)) * 16 + (qq >> 1) * 8;
        *(LAS u32x2*)d0 = (u32x2){reg[i].x, reg[i].y}; *(LAS u32x2*)(d0 + 256) = (u32x2){reg[i].z, reg[i].w}; }
}
__device__ __forceinline__ s16x8 pack_b(f32x4 a, f32x4 b) { v4u w; w.x = pk2(a.x, a.y); w.y = pk2(a.z, a.w); w.z = pk2(b.x, b.y); w.w = pk2(b.z, b.w); return __builtin_bit_cast(s16x8, w); }
#define MF16(a, b, c) __builtin_amdgcn_mfma_f32_16x16x32_bf16(a, b, c, 0, 0, 0)
template <bool DRY, int SKIP = 0> __device__ __forceinline__ void scan_task(Frame& F, int cn0, int nchunk, int h, int hf, const float* s0, float* sout, bool write_s) {
    const int lane = F.lane, wave = F.wave, e = lane & 15, g = lane >> 4;
    LAS unsigned char* ring = F.lds;
    if (wave >= 4) {
#ifndef SCAN_NO_LOADER
        const int lt = F.tid - 256; v4u rw[4], rq[4], rk[4], ri[2], sw[4], sq[4], sk[4], si[2];
#define LD_SET(cn, W, Q, K, I) do { const size_t blk_ = (size_t)((cn) * 8 + h) * 8192; ld_tile<128, 4>(((bf16*)(F.ws + WS_U1)) + blk_, lt, W); ld_tile<128, 4>(((bf16*)(F.ws + WS_U5)) + blk_, lt, Q); ld_tile<64, 4>(((bf16*)(F.ws + WS_U2)) + blk_, lt, K); ld_tile<64, 2>(((bf16*)(F.ws + WS_INTRA)) + (size_t)((cn) * 8 + h) * 4096, lt, I); } while (0)
#define ST_SET(st, W, Q, K, I) do { LAS unsigned char* b_ = ring + (st) * SC_STAGE; st_tile<128, 4>(b_ + SC_WN, lt, W); st_tile<128, 4>(b_ + SC_QP, lt, Q); st_tile<64, 4>(b_ + SC_KPT, lt, K); st_tile<64, 2>(b_ + SC_IN, lt, I); } while (0)
        if (!(SKIP & 1)) { LD_SET(cn0, rw, rq, rk, ri); ST_SET(0, rw, rq, rk, ri); if (nchunk > 1) LD_SET(cn0 + 1, sw, sq, sk, si); if (nchunk > 2) LD_SET(cn0 + 2, rw, rq, rk, ri); }
        LDS_WAIT(); __builtin_amdgcn_s_barrier();
#pragma unroll 1
        for (int n = 0; n < nchunk; ++n) {
            if (n + 1 < nchunk && !(SKIP & 1)) {
                if (n & 1) { ST_SET(0, rw, rq, rk, ri); if (n + 3 < nchunk) LD_SET(cn0 + n + 3, rw, rq, rk, ri); }
                else { ST_SET(1, sw, sq, sk, si); if (n + 3 < nchunk) LD_SET(cn0 + n + 3, sw, sq, sk, si); } }
            LDS_WAIT(); __builtin_amdgcn_s_barrier();
        }
#undef LD_SET
#undef ST_SET
#endif
    } else {
#ifndef SCAN_NO_SCAN
        const int e0 = 64 * hf + 16 * wave + e;
        f32x4 S[8];
#pragma unroll
        for (int dt = 0; dt < 8; ++dt) { const float* p = (const float*)((const char*)s0 + (size_t)((unsigned)((16 * dt + 4 * g) * 128 + e0) * 4u)); S[dt] = (f32x4){p[0], p[128], p[256], p[384]}; }
        u32x2 ucur[4], unext[4];
        { const bf16* up = ((bf16*)(F.ws + WS_U3)) + ((size_t)(cn0 * 8 + h) * 128 + e0) * 64 + 4 * g;
#pragma unroll
          for (int mt = 0; mt < 4; ++mt) ucur[mt] = *(const u32x2*)(up + 16 * mt); }
        __builtin_amdgcn_s_barrier();
#pragma unroll 1
        for (int n = 0; n < nchunk; ++n) {
            const int cn = cn0 + n; const LAS unsigned char* st = ring + (n & 1) * SC_STAGE + lane * 16;
            const float gl = ((float*)(F.ws + WS_GL))[cn * 8 + h];
            bf16* op = ((bf16*)(F.ws + WS_U3)) + ((size_t)(cn * 8 + h) * 128 + e0) * 64 + 4 * g;
            if (n + 1 < nchunk) {
#pragma unroll
                for (int mt = 0; mt < 4; ++mt) unext[mt] = *(const u32x2*)(op + 8 * 128 * 64 + 16 * mt); }
            if (SKIP & 2) { LDS_WAIT(); __builtin_amdgcn_s_barrier(); continue; }
            s16x8 Sb[4];
#pragma unroll
            for (int ks = 0; ks < 4; ++ks) Sb[ks] = pack_b(S[2 * ks], S[2 * ks + 1]);
            f32x4 Vn[4], O[4];
#pragma unroll
            for (int mt = 0; mt < 4; ++mt) { Vn[mt] = (f32x4){bflo(ucur[mt].x), bfhi(ucur[mt].x), bflo(ucur[mt].y), bfhi(ucur[mt].y)}; O[mt] = (f32x4){0.f, 0.f, 0.f, 0.f}; }
            s16x8 fa[8], fb[8];
#define FENCE() asm volatile("" ::: "memory")
#define LD_WQ(dst, mt) do { _Pragma("unroll") for (int ks = 0; ks < 4; ++ks) { dst[ks] = *(const LAS s16x8*)(st + SC_WN + ((mt) * 4 + ks) * 1024); dst[4 + ks] = *(const LAS s16x8*)(st + SC_QP + ((mt) * 4 + ks) * 1024); } } while (0)
#define MM_WQ(src, mt) do { _Pragma("unroll") for (int ks = 0; ks < 4; ++ks) { Vn[mt] = MF16(src[ks], Sb[ks], Vn[mt]); O[mt] = MF16(src[4 + ks], Sb[ks], O[mt]); } } while (0)
#define LD_4(dst, off, a) do { _Pragma("unroll") for (int i_ = 0; i_ < 4; ++i_) dst[i_] = *(const LAS s16x8*)(st + (off) + ((a) * 4 + i_) * 1024); } while (0)
#define MM_IN(src, mp) do { O[2 * (mp)] = MF16(src[0], Vb[0], O[2 * (mp)]); O[2 * (mp)] = MF16(src[1], Vb[1], O[2 * (mp)]); O[2 * (mp) + 1] = MF16(src[2], Vb[0], O[2 * (mp) + 1]); O[2 * (mp) + 1] = MF16(src[3], Vb[1], O[2 * (mp) + 1]); } while (0)
#define MM_KP(src, dp) do { S[2 * (dp)] = MF16(src[0], Vb[0], S[2 * (dp)]); S[2 * (dp)] = MF16(src[1], Vb[1], S[2 * (dp)]); S[2 * (dp) + 1] = MF16(src[2], Vb[0], S[2 * (dp) + 1]); S[2 * (dp) + 1] = MF16(src[3], Vb[1], S[2 * (dp) + 1]); } while (0)
            LD_WQ(fa, 0); FENCE(); LD_WQ(fb, 1); MM_WQ(fa, 0); FENCE(); LD_WQ(fa, 2); MM_WQ(fb, 1); FENCE(); LD_WQ(fb, 3); MM_WQ(fa, 2); FENCE(); LD_4(fa, SC_IN, 0); MM_WQ(fb, 3); FENCE();
#pragma unroll
            for (int dt = 0; dt < 8; ++dt) S[dt] = S[dt] * gl;
            s16x8 Vb[2];
#pragma unroll
            for (int k2 = 0; k2 < 2; ++k2) Vb[k2] = pack_b(Vn[2 * k2], Vn[2 * k2 + 1]);
            LD_4(fb, SC_IN, 1); MM_IN(fa, 0); FENCE(); LD_4(fa, SC_KPT, 0); MM_IN(fb, 1); FENCE(); LD_4(fb, SC_KPT, 1); MM_KP(fa, 0); FENCE(); LD_4(fa, SC_KPT, 2); MM_KP(fb, 1); FENCE(); LD_4(fb, SC_KPT, 3); MM_KP(fa, 2); FENCE(); MM_KP(fb, 3);
#undef FENCE
#undef LD_WQ
#undef MM_WQ
#undef LD_4
#undef MM_IN
#undef MM_KP
#pragma unroll
            for (int mt = 0; mt < 4; ++mt) { u32x2 w; w.x = pk2(O[mt].x, O[mt].y); w.y = pk2(O[mt].z, O[mt].w); if (!DRY) *(u32x2*)(op + 16 * mt) = w; else asm volatile("" :: "v"(w.x), "v"(w.y)); ucur[mt] = unext[mt]; }
            LDS_WAIT(); __builtin_amdgcn_s_barrier();
        }
        { unsigned so = (unsigned)((4 * g) * 128 + e0) * 4u; asm volatile("" : "+v"(so));
#pragma unroll
          for (int dt = 0; dt < 8; ++dt) { float* p = (float*)((char*)sout + (size_t)(so + dt * 8192u)); if (!DRY && write_s) { p[0] = S[dt].x; p[128] = S[dt].y; p[256] = S[dt].z; p[384] = S[dt].w; } else asm volatile("" :: "v"(S[dt].x), "v"(S[dt].y), "v"(S[dt].z), "v"(S[dt].w)); } }
#endif
    }
}

__device__ __forceinline__ void scanA_task(Frame& F, int cn0, int nchunk, int h, int hf, float* sout, bf16* mout) {
    const int lane = F.lane, wave = F.wave, e = lane & 15, g = lane >> 4;
    LAS unsigned char* ring = F.lds;
    if (wave >= 4) {
        const int lt = F.tid - 256; v4u rw[4], rk[4];
#define LD_A(cn) do { const size_t blk_ = (size_t)((cn) * 8 + h) * 8192; ld_tile<128, 4>(((bf16*)(F.ws + WS_U1)) + blk_, lt, rw); ld_tile<64, 4>(((bf16*)(F.ws + WS_U2)) + blk_, lt, rk); } while (0)
#define ST_A(st) do { LAS unsigned char* b_ = ring + (st) * SC_STAGE; st_tile<128, 4>(b_ + SC_WN, lt, rw); st_tile<64, 4>(b_ + SC_KPT, lt, rk); } while (0)
        LD_A(cn0); ST_A(0); if (nchunk > 1) LD_A(cn0 + 1);
        LDS_WAIT(); __builtin_amdgcn_s_barrier();
#pragma unroll 1
        for (int n = 0; n < nchunk; ++n) {
            if (n + 1 < nchunk) { ST_A((n + 1) & 1); if (n + 2 < nchunk) LD_A(cn0 + n + 2); }
            LDS_WAIT(); __builtin_amdgcn_s_barrier();
        }
#undef LD_A
#undef ST_A
    } else {
        const int e0 = 64 * hf + 16 * wave + e;
        f32x4 S[8], X[8];
#pragma unroll
        for (int dt = 0; dt < 8; ++dt) { S[dt] = (f32x4){0.f, 0.f, 0.f, 0.f}; const int d0 = 16 * dt + 4 * g;
            X[dt] = (f32x4){d0 == e0 ? 1.f : 0.f, d0 + 1 == e0 ? 1.f : 0.f, d0 + 2 == e0 ? 1.f : 0.f, d0 + 3 == e0 ? 1.f : 0.f}; }
        u32x2 ucur[4], unext[4];
        { const bf16* up = ((bf16*)(F.ws + WS_U3)) + ((size_t)(cn0 * 8 + h) * 128 + e0) * 64 + 4 * g;
#pragma unroll
          for (int mt = 0; mt < 4; ++mt) ucur[mt] = *(const u32x2*)(up + 16 * mt); }
        __builtin_amdgcn_s_barrier();
#pragma unroll 1
        for (int n = 0; n < nchunk; ++n) {
            const int cn = cn0 + n; const LAS unsigned char* st = ring + (n & 1) * SC_STAGE + lane * 16;
            const float gl = ((float*)(F.ws + WS_GL))[cn * 8 + h];
            const bf16* op = ((bf16*)(F.ws + WS_U3)) + ((size_t)(cn * 8 + h) * 128 + e0) * 64 + 4 * g;
            if (n + 1 < nchunk) {
#pragma unroll
                for (int mt = 0; mt < 4; ++mt) unext[mt] = *(const u32x2*)(op + 8 * 128 * 64 + 16 * mt); }
            s16x8 Sb[4], Xb[4];
#pragma unroll
            for (int ks = 0; ks < 4; ++ks) { Sb[ks] = pack_b(S[2 * ks], S[2 * ks + 1]); Xb[ks] = pack_b(X[2 * ks], X[2 * ks + 1]); }
            f32x4 Vn[4], Vx[4];
#pragma unroll
            for (int mt = 0; mt < 4; ++mt) { Vn[mt] = (f32x4){bflo(ucur[mt].x), bfhi(ucur[mt].x), bflo(ucur[mt].y), bfhi(ucur[mt].y)}; Vx[mt] = (f32x4){0.f, 0.f, 0.f, 0.f}; }
#pragma unroll
            for (int mt = 0; mt < 4; ++mt)
#pragma unroll
                for (int ks = 0; ks < 4; ++ks) { const s16x8 aw = *(const LAS s16x8*)(st + SC_WN + (mt * 4 + ks) * 1024);
                    Vn[mt] = MF16(aw, Sb[ks], Vn[mt]); Vx[mt] = MF16(aw, Xb[ks], Vx[mt]); if (ks == 3) asm volatile("" ::: "memory"); }
#pragma unroll
            for (int dt = 0; dt < 8; ++dt) { S[dt] = S[dt] * gl; X[dt] = X[dt] * gl; }
            s16x8 Vb[2], Wb[2];
#pragma unroll
            for (int k2 = 0; k2 < 2; ++k2) { Vb[k2] = pack_b(Vn[2 * k2], Vn[2 * k2 + 1]); Wb[k2] = pack_b(Vx[2 * k2], Vx[2 * k2 + 1]); }
#pragma unroll
            for (int dt = 0; dt < 8; ++dt)
#pragma unroll
                for (int k2 = 0; k2 < 2; ++k2) { const s16x8 ak = *(const LAS s16x8*)(st + SC_KPT + (dt * 2 + k2) * 1024); S[dt] = MF16(ak, Vb[k2], S[dt]); X[dt] = MF16(ak, Wb[k2], X[dt]); if (k2 == 1 && (dt & 1)) asm volatile("" ::: "memory"); }
#pragma unroll
            for (int mt = 0; mt < 4; ++mt) ucur[mt] = unext[mt];
            LDS_WAIT(); __builtin_amdgcn_s_barrier();
        }
        { unsigned so = (unsigned)((4 * g) * 128 + e0); asm volatile("" : "+v"(so));
#pragma unroll
          for (int dt = 0; dt < 8; ++dt) { float* p = sout + so + dt * 2048u; p[0] = S[dt].x; p[128] = S[dt].y; p[256] = S[dt].z; p[384] = S[dt].w;
              bf16* q = mout + so + dt * 2048u; q[0] = (bf16)f2bf(X[dt].x); q[128] = (bf16)f2bf(X[dt].y); q[256] = (bf16)f2bf(X[dt].z); q[384] = (bf16)f2bf(X[dt].w); } }
    }
}
__device__ __forceinline__ void scanB_task(Frame& F, int ngroups, int h, int cq, const bf16* MG, float* SG) {
    const int lane = F.lane, e = lane & 15, g4 = lane >> 4, cb = F.wave & 1, rq = F.wave >> 1;
    LAS unsigned char* ring = F.lds; LAS unsigned char* XB = ring + 2 * SC_STAGE;
    const int e0 = 32 * cq + 16 * cb + e; const size_t roff = (size_t)(32 * rq + 4 * g4) * 128 + e0;
    v4u rm[3][4]; f32x4 Bq[3][2];
    ld_tile<128, 4>(MG + (size_t)h * 16384, F.tid, rm[0]); st_tile<128, 4>(ring, F.tid, rm[0]);
    if (1 < ngroups) ld_tile<128, 4>(MG + (size_t)(1 * 8 + h) * 16384, F.tid, rm[1]);
    if (2 < ngroups) ld_tile<128, 4>(MG + (size_t)(2 * 8 + h) * 16384, F.tid, rm[2]);
    if (3 < ngroups) ld_tile<128, 4>(MG + (size_t)(3 * 8 + h) * 16384, F.tid, rm[0]);
#pragma unroll
    for (int q = 0; q < 3; ++q) if (q < ngroups) { const float* bp0 = SG + (size_t)(q * 8 + h) * 16384 + roff;
#pragma unroll
        for (int dt = 0; dt < 2; ++dt) { const float* p = bp0 + dt * 2048; Bq[q][dt] = (f32x4){p[0], p[128], p[256], p[384]}; } }
    *(LAS v4u*)(XB + (cb * 4 + rq) * 1024 + lane * 16) = (v4u){0u, 0u, 0u, 0u};
    LDS_WAIT(); __builtin_amdgcn_s_barrier();
#pragma unroll 1
    for (int n0 = 0; n0 < ngroups; n0 += 3) {
#pragma unroll
        for (int j = 0; j < 3; ++j) { const int n = n0 + j;
            if (n < ngroups) {
                const LAS unsigned char* st = ring + (n & 1) * SC_STAGE + lane * 16;
                const LAS unsigned char* xr = XB + (((n & 1) * 2 + cb) * 4) * 1024 + lane * 16;
                s16x8 Sb[4];
#pragma unroll
                for (int ks = 0; ks < 4; ++ks) Sb[ks] = *(const LAS s16x8*)(xr + ks * 1024);
                f32x4 S[2];
#pragma unroll
                for (int dt = 0; dt < 2; ++dt) { f32x4 acc = Bq[j][dt];
#pragma unroll
                    for (int ks = 0; ks < 4; ++ks) { const s16x8 am = *(const LAS s16x8*)(st + ((2 * rq + dt) * 4 + ks) * 1024); acc = MF16(am, Sb[ks], acc); }
                    S[dt] = acc; }
                *(LAS s16x8*)(XB + (((((n + 1) & 1) * 2 + cb) * 4) + rq) * 1024 + lane * 16) = pack_b(S[0], S[1]);
                if (n + 1 < ngroups) st_tile<128, 4>(ring + ((n + 1) & 1) * SC_STAGE, F.tid, rm[(j + 1) % 3]);
                if (n + 4 < ngroups) ld_tile<128, 4>(MG + (size_t)((n + 4) * 8 + h) * 16384, F.tid, rm[(j + 1) % 3]);
                float* bp = SG + (size_t)(n * 8 + h) * 16384 + roff;
                if (n + 3 < ngroups) {
#pragma unroll
                    for (int dt = 0; dt < 2; ++dt) { const float* p = bp + 3 * 8 * 16384 + dt * 2048; Bq[j][dt] = (f32x4){p[0], p[128], p[256], p[384]}; } }
#pragma unroll
                for (int dt = 0; dt < 2; ++dt) { float* p = bp + dt * 2048; p[0] = S[dt].x; p[128] = S[dt].y; p[256] = S[dt].z; p[384] = S[dt].w; }
                LDS_WAIT(); __builtin_amdgcn_s_barrier(); } }
    }
}
#undef MF16
constexpr int SCAN_NG = 16, SCAN_GC = 16;
constexpr size_t WS_MG = 242 * MiB, WS_SG = 246 * MiB;
__device__ __forceinline__ void scanA_phase(Frame& F) {
    const int bx = blockIdx.x; bf16* MG = (bf16*)(F.ws + WS_MG); float* SG = (float*)(F.ws + WS_SG);
    if (bx < (SCAN_NG - 1) * 16) { const int gq = bx >> 4, h = bx & 7, hf = (bx >> 3) & 1;
        scanA_task(F, gq * SCAN_GC, SCAN_GC, h, hf, SG + (size_t)(gq * 8 + h) * 16384, MG + (size_t)(gq * 8 + h) * 16384); }
    for (int t = (bx + 16) % F.G; t < 512; t += F.G) { const int b = t >> 4, h = t & 7, hf = (t >> 3) & 1;
        scan_task<false>(F, 256 + b, 1, h, hf, ((const float*)(F.in[3])) + (size_t)(b * 8 + h) * 16384, F.out + OFF_SS + (size_t)(b * 8 + h) * 16384, true); }
}
constexpr int SCANB_WGS = 32;
__device__ __forceinline__ void scanB_phase(Frame& F) { const int bx = blockIdx.x; for (int t = bx; t < SCANB_WGS; t += F.G) { scanB_task(F, SCAN_NG - 1, t & 7, t >> 3, (const bf16*)(F.ws + WS_MG), (float*)(F.ws + WS_SG)); __syncthreads(); } }
template <bool DRY, int SKIP = 0> __device__ __forceinline__ void scanC_phase(Frame& F) {
    const int bx = blockIdx.x;
    for (int t = bx; t < SCAN_NG * 16; t += F.G) { const int gq = t >> 4, h = t & 7, hf = (t >> 3) & 1;
        const float* s0 = gq == 0 ? (const float*)(F.ws + WS_CTL + 512 * 1024) : (const float*)(F.ws + WS_SG) + (size_t)((gq - 1) * 8 + h) * 16384;
        scan_task<DRY, SKIP>(F, gq * SCAN_GC, SCAN_GC, h, hf, s0, F.out + OFF_PS + (size_t)h * 16384, gq == SCAN_NG - 1); }
}
struct NgRegs { unsigned short o[16]; v4u z0, z1; };
__device__ __forceinline__ void ng_load(Frame& F, int it, int c, int eg, NgRegs& r) {
    const int cn = it >> 3, h = it & 7;
    const bf16* op = ((bf16*)(F.ws + WS_U3)) + ((size_t)(cn * 8 + h) * 128 + 16 * eg) * 64 + c;
#pragma unroll
    for (int i = 0; i < 16; ++i) r.o[i] = op[i * 64];
    const size_t ro = (size_t)(cn * 64 + c) * D + h * 128 + 16 * eg;
    r.z0 = *(const v4u*)(((bf16*)(F.ws + WS_U2)) + ro); r.z1 = *(const v4u*)(((bf16*)(F.ws + WS_U2)) + ro + 8);
}
__device__ __forceinline__ void normgate_phase(Frame& F) {
    const int tid = F.tid, c = tid & 63, eg = F.wave; LAS float* red = (LAS float*)F.lds;
    int it = F.vcu; if (it >= NCH * 8) return;
    NgRegs cur, nxt; ng_load(F, it, c, eg, cur); int par = 0;
    const float* nw = (F.in[16]) + 16 * eg;
#pragma unroll 1
    for (; it < NCH * 8; it += F.G) {
        const bool has_next = it + F.G < NCH * 8;
        if (has_next) ng_load(F, it + F.G, c, eg, nxt);
        float o[16]; float ss = 0.f;
#pragma unroll
        for (int i = 0; i < 16; ++i) { o[i] = bf2f(cur.o[i]); ss += o[i] * o[i]; }
        LAS float* rd = red + par * 512; rd[eg * 64 + c] = ss;
        __syncthreads();
        float tot = 0.f;
#pragma unroll
        for (int w = 0; w < 8; ++w) tot += rd[w * 64 + c];
        const float ri = __builtin_amdgcn_rsqf(tot * (1.f / 128.f) + EPS);
        const unsigned zz[8] = {cur.z0.x, cur.z0.y, cur.z0.z, cur.z0.w, cur.z1.x, cur.z1.y, cur.z1.z, cur.z1.w}; unsigned w[8];
#pragma unroll
        for (int i = 0; i < 8; ++i) w[i] = pk2(o[2 * i] * ri * nw[2 * i] * siluf(bflo(zz[i])), o[2 * i + 1] * ri * nw[2 * i + 1] * siluf(bfhi(zz[i])));
        const int cn = it >> 3, h = it & 7;
        bf16* dst = ((bf16*)(F.ws + WS_U1)) + (size_t)(cn * 64 + c) * D + h * 128 + 16 * eg;
        *(v4u*)dst = (v4u){w[0], w[1], w[2], w[3]}; *(v4u*)(dst + 8) = (v4u){w[4], w[5], w[6], w[7]};
        cur = nxt; par ^= 1;
    }
}
#ifndef PREP_STAGGER
#define PREP_STAGGER 3
#endif
#ifndef PREP_DROP
#define PREP_DROP 2
#endif
__device__ __forceinline__ int prep_unit_id(const Frame& F, int i) {
    if (F.G != 256) { const long it = (long)F.vcu + (long)i * F.G; return it < NCH * 8 ? (int)it : -1; }
    const int v = F.vcu;
    if (v < 64) return i < 9 - PREP_DROP ? v + 256 * i : -1;
    if (i < 9) return v + 256 * i;
    const int e = (v - 64) >> 3;
    return (i == 9 && e < 8 * PREP_DROP) ? 8 * (e & 7) + (v & 7) + 256 * (9 - PREP_DROP + (e >> 3)) : -1;
}
#ifndef ADA_NA
#define ADA_NA 0
#endif
enum Phase { PH_P0 = 0, PH_H1, PH_G1, PH_G2, PH_H2, PH_F1, PH_PREP, PH_SCAN, PH_SCANB, PH_SCANC, PH_F2, PH_NG, PH_G4A, PH_G4B, PH_G5, PH_H3, PH_G6, PH_G7, PH_FIN, PH_COUNT };
struct Args { const float* in[28]; float* out; unsigned char* ws; int ph_lo, ph_hi; };
static_assert(sizeof(Args) == 28 * 8 + 8 + 8 + 8, "Args has no padding");

#ifdef ONLY_PH
#define PHON(x) ((x) == ONLY_PH)
#else
#define PHON(x) true
#endif
template <class Epi> __device__ __forceinline__ void run_gemm(Frame& F, const bf16* A, const bf16* Bt, int N, int K, const Epi& E, int lda = 0) {
    pg8::Gemm g{A, Bt, M, N, K, lda}; pg8::StaticOrder S; S.init(M, N, F.G, (int)blockIdx.x); S.ntf = K / 64;
    pg8::gemm_phase<Epi, pg8::StaticOrder, PG8_ALIGN, PG8_SP2>(F.lds, g, S, E);
}

struct SplitOrder : pg8::StaticOrder {
    bool split; int probe2 = 0; bool only_first = false;
    __device__ __forceinline__ bool next(int i, pg8::Unit& u) const {
        if (!split) return pg8::StaticOrder::next(i, u);
        if (only_first && i > 0) return false;
        if (probe2) { if (i > 0) return false; i = 1; }
        if (i > 1) return false;
        const int x = c & 7, j = c >> 3;
        if (i == 0) { u.pm = 8 * x + (j & 7); u.pn = j >> 3; u.k0 = 0; u.nt = ntf; u.piece = 0; u.lidx = 0; return true; }
        const int P = 8, pc = x, pairs = ntf / 2, base = pairs / P, extra = pairs - base * P;
        u.pm = 64 + (j & 7); u.pn = j >> 3; u.lidx = (j & 7) * 4 + (j >> 3);
        u.k0 = 2 * (pc * base + (pc < extra ? pc : extra)); u.nt = 2 * (base + (pc < extra ? 1 : 0)); u.piece = pc + 1; if (probe2 == 2) u.nt = 2; return true;
    }
};
struct PiecesAB : pg8::StaticOrder {
    __device__ __forceinline__ bool next(int i, pg8::Unit& u) const {
        if (i > 0) return false;
        const int x = c & 7, j = c >> 3;
        u.pm = 64 + (j & 7); u.pn = j >> 3; u.lidx = (j & 7) * 4 + (j >> 3); u.k0 = 4 * (x & 3); u.nt = 4; u.piece = x + 1; return true;
    }
};
__device__ __forceinline__ void branch_fixup_rows(Frame& F, const bf16* part) {
    const int gw = F.vcu * NWAVES + F.wave, NGW = F.G * NWAVES;
    for (int m = MP + gw; m < M; m += NGW) {
        GAS u32x2* ga = (GAS u32x2*)(((bf16*)(F.ws + WS_U5)) + (size_t)m * D) + F.lane; const GAS u32x2* gb = (const GAS u32x2*)(((bf16*)(F.ws + WS_U6)) + (size_t)m * D) + F.lane;
#pragma unroll
        for (int j = 0; j < 4; ++j) { const int li = ((m >> 8) - 64) * 4 + j;
            const GAS u32x2* pp = (const GAS u32x2*)(part + (size_t)li * 8 * 65536 + (size_t)(m & 255) * 256) + F.lane; f32x4 sa = (f32x4){0.f, 0.f, 0.f, 0.f}, sb = sa;
#pragma unroll
            for (int p = 0; p < 4; ++p) { const u32x2 w = pp[(size_t)p * 16384]; sa += (f32x4){bflo(w.x), bfhi(w.x), bflo(w.y), bfhi(w.y)}; }
#pragma unroll
            for (int p = 4; p < 8; ++p) { const u32x2 w = pp[(size_t)p * 16384]; sb += (f32x4){bflo(w.x), bfhi(w.x), bflo(w.y), bfhi(w.y)}; }
            const u32x2 a = ga[64 * j], b = gb[64 * j];
            const f32x4 o = (f32x4){sigm(bflo(a.x)) * sa.x + sigm(bflo(b.x)) * sb.x, sigm(bfhi(a.x)) * sa.y + sigm(bfhi(b.x)) * sb.y, sigm(bflo(a.y)) * sa.z + sigm(bflo(b.y)) * sb.z, sigm(bfhi(a.y)) * sa.w + sigm(bfhi(b.y)) * sb.w};
            ga[64 * j] = (u32x2){pk2(o.x, o.y), pk2(o.z, o.w)}; }
    }
}
template <class Epi> __device__ __forceinline__ void run_gemm_split(Frame& F, const bf16* A, const bf16* Bt, int N, int K, const Epi& E, int probe = 0) {
    pg8::Gemm g{A, Bt, M, N, K, 0}; SplitOrder S; S.init(M, N, F.G, (int)blockIdx.x); S.ntf = K / 64; S.split = (F.G == 256); S.only_first = (probe == 2); S.probe2 = probe >= 3 ? probe - 2 : 0;
    pg8::gemm_phase<Epi, SplitOrder, PG8_ALIGN, PG8_SP2>(F.lds, g, S, E);
}
__global__ void __launch_bounds__(NWAVES * 64, 2) mega_fwd(Args args) {
    extern __shared__ __attribute__((aligned(16))) unsigned char lds[];
    Frame F;
    F.lds = (LAS unsigned char*)lds; F.MISC = (volatile LAS unsigned*)(F.lds + MISC_OFF);
    F.tid = threadIdx.x; F.lane = F.tid & 63; F.wave = __builtin_amdgcn_readfirstlane(F.tid >> 6);
    F.G = gridDim.x; { const int bx = blockIdx.x; F.vcu = (F.G % 8 == 0) ? (bx % 8) * (F.G / 8) + bx / 8 : bx; }
    unsigned char* ws = args.ws; F.ctl = (gu32*)(ws + WS_CTL);
    F.in = args.in; F.out = args.out; F.ws = ws;
    for (int u = F.tid; u < (LDS_BYTES - LDSCTL_OFF) / 4; u += NWAVES * 64) ((LAS unsigned*)(F.lds + LDSCTL_OFF))[u] = 0u;
    __syncthreads();
    XcdBarrier bar; bar.bar = (unsigned*)(F.ctl + CW_BAR); bar.x = 0; bar.st = nullptr;
    const bool multi = args.ph_hi - args.ph_lo > 1;
    if (multi) bar = xcd_barrier_post((unsigned*)(F.ctl + CW_BAR), F.MISC + 8);

    const int lo = args.ph_lo, hi = args.ph_hi;
#if defined(PROBE_TS)
    if (blockIdx.x == 0 && F.tid == 0) ((volatile LAS unsigned long long*)(F.lds + LDSCTL_OFF + 512))[0] = __builtin_amdgcn_s_memrealtime();
#endif
#define IN(k) (PHON(k) && lo <= (k) && (k) < hi)
#define SEAM(k) do { if (lo <= (k) && (k) + 1 < hi) xcd_barrier(bar); } while (0)
#if defined(PROBE_TS)
#undef SEAM
#define SEAM(k) do { if (lo <= (k) && (k) + 1 < hi) xcd_barrier(bar); if (blockIdx.x == 0 && F.tid == 0) ((volatile LAS unsigned long long*)(F.lds + LDSCTL_OFF + 512))[(k) + 1] = __builtin_amdgcn_s_memrealtime(); } while (0)
#endif
#if defined(PROBE_P0)
    if (IN(PH_P0)) { { { const bool sp = F.G >= 160; const int nB = sp ? (FFN_I_ALL - 144 * ADA_NA + F.G - 145) / (F.G - 144) : (FFN_I_ALL + F.G - 1) / F.G; const int tlo = !sp ? F.vcu * nB : F.vcu < 144 ? F.vcu * ADA_NA : 144 * ADA_NA + (F.vcu - 144) * nB; const int thi = tlo + ((sp && F.vcu < 144) ? ADA_NA : nB);
        for (int it = F.vcu; it < 144; it += F.G) ada_item(F, it); convert_ffn_range(F, (F.in[9]), (F.in[10]), ((bf16*)(F.ws + WS_W)) + W_FIN, ((bf16*)(F.ws + WS_W)) + W_FOUT, tlo, thi); } }  xcd_barrier(bar); }
#endif
    if (IN(PH_P0)) { { { const bool sp = F.G >= 160; const int nB = sp ? (FFN_I_ALL - 144 * ADA_NA + F.G - 145) / (F.G - 144) : (FFN_I_ALL + F.G - 1) / F.G; const int tlo = !sp ? F.vcu * nB : F.vcu < 144 ? F.vcu * ADA_NA : 144 * ADA_NA + (F.vcu - 144) * nB; const int thi = tlo + ((sp && F.vcu < 144) ? ADA_NA : nB);
        for (int it = F.vcu; it < 144; it += F.G) ada_item(F, it); convert_ffn_range(F, (F.in[9]), (F.in[10]), ((bf16*)(F.ws + WS_W)) + W_FIN, ((bf16*)(F.ws + WS_W)) + W_FOUT, tlo, thi); } } }
    SEAM(PH_P0);
#if defined(PROBE_H1)
#if defined(PROBE_BAR)
    if (IN(PH_H1)) { for (int i_ = 0; i_ < 10; ++i_) xcd_barrier(bar); }
#endif
    if (IN(PH_H1)) { rmsmod_rows<false>(F, true, (F.in[8]), 0, ((bf16*)(F.ws + WS_U1)));  xcd_barrier(bar); }
#endif
    if (IN(PH_H1)) { rmsmod_rows<false>(F, true, (F.in[8]), 0, ((bf16*)(F.ws + WS_U1))); }
    SEAM(PH_H1);
#if defined(PROBE_G1)
    if (IN(PH_G1)) { run_gemm(F, ((bf16*)(F.ws + WS_U1)), ((bf16*)(F.ws + WS_W)) + W_FIN, 2 * DFF, D, EpiSwiglu{((bf16*)(F.ws + WS_U2))});  xcd_barrier(bar); }
#endif
    if (IN(PH_G1)) { run_gemm(F, ((bf16*)(F.ws + WS_U1)), ((bf16*)(F.ws + WS_W)) + W_FIN, 2 * DFF, D, EpiSwiglu{((bf16*)(F.ws + WS_U2))}); }
    SEAM(PH_G1);
#if defined(PROBE_G2)
    if (IN(PH_G2)) { run_gemm_split(F, ((bf16*)(F.ws + WS_U2)), ((bf16*)(F.ws + WS_W)) + W_FOUT, D, DFF, EpiResid<true>{(F.in[0]), (F.in[1]), (bf16*)F.out, ((float*)(F.ws + WS_ADA)), 2, 0.5f, (bf16*)(F.ws + WS_U5)}, PROBE_G2);  xcd_barrier(bar); }
#endif
    if (IN(PH_G2)) { run_gemm_split(F, ((bf16*)(F.ws + WS_U2)), ((bf16*)(F.ws + WS_W)) + W_FOUT, D, DFF, EpiResid<true>{(F.in[0]), (F.in[1]), (bf16*)F.out, ((float*)(F.ws + WS_ADA)), 2, 0.5f, (bf16*)(F.ws + WS_U5)}); }
    SEAM(PH_G2);
#if defined(PROBE_H2)
    if (IN(PH_H2)) { { if (PROBE_H2 & 1) convert_mixer(F, 0, F.vcu * NWAVES + F.wave, F.G * NWAVES); __syncthreads(); if (PROBE_H2 & 2) rmsmod_rows<true>(F, false, (F.in[11]), 1, (bf16*)F.out + 1024, Leftover{F.G == 256 ? (const bf16*)(F.ws + WS_U5) : nullptr, true, 2, 0.5f}, 2048); if (PROBE_H2 & 4) rmsmod_rows<false>(F, false, (F.in[11]), 1, (bf16*)F.out + 1024, Leftover{F.G == 256 ? (const bf16*)(F.ws + WS_U5) : nullptr, true, 2, 0.5f}, 2048); }  xcd_barrier(bar); }
#endif
    if (IN(PH_H2)) { { convert_mixer(F, 0, F.vcu * NWAVES + F.wave, F.G * NWAVES); if (F.G != 256) convert_mixer(F, 1, F.vcu * NWAVES + F.wave, F.G * NWAVES); __syncthreads(); rmsmod_rows<true>(F, false, (F.in[11]), 1, (bf16*)F.out + 1024, Leftover{F.G == 256 ? (const bf16*)(F.ws + WS_U5) : nullptr, true, 2, 0.5f}, 2048); } }
    SEAM(PH_H2);
#if defined(PROBE_F1)
    if (IN(PH_F1)) { run_gemm(F, (bf16*)F.out + 1024, ((bf16*)(F.ws + WS_W)) + W_IN, 4352, D, EpiF1{((bf16*)(F.ws + WS_U1)), ((bf16*)(F.ws + WS_U2)), ((bf16*)(F.ws + WS_U3)), ((bf16*)(F.ws + WS_U4)), ((bf16*)(F.ws + WS_KV)), ((bf16*)(F.ws + WS_TAIL)), F.out}, 2048);  xcd_barrier(bar); }
#endif
    if (IN(PH_F1)) { run_gemm(F, (bf16*)F.out + 1024, ((bf16*)(F.ws + WS_W)) + W_IN, 4352, D, EpiF1{((bf16*)(F.ws + WS_U1)), ((bf16*)(F.ws + WS_U2)), ((bf16*)(F.ws + WS_U3)), ((bf16*)(F.ws + WS_U4)), ((bf16*)(F.ws + WS_KV)), ((bf16*)(F.ws + WS_TAIL)), F.out}, 2048); }
    SEAM(PH_F1);
#if defined(PROBE_PREP)
    if (IN(PH_PREP)) { PrepRegs PR; int it = F.vcu; if (it < NCH * 8) prep_fetch(F, it, F.tid & 15, F.tid >> 4, PR); for (int par = 0; it < NCH * 8; it += F.G, par ^= 1) gdn_prep_unit<true, PROBE_PREP>(F, it >> 3, it & 7, PR, it + F.G < NCH * 8 ? it + F.G : -1, par); xcd_barrier(bar); }
#endif
#if defined(PROBE_SWA)
    if (IN(PH_PREP)) { for (int it = F.vcu; it < NCH * 2; it += F.G) swa_unit<true>(F, it >> 1, it & 1); xcd_barrier(bar); }
#endif
    if (IN(PH_PREP)) {
                        const int nsw0 = (F.G == 256) ? ((F.vcu >> 3) % PREP_STAGGER) : 0;
#ifndef NO_SWA
                        for (int k = 0; k < nsw0; ++k) { const int it = F.vcu + k * F.G; if (it < NCH * 2) swa_unit<false>(F, it >> 1, it & 1); }
#endif
#ifndef NO_PREP
                        for (int k = F.wave; prep_unit_id(F, k) >= 0; k += NWAVES) prep_gates(F, prep_unit_id(F, k), F.lane);
                        for (int i = F.tid; i < 12 * 128; i += NWAVES * 64) { const int tj = i >> 7, cc = i & 127; ((LAS float*)(F.lds + PR_CW))[i] = (F.in[13])[(tj & 3) * 3072 + (tj >> 2) * 1024 + (F.vcu & 7) * 128 + cc]; }
                        asm volatile("s_waitcnt vmcnt(0)" ::: "memory"); __syncthreads();
#if defined(PROBE_PS)
                        if (blockIdx.x == 0 && F.tid == 0) ((volatile LAS unsigned long long*)(F.lds + LDSCTL_OFF + 768))[15] = __builtin_amdgcn_s_memrealtime();
#endif
                        { PrepRegs PR; int it = prep_unit_id(F, 0); if (it >= 0) prep_fetch(F, it, F.tid & 15, F.tid >> 4, PR);
                          for (int i = 0; it >= 0; ++i) { const int itn = prep_unit_id(F, i + 1); gdn_prep_unit<false>(F, it >> 3, it & 7, PR, itn, i & 1); it = itn; } }
#endif
#ifndef NO_SWA
                        for (int it = F.vcu + nsw0 * F.G; it < NCH * 2; it += F.G) swa_unit<false>(F, it >> 1, it & 1);
#endif
                      }
    SEAM(PH_PREP);
#if defined(PROBE_SCANA)
    if (IN(PH_SCAN)) { scanA_phase(F); xcd_barrier(bar); }
#endif
    if (IN(PH_SCAN)) { scanA_phase(F); }
    SEAM(PH_SCAN);
    if (IN(PH_SCANB)) { scanB_phase(F); if (F.G == 256 && blockIdx.x >= SCANB_WGS) convert_mixer(F, 1, ((int)blockIdx.x - SCANB_WGS) * NWAVES + F.wave, (256 - SCANB_WGS) * NWAVES); }
    SEAM(PH_SCANB);
#if defined(PROBE_SCANC)
    if (IN(PH_SCANC)) { scanC_phase<true, PROBE_SCANC>(F); xcd_barrier(bar); }
#endif
    if (IN(PH_SCANC)) { scanC_phase<false>(F); }
    SEAM(PH_SCANC);
#if defined(PROBE_F2)
    if (IN(PH_F2)) { run_gemm(F, (bf16*)F.out + 1024, ((bf16*)(F.ws + WS_W)) + W_IN + (size_t)4352 * D, 3072, D, EpiF2{((bf16*)(F.ws + WS_U2)), ((bf16*)(F.ws + WS_U5)), ((bf16*)(F.ws + WS_U6))}, 2048);  xcd_barrier(bar); }
#endif
    if (IN(PH_F2)) { run_gemm(F, (bf16*)F.out + 1024, ((bf16*)(F.ws + WS_W)) + W_IN + (size_t)4352 * D, 3072, D, EpiF2{((bf16*)(F.ws + WS_U2)), ((bf16*)(F.ws + WS_U5)), ((bf16*)(F.ws + WS_U6))}, 2048);  if (F.G == 256 && blockIdx.x >= 96) { __syncthreads(); convert_ffn(F, (F.in[23]), (F.in[24]), (bf16*)(F.ws + WS_MG), nullptr, ((int)blockIdx.x - 96) * NWAVES + F.wave, 160 * NWAVES); } }
    SEAM(PH_F2);
#if defined(PROBE_NG)
    if (IN(PH_NG)) { normgate_phase(F);  xcd_barrier(bar); }
#endif
    if (IN(PH_NG)) { normgate_phase(F); }
    SEAM(PH_NG);
    if (IN(PH_G4A)) { if (F.G == 256) run_gemm_split(F, ((bf16*)(F.ws + WS_U1)), ((bf16*)(F.ws + WS_W)) + W_A, D, D, EpiGate<0>{((bf16*)(F.ws + WS_U5)), nullptr}, 2);
                      else run_gemm(F, ((bf16*)(F.ws + WS_U1)), ((bf16*)(F.ws + WS_W)) + W_A, D, D, EpiGate<0>{((bf16*)(F.ws + WS_U5)), nullptr}); }
    SEAM(PH_G4A);
    if (IN(PH_G4B)) { if (F.G == 256) { run_gemm_split(F, ((bf16*)(F.ws + WS_U4)), ((bf16*)(F.ws + WS_W)) + W_B, D, D, EpiGate<1>{((bf16*)(F.ws + WS_U5)), ((bf16*)(F.ws + WS_U6))}, 2);
                          const bool sb_ = ((blockIdx.x & 7) >> 2) != 0;
                          pg8::Gemm g{sb_ ? ((const bf16*)(F.ws + WS_U4)) : ((const bf16*)(F.ws + WS_U1)), ((const bf16*)(F.ws + WS_W)) + (sb_ ? W_B : W_A), M, D, D, 0}; PiecesAB S; S.init(M, D, F.G, (int)blockIdx.x); S.ntf = 16;
                          pg8::gemm_phase<EpiPart, PiecesAB, PG8_ALIGN, PG8_SP2>(F.lds, g, S, EpiPart{(bf16*)(F.ws + WS_U2)}); }
                      else run_gemm(F, ((bf16*)(F.ws + WS_U4)), ((bf16*)(F.ws + WS_W)) + W_B, D, D, EpiGate<1>{((bf16*)(F.ws + WS_U5)), ((bf16*)(F.ws + WS_U6))}); }
    SEAM(PH_G4B);
    if (IN(PH_G5) && F.G == 256) { branch_fixup_rows(F, (const bf16*)(F.ws + WS_U2)); xcd_barrier(bar); }
    if (IN(PH_G5)) { run_gemm_split(F, ((bf16*)(F.ws + WS_U5)), ((bf16*)(F.ws + WS_W)) + W_O, D, D, EpiResid<false>{nullptr, nullptr, (bf16*)F.out, ((float*)(F.ws + WS_ADA)), 5, 1.0f, (bf16*)(F.ws + WS_U2)}); }
    SEAM(PH_G5);
#if defined(PROBE_H3)
    if (IN(PH_H3)) { { convert_ffn(F, (F.in[23]), (F.in[24]), F.G == 256 ? nullptr : (bf16*)(F.ws + WS_MG), ((bf16*)(F.ws + WS_W)) + W_FOUT, F.vcu * NWAVES + F.wave, F.G * NWAVES); rmsmod_rows<false>(F, false, (F.in[22]), 2, ((bf16*)(F.ws + WS_U1)), Leftover{F.G == 256 ? (const bf16*)(F.ws + WS_U2) : nullptr, false, 5, 1.0f}); }  xcd_barrier(bar); }
#endif
    if (IN(PH_H3)) { { convert_ffn(F, (F.in[23]), (F.in[24]), F.G == 256 ? nullptr : (bf16*)(F.ws + WS_MG), ((bf16*)(F.ws + WS_W)) + W_FOUT, F.vcu * NWAVES + F.wave, F.G * NWAVES); rmsmod_rows<false>(F, false, (F.in[22]), 2, ((bf16*)(F.ws + WS_U1)), Leftover{F.G == 256 ? (const bf16*)(F.ws + WS_U2) : nullptr, false, 5, 1.0f}); } }
    SEAM(PH_H3);
#if defined(PROBE_G6)
    if (IN(PH_G6)) { run_gemm(F, ((bf16*)(F.ws + WS_U1)), ((bf16*)(F.ws + WS_W)) + W_FIN, 2 * DFF, D, EpiSwiglu{((bf16*)(F.ws + WS_U2))});  xcd_barrier(bar); }
#endif
    if (IN(PH_G6)) { run_gemm(F, ((bf16*)(F.ws + WS_U1)), (const bf16*)(F.ws + WS_MG), 2 * DFF, D, EpiSwiglu{((bf16*)(F.ws + WS_U2))}); }
    SEAM(PH_G6);
    if (IN(PH_G7)) { run_gemm_split(F, ((bf16*)(F.ws + WS_U2)), ((bf16*)(F.ws + WS_W)) + W_FOUT, D, DFF, EpiResid<false>{nullptr, nullptr, (bf16*)F.out, ((float*)(F.ws + WS_ADA)), 8, 0.5f, (bf16*)(F.ws + WS_U5)}); }
    SEAM(PH_G7);
    if (IN(PH_FIN)) { final_norm_rows(F, Leftover{F.G == 256 ? (const bf16*)(F.ws + WS_U5) : nullptr, false, 8, 0.5f}); }
    SEAM(PH_FIN);
#if defined(PROBE_TS)
    if (blockIdx.x == 0 && F.tid == 0) { volatile LAS unsigned long long* ts = (volatile LAS unsigned long long*)(F.lds + LDSCTL_OFF + 512); unsigned long long tot = 0;
        for (int k = 0; k < PH_COUNT; ++k) if ((PROBE_TS >> k) & 1) tot += ts[k + 1] - ts[k];
#if defined(PROBE_PS)
        tot += ((volatile LAS unsigned long long*)(F.lds + LDSCTL_OFF + 768))[PROBE_PS];
#endif
        const unsigned long long t0 = __builtin_amdgcn_s_memrealtime(); while (__builtin_amdgcn_s_memrealtime() - t0 < tot) __builtin_amdgcn_s_sleep(8); }
#endif
#undef IN
#undef SEAM
}

extern "C" void kernel_launch(void* const* d_in, const int* in_sizes, int n_in, void* d_out, int out_size, void* d_ws, size_t ws_size, hipStream_t stream) {
    static int grid = 0;
    if (grid == 0) {
        if (n_in != 28 || in_sizes[0] != MP * D || (size_t)out_size != OUT_TOTAL || ws_size < WS_END) { fprintf(stderr, "kernel_launch: unexpected shapes (n_in %d, in0 %d, out %d, ws %zu); nothing launched\n", n_in, n_in > 0 ? in_sizes[0] : -1, out_size, ws_size); grid = -1; return; }
        int dev = 0, cus = 0, per_cu = 0;
        if (hipGetDevice(&dev) != hipSuccess || hipDeviceGetAttribute(&cus, hipDeviceAttributeMultiprocessorCount, dev) != hipSuccess) { grid = -1; return; }
        if (hipFuncSetAttribute((const void*)mega_fwd, hipFuncAttributeMaxDynamicSharedMemorySize, LDS_BYTES) != hipSuccess) { fprintf(stderr, "kernel_launch: hipFuncSetAttribute failed\n"); grid = -1; return; }
        if (hipOccupancyMaxActiveBlocksPerMultiprocessor(&per_cu, (const void*)mega_fwd, NWAVES * 64, LDS_BYTES) != hipSuccess || per_cu < 1) fprintf(stderr, "kernel_launch: occupancy query reports %d\n", per_cu);
        (void)hipGetLastError();
        grid = cus;
    }
    if (grid < 0) return;
    if (hipMemsetAsync((char*)d_ws + WS_CTL, 0, CTL_ZERO_BYTES, stream) != hipSuccess) return;
    Args a{};
    for (int i = 0; i < 28; ++i) a.in[i] = (const float*)d_in[i];
    a.out = (float*)d_out; a.ws = (unsigned char*)d_ws;
#if MK_PER_PHASE
    for (int ph = 0; ph < PH_COUNT; ++ph) { a.ph_lo = ph; a.ph_hi = ph + 1; hipLaunchKernelGGL(mega_fwd, dim3(grid), dim3(NWAVES * 64), LDS_BYTES, stream, a); }
#else
    a.ph_lo = 0; a.ph_hi = PH_COUNT; hipLaunchKernelGGL(mega_fwd, dim3(grid), dim3(NWAVES * 64), LDS_BYTES, stream, a);
#endif
    const hipError_t le = hipPeekAtLastError();
    if (le != hipSuccess) fprintf(stderr, "kernel_launch: launch failed: %s\n", hipGetErrorName(le));
}
```

```cpp
#include <hip/hip_runtime.h>
#include <cstdio>
#include <cstdint>
namespace pg8 {
#define PG8_LAS __attribute__((address_space(3)))
typedef unsigned short bf16_t;
typedef short bf16x8 __attribute__((ext_vector_type(8)));
typedef float f32x4 __attribute__((ext_vector_type(4)));
typedef unsigned u32x4 __attribute__((ext_vector_type(4)));
constexpr int BM = 256, BK = 64, HALF = 128, HTB = HALF * BK * 2  , STAGE_BYTES = 8 * HTB, NXCD = 8, WGM = 8;

__host__ __device__ __forceinline__ int lds_byte(int r, int c) { const int st = (r >> 4) * 2 + (c >> 5), rr = r & 15, cc = c & 31, ob = rr * 64 + cc * 2; return st * 1024 + (ob ^ (((ob >> 9) & 1) << 5)); }
__host__ __device__ __forceinline__ void stage_rc(int b, int& R, int& C) { const int st = b / 1024, sb = b % 1024, swz = sb ^ (((sb >> 9) & 1) << 5); R = (st >> 1) * 16 + swz / 64; C = (st & 1) * 32 + (swz % 64) / 2; }
__host__ __device__ __forceinline__ int perm32(int rho) { const int n = rho >> 4, i = rho & 15; return 8 * (i >> 2) + 4 * n + (i & 3); }

struct Unit { int pm, pn, k0, nt, piece, lidx; };
struct Gemm { const bf16_t* A; const bf16_t* Bt; int M, N, K; int lda; };

struct StaticOrder {
    int nM, nN, nwg, G, c, ntf;
    __host__ __device__ void init(int M, int N, int G_, int c_) { nM = M / BM; nN = N / BM; nwg = nM * nN; G = G_; c = c_; }
    __host__ __device__ bool next(int i, Unit& u) const {
        const long L = (long)i * G + c; if (L >= nwg) return false;
        int wgid = (int)L; { const int q = nwg / NXCD, r = nwg % NXCD, xcd = wgid % NXCD, off = wgid / NXCD; wgid = (xcd < r ? xcd * (q + 1) : r * (q + 1) + (xcd - r) * q) + off; }
        const int nig = WGM * nN, gid = wgid / nig, fm = gid * WGM, gsz = (nM - fm) < WGM ? (nM - fm) : WGM;
        u.pm = fm + ((wgid % nig) % gsz); u.pn = (wgid % nig) / gsz; u.k0 = 0; u.nt = ntf; u.piece = 0; u.lidx = 0; return true;
    }
    __device__ __forceinline__ void a_ready(const Unit&) const {}
    __device__ __forceinline__ void done(const Unit&) const {}
};

__device__ __forceinline__ unsigned cvt_pk_bf16(float lo, float hi) { unsigned r; asm volatile("v_cvt_pk_bf16_f32 %0, %1, %2" : "=v"(r) : "v"(lo), "v"(hi)); return r; }

template <class Epi, class Sched, bool ALIGN_EPI = false, bool SP2 = false>
__device__ __forceinline__ void gemm_phase(PG8_LAS unsigned char* lds, const Gemm g, const Sched& S, const Epi& E) {
    const int tid = threadIdx.x, wid = __builtin_amdgcn_readfirstlane(tid >> 6), lane = tid & 63, wr = wid >> 2, wc = wid & 3, fr = lane & 15, fq = lane >> 4;
    const int K = g.K, lda = g.lda ? g.lda : g.K;
    unsigned voffA[2], voffB[2];
#pragma unroll
    for (int i = 0; i < 2; ++i) { int R, C; stage_rc(tid * 16 + i * 8192, R, C); const int Rb = Epi::PERM ? ((R & ~31) + perm32(R & 31)) : R;
        voffA[i] = (unsigned)(R * lda + C) * 2u; voffB[i] = (unsigned)(Rb * K + C) * 2u; }
    const size_t kstep = (size_t)(BK * 2);
    const size_t hstep = (size_t)HALF * K * 2;
    const size_t tstep = 2 * hstep;
    const size_t hstepA = (size_t)HALF * lda * 2, tstepA = 2 * hstepA;
    const unsigned ldsw = (unsigned)wid * 1024u;
    const int aoff = lds_byte(wr * 64 + fr, fq * 8), boff = lds_byte(wc * 32 + fr, fq * 8);
#define PG8_SA(b, h) (((b) * 2 + (h)) * HTB)
#define PG8_SB(b, h) ((4 + (b) * 2 + (h)) * HTB)
#define PG8_STAGE(bufoff, gbase, voff) do { _Pragma("unroll") for (int _i = 0; _i < 2; ++_i) \
        __builtin_amdgcn_global_load_lds((const unsigned*)((const char*)(gbase) + (voff)[_i]), (PG8_LAS unsigned*)(lds + (bufoff) + ldsw + _i * 8192), 16, 0, 0); } while (0)
#define PG8_LDA(dst, b, h) do { _Pragma("unroll") for (int m = 0; m < 4; ++m) _Pragma("unroll") for (int k = 0; k < 2; ++k) dst[m][k] = *(const PG8_LAS bf16x8*)(lds + PG8_SA(b, h) + aoff + m * 2048 + k * 1024); } while (0)
#define PG8_LDB(dst, b, h) do { _Pragma("unroll") for (int n = 0; n < 2; ++n) _Pragma("unroll") for (int k = 0; k < 2; ++k) dst[n][k] = *(const PG8_LAS bf16x8*)(lds + PG8_SB(b, h) + boff + n * 2048 + k * 1024); } while (0)
#define PG8_MMA(ai, bj, At, Bt) do { __builtin_amdgcn_s_setprio(1); _Pragma("unroll") for (int m = 0; m < 4; ++m) _Pragma("unroll") for (int n = 0; n < 2; ++n) _Pragma("unroll") for (int k = 0; k < 2; ++k) \
        acc[ai][bj][m][n] = __builtin_amdgcn_mfma_f32_16x16x32_bf16(Bt[n][k], At[m][k], acc[ai][bj][m][n], 0, 0, 0); __builtin_amdgcn_s_setprio(0); } while (0)
#define PG8_WAIT_V(n) asm volatile("s_waitcnt vmcnt(" #n ")" ::: "memory")
#define PG8_WAIT_L(n) asm volatile("s_waitcnt lgkmcnt(" #n ")" ::: "memory")
#define PG8_BAR __builtin_amdgcn_s_barrier()
#define PG8_SCHED __builtin_amdgcn_sched_barrier(0)
    Unit cur, nxt; int ui = 0;
    if (!S.next(0, cur)) return;
    f32x4 acc[2][2][4][2];
#pragma unroll
    for (int a = 0; a < 2; ++a)
#pragma unroll
        for (int b = 0; b < 2; ++b)
#pragma unroll
            for (int m = 0; m < 4; ++m)
#pragma unroll
                for (int n = 0; n < 2; ++n) acc[a][b][m][n] = (f32x4){0.f, 0.f, 0.f, 0.f};
    bf16x8 At[4][2], B0[2][2], B1[2][2];
    const char* cA = (const char*)g.A + (size_t)cur.pm * tstepA + (size_t)cur.k0 * kstep; const char* cB = (const char*)g.Bt + (size_t)cur.pn * tstep + (size_t)cur.k0 * kstep;
    S.a_ready(cur);
    if constexpr (SP2) {
        PG8_STAGE(PG8_SB(0, 0), cB, voffB); PG8_STAGE(PG8_SB(0, 1), cB + hstep, voffB); PG8_STAGE(PG8_SA(0, 0), cA, voffA); PG8_STAGE(PG8_SA(0, 1), cA + hstepA, voffA);
        if (wr == 1) PG8_BAR;
        PG8_WAIT_V(2); PG8_BAR;
        PG8_STAGE(PG8_SB(1, 0), cB + kstep, voffB); PG8_STAGE(PG8_SA(1, 0), cA + kstep, voffA); PG8_STAGE(PG8_SB(1, 1), cB + hstep + kstep, voffB);
        PG8_WAIT_V(6); PG8_BAR;
    } else {
        PG8_STAGE(PG8_SB(0, 0), cB, voffB); PG8_STAGE(PG8_SA(0, 0), cA, voffA); PG8_STAGE(PG8_SB(0, 1), cB + hstep, voffB); PG8_STAGE(PG8_SA(0, 1), cA + hstepA, voffA);
        if (wr == 1) PG8_BAR;
        PG8_WAIT_V(4); PG8_BAR;
        PG8_STAGE(PG8_SB(1, 0), cB + kstep, voffB); PG8_STAGE(PG8_SA(1, 0), cA + kstep, voffA); PG8_STAGE(PG8_SB(1, 1), cB + hstep + kstep, voffB);
        PG8_WAIT_V(6); PG8_BAR;
    }
    for (;;) {
        const bool has_next = S.next(ui + 1, nxt);
        const char* nA = has_next ? (const char*)g.A + (size_t)nxt.pm * tstepA + (size_t)nxt.k0 * kstep : cA; const char* nB = has_next ? (const char*)g.Bt + (size_t)nxt.pn * tstep + (size_t)nxt.k0 * kstep : cB;
        const int cnt = cur.nt;
        for (int t = 0; t < cnt; t += 2) {
            const bool last = (t == cnt - 2);
            const char* a1 = cA + (size_t)(t + 1) * kstep;
            const char* a2 = last ? nA : cA + (size_t)(t + 2) * kstep; const char* b2 = last ? nB : cB + (size_t)(t + 2) * kstep;
            const char* a3 = a2 + kstep; const char* b3 = b2 + kstep;
            if (last && has_next) S.a_ready(nxt);
            if constexpr (SP2) {
            PG8_LDB(B0, 0, 0); PG8_LDB(B1, 0, 1); PG8_SCHED; PG8_LDA(At, 0, 0); PG8_STAGE(PG8_SA(1, 1), a1 + hstepA, voffA);
            PG8_WAIT_V(8); PG8_WAIT_L(0); PG8_BAR; PG8_MMA(0, 0, At, B0); PG8_MMA(0, 1, At, B1); PG8_BAR; PG8_SCHED;
            PG8_LDA(At, 0, 1); PG8_STAGE(PG8_SB(0, 0), b2, voffB); PG8_STAGE(PG8_SB(0, 1), b2 + hstep, voffB); PG8_STAGE(PG8_SA(0, 0), a2, voffA);
            PG8_WAIT_V(8); PG8_WAIT_L(0); PG8_BAR; PG8_MMA(1, 0, At, B0); PG8_MMA(1, 1, At, B1); PG8_BAR; PG8_SCHED;
            PG8_LDB(B0, 1, 0); PG8_LDB(B1, 1, 1); PG8_SCHED; PG8_LDA(At, 1, 0); PG8_STAGE(PG8_SA(0, 1), a2 + hstepA, voffA);
            PG8_WAIT_V(8); PG8_WAIT_L(0); PG8_BAR; PG8_MMA(0, 0, At, B0); PG8_MMA(0, 1, At, B1); PG8_BAR; PG8_SCHED;
            PG8_LDA(At, 1, 1); PG8_STAGE(PG8_SB(1, 0), b3, voffB); PG8_STAGE(PG8_SB(1, 1), b3 + hstep, voffB); PG8_STAGE(PG8_SA(1, 0), a3, voffA);
            PG8_WAIT_V(8); PG8_WAIT_L(0); PG8_BAR; PG8_MMA(1, 0, At, B0); PG8_MMA(1, 1, At, B1); PG8_BAR; PG8_SCHED;
            } else {
            PG8_LDB(B0, 0, 0); PG8_SCHED; PG8_LDA(At, 0, 0); PG8_STAGE(PG8_SA(1, 1), a1 + hstepA, voffA);
            PG8_WAIT_L(8); PG8_BAR; PG8_WAIT_L(0); PG8_MMA(0, 0, At, B0); PG8_BAR; PG8_SCHED;
            PG8_LDB(B1, 0, 1); PG8_STAGE(PG8_SB(0, 0), b2, voffB);
            PG8_BAR; PG8_WAIT_L(0); PG8_MMA(0, 1, At, B1); PG8_BAR;
            PG8_LDA(At, 0, 1); PG8_STAGE(PG8_SA(0, 0), a2, voffA);
            PG8_BAR; PG8_WAIT_L(0); PG8_MMA(1, 0, At, B0); PG8_BAR; PG8_SCHED;
            PG8_STAGE(PG8_SB(0, 1), b2 + hstep, voffB);
            PG8_WAIT_V(6); PG8_BAR; PG8_MMA(1, 1, At, B1); PG8_BAR;
            PG8_LDB(B0, 1, 0); PG8_SCHED; PG8_LDA(At, 1, 0); PG8_STAGE(PG8_SA(0, 1), a2 + hstepA, voffA);
            PG8_WAIT_L(8); PG8_BAR; PG8_WAIT_L(0); PG8_MMA(0, 0, At, B0); PG8_BAR; PG8_SCHED;
            PG8_LDB(B1, 1, 1); PG8_STAGE(PG8_SB(1, 0), b3, voffB);
            PG8_BAR; PG8_WAIT_L(0); PG8_MMA(0, 1, At, B1); PG8_BAR;
            PG8_LDA(At, 1, 1); PG8_STAGE(PG8_SA(1, 0), a3, voffA);
            PG8_BAR; PG8_WAIT_L(0); PG8_MMA(1, 0, At, B0); PG8_BAR; PG8_SCHED;
            PG8_STAGE(PG8_SB(1, 1), b3 + hstep, voffB);
            PG8_WAIT_V(6); PG8_BAR; PG8_MMA(1, 1, At, B1); PG8_BAR;
            }
        }
        if constexpr (ALIGN_EPI) { if (wr == 0) PG8_BAR; }
        if constexpr (!Epi::AFTER_DRAIN) { E(acc, cur, wr, wc, fr, fq); S.done(cur); }
        if (!has_next) break;
#pragma unroll
        for (int a = 0; a < 2; ++a)
#pragma unroll
            for (int b = 0; b < 2; ++b)
#pragma unroll
                for (int m = 0; m < 4; ++m)
#pragma unroll
                    for (int n = 0; n < 2; ++n) acc[a][b][m][n] = (f32x4){0.f, 0.f, 0.f, 0.f};
        cur = nxt; cA = nA; cB = nB; ++ui;
        if constexpr (ALIGN_EPI) { if (wr == 1) PG8_BAR; }
    }
    PG8_WAIT_V(0);
    if constexpr (!ALIGN_EPI) { if (wr == 0) PG8_BAR; }
    PG8_BAR;
    if constexpr (Epi::AFTER_DRAIN) { E.fused(acc, cur, wr, wc, fr, fq, lds, wid, lane); S.done(cur); }
#undef PG8_SA
#undef PG8_SB
#undef PG8_STAGE
#undef PG8_LDA
#undef PG8_LDB
#undef PG8_MMA
#undef PG8_WAIT_V
#undef PG8_WAIT_L
#undef PG8_BAR
#undef PG8_SCHED
}
}

#ifndef PG8_SP2
#define PG8_SP2 true
#endif
#define GAS __attribute__((address_space(1)))
#define LAS __attribute__((address_space(3)))
typedef unsigned short bf16;
typedef unsigned v4u __attribute__((ext_vector_type(4)));
typedef float f32x4 __attribute__((ext_vector_type(4)));
typedef short bf16x8 __attribute__((ext_vector_type(8)));
typedef GAS unsigned gu32;
typedef GAS unsigned long long gu64;
#define RLX_AGENT __ATOMIC_RELAXED, __HIP_MEMORY_SCOPE_AGENT
#define LDS_WAIT() asm volatile("s_waitcnt lgkmcnt(0)" ::: "memory")
#define VM_WAIT() asm volatile("s_waitcnt vmcnt(0)" ::: "memory")
__device__ __forceinline__ unsigned long long rt() { return __builtin_amdgcn_s_memrealtime(); }
typedef float pkf2_t __attribute__((ext_vector_type(2))); typedef __bf16 pkb2_t __attribute__((ext_vector_type(2)));
__device__ __forceinline__ unsigned pk2(float lo, float hi) { pkf2_t v = {lo, hi}; pkb2_t b = __builtin_convertvector(v, pkb2_t); return __builtin_bit_cast(unsigned, b); }
__device__ __forceinline__ unsigned f2bf(float f) { return pk2(f, 0.f) & 0xffffu; }

#define XB_TMO      128
#define XB_XCNT(j)  (256  + 64 * (j))
#define XB_XSUB(j)  (1280 + 64 * (j))
#define XB_XGEN(j)  (2304 + 64 * (j))
#define XB_TOP      3328
#define XB_TOPGEN   3392
#define XCD_BAR_WORDS 3456
#define XB_SPIN_CAP (1u << 18)

__device__ __forceinline__ unsigned xb_ld(unsigned* p)              { return __hip_atomic_load(p, __ATOMIC_RELAXED, __HIP_MEMORY_SCOPE_AGENT); }
__device__ __forceinline__ unsigned xb_add(unsigned* p, unsigned v) { return __hip_atomic_fetch_add(p, v, __ATOMIC_RELAXED, __HIP_MEMORY_SCOPE_AGENT); }
__device__ __forceinline__ unsigned xb_xcc_id() { return (unsigned)__builtin_amdgcn_s_getreg((3 << 11) | 20) & 0xFu; }
#define XB_SPIN(cond, bar) do { unsigned _sp = 0; while (cond) { __builtin_amdgcn_s_sleep(1); \
    if ((++_sp & 255u) == 0u) { if (xb_ld(&(bar)[XB_TMO])) break; if (_sp > XB_SPIN_CAP) { atomicAdd(&(bar)[XB_TMO], 1u); break; } } } } while (0)

struct XcdBarrier {
    unsigned* bar; unsigned x;
    volatile LAS unsigned* st;
};

__device__ __forceinline__ XcdBarrier xcd_barrier_post(unsigned* bar, volatile LAS unsigned* st) {
    XcdBarrier b; b.bar = bar; b.x = xb_xcc_id(); b.st = st;
    if (threadIdx.x == 0) (void)xb_add(&bar[XB_XCNT(b.x)], 1u);
    return b;
}
__device__ __forceinline__ void xcd_barrier_complete(unsigned* bar, unsigned x, unsigned& nloc, unsigned& nx) {
    const unsigned G = gridDim.x * gridDim.y * gridDim.z;
    unsigned sum, cnt, mine, sp = 0u;
    for (;;) {
        sum = 0u; cnt = 0u; mine = 0u;
#pragma unroll
        for (unsigned j = 0; j < 16; ++j) { const unsigned c = xb_ld(&bar[XB_XCNT(j)]); sum += c; cnt += (c > 0u) ? 1u : 0u; mine = (j == x) ? c : mine; }
        if (sum == G) break;
        __builtin_amdgcn_s_sleep(1);
        if ((++sp & 255u) == 0u) { if (xb_ld(&bar[XB_TMO])) break; if (sp > XB_SPIN_CAP) { atomicAdd(&bar[XB_TMO], 1u); break; } }
    }
    nloc = mine > 0u ? mine : 1u; nx = cnt > 0u ? cnt : 1u;
}

__device__ __forceinline__ void xcd_barrier(const XcdBarrier& b) {
    asm volatile("s_waitcnt vmcnt(0)" ::: "memory");
    __syncthreads();
    if (threadIdx.x == 0) {
        unsigned* bar = b.bar;
        __builtin_amdgcn_s_waitcnt(0);
        unsigned nloc = b.st[0], nx = b.st[1];
        if (nloc == 0u) { xcd_barrier_complete(bar, b.x, nloc, nx); b.st[0] = nloc; b.st[1] = nx; }
        const unsigned old = xb_add(&bar[XB_XSUB(b.x)], 1u);
        const unsigned gen = old / nloc;
        if (old + 1u == (gen + 1u) * nloc) {
            __builtin_amdgcn_fence(__ATOMIC_RELEASE, "agent");
            asm volatile("s_waitcnt vmcnt(0)" ::: "memory");
            const unsigned og = xb_add(&bar[XB_TOP], 1u);
            const unsigned tg = og / nx;
            if (og + 1u == (tg + 1u) * nx) xb_add(&bar[XB_TOPGEN], 1u);
            else XB_SPIN(xb_ld(&bar[XB_TOPGEN]) == tg, bar);
            __builtin_amdgcn_fence(__ATOMIC_ACQUIRE, "agent");
            xb_add(&bar[XB_XGEN(b.x)], 1u);
            asm volatile("s_waitcnt vmcnt(0)" ::: "memory");
        } else {
            XB_SPIN(xb_ld(&bar[XB_XGEN(b.x)]) == gen, bar);
            __builtin_amdgcn_fence(__ATOMIC_ACQUIRE, "agent");
            asm volatile("s_waitcnt vmcnt(0)" ::: "memory");
        }
    }
    __syncthreads();
}
#ifndef PG8_ALIGN
#define PG8_ALIGN true
#endif
constexpr int NWAVES = 8;
#ifndef MK_PER_PHASE
#define MK_PER_PHASE 0
#endif
constexpr int D = 1024, MP = 16384, MSMP = 2048, M = MP + MSMP, NCH = M / 64, DFF = 2816, INCOLS = 7440, NB = 33, ADAW = 9 * D;
constexpr float EPS = 1e-6f;
constexpr size_t OFF_Y = 0, OFF_PCONV = (size_t)M * D, OFF_PS = OFF_PCONV + 3 * 3072, OFF_PK = OFF_PS + 8 * 128 * 128, OFF_PV = OFF_PK + 128 * 128,
                 OFF_SCONV = OFF_PV + 128 * 128, OFF_SS = OFF_SCONV + 32 * 3 * 3072, OFF_SK = OFF_SS + (size_t)32 * 8 * 128 * 128, OFF_SV = OFF_SK + 32 * 128 * 128, OUT_TOTAL = OFF_SV + 32 * 128 * 128;
constexpr size_t MiB = 1u << 20;
constexpr size_t WS_CTL = 0, CTL_ZERO_BYTES = 1 * MiB, WS_ADA = 1 * MiB, WS_BA = 5 * MiB / 2, WS_GL = 4 * MiB, WS_W = 5 * MiB;
constexpr size_t WS_U1 = 26 * MiB, WS_U2 = 62 * MiB, WS_U3 = 98 * MiB, WS_U4 = 134 * MiB, WS_U5 = 170 * MiB, WS_U6 = 206 * MiB;
constexpr size_t WS_INTRA = 206 * MiB, WS_KV = 224 * MiB, WS_TAIL = 233 * MiB, WS_END = 254 * MiB;
static_assert((size_t)M * D * 2 == 36 * MiB && (size_t)NB * ADAW * 4 <= 3 * MiB / 2 && (size_t)M * 16 * 4 <= 3 * MiB / 2, "ws map");
static_assert((size_t)NCH * 8 * 64 * 64 * 2 == 18 * MiB && (size_t)M * 256 * 2 == 9 * MiB && WS_TAIL + (size_t)NCH * 3 * 3072 * 2 <= WS_END && (size_t)M * DFF * 2 <= 108 * MiB, "ws map 2");
constexpr size_t W_FIN = 0, W_FOUT = (size_t)2 * DFF * D;
constexpr size_t W_IN = 0, W_A = (size_t)7424 * D, W_B = W_A + (size_t)D * D, W_O = W_B + (size_t)D * D;
static_assert((W_O + (size_t)D * D) * 2 <= 21 * MiB, "w slot");
constexpr int CW_TMO = 0, CW_BAR = 4096;
constexpr int RING_BYTES = 131072, LDSCTL_OFF = RING_BYTES, MISC_OFF = LDSCTL_OFF + 320, LDS_BYTES = 147456;

struct Frame {
    LAS unsigned char* lds; volatile LAS unsigned* MISC; gu32* ctl;
    int tid, lane, wave, vcu, G;
    const float* const* in; float* out; unsigned char* ws;
};
typedef float f32x2 __attribute__((ext_vector_type(2)));
typedef unsigned u32x2 __attribute__((ext_vector_type(2)));
__device__ __forceinline__ float bflo(unsigned u) { return __builtin_bit_cast(float, u << 16); }
__device__ __forceinline__ float bfhi(unsigned u) { return __builtin_bit_cast(float, u & 0xffff0000u); }
__device__ __forceinline__ float bf2f(bf16 h) { return __builtin_bit_cast(float, (unsigned)h << 16); }
__device__ __forceinline__ float fexp(float x) { return __builtin_amdgcn_exp2f(x * 1.4426950408889634f); }
__device__ __forceinline__ float sigm(float x) { return __builtin_amdgcn_rcpf(1.f + fexp(-x)); }
__device__ __forceinline__ float siluf(float x) { return x * sigm(x); }
__device__ __forceinline__ float wave_sum(float v) {
#pragma unroll
    for (int o = 1; o < 64; o <<= 1) v += __shfl_xor(v, o);
    return v;
}
__device__ __forceinline__ int mod_row(int m) { return m < MP ? 0 : 1 + ((m - MP) >> 6); }

__device__ __forceinline__ void transpose_item(const float* W, int ldw, int c0, int K, bf16* WT, int drow0, LAS float* scr, int k0, int lane) {
    f32x4 wv[8];
#pragma unroll
    for (int i = 0; i < 8; ++i) wv[i] = *(const f32x4*)(W + (size_t)(k0 + 8 * i + (lane >> 3)) * ldw + c0 + 4 * (lane & 7));
#pragma unroll
    for (int i = 0; i < 8; ++i) { LAS float* d = scr + (8 * i + (lane >> 3)) * 33 + 4 * (lane & 7); d[0] = wv[i].x; d[1] = wv[i].y; d[2] = wv[i].z; d[3] = wv[i].w; }
    LDS_WAIT(); asm volatile("" ::: "memory");
    const int c = lane & 7;
#pragma unroll
    for (int j = 0; j < 4; ++j) { const int n = (lane >> 3) + 8 * j; const LAS float* s = scr + (8 * c) * 33 + n;
        v4u o; o.x = pk2(s[0 * 33], s[1 * 33]); o.y = pk2(s[2 * 33], s[3 * 33]); o.z = pk2(s[4 * 33], s[5 * 33]); o.w = pk2(s[6 * 33], s[7 * 33]);
        *(GAS v4u*)(WT + (size_t)(drow0 + n) * K + k0 + 8 * c) = o; }
    LDS_WAIT(); asm volatile("" ::: "memory");
}
__device__ __forceinline__ void convert_ffn(Frame& F, const float* w_in, const float* w_out, bf16* dst_in, bf16* dst_out, int gw, int NGW) {
    LAS float* scr = (LAS float*)(F.lds + F.wave * 16384);
    constexpr int I_IN = 16 * 176, I_OUT = 44 * 32;
    if (dst_in) for (int it = gw; it < I_IN; it += NGW) { const int kb = it / 176, nb = it % 176, c0 = 32 * nb; const int j0 = c0 < DFF ? c0 : c0 - DFF;
        const int drow0 = (j0 >> 7) * 256 + (c0 < DFF ? 0 : 128) + (j0 & 127);
        transpose_item(w_in, 2 * DFF, c0, D, dst_in, drow0, scr, 64 * kb, F.lane); }
    if (dst_out) for (int r = gw; r < I_OUT; r += NGW) { const int kb = r / 32, nb = r % 32; transpose_item(w_out, D, 32 * nb, DFF, dst_out, 32 * nb, scr, 64 * kb, F.lane); }
}
__device__ __forceinline__ void convert_mixer(Frame& F, int part, int gw, int NGW) {
    LAS float* scr = (LAS float*)(F.lds + F.wave * 16384);
    constexpr int NB0 = 4352 / 32, NB1 = (7424 - 4352) / 32, I_SQ = 16 * 32;
    const int nb_n = part == 0 ? NB0 : NB1, i_in = 16 * nb_n, i_tot = part == 0 ? i_in : i_in + 3 * I_SQ;
    for (int it = gw; it < i_tot; it += NGW) {
        if (it < i_in) { const int kb = it / nb_n, nb = it % nb_n, dr = 32 * nb + (part == 0 ? 0 : 4352);
            const int c0 = dr < 3072 ? dr : dr < 4352 ? 4112 + (dr - 3072) : dr < 5376 ? 3072 + (dr - 4352) : 5392 + (dr - 5376);
            transpose_item((F.in[12]), INCOLS, c0, D, ((bf16*)(F.ws + WS_W)) + W_IN, dr, scr, 64 * kb, F.lane); }
        else { int r = it - i_in; const int which = r / I_SQ; r %= I_SQ; const int kb = r / 32, nb = r % 32;
            const float* src = which == 0 ? (F.in[19]) : which == 1 ? (F.in[20]) : (F.in[21]); bf16* dst = ((bf16*)(F.ws + WS_W)) + (which == 0 ? W_A : which == 1 ? W_B : W_O);
            transpose_item(src, D, 32 * nb, D, dst, 32 * nb, scr, 64 * kb, F.lane); }
    }
}
__device__ __forceinline__ int ada_row_off(int s) { return s < 31 ? s * 4112 : 131584 + (s - 31) * 4112; }
__device__ __forceinline__ void split_bf(float a, float b, unsigned& hi, unsigned& lo) {
    hi = pk2(a, b); lo = pk2(a - __builtin_bit_cast(float, hi << 16), b - __builtin_bit_cast(float, hi & 0xffff0000u)); }
__device__ __forceinline__ void ada_item(Frame& F, int item) {
    for (int idx = F.tid; idx < 33 * 1024; idx += 512) { const int b = idx >> 10, k = idx & 1023;
        const float c = (b == 0) ? (F.in[6])[k] : (F.in[7])[(b - 1) * 1024 + k]; *(LAS float*)(F.lds + ada_row_off(b == 0 ? 32 : b - 1) + 4 * k) = c / (1.f + __expf(-c)); }
    __syncthreads();
    const int i16 = F.lane & 15, kg = F.lane >> 4, k0 = F.wave * 128;
    const float* wp = (F.in[25]) + (size_t)(k0 + 8 * kg) * ADAW + item * 64 + 4 * i16;
    f32x4 acc[3][4], ld[2][8];
#pragma unroll
    for (int mt = 0; mt < 3; ++mt)
#pragma unroll
        for (int t = 0; t < 4; ++t) acc[mt][t] = (f32x4){0.f, 0.f, 0.f, 0.f};
#pragma unroll
    for (int j = 0; j < 8; ++j) ld[0][j] = *(const f32x4*)(wp + (size_t)j * ADAW);
#pragma unroll
    for (int j = 0; j < 8; ++j) ld[1][j] = *(const f32x4*)(wp + (size_t)(32 + j) * ADAW);
#pragma unroll
    for (int ks = 0; ks < 4; ++ks) {
        bf16x8 bh[4], bl[4];
#pragma unroll
        for (int t = 0; t < 4; ++t) { unsigned h0, h1, h2, h3, l0, l1, l2, l3; split_bf(ld[ks & 1][0][t], ld[ks & 1][1][t], h0, l0); split_bf(ld[ks & 1][2][t], ld[ks & 1][3][t], h1, l1);
            split_bf(ld[ks & 1][4][t], ld[ks & 1][5][t], h2, l2); split_bf(ld[ks & 1][6][t], ld[ks & 1][7][t], h3, l3); bh[t] = __builtin_bit_cast(bf16x8, (v4u){h0, h1, h2, h3}); bl[t] = __builtin_bit_cast(bf16x8, (v4u){l0, l1, l2, l3}); }
        if (ks + 2 < 4) {
#pragma unroll
            for (int j = 0; j < 8; ++j) ld[ks & 1][j] = *(const f32x4*)(wp + (size_t)(32 * (ks + 2) + j) * ADAW); }
#pragma unroll
        for (int mt = 0; mt < 3; ++mt) { const LAS float* ap = (const LAS float*)(F.lds + ada_row_off(mt < 2 ? 16 * mt + i16 : 32)) + k0 + 32 * ks + 8 * kg;
            const f32x4 a0 = *(const LAS f32x4*)ap, a1 = *(const LAS f32x4*)(ap + 4); unsigned h0, h1, h2, h3, l0, l1, l2, l3;
            split_bf(a0.x, a0.y, h0, l0); split_bf(a0.z, a0.w, h1, l1); split_bf(a1.x, a1.y, h2, l2); split_bf(a1.z, a1.w, h3, l3);
            const bf16x8 ah = __builtin_bit_cast(bf16x8, (v4u){h0, h1, h2, h3}), al = __builtin_bit_cast(bf16x8, (v4u){l0, l1, l2, l3});
#pragma unroll
            for (int t = 0; t < 4; ++t) { acc[mt][t] = __builtin_amdgcn_mfma_f32_16x16x32_bf16(ah, bh[t], acc[mt][t], 0, 0, 0);
                acc[mt][t] = __builtin_amdgcn_mfma_f32_16x16x32_bf16(ah, bl[t], acc[mt][t], 0, 0, 0); acc[mt][t] = __builtin_amdgcn_mfma_f32_16x16x32_bf16(al, bh[t], acc[mt][t], 0, 0, 0); } }
    }
    __syncthreads();
    LAS float* red = (LAS float*)F.lds;
#pragma unroll
    for (int mt = 0; mt < 2; ++mt)
#pragma unroll
        for (int i = 0; i < 4; ++i) *(LAS f32x4*)(red + (F.wave * 33 + 16 * mt + 4 * kg + i + 1) * 64 + 4 * i16) = (f32x4){acc[mt][0][i], acc[mt][1][i], acc[mt][2][i], acc[mt][3][i]};
    if (kg == 0) *(LAS f32x4*)(red + (F.wave * 33) * 64 + 4 * i16) = (f32x4){acc[2][0][0], acc[2][1][0], acc[2][2][0], acc[2][3][0]};
    __syncthreads();
    for (int idx = F.tid; idx < 33 * 64; idx += 512) { const int b = idx >> 6, l = idx & 63; float s = 0.f;
#pragma unroll
        for (int w = 0; w < 8; ++w) s += red[(w * 33 + b) * 64 + l];
        ((float*)(F.ws + WS_ADA))[(size_t)b * ADAW + item * 64 + l] = s + (F.in[26])[item * 64 + l]; }
    __syncthreads();
}
__device__ __forceinline__ void convert_ffn_range(Frame& F, const float* w_in, const float* w_out, bf16* dst_in, bf16* dst_out, int lo, int hi) {
    LAS float* scr = (LAS float*)(F.lds + F.wave * 16384);
    constexpr int I_IN = 16 * 176, I_OUT = 44 * 32;
    if (hi > I_IN + I_OUT) hi = I_IN + I_OUT;
    for (int it = lo + F.wave; it < hi; it += NWAVES) {
        if (it < I_IN) { const int kb = it / 176, nb = it % 176, c0 = 32 * nb; const int j0 = c0 < DFF ? c0 : c0 - DFF;
            const int drow0 = (j0 >> 7) * 256 + (c0 < DFF ? 0 : 128) + (j0 & 127);
            transpose_item(w_in, 2 * DFF, c0, D, dst_in, drow0, scr, 64 * kb, F.lane); }
        else { const int r = it - I_IN; const int kb = r / 32, nb = r % 32; transpose_item(w_out, D, 32 * nb, DFF, dst_out, 32 * nb, scr, 64 * kb, F.lane); } }
}
__device__ __forceinline__ int left_index(int pm, int pn) { return pm >= 64 ? (pm - 64) * 4 + pn : -1; }
struct Leftover { const bf16* part; bool base_in; int gi; float scale; };
__device__ __forceinline__ void load_row(Frame& F, int m, bool from_in, const Leftover& LO, f32x4 (&v)[4]) {
    const float* irow = m < MP ? (F.in[0]) + (size_t)m * D : (F.in[1]) + (size_t)(m - MP) * D;
    GAS u32x2* xb = (GAS u32x2*)((bf16*)F.out + (size_t)m * 2048) + F.lane;
#pragma unroll
    for (int j = 0; j < 4; ++j) { const int li = LO.part ? left_index(m >> 8, j) : -1;
        if (li < 0) { if (from_in) v[j] = *((const GAS f32x4*)irow + 64 * j + F.lane); else { const u32x2 w = xb[64 * j]; v[j] = (f32x4){bflo(w.x), bfhi(w.x), bflo(w.y), bfhi(w.y)}; } }
        else { f32x4 bs; if (LO.base_in) bs = *((const GAS f32x4*)irow + 64 * j + F.lane); else { const u32x2 w = xb[64 * j]; bs = (f32x4){bflo(w.x), bfhi(w.x), bflo(w.y), bfhi(w.y)}; }
            const f32x4 gv = *((const GAS f32x4*)(((float*)(F.ws + WS_ADA)) + (size_t)mod_row(m) * ADAW + LO.gi * D) + 64 * j + F.lane);
            const GAS u32x2* pp = (const GAS u32x2*)(LO.part + (size_t)li * 8 * 65536 + (size_t)(m & 255) * 256) + F.lane; f32x4 s = (f32x4){0.f, 0.f, 0.f, 0.f};
#pragma unroll
            for (int p = 0; p < 8; ++p) { const u32x2 w = pp[(size_t)p * 16384]; s += (f32x4){bflo(w.x), bfhi(w.x), bflo(w.y), bfhi(w.y)}; }
            v[j] = bs + gv * s * LO.scale; xb[64 * j] = (u32x2){pk2(v[j].x, v[j].y), pk2(v[j].z, v[j].w)}; } }
}
struct RowBuf { f32x4 x[4], sc[4], sh[4]; };
__device__ __forceinline__ void rmsmod_row(const RowBuf& rb, const f32x4 (&gq)[4], bf16* orow, int lane, f32x4 (&hv)[4]) {
    float s = 0.f;
#pragma unroll
    for (int j = 0; j < 4; ++j) s += (rb.x[j].x * rb.x[j].x + rb.x[j].y * rb.x[j].y) + (rb.x[j].z * rb.x[j].z + rb.x[j].w * rb.x[j].w);
    const float r = __builtin_amdgcn_rsqf(wave_sum(s) * (1.f / D) + EPS);
    GAS u32x2* o8 = (GAS u32x2*)orow + lane;
#pragma unroll
    for (int j = 0; j < 4; ++j) { const f32x4 h = (rb.x[j] * r) * gq[j] * (rb.sc[j] + 1.f) + rb.sh[j]; hv[j] = h;
        u32x2 w; w.x = pk2(h.x, h.y); w.y = pk2(h.z, h.w); o8[64 * j] = w; }
}
template <bool WITH_BA>
__device__ __forceinline__ void rmsmod_rows(Frame& F, bool from_in, const float* g, int li, bf16* dst, const Leftover LO = Leftover{nullptr, false, 0, 0.f}, int dld = D) {
    const int gw = F.vcu * NWAVES + F.wave, NGW = F.G * NWAVES;
    LAS float* wba = (LAS float*)F.lds;
    if (WITH_BA) { for (int idx = F.tid; idx < 16 * 1024; idx += 512) { const int k = idx >> 4, j = idx & 15; wba[j * 1024 + k] = (F.in[12])[(size_t)k * INCOLS + 4096 + j]; } __syncthreads(); }
    f32x4 gq[4];
#pragma unroll
    for (int j = 0; j < 4; ++j) gq[j] = ((const GAS f32x4*)g)[64 * j + F.lane];
    RowBuf cur, nxt;
#define ROW_FETCH(mm, B) do { const float* ad_ = ((float*)(F.ws + WS_ADA)) + (size_t)mod_row(mm) * ADAW + (3 * li) * D; load_row(F, mm, from_in, LO, B.x); \
        _Pragma("unroll") for (int j = 0; j < 4; ++j) { B.sh[j] = ((const GAS f32x4*)ad_)[64 * j + F.lane]; B.sc[j] = ((const GAS f32x4*)(ad_ + D))[64 * j + F.lane]; } } while (0)
    if (gw < M) ROW_FETCH(gw, cur);
    for (int m = gw; m < M; m += NGW) {
        if (m + NGW < M) ROW_FETCH(m + NGW, nxt);
        f32x4 hv[4]; rmsmod_row(cur, gq, dst + (size_t)m * dld, F.lane, hv);
        if (WITH_BA) { float p[16];
#pragma unroll
            for (int j = 0; j < 16; ++j) { float s = 0.f;
#pragma unroll
                for (int jj = 0; jj < 4; ++jj) { const f32x4 w = *(const LAS f32x4*)(wba + j * 1024 + 256 * jj + 4 * F.lane); s += (hv[jj].x * w.x + hv[jj].y * w.y) + (hv[jj].z * w.z + hv[jj].w * w.w); }
                p[j] = s; if ((j & 3) == 3) asm volatile("" ::: "memory"); }
            { const bool up = F.lane & 32;
#pragma unroll
              for (int i = 0; i < 8; ++i) { const float snd = up ? p[i] : p[8 + i]; const float rcv = __shfl_xor(snd, 32); p[i] = (up ? p[8 + i] : p[i]) + rcv; } }
            { const bool up = F.lane & 16;
#pragma unroll
              for (int i = 0; i < 4; ++i) { const float snd = up ? p[i] : p[4 + i]; const float rcv = __shfl_xor(snd, 16); p[i] = (up ? p[4 + i] : p[i]) + rcv; } }
            { const bool up = F.lane & 8;
#pragma unroll
              for (int i = 0; i < 2; ++i) { const float snd = up ? p[i] : p[2 + i]; const float rcv = __shfl_xor(snd, 8); p[i] = (up ? p[2 + i] : p[i]) + rcv; } }
            { const bool up = F.lane & 4; const float snd = up ? p[0] : p[1]; const float rcv = __shfl_xor(snd, 4); p[0] = (up ? p[1] : p[0]) + rcv; }
            p[0] += __shfl_xor(p[0], 2); p[0] += __shfl_xor(p[0], 1);
            if ((F.lane & 3) == 0) ((float*)(F.ws + WS_BA))[(size_t)m * 16 + (((F.lane >> 5) & 1) * 8 + ((F.lane >> 4) & 1) * 4 + ((F.lane >> 3) & 1) * 2 + ((F.lane >> 2) & 1))] = p[0]; }
        cur = nxt;
    }
#undef ROW_FETCH
    if (WITH_BA) __syncthreads();
}
__device__ __forceinline__ void final_norm_rows(Frame& F, const Leftover LO) {
    const int gw = F.vcu * NWAVES + F.wave, NGW = F.G * NWAVES;
    f32x4 gq[4], cur[4], nxt[4];
#pragma unroll
    for (int j = 0; j < 4; ++j) gq[j] = ((const GAS f32x4*)(F.in[27]))[64 * j + F.lane];
    if (gw < M) load_row(F, gw, false, LO, cur);
    for (int m = gw; m < M; m += NGW) {
        if (m + NGW < M) load_row(F, m + NGW, false, LO, nxt);
        GAS f32x4* xr = (GAS f32x4*)(F.out + (size_t)m * D) + F.lane; float s = 0.f;
#pragma unroll
        for (int j = 0; j < 4; ++j) s += (cur[j].x * cur[j].x + cur[j].y * cur[j].y) + (cur[j].z * cur[j].z + cur[j].w * cur[j].w);
        const float r = __builtin_amdgcn_rsqf(wave_sum(s) * (1.f / D) + EPS);
#pragma unroll
        for (int j = 0; j < 4; ++j) { xr[64 * j] = (cur[j] * r) * gq[j]; cur[j] = nxt[j]; }
    }
}
typedef pg8::f32x4 pf4; typedef pg8::u32x4 pu4;
#ifndef WT_STORES
#define WT_STORES 0
#endif
__device__ __forceinline__ void st16(void* p, pu4 v) {
#if WT_STORES
    asm volatile("global_store_dwordx4 %0, %1, off sc1\n\ts_nop 1" :: "v"(p), "v"(v) : "memory");
#else
    *(pu4*)p = v;
#endif
}
__device__ __forceinline__ void st16f(void* p, pf4 v) { st16(p, __builtin_bit_cast(pu4, v)); }
typedef float pf2 __attribute__((ext_vector_type(2)));
__device__ __forceinline__ pf2 silu_mul2(pf2 g, pf2 u) { const pf2 s = g * (-1.4426950408889634f); pf2 e; e.x = __builtin_amdgcn_exp2f(s.x); e.y = __builtin_amdgcn_exp2f(s.y);
    const pf2 d = e + 1.0f; pf2 r; r.x = __builtin_amdgcn_rcpf(d.x); r.y = __builtin_amdgcn_rcpf(d.y); return (g * r) * u; }
__device__ __forceinline__ pf4 silu_mul4(pf4 g, pf4 u) { const pf2 a = silu_mul2((pf2){g.x, g.y}, (pf2){u.x, u.y}), b = silu_mul2((pf2){g.z, g.w}, (pf2){u.z, u.w}); return (pf4){a.x, a.y, b.x, b.y}; }
__device__ __forceinline__ pu4 pack8(pf4 a, pf4 b) { pu4 w; w.x = pg8::cvt_pk_bf16(a.x, a.y); w.y = pg8::cvt_pk_bf16(a.z, a.w); w.z = pg8::cvt_pk_bf16(b.x, b.y); w.w = pg8::cvt_pk_bf16(b.z, b.w); return w; }
struct EpiSwiglu {
    static constexpr bool PERM = true, AFTER_DRAIN = false; bf16* O;
    __device__ __forceinline__ void operator()(const pf4 (&acc)[2][2][4][2], const pg8::Unit& u, int wr, int wc, int fr, int fq) const {
        const int row0 = u.pm * 256 + wr * 64 + fr, col0 = u.pn * 128 + wc * 32 + 8 * fq;
#pragma unroll
        for (int ai = 0; ai < 2; ++ai)
#pragma unroll
            for (int m = 0; m < 4; ++m) { bf16* p = O + (size_t)(row0 + ai * 128 + m * 16) * DFF + col0;
                const pf4 h0 = silu_mul4(acc[ai][0][m][0], acc[ai][1][m][0]), h1 = silu_mul4(acc[ai][0][m][1], acc[ai][1][m][1]);
                st16(p, pack8(h0, h1)); }
    }
};
template <bool BASE_IN> struct EpiResid {
    static constexpr bool PERM = true, AFTER_DRAIN = false; const float* in0; const float* in1; bf16* xb; const float* ada; int gi; float scale; bf16* part;
    __device__ __forceinline__ void operator()(const pf4 (&acc)[2][2][4][2], const pg8::Unit& u, int wr, int wc, int fr, int fq) const {
        if (u.piece) {
            char* pb = (char*)(part + ((size_t)u.lidx * 8 + (u.piece - 1)) * 65536);
#pragma unroll
            for (int ai = 0; ai < 2; ++ai)
#pragma unroll
                for (int bj = 0; bj < 2; ++bj) { unsigned off = (unsigned)((ai * 128 + wr * 64 + fr) * 256 + wc * 32 + 8 * fq + bj * 128) * 2u; asm volatile("" : "+v"(off));
#pragma unroll
                    for (int m = 0; m < 4; ++m) { *(pu4*)(pb + (size_t)off) = pack8(acc[ai][bj][m][0], acc[ai][bj][m][1]); off += 16u * 256u * 2u; }
                    asm volatile("" ::: "memory"); }
            return; }
        const int rowt = u.pm * 256, col0 = u.pn * 256 + wc * 32 + 8 * fq;
        const char* ib = (const char*)(rowt < MP ? in0 + (size_t)rowt * D : in1 + (size_t)(rowt - MP) * D); char* xo = (char*)(xb + (size_t)rowt * 2048);
#pragma unroll
        for (int ai = 0; ai < 2; ++ai) {
            const int b = rowt < MP ? 0 : 1 + ((rowt - MP) >> 6) + ai * 2 + wr; const char* ga = (const char*)(ada + (size_t)b * ADAW + gi * D);
#pragma unroll
            for (int bj = 0; bj < 2; ++bj) { unsigned co = (unsigned)(col0 + bj * 128); asm volatile("" : "+v"(co));
                const pf4 g0 = *(const pf4*)(ga + (size_t)co * 4u) * scale, g1 = *(const pf4*)(ga + (size_t)co * 4u + 16) * scale;
                unsigned r = (unsigned)(ai * 128 + wr * 64 + fr);
#pragma unroll
                for (int m = 0; m < 4; ++m) { pf4 b0, b1;
                    if (BASE_IN) { const char* p = ib + ((size_t)r * D + co) * 4u; b0 = *(const pf4*)p; b1 = *(const pf4*)(p + 16); }
                    else { const pu4 w = *(const pu4*)(xo + ((size_t)r * 2048 + co) * 2u); b0 = (pf4){bflo(w.x), bfhi(w.x), bflo(w.y), bfhi(w.y)}; b1 = (pf4){bflo(w.z), bfhi(w.z), bflo(w.w), bfhi(w.w)}; }
                    *(pu4*)(xo + ((size_t)r * 2048 + co) * 2u) = pack8(b0 + g0 * acc[ai][bj][m][0], b1 + g1 * acc[ai][bj][m][1]); r += 16u; }
                asm volatile("" ::: "memory"); }
        }
    }
};
struct EpiPart {
    static constexpr bool PERM = true, AFTER_DRAIN = false; bf16* part;
    __device__ __forceinline__ void operator()(const pf4 (&acc)[2][2][4][2], const pg8::Unit& u, int wr, int wc, int fr, int fq) const {
        char* pb = (char*)(part + ((size_t)u.lidx * 8 + (u.piece - 1)) * 65536);
#pragma unroll
        for (int ai = 0; ai < 2; ++ai)
#pragma unroll
            for (int bj = 0; bj < 2; ++bj) { unsigned off = (unsigned)((ai * 128 + wr * 64 + fr) * 256 + wc * 32 + 8 * fq + bj * 128) * 2u; asm volatile("" : "+v"(off));
#pragma unroll
                for (int m = 0; m < 4; ++m) { *(pu4*)(pb + (size_t)off) = pack8(acc[ai][bj][m][0], acc[ai][bj][m][1]); off += 16u * 256u * 2u; }
                asm volatile("" ::: "memory"); }
    }
};
struct EpiF1 {
    static constexpr bool PERM = true, AFTER_DRAIN = false; bf16 *U1, *U2, *U3, *U4, *KV, *TAIL; float* out;
    __device__ __forceinline__ void operator()(const pf4 (&acc)[2][2][4][2], const pg8::Unit& u, int wr, int wc, int fr, int fq) const {
        const int pn = u.pn, dcol = wc * 32 + 8 * fq;
        if (pn < 12) {
            char* Ub = (char*)U1 + (size_t)((pn >> 2) == 0 ? 4 : (pn >> 2)) * (36u << 20);
#pragma unroll
            for (int ai = 0; ai < 2; ++ai) { const int cn = u.pm * 4 + ai * 2 + wr;
#pragma unroll
                for (int bj = 0; bj < 2; ++bj) { unsigned off = (unsigned)(((cn * 8 + (pn & 3) * 2 + bj) * 64 + fr) * 128 + dcol) * 2u; asm volatile("" : "+v"(off));
#pragma unroll
                    for (int m = 0; m < 4; ++m) { st16(Ub + (size_t)off, pack8(acc[ai][bj][m][0], acc[ai][bj][m][1])); off += 16u * 128u * 2u; }
                    asm volatile("" ::: "memory"); } }
            if (fr >= 13) {
#pragma unroll
                for (int ai = 0; ai < 2; ++ai) { const int cn = u.pm * 4 + ai * 2 + wr;
#pragma unroll
                    for (int bj = 0; bj < 2; ++bj) { const int j = fr - 13, qc = pn * 256 + bj * 128 + dcol; const pf4 v0 = acc[ai][bj][3][0], v1 = acc[ai][bj][3][1];
                        *(pu4*)(TAIL + ((size_t)cn * 3 + j) * 3072 + qc) = pack8(v0, v1);
                        if (cn >= 255) { float* o = out + (cn == 255 ? OFF_PCONV + (size_t)j * 3072 : OFF_SCONV + ((size_t)(cn - 256) * 3 + j) * 3072) + qc; *(pf4*)o = v0; *(pf4*)(o + 4) = v1; } } } }
        } else if (pn < 16) {
#pragma unroll
            for (int ai = 0; ai < 2; ++ai)
#pragma unroll
                for (int bj = 0; bj < 2; ++bj) { unsigned off = (unsigned)((u.pm * 256 + ai * 128 + wr * 64 + fr) * D + (pn - 12) * 256 + bj * 128 + dcol) * 2u; asm volatile("" : "+v"(off));
#pragma unroll
                    for (int m = 0; m < 4; ++m) { st16((char*)U4 + (size_t)off, pack8(acc[ai][bj][m][0], acc[ai][bj][m][1])); off += 16u * D * 2u; }
                    asm volatile("" ::: "memory"); }
        } else {
#pragma unroll
            for (int ai = 0; ai < 2; ++ai) { const int cn = u.pm * 4 + ai * 2 + wr;
#pragma unroll
                for (int bj = 0; bj < 2; ++bj) { unsigned off = (unsigned)((cn * 64 + fr) * 256 + bj * 128 + dcol) * 2u; asm volatile("" : "+v"(off));
#pragma unroll
                    for (int m = 0; m < 4; ++m) { st16((char*)KV + (size_t)off, pack8(acc[ai][bj][m][0], acc[ai][bj][m][1])); off += 16u * 256u * 2u; }
                    asm volatile("" ::: "memory");
                    if (cn >= 254) {
                        float* ob = cn < 256 ? out + (bj == 0 ? OFF_PK : OFF_PV) + (size_t)((cn - 254) * 64 + fr) * 128 + dcol
                                             : out + (bj == 0 ? OFF_SK : OFF_SV) + (size_t)(cn - 256) * 16384 + (size_t)(64 + fr) * 128 + dcol;
#pragma unroll
                        for (int m = 0; m < 4; ++m) { *(pf4*)(ob + m * 16 * 128) = acc[ai][bj][m][0]; *(pf4*)(ob + m * 16 * 128 + 4) = acc[ai][bj][m][1]; }
                        asm volatile("" ::: "memory"); } } }
        }
    }
};
struct EpiF2 {
    static constexpr bool PERM = true, AFTER_DRAIN = false; bf16 *Z, *GA, *GB;
    __device__ __forceinline__ void operator()(const pf4 (&acc)[2][2][4][2], const pg8::Unit& u, int wr, int wc, int fr, int fq) const {
        const int t_ = u.pn >> 2; bf16* Ob = (bf16*)((char*)Z + (size_t)(108 * t_ - 72 * (t_ >> 1)) * (1u << 20)); const int col0 = (u.pn & 3) * 256 + wc * 32 + 8 * fq, row0 = u.pm * 256 + wr * 64 + fr;
#pragma unroll
        for (int ai = 0; ai < 2; ++ai)
#pragma unroll
            for (int m = 0; m < 4; ++m)
#pragma unroll
                for (int bj = 0; bj < 2; ++bj) st16(Ob + (size_t)(row0 + ai * 128 + m * 16) * D + col0 + bj * 128, pack8(acc[ai][bj][m][0], acc[ai][bj][m][1]));
    }
};
template <int MODE> struct EpiGate {
    static constexpr bool PERM = true, AFTER_DRAIN = false; bf16* T; const bf16* G2;
    __device__ __forceinline__ void operator()(const pf4 (&acc)[2][2][4][2], const pg8::Unit& u, int wr, int wc, int fr, int fq) const {
        const int col0 = u.pn * 256 + wc * 32 + 8 * fq, row0 = u.pm * 256 + wr * 64 + fr;
#pragma unroll
        for (int ai = 0; ai < 2; ++ai)
#pragma unroll
            for (int m = 0; m < 4; ++m)
#pragma unroll
                for (int bj = 0; bj < 2; ++bj) { const size_t off = (size_t)(row0 + ai * 128 + m * 16) * D + col0 + bj * 128;
                    const pu4 gv = *(const pu4*)((MODE == 0 ? (const bf16*)T : G2) + off); pu4 tv = (pu4){0u, 0u, 0u, 0u}; if (MODE == 1) tv = *(const pu4*)(T + off);
                    const pf4 a0 = acc[ai][bj][m][0], a1 = acc[ai][bj][m][1]; pf4 o0, o1;
                    o0.x = bflo(tv.x) + sigm(bflo(gv.x)) * a0.x; o0.y = bfhi(tv.x) + sigm(bfhi(gv.x)) * a0.y; o0.z = bflo(tv.y) + sigm(bflo(gv.y)) * a0.z; o0.w = bfhi(tv.y) + sigm(bfhi(gv.y)) * a0.w;
                    o1.x = bflo(tv.z) + sigm(bflo(gv.z)) * a1.x; o1.y = bfhi(tv.z) + sigm(bfhi(gv.z)) * a1.y; o1.z = bflo(tv.w) + sigm(bflo(gv.w)) * a1.z; o1.w = bfhi(tv.w) + sigm(bfhi(gv.w)) * a1.w;
                    st16(T + off, pack8(o0, o1)); }
    }
};
typedef short s16x8 __attribute__((ext_vector_type(8)));
constexpr int PR_RHST = 0, PR_QB = 69632, PR_KB = 87040, PR_AM = 104448, PR_TB = 121856, PR_SC = 126976, PR_IL = 132096, PR_CW = 141312;
static_assert(PR_IL + 64 * 72 * 2 <= PR_CW && PR_CW + 12 * 128 * 4 <= LDS_BYTES, "prep LDS map (IL, CW)");
static_assert(PR_SC + 2 * 1536 <= RING_BYTES, "prep LDS map");
constexpr size_t WS_GATES = 242 * MiB;
struct PrepRegs { v4u raw[3][5]; float gate; };
__device__ __forceinline__ void prep_fetch(Frame& F, int it, int ch8, int rg, PrepRegs& P) {
    const int cn = it >> 3, h = it & 7; const size_t blk = (size_t)(cn * 8 + h) * 64 * 128;
    P.gate = ((const float*)(F.ws + WS_GATES))[(size_t)it * 256 + ((rg * 16 + ch8) & 255)];
#pragma unroll
    for (int t = 0; t < 3; ++t) { const int ch = t * 1024 + h * 128 + 8 * ch8; const bf16* Ub = (t == 0 ? ((bf16*)(F.ws + WS_U5)) : t == 1 ? ((bf16*)(F.ws + WS_U2)) : ((bf16*)(F.ws + WS_U3))) + blk + 8 * ch8;
#pragma unroll
        for (int j = 0; j < 5; ++j) { const int rr = 2 * rg - 3 + j;
            if (rr >= 0) P.raw[t][j] = *(const v4u*)(Ub + rr * 128);
            else if (cn > 0 && cn < 256) P.raw[t][j] = *(const v4u*)(((bf16*)(F.ws + WS_TAIL)) + ((size_t)(cn - 1) * 3 + (3 + rr)) * 3072 + ch);
            else if (cn == 0) P.raw[t][j] = (v4u){0u, 0u, 0u, 0u};
            else { const float* p = (F.in[2]) + ((size_t)(cn - 256) * 3 + (3 + rr)) * 3072 + ch; const f32x4 a = *(const f32x4*)p, b = *(const f32x4*)(p + 4);
                P.raw[t][j] = (v4u){pk2(a.x, a.y), pk2(a.z, a.w), pk2(b.x, b.y), pk2(b.z, b.w)}; } } }
}
__device__ __forceinline__ void prep_gates(Frame& F, int it, int lane) {
    const int cn = it >> 3, h = it & 7, row = cn * 64 + lane; const float braw = ((float*)(F.ws + WS_BA))[(size_t)row * 16 + h], araw = ((float*)(F.ws + WS_BA))[(size_t)row * 16 + 8 + h];
    const float beta = 1.f / (1.f + expf(-braw)); const float xx = araw + (F.in[15])[h]; const float sp = xx > 20.f ? xx : log1pf(expf(xx)); const float g = -expf((F.in[14])[h]) * sp;
    float gcs = g;
#pragma unroll
    for (int o = 1; o < 64; o <<= 1) { const float t = __shfl_up(gcs, o); if (lane >= o) gcs += t; }
    const float glast = __shfl(gcs, 63);
    float* G = (float*)(F.ws + WS_GATES) + (size_t)it * 256;
    G[lane] = beta; G[64 + lane] = gcs; G[128 + lane] = expf(gcs); G[192 + lane] = expf(glast - gcs);
    if (lane == 63) ((float*)(F.ws + WS_GL))[it] = expf(glast);
}
#if defined(PROBE_PS)
#define PS_MARK(k) do { if (blockIdx.x == 0 && F.tid == 0) { const unsigned long long t_ = __builtin_amdgcn_s_memrealtime(); volatile LAS unsigned long long* a_ = (volatile LAS unsigned long long*)(F.lds + LDSCTL_OFF + 768); a_[(k)] += t_ - a_[15]; a_[15] = t_; } } while (0)
#else
#define PS_MARK(k) do {} while (0)
#endif
template <bool DRY, int SKIP = 0> __device__ __forceinline__ void gdn_prep_unit(Frame& F, int cn, int h, PrepRegs& P, int it_next, int par) {
    const int tid = F.tid, lane = F.lane, wave = F.wave, ch8 = tid & 15, rg = tid >> 4;
    LAS float* RHST = (LAS float*)(F.lds + PR_RHST); LAS bf16* QB = (LAS bf16*)(F.lds + PR_QB); LAS bf16* KB = (LAS bf16*)(F.lds + PR_KB);
    LAS float* AM = (LAS float*)(F.lds + PR_AM); LAS bf16* TB = (LAS bf16*)(F.lds + PR_TB);
    LAS float* SC = (LAS float*)(F.lds + PR_SC + (par ? 1536 : 0)); LAS float *S_BETA = SC, *S_GC = SC + 64, *S_EG = SC + 128, *S_EK = SC + 192;
    const size_t blk = (size_t)(cn * 8 + h) * 64 * 128;
    PS_MARK(0);
    const float gate_rec = P.gate;
    float y[3][2][8]; int ch8v = ch8, rgv = rg; asm volatile("" : "+v"(ch8v), "+v"(rgv));
#pragma unroll
    for (int t = 0; t < 3; ++t) { const int ch = t * 1024 + h * 128 + 8 * ch8v;
        float x[5][8];
#pragma unroll
        for (int j = 0; j < 5; ++j) { const v4u w = P.raw[t][j]; x[j][0] = bflo(w.x); x[j][1] = bfhi(w.x); x[j][2] = bflo(w.y); x[j][3] = bfhi(w.y); x[j][4] = bflo(w.z); x[j][5] = bfhi(w.z); x[j][6] = bflo(w.w); x[j][7] = bfhi(w.w); }
        const LAS float* cw = (const LAS float*)(F.lds + PR_CW) + t * 512 + 8 * ch8v;
#pragma unroll
        for (int hh = 0; hh < 2; ++hh) { const f32x4 w0 = *(const LAS f32x4*)(cw + 4 * hh), w1 = *(const LAS f32x4*)(cw + 128 + 4 * hh), w2 = *(const LAS f32x4*)(cw + 256 + 4 * hh), w3 = *(const LAS f32x4*)(cw + 384 + 4 * hh);
#pragma unroll
            for (int i = 0; i < 4; ++i)
#pragma unroll
                for (int r2 = 0; r2 < 2; ++r2) { const int ii = 4 * hh + i; if (SKIP & 8) y[t][r2][ii] = x[r2 + 3][ii] + w0[i]; else y[t][r2][ii] = siluf((w0[i] * x[r2][ii] + w1[i] * x[r2 + 1][ii]) + (w2[i] * x[r2 + 2][ii] + w3[i] * x[r2 + 3][ii])); } }
        asm volatile("" ::: "memory"); }
    float rn[2][2];
#pragma unroll
    for (int t = 0; t < 2; ++t)
#pragma unroll
        for (int r2 = 0; r2 < 2; ++r2) { float s = 0.f;
#pragma unroll
            for (int i = 0; i < 8; ++i) s += y[t][r2][i] * y[t][r2][i];
            s += __shfl_xor(s, 1); s += __shfl_xor(s, 2); s += __shfl_xor(s, 4); s += __shfl_xor(s, 8);
            rn[t][r2] = __builtin_amdgcn_rsqf(s + EPS) * (t == 0 ? 0.08838834764831845f : 1.f); }
    if (tid < 256) SC[tid] = gate_rec;
    LDS_WAIT(); __builtin_amdgcn_s_barrier();
    PS_MARK(1);
    if (SKIP & 16) { asm volatile("" :: "v"(y[0][0][0]), "v"(y[1][1][7]), "v"(y[2][0][3]), "v"(rn[0][0]), "v"(rn[1][1])); } else
    { int c8 = 8 * ch8, r0 = 2 * rg; asm volatile("" : "+v"(c8), "+v"(r0));
      float be[2], eg[2], ek[2];
#pragma unroll
      for (int r2 = 0; r2 < 2; ++r2) { be[r2] = S_BETA[r0 + r2]; eg[r2] = S_EG[r0 + r2]; ek[r2] = S_EK[r0 + r2]; }
#pragma unroll
      for (int r2 = 0; r2 < 2; ++r2) { float q[8], k[8];
#pragma unroll
          for (int i = 0; i < 8; ++i) { q[i] = y[0][r2][i] * rn[0][r2]; k[i] = y[1][r2][i] * rn[1][r2]; }
          const int row = r0 + r2;
          *(LAS v4u*)(QB + row * 136 + c8) = (v4u){pk2(q[0], q[1]), pk2(q[2], q[3]), pk2(q[4], q[5]), pk2(q[6], q[7])};
          *(LAS v4u*)(KB + row * 136 + c8) = (v4u){pk2(k[0], k[1]), pk2(k[2], k[3]), pk2(k[4], k[5]), pk2(k[6], k[7])};
          if (!DRY) *(v4u*)(((bf16*)(F.ws + WS_U5)) + blk + row * 128 + c8) = (v4u){pk2(q[0] * eg[r2], q[1] * eg[r2]), pk2(q[2] * eg[r2], q[3] * eg[r2]), pk2(q[4] * eg[r2], q[5] * eg[r2]), pk2(q[6] * eg[r2], q[7] * eg[r2])};
#pragma unroll
          for (int i = 0; i < 8; ++i) {
              y[1][r2][i] = k[i] * be[r2] * eg[r2]; y[2][r2][i] = y[2][r2][i] * be[r2]; } }
#pragma unroll
      for (int i = 0; i < 8; ++i) {
          const int rs = (r0 + (c8 >> 1)) & 63;
          *(LAS f32x2*)(RHST + (c8 + i) * 68 + rs) = (f32x2){y[2][0][i], y[2][1][i]};
          *(LAS f32x2*)(RHST + (128 + c8 + i) * 68 + rs) = (f32x2){y[1][0][i], y[1][1][i]}; } }
    LDS_WAIT(); __builtin_amdgcn_s_barrier();
    PS_MARK(2);
    if (!(SKIP & 2)) { int l4 = lane; asm volatile("" : "+v"(l4)); const int ti = wave & 3, fr = l4 & 15, fq = l4 >> 4; const LAS bf16* Ab = (wave < 4 ? KB : QB) + (16 * ti + fr) * 136 + 8 * fq;
      s16x8 a[4];
#pragma unroll
      for (int s = 0; s < 4; ++s) a[s] = *(const LAS s16x8*)(Ab + 32 * s);
      LAS bf16* IL = (LAS bf16*)(F.lds + PR_IL);
#pragma unroll
      for (int tj = 0; tj < 4; ++tj) { if (wave < 4 && tj > ti) continue;
          f32x4 acc = (f32x4){0.f, 0.f, 0.f, 0.f}; const LAS bf16* Bb = KB + (16 * tj + fr) * 136 + 8 * fq;
#pragma unroll
          for (int s = 0; s < 4; ++s) { const s16x8 b = *(const LAS s16x8*)(Bb + 32 * s); acc = __builtin_amdgcn_mfma_f32_16x16x32_bf16(a[s], b, acc, 0, 0, 0); }
          const int j = 16 * tj + fr; const float gj = S_GC[j];
#pragma unroll
          for (int r = 0; r < 4; ++r) { const int i = 16 * ti + 4 * fq + r; const float dec = fexp(fminf(S_GC[i] - gj, 0.f));
              if (wave < 4) AM[i * 68 + j] = (i > j) ? -(S_BETA[i] * acc[r] * dec) : 0.f;
              else { const unsigned iv = f2bf((i >= j) ? acc[r] * dec : 0.f); IL[i * 72 + j] = (bf16)iv; } } }
      if (wave < 4) {
          LDS_WAIT(); asm volatile("" ::: "memory");
          const int j = l4 & 15; int zv = 0; asm volatile("" : "+v"(zv)); const LAS float* Ad = AM + zv + (16 * ti) * 68 + 16 * ti; float t[16];
          f32x4 ar[16][4];
#pragma unroll
          for (int i = 1; i < 16; ++i)
#pragma unroll
              for (int k4 = 0; k4 < (i + 3) / 4; ++k4) ar[i][k4] = *(const LAS f32x4*)(Ad + i * 68 + 4 * k4);
#pragma unroll
          for (int i = 0; i < 16; ++i) { float acc = (i == j) ? 1.f : 0.f;
#pragma unroll
              for (int k = 0; k < i; ++k) acc += ar[i][k >> 2][k & 3] * t[k];
              t[i] = acc; }
          if (l4 < 16) {
#pragma unroll
              for (int i = 0; i < 16; ++i) TB[(16 * ti + i) * 16 + j] = (bf16)f2bf(t[i]); } } }
    LDS_WAIT(); __builtin_amdgcn_s_barrier();
    PS_MARK(3);
    if (!(SKIP & 4)) { int l6 = lane; asm volatile("" : "+v"(l6)); const int n = l6 & 15, g = l6 >> 4; f32x4 R[4][2];
#pragma unroll
      for (int b = 0; b < 4; ++b)
#pragma unroll
          for (int nt = 0; nt < 2; ++nt) { const int col = 32 * wave + 16 * nt + n; R[b][nt] = *(const LAS f32x4*)(RHST + col * 68 + ((16 * b + 4 * g + 4 * ((col >> 3) & 15)) & 63)); }
      LDS_WAIT(); __builtin_amdgcn_s_barrier();
      const LAS bf16* tb = TB + n * 16 + 4 * g; const LAS float* am = AM + n * 68 + 4 * g;
#pragma unroll
      for (int b = 0; b < 4; ++b) {
          const u32x2 tw = *(const LAS u32x2*)(tb + (16 * b) * 16); const s16x8 ta = __builtin_bit_cast(s16x8, (v4u){tw.x, tw.y, 0u, 0u});
          s16x8 xb[2];
#pragma unroll
          for (int nt = 0; nt < 2; ++nt) { const s16x8 rb = __builtin_bit_cast(s16x8, (v4u){pk2(R[b][nt].x, R[b][nt].y), pk2(R[b][nt].z, R[b][nt].w), 0u, 0u});
              R[b][nt] = __builtin_amdgcn_mfma_f32_16x16x32_bf16(ta, rb, (f32x4){0.f, 0.f, 0.f, 0.f}, 0, 0, 0);
              xb[nt] = __builtin_bit_cast(s16x8, (v4u){pk2(R[b][nt].x, R[b][nt].y), pk2(R[b][nt].z, R[b][nt].w), 0u, 0u}); }
#pragma unroll
          for (int b2 = b + 1; b2 < 4; ++b2) { const f32x4 av = *(const LAS f32x4*)(am + (16 * b2) * 68 + 16 * b); const s16x8 aa = __builtin_bit_cast(s16x8, (v4u){pk2(av.x, av.y), pk2(av.z, av.w), 0u, 0u});
              R[b2][0] = __builtin_amdgcn_mfma_f32_16x16x32_bf16(aa, xb[0], R[b2][0], 0, 0, 0); R[b2][1] = __builtin_amdgcn_mfma_f32_16x16x32_bf16(aa, xb[1], R[b2][1], 0, 0, 0); } }
      if (wave < 4) { LAS bf16* UL = (LAS bf16*)(F.lds + PR_RHST) + (32 * wave + n) * 72 + 4 * g;
#pragma unroll
          for (int b = 0; b < 4; ++b)
#pragma unroll
              for (int nt = 0; nt < 2; ++nt) *(LAS u32x2*)(UL + nt * 16 * 72 + 16 * b) = (u32x2){pk2(R[b][nt].x, R[b][nt].y), pk2(R[b][nt].z, R[b][nt].w)}; }
      else { LAS bf16* WL = QB + (4 * g) * 136 + 32 * (wave - 4) + n;
#pragma unroll
          for (int b = 0; b < 4; ++b)
#pragma unroll
              for (int nt = 0; nt < 2; ++nt)
#pragma unroll
                  for (int r = 0; r < 4; ++r) WL[(16 * b + r) * 136 + 16 * nt] = (bf16)f2bf(-R[b][nt][r]); } }
    LDS_WAIT(); __builtin_amdgcn_s_barrier();
    PS_MARK(5);
    if (it_next >= 0) { int c9 = ch8, r9 = rg; asm volatile("" : "+v"(c9), "+v"(r9)); prep_fetch(F, it_next, c9, r9, P); }
    if (!DRY) { int t5 = tid; asm volatile("" : "+v"(t5));
#pragma unroll
        for (int i = 0; i < 2; ++i) { const int id = t5 + 512 * i, row = id >> 4, q = id & 15; *(v4u*)(((bf16*)(F.ws + WS_U1)) + blk + row * 128 + 8 * q) = *(const LAS v4u*)(QB + row * 136 + 8 * q); }
        { const int row = t5 >> 3, q = t5 & 7; *(v4u*)(((bf16*)(F.ws + WS_INTRA)) + (size_t)(cn * 8 + h) * 4096 + row * 64 + 8 * q) = *(const LAS v4u*)((LAS bf16*)(F.lds + PR_IL) + row * 72 + 8 * q); }
#pragma unroll
        for (int i = 0; i < 2; ++i) { const int id = t5 + 512 * i, row = id >> 3, q = id & 7;
            *(v4u*)(((bf16*)(F.ws + WS_U3)) + blk + row * 64 + 8 * q) = *(const LAS v4u*)((LAS bf16*)(F.lds + PR_RHST) + row * 72 + 8 * q);
            float kv[8];
#pragma unroll
            for (int j = 0; j < 8; ++j) kv[j] = bf2f(KB[(8 * q + j) * 136 + row]) * S_EK[8 * q + j];
            *(v4u*)(((bf16*)(F.ws + WS_U2)) + blk + row * 64 + 8 * q) = (v4u){pk2(kv[0], kv[1]), pk2(kv[2], kv[3]), pk2(kv[4], kv[5]), pk2(kv[6], kv[7])}; } }
    PS_MARK(6);
    LDS_WAIT();
}
typedef float f32x16 __attribute__((ext_vector_type(16)));
constexpr int SW_KS = 0, SW_VT = 27648, SW_TB = 53248;
__device__ __forceinline__ int t5_bucket(int rel) { const int n = rel < 0 ? -rel : rel;
    const int b = n < 8 ? n : n < 12 ? 8 : n < 16 ? 9 : n < 23 ? 10 : n < 32 ? 11 : n < 46 ? 12 : n < 64 ? 13 : n < 91 ? 14 : 15; return (rel > 0 ? 16 : 0) + b; }
template <bool DRY> __device__ __forceinline__ void swa_unit(Frame& F, int cn, int kh) {
    const int tid = F.tid, lane = F.lane, wave = F.wave, r32 = lane & 31, hi = lane >> 5;
    LAS bf16* KS = (LAS bf16*)(F.lds + SW_KS); LAS bf16* VT = (LAS bf16*)(F.lds + SW_VT); LAS float* TB = (LAS float*)(F.lds + SW_TB);
    const bool smp = cn >= 256; const int b = cn - 256;
#pragma unroll
    for (int it = 0; it < 3; ++it) { const int id = tid + 512 * it, row = id >> 3, dq = id & 7;
        v4u kw = (v4u){0u, 0u, 0u, 0u}, vw = kw;
        if (smp && row < 128) { const size_t so = ((size_t)(b * 128 + row) * 2 + kh) * 64 + dq * 8;
            const f32x4 k0 = *(const f32x4*)((F.in[4]) + so), k1 = *(const f32x4*)((F.in[4]) + so + 4), v0 = *(const f32x4*)((F.in[5]) + so), v1 = *(const f32x4*)((F.in[5]) + so + 4);
            kw = (v4u){pk2(k0.x, k0.y), pk2(k0.z, k0.w), pk2(k1.x, k1.y), pk2(k1.z, k1.w)}; vw = (v4u){pk2(v0.x, v0.y), pk2(v0.z, v0.w), pk2(v1.x, v1.y), pk2(v1.z, v1.w)};
            if (row >= 64 && !DRY) { float* ok = F.out + OFF_SK + (size_t)b * 16384 + (size_t)(row - 64) * 128 + kh * 64 + dq * 8; float* ov = F.out + OFF_SV + (size_t)b * 16384 + (size_t)(row - 64) * 128 + kh * 64 + dq * 8;
                *(f32x4*)ok = k0; *(f32x4*)(ok + 4) = k1; *(f32x4*)ov = v0; *(f32x4*)(ov + 4) = v1; } }
        else { const int kp = smp ? (MP + b * 64 + row - 128) : (cn * 64 - 128 + row);
            if (kp >= 0) { const bf16* src = ((bf16*)(F.ws + WS_KV)) + (size_t)kp * 256 + kh * 64 + dq * 8; kw = *(const v4u*)src; vw = *(const v4u*)(src + 128); } }
        *(LAS v4u*)(KS + row * 72 + dq * 8) = kw;
        LAS bf16* vt = VT + (dq * 8) * 200 + row;
        vt[0] = (bf16)(vw.x & 0xffffu); vt[200] = (bf16)(vw.x >> 16); vt[400] = (bf16)(vw.y & 0xffffu); vt[600] = (bf16)(vw.y >> 16);
        vt[800] = (bf16)(vw.z & 0xffffu); vt[1000] = (bf16)(vw.z >> 16); vt[1200] = (bf16)(vw.w & 0xffffu); vt[1400] = (bf16)(vw.w >> 16); }
    for (int id = tid; id < 8 * 256; id += 512) { const int hl = id >> 8, ix = id & 255; TB[id] = ix < 255 ? (F.in[18])[t5_bucket(ix - 191) * 16 + kh * 8 + hl] : 0.f; }
    __syncthreads();
    const int head = kh * 8 + wave; const float sink = (F.in[17])[head];
    bf16* Qg = ((bf16*)(F.ws + WS_U4)) + (size_t)(cn * 64) * D + head * 64;
    const LAS float* tb = TB + wave * 256;
#pragma unroll 1
    for (int qt = 0; qt < 2; ++qt) {
        s16x8 qf[4];
#pragma unroll
        for (int s = 0; s < 4; ++s) qf[s] = *(const s16x8*)(Qg + (size_t)(32 * qt + r32) * D + 16 * s + 8 * hi);
        f32x16 P[6]; const int qi = 32 * qt + r32; float mx = -INFINITY;
#pragma unroll
        for (int kt = 0; kt < 6; ++kt) { f32x16 acc = {};
#pragma unroll
            for (int s = 0; s < 4; ++s) { const s16x8 a = *(const LAS s16x8*)(KS + (32 * kt + r32) * 72 + 16 * s + 8 * hi); acc = __builtin_amdgcn_mfma_f32_32x32x16_bf16(a, qf[s], acc, 0, 0, 0); }
#pragma unroll
            for (int r = 0; r < 16; ++r) { const int j = 32 * kt + (r & 3) + 8 * (r >> 2) + 4 * hi; float l = acc[r] * 0.125f + tb[j - qi + 63];
                if (!smp && cn * 64 + j < 128) l = -INFINITY; acc[r] = l; mx = fmaxf(mx, l); }
            P[kt] = acc; asm volatile("" ::: "memory"); }
        mx = fmaxf(mx, __shfl_xor(mx, 32)); mx = fmaxf(mx, sink);
        float sum = 0.f;
#pragma unroll
        for (int kt = 0; kt < 6; ++kt)
#pragma unroll
            for (int r = 0; r < 16; ++r) { const float p = fexp(P[kt][r] - mx); P[kt][r] = p; sum += p; }
        sum += __shfl_xor(sum, 32);
        const float inv = 1.f / (sum + fexp(sink - mx));
        f32x16 O[2]; O[0] = (f32x16){}; O[1] = (f32x16){};
#pragma unroll
        for (int kt = 0; kt < 6; ++kt) {
#pragma unroll
            for (int s2 = 0; s2 < 2; ++s2) { v4u pw; pw.x = pk2(P[kt][8 * s2] * inv, P[kt][8 * s2 + 1] * inv); pw.y = pk2(P[kt][8 * s2 + 2] * inv, P[kt][8 * s2 + 3] * inv);
                pw.z = pk2(P[kt][8 * s2 + 4] * inv, P[kt][8 * s2 + 5] * inv); pw.w = pk2(P[kt][8 * s2 + 6] * inv, P[kt][8 * s2 + 7] * inv);
                const s16x8 pa = __builtin_bit_cast(s16x8, pw);
#pragma unroll
                for (int dt = 0; dt < 2; ++dt) { const LAS bf16* vp = VT + (32 * dt + r32) * 200 + 32 * kt + 16 * s2 + 4 * hi;
                    const u32x2 lo = *(const LAS u32x2*)vp, hh = *(const LAS u32x2*)(vp + 8);
                    const s16x8 vb = __builtin_bit_cast(s16x8, (v4u){lo.x, lo.y, hh.x, hh.y});
                    O[dt] = __builtin_amdgcn_mfma_f32_32x32x16_bf16(pa, vb, O[dt], 0, 0, 0); } }
            asm volatile("" ::: "memory"); }
#pragma unroll
        for (int dt = 0; dt < 2; ++dt)
#pragma unroll
            for (int r = 0; r < 16; ++r) { const int q = 32 * qt + (r & 3) + 8 * (r >> 2) + 4 * hi; const unsigned ov = f2bf(O[dt][r]); if (!DRY) Qg[(size_t)q * D + 32 * dt + r32] = (bf16)ov; else asm volatile("" :: "v"(ov)); }
    }
    __syncthreads();
}
constexpr int SC_WN = 0, SC_QP = 16384, SC_KPT = 32768, SC_IN = 49152, SC_STAGE = 57344;
template <int C, int NCHUNK> __device__ __forceinline__ void tile_rq(int lt, int i, int& row, int& q) {
    const int l = lt & 63, lw = lt >> 6, grp = l >> 4, s = NCHUNK * lw + i;
    const int rb = (C == 128) ? (s >> 1) : s, qb = (C == 128) ? 8 * (s & 1) : 0;
    row = 8 * rb + (l & 7); q = qb + 4 * (grp >> 1) + (grp & 1) + 2 * ((l >> 3) & 1);
}
template <int C, int NCHUNK> __device__ __forceinline__ void ld_tile(const bf16* src, int lt, v4u (&reg)[NCHUNK]) {
#pragma unroll
    for (int i = 0; i < NCHUNK; ++i) { int row, q; tile_rq<C, NCHUNK>(lt, i, row, q); reg[i] = *(const v4u*)(src + (size_t)row * C + 8 * q); }
}
template <int C, int NCHUNK> __device__ __forceinline__ void st_tile(LAS unsigned char* base, int lt, const v4u (&reg)[NCHUNK]) {
#pragma unroll
    for (int i = 0; i < NCHUNK; ++i) { int row, q; tile_rq<C, NCHUNK>(lt, i, row, q); const int ks = q >> 2, qq = q & 3;
        LAS unsigned char* d0 = base + ((row >> 4) * (C / 32) + ks) * 1024 + ((2 * (qq & 1)) * 16 + (row & 15)) * 16 + (qq >> 1) * 8;
        *(LAS u32x2*)d0 = (u32x2){reg[i].x, reg[i].y}; *(LAS u32x2*)(d0 + 256) = (u32x2){reg[i].z, reg[i].w}; }
}
__device__ __forceinline__ s16x8 pack_b(f32x4 a, f32x4 b) { v4u w; w.x = pk2(a.x, a.y); w.y = pk2(a.z, a.w); w.z = pk2(b.x, b.y); w.w = pk2(b.z, b.w); return __builtin_bit_cast(s16x8, w); }
#define MF16(a, b, c) __builtin_amdgcn_mfma_f32_16x16x32_bf16(a, b, c, 0, 0, 0)
template <bool DRY, int SKIP = 0> __device__ __forceinline__ void scan_task(Frame& F, int cn0, int nchunk, int h, int hf, const float* s0, float* sout, bool write_s) {
    const int lane = F.lane, wave = F.wave, e = lane & 15, g = lane >> 4;
    LAS unsigned char* ring = F.lds;
    if (wave >= 4) {
#ifndef SCAN_NO_LOADER
        const int lt = F.tid - 256; v4u rw[4], rq[4], rk[4], ri[2], sw[4], sq[4], sk[4], si[2];
#define LD_SET(cn, W, Q, K, I) do { const size_t blk_ = (size_t)((cn) * 8 + h) * 8192; ld_tile<128, 4>(((bf16*)(F.ws + WS_U1)) + blk_, lt, W); ld_tile<128, 4>(((bf16*)(F.ws + WS_U5)) + blk_, lt, Q); ld_tile<64, 4>(((bf16*)(F.ws + WS_U2)) + blk_, lt, K); ld_tile<64, 2>(((bf16*)(F.ws + WS_INTRA)) + (size_t)((cn) * 8 + h) * 4096, lt, I); } while (0)
#define ST_SET(st, W, Q, K, I) do { LAS unsigned char* b_ = ring + (st) * SC_STAGE; st_tile<128, 4>(b_ + SC_WN, lt, W); st_tile<128, 4>(b_ + SC_QP, lt, Q); st_tile<64, 4>(b_ + SC_KPT, lt, K); st_tile<64, 2>(b_ + SC_IN, lt, I); } while (0)
        if (!(SKIP & 1)) { LD_SET(cn0, rw, rq, rk, ri); ST_SET(0, rw, rq, rk, ri); if (nchunk > 1) LD_SET(cn0 + 1, sw, sq, sk, si); if (nchunk > 2) LD_SET(cn0 + 2, rw, rq, rk, ri); }
        LDS_WAIT(); __builtin_amdgcn_s_barrier();
#pragma unroll 1
        for (int n = 0; n < nchunk; ++n) {
            if (n + 1 < nchunk && !(SKIP & 1)) {
                if (n & 1) { ST_SET(0, rw, rq, rk, ri); if (n + 3 < nchunk) LD_SET(cn0 + n + 3, rw, rq, rk, ri); }
                else { ST_SET(1, sw, sq, sk, si); if (n + 3 < nchunk) LD_SET(cn0 + n + 3, sw, sq, sk, si); } }
            LDS_WAIT(); __builtin_amdgcn_s_barrier();
        }
#undef LD_SET
#undef ST_SET
#endif
    } else {
#ifndef SCAN_NO_SCAN
        const int e0 = 64 * hf + 16 * wave + e;
        f32x4 S[8];
#pragma unroll
        for (int dt = 0; dt < 8; ++dt) { const float* p = (const float*)((const char*)s0 + (size_t)((unsigned)((16 * dt + 4 * g) * 128 + e0) * 4u)); S[dt] = (f32x4){p[0], p[128], p[256], p[384]}; }
        u32x2 ucur[4], unext[4];
        { const bf16* up = ((bf16*)(F.ws + WS_U3)) + ((size_t)(cn0 * 8 + h) * 128 + e0) * 64 + 4 * g;
#pragma unroll
          for (int mt = 0; mt < 4; ++mt) ucur[mt] = *(const u32x2*)(up + 16 * mt); }
        __builtin_amdgcn_s_barrier();
#pragma unroll 1
        for (int n = 0; n < nchunk; ++n) {
            const int cn = cn0 + n; const LAS unsigned char* st = ring + (n & 1) * SC_STAGE + lane * 16;
            const float gl = ((float*)(F.ws + WS_GL))[cn * 8 + h];
            bf16* op = ((bf16*)(F.ws + WS_U3)) + ((size_t)(cn * 8 + h) * 128 + e0) * 64 + 4 * g;
            if (n + 1 < nchunk) {
#pragma unroll
                for (int mt = 0; mt < 4; ++mt) unext[mt] = *(const u32x2*)(op + 8 * 128 * 64 + 16 * mt); }
            if (SKIP & 2) { LDS_WAIT(); __builtin_amdgcn_s_barrier(); continue; }
            s16x8 Sb[4];
#pragma unroll
            for (int ks = 0; ks < 4; ++ks) Sb[ks] = pack_b(S[2 * ks], S[2 * ks + 1]);
            f32x4 Vn[4], O[4];
#pragma unroll
            for (int mt = 0; mt < 4; ++mt) { Vn[mt] = (f32x4){bflo(ucur[mt].x), bfhi(ucur[mt].x), bflo(ucur[mt].y), bfhi(ucur[mt].y)}; O[mt] = (f32x4){0.f, 0.f, 0.f, 0.f}; }
            s16x8 fa[8], fb[8];
#define FENCE() asm volatile("" ::: "memory")
#define LD_WQ(dst, mt) do { _Pragma("unroll") for (int ks = 0; ks < 4; ++ks) { dst[ks] = *(const LAS s16x8*)(st + SC_WN + ((mt) * 4 + ks) * 1024); dst[4 + ks] = *(const LAS s16x8*)(st + SC_QP + ((mt) * 4 + ks) * 1024); } } while (0)
#define MM_WQ(src, mt) do { _Pragma("unroll") for (int ks = 0; ks < 4; ++ks) { Vn[mt] = MF16(src[ks], Sb[ks], Vn[mt]); O[mt] = MF16(src[4 + ks], Sb[ks], O[mt]); } } while (0)
#define LD_4(dst, off, a) do { _Pragma("unroll") for (int i_ = 0; i_ < 4; ++i_) dst[i_] = *(const LAS s16x8*)(st + (off) + ((a) * 4 + i_) * 1024); } while (0)
#define MM_IN(src, mp) do { O[2 * (mp)] = MF16(src[0], Vb[0], O[2 * (mp)]); O[2 * (mp)] = MF16(src[1], Vb[1], O[2 * (mp)]); O[2 * (mp) + 1] = MF16(src[2], Vb[0], O[2 * (mp) + 1]); O[2 * (mp) + 1] = MF16(src[3], Vb[1], O[2 * (mp) + 1]); } while (0)
#define MM_KP(src, dp) do { S[2 * (dp)] = MF16(src[0], Vb[0], S[2 * (dp)]); S[2 * (dp)] = MF16(src[1], Vb[1], S[2 * (dp)]); S[2 * (dp) + 1] = MF16(src[2], Vb[0], S[2 * (dp) + 1]); S[2 * (dp) + 1] = MF16(src[3], Vb[1], S[2 * (dp) + 1]); } while (0)
            LD_WQ(fa, 0); FENCE(); LD_WQ(fb, 1); MM_WQ(fa, 0); FENCE(); LD_WQ(fa, 2); MM_WQ(fb, 1); FENCE(); LD_WQ(fb, 3); MM_WQ(fa, 2); FENCE(); LD_4(fa, SC_IN, 0); MM_WQ(fb, 3); FENCE();
#pragma unroll
            for (int dt = 0; dt < 8; ++dt) S[dt] = S[dt] * gl;
            s16x8 Vb[2];
#pragma unroll
            for (int k2 = 0; k2 < 2; ++k2) Vb[k2] = pack_b(Vn[2 * k2], Vn[2 * k2 + 1]);
            LD_4(fb, SC_IN, 1); MM_IN(fa, 0); FENCE(); LD_4(fa, SC_KPT, 0); MM_IN(fb, 1); FENCE(); LD_4(fb, SC_KPT, 1); MM_KP(fa, 0); FENCE(); LD_4(fa, SC_KPT, 2); MM_KP(fb, 1); FENCE(); LD_4(fb, SC_KPT, 3); MM_KP(fa, 2); FENCE(); MM_KP(fb, 3);
#undef FENCE
#undef LD_WQ
#undef MM_WQ
#undef LD_4
#undef MM_IN
#undef MM_KP
#pragma unroll
            for (int mt = 0; mt < 4; ++mt) { u32x2 w; w.x = pk2(O[mt].x, O[mt].y); w.y = pk2(O[mt].z, O[mt].w); if (!DRY) *(u32x2*)(op + 16 * mt) = w; else asm volatile("" :: "v"(w.x), "v"(w.y)); ucur[mt] = unext[mt]; }
            LDS_WAIT(); __builtin_amdgcn_s_barrier();
        }
        { unsigned so = (unsigned)((4 * g) * 128 + e0) * 4u; asm volatile("" : "+v"(so));
#pragma unroll
          for (int dt = 0; dt < 8; ++dt) { float* p = (float*)((char*)sout + (size_t)(so + dt * 8192u)); if (!DRY && write_s) { p[0] = S[dt].x; p[128] = S[dt].y; p[256] = S[dt].z; p[384] = S[dt].w; } else asm volatile("" :: "v"(S[dt].x), "v"(S[dt].y), "v"(S[dt].z), "v"(S[dt].w)); } }
#endif
    }
}

__device__ __forceinline__ void scanA_task(Frame& F, int cn0, int nchunk, int h, int hf, float* sout, bf16* mout) {
    const int lane = F.lane, wave = F.wave, e = lane & 15, g = lane >> 4;
    LAS unsigned char* ring = F.lds;
    if (wave >= 4) {
        const int lt = F.tid - 256; v4u rw[4], rk[4];
#define LD_A(cn) do { const size_t blk_ = (size_t)((cn) * 8 + h) * 8192; ld_tile<128, 4>(((bf16*)(F.ws + WS_U1)) + blk_, lt, rw); ld_tile<64, 4>(((bf16*)(F.ws + WS_U2)) + blk_, lt, rk); } while (0)
#define ST_A(st) do { LAS unsigned char* b_ = ring + (st) * SC_STAGE; st_tile<128, 4>(b_ + SC_WN, lt, rw); st_tile<64, 4>(b_ + SC_KPT, lt, rk); } while (0)
        LD_A(cn0); ST_A(0); if (nchunk > 1) LD_A(cn0 + 1);
        LDS_WAIT(); __builtin_amdgcn_s_barrier();
#pragma unroll 1
        for (int n = 0; n < nchunk; ++n) {
            if (n + 1 < nchunk) { ST_A((n + 1) & 1); if (n + 2 < nchunk) LD_A(cn0 + n + 2); }
            LDS_WAIT(); __builtin_amdgcn_s_barrier();
        }
#undef LD_A
#undef ST_A
    } else {
        const int e0 = 64 * hf + 16 * wave + e;
        f32x4 S[8], X[8];
#pragma unroll
        for (int dt = 0; dt < 8; ++dt) { S[dt] = (f32x4){0.f, 0.f, 0.f, 0.f}; const int d0 = 16 * dt + 4 * g;
            X[dt] = (f32x4){d0 == e0 ? 1.f : 0.f, d0 + 1 == e0 ? 1.f : 0.f, d0 + 2 == e0 ? 1.f : 0.f, d0 + 3 == e0 ? 1.f : 0.f}; }
        u32x2 ucur[4], unext[4];
        { const bf16* up = ((bf16*)(F.ws + WS_U3)) + ((size_t)(cn0 * 8 + h) * 128 + e0) * 64 + 4 * g;
#pragma unroll
          for (int mt = 0; mt < 4; ++mt) ucur[mt] = *(const u32x2*)(up + 16 * mt); }
        __builtin_amdgcn_s_barrier();
#pragma unroll 1
        for (int n = 0; n < nchunk; ++n) {
            const int cn = cn0 + n; const LAS unsigned char* st = ring + (n & 1) * SC_STAGE + lane * 16;
            const float gl = ((float*)(F.ws + WS_GL))[cn * 8 + h];
            const bf16* op = ((bf16*)(F.ws + WS_U3)) + ((size_t)(cn * 8 + h) * 128 + e0) * 64 + 4 * g;
            if (n + 1 < nchunk) {
#pragma unroll
                for (int mt = 0; mt < 4; ++mt) unext[mt] = *(const u32x2*)(op + 8 * 128 * 64 + 16 * mt); }
            s16x8 Sb[4], Xb[4];
#pragma unroll
            for (int ks = 0; ks < 4; ++ks) { Sb[ks] = pack_b(S[2 * ks], S[2 * ks + 1]); Xb[ks] = pack_b(X[2 * ks], X[2 * ks + 1]); }
            f32x4 Vn[4], Vx[4];
#pragma unroll
            for (int mt = 0; mt < 4; ++mt) { Vn[mt] = (f32x4){bflo(ucur[mt].x), bfhi(ucur[mt].x), bflo(ucur[mt].y), bfhi(ucur[mt].y)}; Vx[mt] = (f32x4){0.f, 0.f, 0.f, 0.f}; }
#pragma unroll
            for (int mt = 0; mt < 4; ++mt)
#pragma unroll
                for (int ks = 0; ks < 4; ++ks) { const s16x8 aw = *(const LAS s16x8*)(st + SC_WN + (mt * 4 + ks) * 1024);
                    Vn[mt] = MF16(aw, Sb[ks], Vn[mt]); Vx[mt] = MF16(aw, Xb[ks], Vx[mt]); if (ks == 3) asm volatile("" ::: "memory"); }
#pragma unroll
            for (int dt = 0; dt < 8; ++dt) { S[dt] = S[dt] * gl; X[dt] = X[dt] * gl; }
            s16x8 Vb[2], Wb[2];
#pragma unroll
            for (int k2 = 0; k2 < 2; ++k2) { Vb[k2] = pack_b(Vn[2 * k2], Vn[2 * k2 + 1]); Wb[k2] = pack_b(Vx[2 * k2], Vx[2 * k2 + 1]); }
#pragma unroll
            for (int dt = 0; dt < 8; ++dt)
#pragma unroll
                for (int k2 = 0; k2 < 2; ++k2) { const s16x8 ak = *(const LAS s16x8*)(st + SC_KPT + (dt * 2 + k2) * 1024); S[dt] = MF16(ak, Vb[k2], S[dt]); X[dt] = MF16(ak, Wb[k2], X[dt]); if (k2 == 1 && (dt & 1)) asm volatile("" ::: "memory"); }
#pragma unroll
            for (int mt = 0; mt < 4; ++mt) ucur[mt] = unext[mt];
            LDS_WAIT(); __builtin_amdgcn_s_barrier();
        }
        { unsigned so = (unsigned)((4 * g) * 128 + e0); asm volatile("" : "+v"(so));
#pragma unroll
          for (int dt = 0; dt < 8; ++dt) { float* p = sout + so + dt * 2048u; p[0] = S[dt].x; p[128] = S[dt].y; p[256] = S[dt].z; p[384] = S[dt].w;
              bf16* q = mout + so + dt * 2048u; q[0] = (bf16)f2bf(X[dt].x); q[128] = (bf16)f2bf(X[dt].y); q[256] = (bf16)f2bf(X[dt].z); q[384] = (bf16)f2bf(X[dt].w); } }
    }
}
template <int NGR, int J> __device__ __forceinline__ void scanB_step(Frame& F, int n, int h, int cb, int rq, size_t roff, const bf16* MG, float* SG, v4u (&rm)[3][4], f32x4 (&Bq)[3][2]) {
    LAS unsigned char* ring = F.lds; LAS unsigned char* XB = ring + 2 * SC_STAGE; const int lane = F.lane;
    const LAS unsigned char* st = ring + (n & 1) * SC_STAGE + lane * 16;
    const LAS unsigned char* xr = XB + (((n & 1) * 2 + cb) * 4) * 1024 + lane * 16;
    s16x8 Sb[4];
#pragma unroll
    for (int ks = 0; ks < 4; ++ks) Sb[ks] = *(const LAS s16x8*)(xr + ks * 1024);
    f32x4 S[2];
#pragma unroll
    for (int dt = 0; dt < 2; ++dt) { f32x4 acc = Bq[J][dt];
#pragma unroll
        for (int ks = 0; ks < 4; ++ks) { const s16x8 am = *(const LAS s16x8*)(st + ((2 * rq + dt) * 4 + ks) * 1024); acc = MF16(am, Sb[ks], acc); }
        S[dt] = acc; }
    *(LAS s16x8*)(XB + (((((n + 1) & 1) * 2 + cb) * 4) + rq) * 1024 + lane * 16) = pack_b(S[0], S[1]);
    st_tile<128, 4>(ring + ((n + 1) & 1) * SC_STAGE, F.tid, rm[(J + 1) % 3]);
    { const int nm = n + 4 < NGR ? n + 4 : NGR - 1; ld_tile<128, 4>(MG + (size_t)(nm * 8 + h) * 16384, F.tid, rm[(J + 1) % 3]); }
    float* bp = SG + (size_t)(n * 8 + h) * 16384 + roff;
    { const int nb = n + 3 < NGR ? n + 3 : NGR - 1; const float* bq = SG + (size_t)(nb * 8 + h) * 16384 + roff;
#pragma unroll
      for (int dt = 0; dt < 2; ++dt) { const float* p = bq + dt * 2048; Bq[J][dt] = (f32x4){p[0], p[128], p[256], p[384]}; } }
#pragma unroll
    for (int dt = 0; dt < 2; ++dt) { float* p = bp + dt * 2048; p[0] = S[dt].x; p[128] = S[dt].y; p[256] = S[dt].z; p[384] = S[dt].w; }
    LDS_WAIT(); __builtin_amdgcn_s_barrier();
}
template <int NGR> __device__ __forceinline__ void scanB_task(Frame& F, int h, int cq, const bf16* MG, float* SG) {
    static_assert(NGR % 3 == 0 && NGR >= 6, "pass B steps come in threes");
    const int lane = F.lane, e = lane & 15, g4 = lane >> 4, cb = F.wave & 1, rq = F.wave >> 1;
    LAS unsigned char* ring = F.lds; LAS unsigned char* XB = ring + 2 * SC_STAGE;
    const int e0 = 32 * cq + 16 * cb + e; const size_t roff = (size_t)(32 * rq + 4 * g4) * 128 + e0;
    v4u rm[3][4]; f32x4 Bq[3][2];
    ld_tile<128, 4>(MG + (size_t)h * 16384, F.tid, rm[0]); st_tile<128, 4>(ring, F.tid, rm[0]);
    ld_tile<128, 4>(MG + (size_t)(1 * 8 + h) * 16384, F.tid, rm[1]);
    ld_tile<128, 4>(MG + (size_t)(2 * 8 + h) * 16384, F.tid, rm[2]);
    ld_tile<128, 4>(MG + (size_t)(3 * 8 + h) * 16384, F.tid, rm[0]);
#pragma unroll
    for (int q = 0; q < 3; ++q) { const float* bp0 = SG + (size_t)(q * 8 + h) * 16384 + roff;
#pragma unroll
        for (int dt = 0; dt < 2; ++dt) { const float* p = bp0 + dt * 2048; Bq[q][dt] = (f32x4){p[0], p[128], p[256], p[384]}; } }
    *(LAS v4u*)(XB + (cb * 4 + rq) * 1024 + lane * 16) = (v4u){0u, 0u, 0u, 0u};
    LDS_WAIT(); __builtin_amdgcn_s_barrier();
    scanB_step<NGR, 0>(F, 0, h, cb, rq, roff, MG, SG, rm, Bq); scanB_step<NGR, 1>(F, 1, h, cb, rq, roff, MG, SG, rm, Bq); scanB_step<NGR, 2>(F, 2, h, cb, rq, roff, MG, SG, rm, Bq);
#pragma unroll 1
    for (int n0 = 3; n0 < NGR; n0 += 3) {
        scanB_step<NGR, 0>(F, n0, h, cb, rq, roff, MG, SG, rm, Bq); scanB_step<NGR, 1>(F, n0 + 1, h, cb, rq, roff, MG, SG, rm, Bq); scanB_step<NGR, 2>(F, n0 + 2, h, cb, rq, roff, MG, SG, rm, Bq);
    }
}
#undef MF16
constexpr int SCAN_NG = 16, SCAN_GC = 16;
constexpr size_t WS_MG = 242 * MiB, WS_SG = 246 * MiB;
__device__ __forceinline__ void scanA_phase(Frame& F) {
    const int bx = blockIdx.x; bf16* MG = (bf16*)(F.ws + WS_MG); float* SG = (float*)(F.ws + WS_SG);
    if (bx < (SCAN_NG - 1) * 16) { const int gq = bx >> 4, h = bx & 7, hf = (bx >> 3) & 1;
        scanA_task(F, gq * SCAN_GC, SCAN_GC, h, hf, SG + (size_t)(gq * 8 + h) * 16384, MG + (size_t)(gq * 8 + h) * 16384); }
    for (int t = (bx + 16) % F.G; t < 512; t += F.G) { const int b = t >> 4, h = t & 7, hf = (t >> 3) & 1;
        scan_task<false>(F, 256 + b, 1, h, hf, ((const float*)(F.in[3])) + (size_t)(b * 8 + h) * 16384, F.out + OFF_SS + (size_t)(b * 8 + h) * 16384, true); }
}
constexpr int SCANB_WGS = 32;
__device__ __forceinline__ void scanB_phase(Frame& F) { const int bx = blockIdx.x; for (int t = bx; t < SCANB_WGS; t += F.G) { scanB_task<SCAN_NG - 1>(F, t & 7, t >> 3, (const bf16*)(F.ws + WS_MG), (float*)(F.ws + WS_SG)); __syncthreads(); } }
template <bool DRY, int SKIP = 0> __device__ __forceinline__ void scanC_phase(Frame& F) {
    const int bx = blockIdx.x;
    for (int t = bx; t < SCAN_NG * 16; t += F.G) { const int gq = t >> 4, h = t & 7, hf = (t >> 3) & 1;
        const float* s0 = gq == 0 ? (const float*)(F.ws + WS_CTL + 512 * 1024) : (const float*)(F.ws + WS_SG) + (size_t)((gq - 1) * 8 + h) * 16384;
        scan_task<DRY, SKIP>(F, gq * SCAN_GC, SCAN_GC, h, hf, s0, F.out + OFF_PS + (size_t)h * 16384, gq == SCAN_NG - 1); }
}
struct NgRegs { unsigned short o[16]; v4u z0, z1; };
__device__ __forceinline__ void ng_load(Frame& F, int it, int c, int eg, NgRegs& r) {
    const int cn = it >> 3, h = it & 7;
    const bf16* op = ((bf16*)(F.ws + WS_U3)) + ((size_t)(cn * 8 + h) * 128 + 16 * eg) * 64 + c;
#pragma unroll
    for (int i = 0; i < 16; ++i) r.o[i] = op[i * 64];
    const size_t ro = (size_t)(cn * 64 + c) * D + h * 128 + 16 * eg;
    r.z0 = *(const v4u*)(((bf16*)(F.ws + WS_U2)) + ro); r.z1 = *(const v4u*)(((bf16*)(F.ws + WS_U2)) + ro + 8);
}
__device__ __forceinline__ void normgate_phase(Frame& F) {
    const int tid = F.tid, c = tid & 63, eg = F.wave; LAS float* red = (LAS float*)F.lds;
    int it = F.vcu; if (it >= NCH * 8) return;
    NgRegs cur, nxt; ng_load(F, it, c, eg, cur); int par = 0;
    const float* nw = (F.in[16]) + 16 * eg;
#pragma unroll 1
    for (; it < NCH * 8; it += F.G) {
        const bool has_next = it + F.G < NCH * 8;
        if (has_next) ng_load(F, it + F.G, c, eg, nxt);
        float o[16]; float ss = 0.f;
#pragma unroll
        for (int i = 0; i < 16; ++i) { o[i] = bf2f(cur.o[i]); ss += o[i] * o[i]; }
        LAS float* rd = red + par * 512; rd[eg * 64 + c] = ss;
        __syncthreads();
        float tot = 0.f;
#pragma unroll
        for (int w = 0; w < 8; ++w) tot += rd[w * 64 + c];
        const float ri = __builtin_amdgcn_rsqf(tot * (1.f / 128.f) + EPS);
        const unsigned zz[8] = {cur.z0.x, cur.z0.y, cur.z0.z, cur.z0.w, cur.z1.x, cur.z1.y, cur.z1.z, cur.z1.w}; unsigned w[8];
#pragma unroll
        for (int i = 0; i < 8; ++i) w[i] = pk2(o[2 * i] * ri * nw[2 * i] * siluf(bflo(zz[i])), o[2 * i + 1] * ri * nw[2 * i + 1] * siluf(bfhi(zz[i])));
        const int cn = it >> 3, h = it & 7;
        bf16* dst = ((bf16*)(F.ws + WS_U1)) + (size_t)(cn * 64 + c) * D + h * 128 + 16 * eg;
        *(v4u*)dst = (v4u){w[0], w[1], w[2], w[3]}; *(v4u*)(dst + 8) = (v4u){w[4], w[5], w[6], w[7]};
        cur = nxt; par ^= 1;
    }
}
#ifndef PREP_STAGGER
#define PREP_STAGGER 3
#endif
#ifndef PREP_DROP
#define PREP_DROP 2
#endif
__device__ __forceinline__ int prep_unit_id(const Frame& F, int i) {
    if (F.G != 256) { const long it = (long)F.vcu + (long)i * F.G; return it < NCH * 8 ? (int)it : -1; }
    const int v = F.vcu;
    if (v < 64) return i < 9 - PREP_DROP ? v + 256 * i : -1;
    if (i < 9) return v + 256 * i;
    const int e = (v - 64) >> 3;
    return (i == 9 && e < 8 * PREP_DROP) ? 8 * (e & 7) + (v & 7) + 256 * (9 - PREP_DROP + (e >> 3)) : -1;
}
#ifndef CONV1_H2
#define CONV1_H2 0
#endif
#ifndef PROBE_AMP
#define PROBE_AMP 1
#endif
#ifndef ADA_NA
#define ADA_NA 5
#endif
enum Phase { PH_P0 = 0, PH_H1, PH_G1, PH_G2, PH_H2, PH_F1, PH_PREP, PH_SCAN, PH_SCANB, PH_SCANC, PH_F2, PH_NG, PH_G4A, PH_G4B, PH_G5, PH_H3, PH_G6, PH_G7, PH_FIN, PH_COUNT };
struct Args { const float* in[28]; float* out; unsigned char* ws; int ph_lo, ph_hi; };
static_assert(sizeof(Args) == 28 * 8 + 8 + 8 + 8, "Args has no padding");

#ifdef ONLY_PH
#define PHON(x) ((x) == ONLY_PH)
#else
#define PHON(x) true
#endif
template <class Epi> __device__ __forceinline__ void run_gemm(Frame& F, const bf16* A, const bf16* Bt, int N, int K, const Epi& E, int lda = 0) {
    pg8::Gemm g{A, Bt, M, N, K, lda}; pg8::StaticOrder S; S.init(M, N, F.G, (int)blockIdx.x); S.ntf = K / 64;
    pg8::gemm_phase<Epi, pg8::StaticOrder, PG8_ALIGN, PG8_SP2>(F.lds, g, S, E);
}

struct SplitOrder : pg8::StaticOrder {
    bool split; int probe2 = 0; bool only_first = false;
    __device__ __forceinline__ bool next(int i, pg8::Unit& u) const {
        if (!split) return pg8::StaticOrder::next(i, u);
        if (only_first && i > 0) return false;
        if (probe2) { if (i > 0) return false; i = 1; }
        if (i > 1) return false;
        const int x = c & 7, j = c >> 3;
        if (i == 0) { u.pm = 8 * x + (j & 7); u.pn = j >> 3; u.k0 = 0; u.nt = ntf; u.piece = 0; u.lidx = 0; return true; }
        const int P = 8, pc = x, pairs = ntf / 2, base = pairs / P, extra = pairs - base * P;
        u.pm = 64 + (j & 7); u.pn = j >> 3; u.lidx = (j & 7) * 4 + (j >> 3);
        u.k0 = 2 * (pc * base + (pc < extra ? pc : extra)); u.nt = 2 * (base + (pc < extra ? 1 : 0)); u.piece = pc + 1; if (probe2 == 2) u.nt = 2; return true;
    }
};
struct PiecesAB : pg8::StaticOrder {
    __device__ __forceinline__ bool next(int i, pg8::Unit& u) const {
        if (i > 0) return false;
        const int x = c & 7, j = c >> 3;
        u.pm = 64 + (j & 7); u.pn = j >> 3; u.lidx = (j & 7) * 4 + (j >> 3); u.k0 = 4 * (x & 3); u.nt = 4; u.piece = x + 1; return true;
    }
};
__device__ __forceinline__ void branch_fixup_rows(Frame& F, const bf16* part) {
    const int gw = F.vcu * NWAVES + F.wave, NGW = F.G * NWAVES;
    for (int m = MP + gw; m < M; m += NGW) {
        GAS u32x2* ga = (GAS u32x2*)(((bf16*)(F.ws + WS_U5)) + (size_t)m * D) + F.lane; const GAS u32x2* gb = (const GAS u32x2*)(((bf16*)(F.ws + WS_U6)) + (size_t)m * D) + F.lane;
#pragma unroll
        for (int j = 0; j < 4; ++j) { const int li = ((m >> 8) - 64) * 4 + j;
            const GAS u32x2* pp = (const GAS u32x2*)(part + (size_t)li * 8 * 65536 + (size_t)(m & 255) * 256) + F.lane; f32x4 sa = (f32x4){0.f, 0.f, 0.f, 0.f}, sb = sa;
#pragma unroll
            for (int p = 0; p < 4; ++p) { const u32x2 w = pp[(size_t)p * 16384]; sa += (f32x4){bflo(w.x), bfhi(w.x), bflo(w.y), bfhi(w.y)}; }
#pragma unroll
            for (int p = 4; p < 8; ++p) { const u32x2 w = pp[(size_t)p * 16384]; sb += (f32x4){bflo(w.x), bfhi(w.x), bflo(w.y), bfhi(w.y)}; }
            const u32x2 a = ga[64 * j], b = gb[64 * j];
            const f32x4 o = (f32x4){sigm(bflo(a.x)) * sa.x + sigm(bflo(b.x)) * sb.x, sigm(bfhi(a.x)) * sa.y + sigm(bfhi(b.x)) * sb.y, sigm(bflo(a.y)) * sa.z + sigm(bflo(b.y)) * sb.z, sigm(bfhi(a.y)) * sa.w + sigm(bfhi(b.y)) * sb.w};
            ga[64 * j] = (u32x2){pk2(o.x, o.y), pk2(o.z, o.w)}; }
    }
}
template <class Epi> __device__ __forceinline__ void run_gemm_split(Frame& F, const bf16* A, const bf16* Bt, int N, int K, const Epi& E, int probe = 0) {
    pg8::Gemm g{A, Bt, M, N, K, 0}; SplitOrder S; S.init(M, N, F.G, (int)blockIdx.x); S.ntf = K / 64; S.split = (F.G == 256); S.only_first = (probe == 2); S.probe2 = probe >= 3 ? probe - 2 : 0;
    pg8::gemm_phase<Epi, SplitOrder, PG8_ALIGN, PG8_SP2>(F.lds, g, S, E);
}
__global__ void __launch_bounds__(NWAVES * 64, 2) mega_fwd(Args args) {
    extern __shared__ __attribute__((aligned(16))) unsigned char lds[];
    Frame F;
    F.lds = (LAS unsigned char*)lds; F.MISC = (volatile LAS unsigned*)(F.lds + MISC_OFF);
    F.tid = threadIdx.x; F.lane = F.tid & 63; F.wave = __builtin_amdgcn_readfirstlane(F.tid >> 6);
    F.G = gridDim.x; { const int bx = blockIdx.x; F.vcu = (F.G % 8 == 0) ? (bx % 8) * (F.G / 8) + bx / 8 : bx; }
    unsigned char* ws = args.ws; F.ctl = (gu32*)(ws + WS_CTL);
    F.in = args.in; F.out = args.out; F.ws = ws;
    for (int u = F.tid; u < (LDS_BYTES - LDSCTL_OFF) / 4; u += NWAVES * 64) ((LAS unsigned*)(F.lds + LDSCTL_OFF))[u] = 0u;
    __syncthreads();
    XcdBarrier bar; bar.bar = (unsigned*)(F.ctl + CW_BAR); bar.x = 0; bar.st = nullptr;
    const bool multi = args.ph_hi - args.ph_lo > 1;
    if (multi) bar = xcd_barrier_post((unsigned*)(F.ctl + CW_BAR), F.MISC + 8);

    const int lo = args.ph_lo, hi = args.ph_hi;
#if defined(PROBE_TS)
    if (blockIdx.x == 0 && F.tid == 0) ((volatile LAS unsigned long long*)(F.lds + LDSCTL_OFF + 512))[0] = __builtin_amdgcn_s_memrealtime();
#endif
#define IN(k) (PHON(k) && lo <= (k) && (k) < hi)
#define SEAM(k) do { if (lo <= (k) && (k) + 1 < hi) xcd_barrier(bar); } while (0)
#if defined(PROBE_TS)
#undef SEAM
#define SEAM(k) do { if (lo <= (k) && (k) + 1 < hi) xcd_barrier(bar); if (blockIdx.x == 0 && F.tid == 0) ((volatile LAS unsigned long long*)(F.lds + LDSCTL_OFF + 512))[(k) + 1] = __builtin_amdgcn_s_memrealtime(); } while (0)
#endif
#if defined(PROBE_P0)
    if (IN(PH_P0)) { { { const bool sp = F.G >= 160; const int nB = sp ? (4224 - 144 * ADA_NA + F.G - 145) / (F.G - 144) : (4224 + F.G - 1) / F.G; const int tlo = !sp ? F.vcu * nB : F.vcu < 144 ? F.vcu * ADA_NA : 144 * ADA_NA + (F.vcu - 144) * nB; const int thi = tlo + ((sp && F.vcu < 144) ? ADA_NA : nB);
        for (int it = F.vcu; it < 144; it += F.G) ada_item(F, it); convert_ffn_range(F, (F.in[9]), (F.in[10]), ((bf16*)(F.ws + WS_W)) + W_FIN, ((bf16*)(F.ws + WS_W)) + W_FOUT, tlo, thi); } }  xcd_barrier(bar); }
#endif
    if (IN(PH_P0)) { { { const bool sp = F.G >= 160; const int nB = sp ? (4224 - 144 * ADA_NA + F.G - 145) / (F.G - 144) : (4224 + F.G - 1) / F.G; const int tlo = !sp ? F.vcu * nB : F.vcu < 144 ? F.vcu * ADA_NA : 144 * ADA_NA + (F.vcu - 144) * nB; const int thi = tlo + ((sp && F.vcu < 144) ? ADA_NA : nB);
        for (int it = F.vcu; it < 144; it += F.G) ada_item(F, it); convert_ffn_range(F, (F.in[9]), (F.in[10]), ((bf16*)(F.ws + WS_W)) + W_FIN, ((bf16*)(F.ws + WS_W)) + W_FOUT, tlo, thi); } } }
    SEAM(PH_P0);
#if defined(PROBE_H1)
#if defined(PROBE_BAR)
    if (IN(PH_H1)) { for (int i_ = 0; i_ < 10; ++i_) xcd_barrier(bar); }
#endif
    if (IN(PH_H1)) { rmsmod_rows<false>(F, true, (F.in[8]), 0, ((bf16*)(F.ws + WS_U1)));  xcd_barrier(bar); }
#endif
    if (IN(PH_H1)) { rmsmod_rows<false>(F, true, (F.in[8]), 0, ((bf16*)(F.ws + WS_U1))); }
    SEAM(PH_H1);
#if defined(PROBE_G1)
    if (IN(PH_G1)) { run_gemm(F, ((bf16*)(F.ws + WS_U1)), ((bf16*)(F.ws + WS_W)) + W_FIN, 2 * DFF, D, EpiSwiglu{((bf16*)(F.ws + WS_U2))});  xcd_barrier(bar); }
#endif
    if (IN(PH_G1)) { run_gemm(F, ((bf16*)(F.ws + WS_U1)), ((bf16*)(F.ws + WS_W)) + W_FIN, 2 * DFF, D, EpiSwiglu{((bf16*)(F.ws + WS_U2))}); }
    SEAM(PH_G1);
#if defined(PROBE_G2)
    if (IN(PH_G2)) { run_gemm_split(F, ((bf16*)(F.ws + WS_U2)), ((bf16*)(F.ws + WS_W)) + W_FOUT, D, DFF, EpiResid<true>{(F.in[0]), (F.in[1]), (bf16*)F.out, ((float*)(F.ws + WS_ADA)), 2, 0.5f, (bf16*)(F.ws + WS_U5)}, PROBE_G2);  xcd_barrier(bar); }
#endif
    if (IN(PH_G2)) { run_gemm_split(F, ((bf16*)(F.ws + WS_U2)), ((bf16*)(F.ws + WS_W)) + W_FOUT, D, DFF, EpiResid<true>{(F.in[0]), (F.in[1]), (bf16*)F.out, ((float*)(F.ws + WS_ADA)), 2, 0.5f, (bf16*)(F.ws + WS_U5)}); }
    SEAM(PH_G2);
#if defined(PROBE_H2)
    if (IN(PH_H2)) { { if (PROBE_H2 & 1) convert_mixer(F, 0, F.vcu * NWAVES + F.wave, F.G * NWAVES); __syncthreads(); if (PROBE_H2 & 2) rmsmod_rows<true>(F, false, (F.in[11]), 1, (bf16*)F.out + 1024, Leftover{F.G == 256 ? (const bf16*)(F.ws + WS_U5) : nullptr, true, 2, 0.5f}, 2048); if (PROBE_H2 & 4) rmsmod_rows<false>(F, false, (F.in[11]), 1, (bf16*)F.out + 1024, Leftover{F.G == 256 ? (const bf16*)(F.ws + WS_U5) : nullptr, true, 2, 0.5f}, 2048); }  xcd_barrier(bar); }
#endif
    if (IN(PH_H2)) { { convert_mixer(F, 0, F.vcu * NWAVES + F.wave, F.G * NWAVES); if (F.G != 256 || CONV1_H2) convert_mixer(F, 1, F.vcu * NWAVES + F.wave, F.G * NWAVES); __syncthreads(); rmsmod_rows<true>(F, false, (F.in[11]), 1, (bf16*)F.out + 1024, Leftover{F.G == 256 ? (const bf16*)(F.ws + WS_U5) : nullptr, true, 2, 0.5f}, 2048); } }
    SEAM(PH_H2);
#if defined(PROBE_F1)
    if (IN(PH_F1)) { run_gemm(F, (bf16*)F.out + 1024, ((bf16*)(F.ws + WS_W)) + W_IN, 4352, D, EpiF1{((bf16*)(F.ws + WS_U1)), ((bf16*)(F.ws + WS_U2)), ((bf16*)(F.ws + WS_U3)), ((bf16*)(F.ws + WS_U4)), ((bf16*)(F.ws + WS_KV)), ((bf16*)(F.ws + WS_TAIL)), F.out}, 2048);  xcd_barrier(bar); }
#endif
    if (IN(PH_F1)) { run_gemm(F, (bf16*)F.out + 1024, ((bf16*)(F.ws + WS_W)) + W_IN, 4352, D, EpiF1{((bf16*)(F.ws + WS_U1)), ((bf16*)(F.ws + WS_U2)), ((bf16*)(F.ws + WS_U3)), ((bf16*)(F.ws + WS_U4)), ((bf16*)(F.ws + WS_KV)), ((bf16*)(F.ws + WS_TAIL)), F.out}, 2048); }
    SEAM(PH_F1);
#if defined(PROBE_PREP)
    if (IN(PH_PREP)) { PrepRegs PR; int it = F.vcu; if (it < NCH * 8) prep_fetch(F, it, F.tid & 15, F.tid >> 4, PR); for (int par = 0; it < NCH * 8; it += F.G, par ^= 1) gdn_prep_unit<true, PROBE_PREP>(F, it >> 3, it & 7, PR, it + F.G < NCH * 8 ? it + F.G : -1, par); xcd_barrier(bar); }
#endif
#if defined(PROBE_SWA)
    if (IN(PH_PREP)) { for (int it = F.vcu; it < NCH * 2; it += F.G) swa_unit<true>(F, it >> 1, it & 1); xcd_barrier(bar); }
#endif
    if (IN(PH_PREP)) {
                        const int nsw0 = (F.G == 256) ? ((F.vcu >> 3) % PREP_STAGGER) : 0;
#ifndef NO_SWA
                        for (int k = 0; k < nsw0; ++k) { const int it = F.vcu + k * F.G; if (it < NCH * 2) swa_unit<false>(F, it >> 1, it & 1); }
#endif
#ifndef NO_PREP
                        for (int k = F.wave; prep_unit_id(F, k) >= 0; k += NWAVES) prep_gates(F, prep_unit_id(F, k), F.lane);
                        for (int i = F.tid; i < 12 * 128; i += NWAVES * 64) { const int tj = i >> 7, cc = i & 127; ((LAS float*)(F.lds + PR_CW))[i] = (F.in[13])[(tj & 3) * 3072 + (tj >> 2) * 1024 + (F.vcu & 7) * 128 + cc]; }
                        asm volatile("s_waitcnt vmcnt(0)" ::: "memory"); __syncthreads();
#if defined(PROBE_PS)
                        if (blockIdx.x == 0 && F.tid == 0) ((volatile LAS unsigned long long*)(F.lds + LDSCTL_OFF + 768))[15] = __builtin_amdgcn_s_memrealtime();
#endif
                        { PrepRegs PR; int it = prep_unit_id(F, 0); if (it >= 0) prep_fetch(F, it, F.tid & 15, F.tid >> 4, PR);
                          for (int i = 0; it >= 0; ++i) { const int itn = prep_unit_id(F, i + 1); gdn_prep_unit<false>(F, it >> 3, it & 7, PR, itn, i & 1); it = itn; } }
#endif
#ifndef NO_SWA
                        for (int it = F.vcu + nsw0 * F.G; it < NCH * 2; it += F.G) swa_unit<false>(F, it >> 1, it & 1);
#endif
                      }
    SEAM(PH_PREP);
#if defined(PROBE_SCANA)
    if (IN(PH_SCAN)) { scanA_phase(F); xcd_barrier(bar); }
#endif
    if (IN(PH_SCAN)) { scanA_phase(F); }
    SEAM(PH_SCAN);
    if (IN(PH_SCANB)) { scanB_phase(F); if (F.G == 256 && !CONV1_H2 && blockIdx.x >= SCANB_WGS) convert_mixer(F, 1, ((int)blockIdx.x - SCANB_WGS) * NWAVES + F.wave, (256 - SCANB_WGS) * NWAVES); }
    SEAM(PH_SCANB);
#if defined(PROBE_SCANC)
    if (IN(PH_SCANC)) { scanC_phase<true, PROBE_SCANC>(F); xcd_barrier(bar); }
#endif
    if (IN(PH_SCANC)) { scanC_phase<false>(F); }
    SEAM(PH_SCANC);
#if defined(PROBE_F2)
    if (IN(PH_F2)) { run_gemm(F, (bf16*)F.out + 1024, ((bf16*)(F.ws + WS_W)) + W_IN + (size_t)4352 * D, 3072, D, EpiF2{((bf16*)(F.ws + WS_U2)), ((bf16*)(F.ws + WS_U5)), ((bf16*)(F.ws + WS_U6))}, 2048);  xcd_barrier(bar); }
#endif
    if (IN(PH_F2)) { run_gemm(F, (bf16*)F.out + 1024, ((bf16*)(F.ws + WS_W)) + W_IN + (size_t)4352 * D, 3072, D, EpiF2{((bf16*)(F.ws + WS_U2)), ((bf16*)(F.ws + WS_U5)), ((bf16*)(F.ws + WS_U6))}, 2048);  if (F.G == 256 && blockIdx.x >= 96) { __syncthreads(); convert_ffn(F, (F.in[23]), (F.in[24]), (bf16*)(F.ws + WS_MG), nullptr, ((int)blockIdx.x - 96) * NWAVES + F.wave, 160 * NWAVES); } }
    SEAM(PH_F2);
#if defined(PROBE_NG)
    if (IN(PH_NG)) { normgate_phase(F);  xcd_barrier(bar); }
#endif
    if (IN(PH_NG)) { normgate_phase(F); }
    SEAM(PH_NG);
    if (IN(PH_G4A)) { if (F.G == 256) run_gemm_split(F, ((bf16*)(F.ws + WS_U1)), ((bf16*)(F.ws + WS_W)) + W_A, D, D, EpiGate<0>{((bf16*)(F.ws + WS_U5)), nullptr}, 2);
                      else run_gemm(F, ((bf16*)(F.ws + WS_U1)), ((bf16*)(F.ws + WS_W)) + W_A, D, D, EpiGate<0>{((bf16*)(F.ws + WS_U5)), nullptr}); }
    SEAM(PH_G4A);
    if (IN(PH_G4B)) { if (F.G == 256) { run_gemm_split(F, ((bf16*)(F.ws + WS_U4)), ((bf16*)(F.ws + WS_W)) + W_B, D, D, EpiGate<1>{((bf16*)(F.ws + WS_U5)), ((bf16*)(F.ws + WS_U6))}, 2);
                          const bool sb_ = ((blockIdx.x & 7) >> 2) != 0;
                          pg8::Gemm g{sb_ ? ((const bf16*)(F.ws + WS_U4)) : ((const bf16*)(F.ws + WS_U1)), ((const bf16*)(F.ws + WS_W)) + (sb_ ? W_B : W_A), M, D, D, 0}; PiecesAB S; S.init(M, D, F.G, (int)blockIdx.x); S.ntf = 16;
                          pg8::gemm_phase<EpiPart, PiecesAB, PG8_ALIGN, PG8_SP2>(F.lds, g, S, EpiPart{(bf16*)(F.ws + WS_U2)}); }
                      else run_gemm(F, ((bf16*)(F.ws + WS_U4)), ((bf16*)(F.ws + WS_W)) + W_B, D, D, EpiGate<1>{((bf16*)(F.ws + WS_U5)), ((bf16*)(F.ws + WS_U6))}); }
    SEAM(PH_G4B);
    if (IN(PH_G5) && F.G == 256) { branch_fixup_rows(F, (const bf16*)(F.ws + WS_U2)); xcd_barrier(bar); }
    if (IN(PH_G5)) { run_gemm_split(F, ((bf16*)(F.ws + WS_U5)), ((bf16*)(F.ws + WS_W)) + W_O, D, D, EpiResid<false>{nullptr, nullptr, (bf16*)F.out, ((float*)(F.ws + WS_ADA)), 5, 1.0f, (bf16*)(F.ws + WS_U2)}); }
    SEAM(PH_G5);
#if defined(PROBE_H3)
    if (IN(PH_H3)) { { convert_ffn(F, (F.in[23]), (F.in[24]), F.G == 256 ? nullptr : (bf16*)(F.ws + WS_MG), ((bf16*)(F.ws + WS_W)) + W_FOUT, F.vcu * NWAVES + F.wave, F.G * NWAVES); rmsmod_rows<false>(F, false, (F.in[22]), 2, ((bf16*)(F.ws + WS_U1)), Leftover{F.G == 256 ? (const bf16*)(F.ws + WS_U2) : nullptr, false, 5, 1.0f}); }  xcd_barrier(bar); }
#endif
    if (IN(PH_H3)) { { convert_ffn(F, (F.in[23]), (F.in[24]), F.G == 256 ? nullptr : (bf16*)(F.ws + WS_MG), ((bf16*)(F.ws + WS_W)) + W_FOUT, F.vcu * NWAVES + F.wave, F.G * NWAVES); rmsmod_rows<false>(F, false, (F.in[22]), 2, ((bf16*)(F.ws + WS_U1)), Leftover{F.G == 256 ? (const bf16*)(F.ws + WS_U2) : nullptr, false, 5, 1.0f}); } }
    SEAM(PH_H3);
#if defined(PROBE_G6)
    if (IN(PH_G6)) { run_gemm(F, ((bf16*)(F.ws + WS_U1)), ((bf16*)(F.ws + WS_W)) + W_FIN, 2 * DFF, D, EpiSwiglu{((bf16*)(F.ws + WS_U2))});  xcd_barrier(bar); }
#endif
    if (IN(PH_G6)) { run_gemm(F, ((bf16*)(F.ws + WS_U1)), (const bf16*)(F.ws + WS_MG), 2 * DFF, D, EpiSwiglu{((bf16*)(F.ws + WS_U2))}); }
    SEAM(PH_G6);
    if (IN(PH_G7)) { run_gemm_split(F, ((bf16*)(F.ws + WS_U2)), ((bf16*)(F.ws + WS_W)) + W_FOUT, D, DFF, EpiResid<false>{nullptr, nullptr, (bf16*)F.out, ((float*)(F.ws + WS_ADA)), 8, 0.5f, (bf16*)(F.ws + WS_U5)}); }
    SEAM(PH_G7);
    if (IN(PH_FIN)) { final_norm_rows(F, Leftover{F.G == 256 ? (const bf16*)(F.ws + WS_U5) : nullptr, false, 8, 0.5f}); }
    SEAM(PH_FIN);
#if defined(PROBE_TS)
    if (blockIdx.x == 0 && F.tid == 0) { volatile LAS unsigned long long* ts = (volatile LAS unsigned long long*)(F.lds + LDSCTL_OFF + 512); unsigned long long tot = 0;
        for (int k = 0; k < PH_COUNT; ++k) if ((PROBE_TS >> k) & 1) tot += ts[k + 1] - ts[k];
#if defined(PROBE_PS)
        tot += ((volatile LAS unsigned long long*)(F.lds + LDSCTL_OFF + 768))[PROBE_PS];
#endif
        tot *= PROBE_AMP;
        const unsigned long long t0 = __builtin_amdgcn_s_memrealtime(); while (__builtin_amdgcn_s_memrealtime() - t0 < tot) __builtin_amdgcn_s_sleep(8); }
#endif
#undef IN
#undef SEAM
}

extern "C" void kernel_launch(void* const* d_in, const int* in_sizes, int n_in, void* d_out, int out_size, void* d_ws, size_t ws_size, hipStream_t stream) {
    static int grid = 0;
    if (grid == 0) {
        if (n_in != 28 || in_sizes[0] != MP * D || (size_t)out_size != OUT_TOTAL || ws_size < WS_END) { fprintf(stderr, "kernel_launch: unexpected shapes (n_in %d, in0 %d, out %d, ws %zu); nothing launched\n", n_in, n_in > 0 ? in_sizes[0] : -1, out_size, ws_size); grid = -1; return; }
        int dev = 0, cus = 0, per_cu = 0;
        if (hipGetDevice(&dev) != hipSuccess || hipDeviceGetAttribute(&cus, hipDeviceAttributeMultiprocessorCount, dev) != hipSuccess) { grid = -1; return; }
        if (hipFuncSetAttribute((const void*)mega_fwd, hipFuncAttributeMaxDynamicSharedMemorySize, LDS_BYTES) != hipSuccess) { fprintf(stderr, "kernel_launch: hipFuncSetAttribute failed\n"); grid = -1; return; }
        if (hipOccupancyMaxActiveBlocksPerMultiprocessor(&per_cu, (const void*)mega_fwd, NWAVES * 64, LDS_BYTES) != hipSuccess || per_cu < 1) fprintf(stderr, "kernel_launch: occupancy query reports %d\n", per_cu);
        (void)hipGetLastError();
        grid = cus;
    }
    if (grid < 0) return;
    if (hipMemsetAsync((char*)d_ws + WS_CTL, 0, CTL_ZERO_BYTES, stream) != hipSuccess) return;
    Args a{};
    for (int i = 0; i < 28; ++i) a.in[i] = (const float*)d_in[i];
    a.out = (float*)d_out; a.ws = (unsigned char*)d_ws;
#if MK_PER_PHASE
    for (int ph = 0; ph < PH_COUNT; ++ph) { a.ph_lo = ph; a.ph_hi = ph + 1; hipLaunchKernelGGL(mega_fwd, dim3(grid), dim3(NWAVES * 64), LDS_BYTES, stream, a); }
#else
    a.ph_lo = 0; a.ph_hi = PH_COUNT; hipLaunchKernelGGL(mega_fwd, dim3(grid), dim3(NWAVES * 64), LDS_BYTES, stream, a);
#endif
    const hipError_t le = hipPeekAtLastError();
    if (le != hipSuccess) fprintf(stderr, "kernel_launch: launch failed: %s\n", hipGetErrorName(le));
}
```

```cpp
#include <hip/hip_runtime.h>
#include <cstdio>
#include <cstdint>
namespace pg8 {
#define PG8_LAS __attribute__((address_space(3)))
typedef unsigned short bf16_t;
typedef short bf16x8 __attribute__((ext_vector_type(8)));
typedef float f32x4 __attribute__((ext_vector_type(4)));
typedef unsigned u32x4 __attribute__((ext_vector_type(4)));
constexpr int BM = 256, BK = 64, HALF = 128, HTB = HALF * BK * 2  , STAGE_BYTES = 8 * HTB, NXCD = 8, WGM = 8;

__host__ __device__ __forceinline__ int lds_byte(int r, int c) { const int st = (r >> 4) * 2 + (c >> 5), rr = r & 15, cc = c & 31, ob = rr * 64 + cc * 2; return st * 1024 + (ob ^ (((ob >> 9) & 1) << 5)); }
__host__ __device__ __forceinline__ void stage_rc(int b, int& R, int& C) { const int st = b / 1024, sb = b % 1024, swz = sb ^ (((sb >> 9) & 1) << 5); R = (st >> 1) * 16 + swz / 64; C = (st & 1) * 32 + (swz % 64) / 2; }
__host__ __device__ __forceinline__ int perm32(int rho) { const int n = rho >> 4, i = rho & 15; return 8 * (i >> 2) + 4 * n + (i & 3); }

struct Unit { int pm, pn, k0, nt, piece, lidx; };
struct Gemm { const bf16_t* A; const bf16_t* Bt; int M, N, K; int lda; };

struct StaticOrder {
    int nM, nN, nwg, G, c, ntf;
    __host__ __device__ void init(int M, int N, int G_, int c_) { nM = M / BM; nN = N / BM; nwg = nM * nN; G = G_; c = c_; }
    __host__ __device__ bool next(int i, Unit& u) const {
        const long L = (long)i * G + c; if (L >= nwg) return false;
        int wgid = (int)L; { const int q = nwg / NXCD, r = nwg % NXCD, xcd = wgid % NXCD, off = wgid / NXCD; wgid = (xcd < r ? xcd * (q + 1) : r * (q + 1) + (xcd - r) * q) + off; }
        const int nig = WGM * nN, gid = wgid / nig, fm = gid * WGM, gsz = (nM - fm) < WGM ? (nM - fm) : WGM;
        u.pm = fm + ((wgid % nig) % gsz); u.pn = (wgid % nig) / gsz; u.k0 = 0; u.nt = ntf; u.piece = 0; u.lidx = 0; return true;
    }
    __device__ __forceinline__ void a_ready(const Unit&) const {}
    __device__ __forceinline__ void done(const Unit&) const {}
};

__device__ __forceinline__ unsigned cvt_pk_bf16(float lo, float hi) { unsigned r; asm volatile("v_cvt_pk_bf16_f32 %0, %1, %2" : "=v"(r) : "v"(lo), "v"(hi)); return r; }

template <class Epi, class Sched, bool ALIGN_EPI = false, bool SP2 = false>
__device__ __forceinline__ void gemm_phase(PG8_LAS unsigned char* lds, const Gemm g, const Sched& S, const Epi& E) {
    const int tid = threadIdx.x, wid = __builtin_amdgcn_readfirstlane(tid >> 6), lane = tid & 63, wr = wid >> 2, wc = wid & 3, fr = lane & 15, fq = lane >> 4;
    const int K = g.K, lda = g.lda ? g.lda : g.K;
    unsigned voffA[2], voffB[2];
#pragma unroll
    for (int i = 0; i < 2; ++i) { int R, C; stage_rc(tid * 16 + i * 8192, R, C); const int Rb = Epi::PERM ? ((R & ~31) + perm32(R & 31)) : R;
        voffA[i] = (unsigned)(R * lda + C) * 2u; voffB[i] = (unsigned)(Rb * K + C) * 2u; }
    const size_t kstep = (size_t)(BK * 2);
    const size_t hstep = (size_t)HALF * K * 2;
    const size_t tstep = 2 * hstep;
    const size_t hstepA = (size_t)HALF * lda * 2, tstepA = 2 * hstepA;
    const unsigned ldsw = (unsigned)wid * 1024u;
    const int aoff = lds_byte(wr * 64 + fr, fq * 8), boff = lds_byte(wc * 32 + fr, fq * 8);
#define PG8_SA(b, h) (((b) * 2 + (h)) * HTB)
#define PG8_SB(b, h) ((4 + (b) * 2 + (h)) * HTB)
#define PG8_STAGE(bufoff, gbase, voff) do { _Pragma("unroll") for (int _i = 0; _i < 2; ++_i) \
        __builtin_amdgcn_global_load_lds((const unsigned*)((const char*)(gbase) + (voff)[_i]), (PG8_LAS unsigned*)(lds + (bufoff) + ldsw + _i * 8192), 16, 0, 0); } while (0)
#define PG8_LDA(dst, b, h) do { _Pragma("unroll") for (int m = 0; m < 4; ++m) _Pragma("unroll") for (int k = 0; k < 2; ++k) dst[m][k] = *(const PG8_LAS bf16x8*)(lds + PG8_SA(b, h) + aoff + m * 2048 + k * 1024); } while (0)
#define PG8_LDB(dst, b, h) do { _Pragma("unroll") for (int n = 0; n < 2; ++n) _Pragma("unroll") for (int k = 0; k < 2; ++k) dst[n][k] = *(const PG8_LAS bf16x8*)(lds + PG8_SB(b, h) + boff + n * 2048 + k * 1024); } while (0)
#define PG8_MMA(ai, bj, At, Bt) do { __builtin_amdgcn_s_setprio(1); _Pragma("unroll") for (int m = 0; m < 4; ++m) _Pragma("unroll") for (int n = 0; n < 2; ++n) _Pragma("unroll") for (int k = 0; k < 2; ++k) \
        acc[ai][bj][m][n] = __builtin_amdgcn_mfma_f32_16x16x32_bf16(Bt[n][k], At[m][k], acc[ai][bj][m][n], 0, 0, 0); __builtin_amdgcn_s_setprio(0); } while (0)
#define PG8_WAIT_V(n) asm volatile("s_waitcnt vmcnt(" #n ")" ::: "memory")
#define PG8_WAIT_L(n) asm volatile("s_waitcnt lgkmcnt(" #n ")" ::: "memory")
#define PG8_BAR __builtin_amdgcn_s_barrier()
#define PG8_SCHED __builtin_amdgcn_sched_barrier(0)
    Unit cur, nxt; int ui = 0;
    if (!S.next(0, cur)) return;
    f32x4 acc[2][2][4][2];
#pragma unroll
    for (int a = 0; a < 2; ++a)
#pragma unroll
        for (int b = 0; b < 2; ++b)
#pragma unroll
            for (int m = 0; m < 4; ++m)
#pragma unroll
                for (int n = 0; n < 2; ++n) acc[a][b][m][n] = (f32x4){0.f, 0.f, 0.f, 0.f};
    bf16x8 At[4][2], B0[2][2], B1[2][2];
    const char* cA = (const char*)g.A + (size_t)cur.pm * tstepA + (size_t)cur.k0 * kstep; const char* cB = (const char*)g.Bt + (size_t)cur.pn * tstep + (size_t)cur.k0 * kstep;
    S.a_ready(cur);
    if constexpr (SP2) {
        PG8_STAGE(PG8_SB(0, 0), cB, voffB); PG8_STAGE(PG8_SB(0, 1), cB + hstep, voffB); PG8_STAGE(PG8_SA(0, 0), cA, voffA); PG8_STAGE(PG8_SA(0, 1), cA + hstepA, voffA);
        if (wr == 1) PG8_BAR;
        PG8_WAIT_V(2); PG8_BAR;
        PG8_STAGE(PG8_SB(1, 0), cB + kstep, voffB); PG8_STAGE(PG8_SA(1, 0), cA + kstep, voffA); PG8_STAGE(PG8_SB(1, 1), cB + hstep + kstep, voffB);
        PG8_WAIT_V(6); PG8_BAR;
    } else {
        PG8_STAGE(PG8_SB(0, 0), cB, voffB); PG8_STAGE(PG8_SA(0, 0), cA, voffA); PG8_STAGE(PG8_SB(0, 1), cB + hstep, voffB); PG8_STAGE(PG8_SA(0, 1), cA + hstepA, voffA);
        if (wr == 1) PG8_BAR;
        PG8_WAIT_V(4); PG8_BAR;
        PG8_STAGE(PG8_SB(1, 0), cB + kstep, voffB); PG8_STAGE(PG8_SA(1, 0), cA + kstep, voffA); PG8_STAGE(PG8_SB(1, 1), cB + hstep + kstep, voffB);
        PG8_WAIT_V(6); PG8_BAR;
    }
    for (;;) {
        const bool has_next = S.next(ui + 1, nxt);
        const char* nA = has_next ? (const char*)g.A + (size_t)nxt.pm * tstepA + (size_t)nxt.k0 * kstep : cA; const char* nB = has_next ? (const char*)g.Bt + (size_t)nxt.pn * tstep + (size_t)nxt.k0 * kstep : cB;
        const int cnt = cur.nt;
        for (int t = 0; t < cnt; t += 2) {
            const bool last = (t == cnt - 2);
            const char* a1 = cA + (size_t)(t + 1) * kstep;
            const char* a2 = last ? nA : cA + (size_t)(t + 2) * kstep; const char* b2 = last ? nB : cB + (size_t)(t + 2) * kstep;
            const char* a3 = a2 + kstep; const char* b3 = b2 + kstep;
            if (last && has_next) S.a_ready(nxt);
            if constexpr (SP2) {
            PG8_LDB(B0, 0, 0); PG8_LDB(B1, 0, 1); PG8_SCHED; PG8_LDA(At, 0, 0); PG8_STAGE(PG8_SA(1, 1), a1 + hstepA, voffA);
            PG8_WAIT_V(8); PG8_WAIT_L(0); PG8_BAR; PG8_MMA(0, 0, At, B0); PG8_MMA(0, 1, At, B1); PG8_BAR; PG8_SCHED;
            PG8_LDA(At, 0, 1); PG8_STAGE(PG8_SB(0, 0), b2, voffB); PG8_STAGE(PG8_SB(0, 1), b2 + hstep, voffB); PG8_STAGE(PG8_SA(0, 0), a2, voffA);
            PG8_WAIT_V(8); PG8_WAIT_L(0); PG8_BAR; PG8_MMA(1, 0, At, B0); PG8_MMA(1, 1, At, B1); PG8_BAR; PG8_SCHED;
            PG8_LDB(B0, 1, 0); PG8_LDB(B1, 1, 1); PG8_SCHED; PG8_LDA(At, 1, 0); PG8_STAGE(PG8_SA(0, 1), a2 + hstepA, voffA);
            PG8_WAIT_V(8); PG8_WAIT_L(0); PG8_BAR; PG8_MMA(0, 0, At, B0); PG8_MMA(0, 1, At, B1); PG8_BAR; PG8_SCHED;
            PG8_LDA(At, 1, 1); PG8_STAGE(PG8_SB(1, 0), b3, voffB); PG8_STAGE(PG8_SB(1, 1), b3 + hstep, voffB); PG8_STAGE(PG8_SA(1, 0), a3, voffA);
            PG8_WAIT_V(8); PG8_WAIT_L(0); PG8_BAR; PG8_MMA(1, 0, At, B0); PG8_MMA(1, 1, At, B1); PG8_BAR; PG8_SCHED;
            } else {
            PG8_LDB(B0, 0, 0); PG8_SCHED; PG8_LDA(At, 0, 0); PG8_STAGE(PG8_SA(1, 1), a1 + hstepA, voffA);
            PG8_WAIT_L(8); PG8_BAR; PG8_WAIT_L(0); PG8_MMA(0, 0, At, B0); PG8_BAR; PG8_SCHED;
            PG8_LDB(B1, 0, 1); PG8_STAGE(PG8_SB(0, 0), b2, voffB);
            PG8_BAR; PG8_WAIT_L(0); PG8_MMA(0, 1, At, B1); PG8_BAR;
            PG8_LDA(At, 0, 1); PG8_STAGE(PG8_SA(0, 0), a2, voffA);
            PG8_BAR; PG8_WAIT_L(0); PG8_MMA(1, 0, At, B0); PG8_BAR; PG8_SCHED;
            PG8_STAGE(PG8_SB(0, 1), b2 + hstep, voffB);
            PG8_WAIT_V(6); PG8_BAR; PG8_MMA(1, 1, At, B1); PG8_BAR;
            PG8_LDB(B0, 1, 0); PG8_SCHED; PG8_LDA(At, 1, 0); PG8_STAGE(PG8_SA(0, 1), a2 + hstepA, voffA);
            PG8_WAIT_L(8); PG8_BAR; PG8_WAIT_L(0); PG8_MMA(0, 0, At, B0); PG8_BAR; PG8_SCHED;
            PG8_LDB(B1, 1, 1); PG8_STAGE(PG8_SB(1, 0), b3, voffB);
            PG8_BAR; PG8_WAIT_L(0); PG8_MMA(0, 1, At, B1); PG8_BAR;
            PG8_LDA(At, 1, 1); PG8_STAGE(PG8_SA(1, 0), a3, voffA);
            PG8_BAR; PG8_WAIT_L(0); PG8_MMA(1, 0, At, B0); PG8_BAR; PG8_SCHED;
            PG8_STAGE(PG8_SB(1, 1), b3 + hstep, voffB);
            PG8_WAIT_V(6); PG8_BAR; PG8_MMA(1, 1, At, B1); PG8_BAR;
            }
        }
        if constexpr (ALIGN_EPI) { if (wr == 0) PG8_BAR; }
        if constexpr (!Epi::AFTER_DRAIN) { E(acc, cur, wr, wc, fr, fq); S.done(cur); }
        if (!has_next) break;
#pragma unroll
        for (int a = 0; a < 2; ++a)
#pragma unroll
            for (int b = 0; b < 2; ++b)
#pragma unroll
                for (int m = 0; m < 4; ++m)
#pragma unroll
                    for (int n = 0; n < 2; ++n) acc[a][b][m][n] = (f32x4){0.f, 0.f, 0.f, 0.f};
        cur = nxt; cA = nA; cB = nB; ++ui;
        if constexpr (ALIGN_EPI) { if (wr == 1) PG8_BAR; }
    }
    PG8_WAIT_V(0);
    if constexpr (!ALIGN_EPI) { if (wr == 0) PG8_BAR; }
    PG8_BAR;
    if constexpr (Epi::AFTER_DRAIN) { E.fused(acc, cur, wr, wc, fr, fq, lds, wid, lane); S.done(cur); }
#undef PG8_SA
#undef PG8_SB
#undef PG8_STAGE
#undef PG8_LDA
#undef PG8_LDB
#undef PG8_MMA
#undef PG8_WAIT_V
#undef PG8_WAIT_L
#undef PG8_BAR
#undef PG8_SCHED
}
}

#ifndef PG8_SP2
#define PG8_SP2 true
#endif
#define GAS __attribute__((address_space(1)))
#define LAS __attribute__((address_space(3)))
typedef unsigned short bf16;
typedef unsigned v4u __attribute__((ext_vector_type(4)));
typedef float f32x4 __attribute__((ext_vector_type(4)));
typedef short bf16x8 __attribute__((ext_vector_type(8)));
typedef GAS unsigned gu32;
typedef GAS unsigned long long gu64;
#define RLX_AGENT __ATOMIC_RELAXED, __HIP_MEMORY_SCOPE_AGENT
#define LDS_WAIT() asm volatile("s_waitcnt lgkmcnt(0)" ::: "memory")
#define VM_WAIT() asm volatile("s_waitcnt vmcnt(0)" ::: "memory")
__device__ __forceinline__ unsigned long long rt() { return __builtin_amdgcn_s_memrealtime(); }
typedef float pkf2_t __attribute__((ext_vector_type(2))); typedef __bf16 pkb2_t __attribute__((ext_vector_type(2)));
__device__ __forceinline__ unsigned pk2(float lo, float hi) { pkf2_t v = {lo, hi}; pkb2_t b = __builtin_convertvector(v, pkb2_t); return __builtin_bit_cast(unsigned, b); }
__device__ __forceinline__ unsigned f2bf(float f) { return pk2(f, 0.f) & 0xffffu; }

#define XB_TMO      128
#define XB_XCNT(j)  (256  + 64 * (j))
#define XB_XSUB(j)  (1280 + 64 * (j))
#define XB_XGEN(j)  (2304 + 64 * (j))
#define XB_TOP      3328
#define XB_TOPGEN   3392
#define XCD_BAR_WORDS 3456
#define XB_SPIN_CAP (1u << 18)

__device__ __forceinline__ unsigned xb_ld(unsigned* p)              { return __hip_atomic_load(p, __ATOMIC_RELAXED, __HIP_MEMORY_SCOPE_AGENT); }
__device__ __forceinline__ unsigned xb_add(unsigned* p, unsigned v) { return __hip_atomic_fetch_add(p, v, __ATOMIC_RELAXED, __HIP_MEMORY_SCOPE_AGENT); }
__device__ __forceinline__ unsigned xb_xcc_id() { return (unsigned)__builtin_amdgcn_s_getreg((3 << 11) | 20) & 0xFu; }
#define XB_SPIN(cond, bar) do { unsigned _sp = 0; while (cond) { __builtin_amdgcn_s_sleep(1); \
    if ((++_sp & 255u) == 0u) { if (xb_ld(&(bar)[XB_TMO])) break; if (_sp > XB_SPIN_CAP) { atomicAdd(&(bar)[XB_TMO], 1u); break; } } } } while (0)

struct XcdBarrier {
    unsigned* bar; unsigned x;
    volatile LAS unsigned* st;
};

__device__ __forceinline__ XcdBarrier xcd_barrier_post(unsigned* bar, volatile LAS unsigned* st) {
    XcdBarrier b; b.bar = bar; b.x = xb_xcc_id(); b.st = st;
    if (threadIdx.x == 0) (void)xb_add(&bar[XB_XCNT(b.x)], 1u);
    return b;
}
__device__ __forceinline__ void xcd_barrier_complete(unsigned* bar, unsigned x, unsigned& nloc, unsigned& nx) {
    const unsigned G = gridDim.x * gridDim.y * gridDim.z;
    unsigned sum, cnt, mine, sp = 0u;
    for (;;) {
        sum = 0u; cnt = 0u; mine = 0u;
#pragma unroll
        for (unsigned j = 0; j < 16; ++j) { const unsigned c = xb_ld(&bar[XB_XCNT(j)]); sum += c; cnt += (c > 0u) ? 1u : 0u; mine = (j == x) ? c : mine; }
        if (sum == G) break;
        __builtin_amdgcn_s_sleep(1);
        if ((++sp & 255u) == 0u) { if (xb_ld(&bar[XB_TMO])) break; if (sp > XB_SPIN_CAP) { atomicAdd(&bar[XB_TMO], 1u); break; } }
    }
    nloc = mine > 0u ? mine : 1u; nx = cnt > 0u ? cnt : 1u;
}

__device__ __forceinline__ void xcd_barrier(const XcdBarrier& b) {
    asm volatile("s_waitcnt vmcnt(0)" ::: "memory");
    __syncthreads();
    if (threadIdx.x == 0) {
        unsigned* bar = b.bar;
        __builtin_amdgcn_s_waitcnt(0);
        unsigned nloc = b.st[0], nx = b.st[1];
        if (nloc == 0u) { xcd_barrier_complete(bar, b.x, nloc, nx); b.st[0] = nloc; b.st[1] = nx; }
        const unsigned old = xb_add(&bar[XB_XSUB(b.x)], 1u);
        const unsigned gen = old / nloc;
        if (old + 1u == (gen + 1u) * nloc) {
            __builtin_amdgcn_fence(__ATOMIC_RELEASE, "agent");
            asm volatile("s_waitcnt vmcnt(0)" ::: "memory");
            const unsigned og = xb_add(&bar[XB_TOP], 1u);
            const unsigned tg = og / nx;
            if (og + 1u == (tg + 1u) * nx) xb_add(&bar[XB_TOPGEN], 1u);
            else XB_SPIN(xb_ld(&bar[XB_TOPGEN]) == tg, bar);
            __builtin_amdgcn_fence(__ATOMIC_ACQUIRE, "agent");
            xb_add(&bar[XB_XGEN(b.x)], 1u);
            asm volatile("s_waitcnt vmcnt(0)" ::: "memory");
        } else {
            XB_SPIN(xb_ld(&bar[XB_XGEN(b.x)]) == gen, bar);
            __builtin_amdgcn_fence(__ATOMIC_ACQUIRE, "agent");
            asm volatile("s_waitcnt vmcnt(0)" ::: "memory");
        }
    }
    __syncthreads();
}
#ifndef PG8_ALIGN
#define PG8_ALIGN true
#endif
constexpr int NWAVES = 8;
#ifndef MK_PER_PHASE
#define MK_PER_PHASE 0
#endif
constexpr int D = 1024, MP = 16384, MSMP = 2048, M = MP + MSMP, NCH = M / 64, DFF = 2816, INCOLS = 7440, NB = 33, ADAW = 9 * D;
constexpr float EPS = 1e-6f;
constexpr size_t OFF_Y = 0, OFF_PCONV = (size_t)M * D, OFF_PS = OFF_PCONV + 3 * 3072, OFF_PK = OFF_PS + 8 * 128 * 128, OFF_PV = OFF_PK + 128 * 128,
                 OFF_SCONV = OFF_PV + 128 * 128, OFF_SS = OFF_SCONV + 32 * 3 * 3072, OFF_SK = OFF_SS + (size_t)32 * 8 * 128 * 128, OFF_SV = OFF_SK + 32 * 128 * 128, OUT_TOTAL = OFF_SV + 32 * 128 * 128;
constexpr size_t MiB = 1u << 20;
constexpr size_t WS_CTL = 0, CTL_ZERO_BYTES = 1 * MiB, WS_ADA = 1 * MiB, WS_BA = 5 * MiB / 2, WS_GL = 4 * MiB, WS_W = 5 * MiB;
constexpr size_t WS_U1 = 26 * MiB, WS_U2 = 62 * MiB, WS_U3 = 98 * MiB, WS_U4 = 134 * MiB, WS_U5 = 170 * MiB, WS_U6 = 206 * MiB;
constexpr size_t WS_INTRA = 206 * MiB, WS_KV = 224 * MiB, WS_TAIL = 233 * MiB, WS_END = 254 * MiB;
static_assert((size_t)M * D * 2 == 36 * MiB && (size_t)NB * ADAW * 4 <= 3 * MiB / 2 && (size_t)M * 16 * 4 <= 3 * MiB / 2, "ws map");
static_assert((size_t)NCH * 8 * 64 * 64 * 2 == 18 * MiB && (size_t)M * 256 * 2 == 9 * MiB && WS_TAIL + (size_t)NCH * 3 * 3072 * 2 <= WS_END && (size_t)M * DFF * 2 <= 108 * MiB, "ws map 2");
constexpr size_t W_FIN = 0, W_FOUT = (size_t)2 * DFF * D;
constexpr size_t W_IN = 0, W_A = (size_t)7424 * D, W_B = W_A + (size_t)D * D, W_O = W_B + (size_t)D * D;
static_assert((W_O + (size_t)D * D) * 2 <= 21 * MiB, "w slot");
constexpr int CW_TMO = 0, CW_BAR = 4096;
constexpr int RING_BYTES = 131072, LDSCTL_OFF = RING_BYTES, MISC_OFF = LDSCTL_OFF + 320, LDS_BYTES = 147456;

struct Frame {
    LAS unsigned char* lds; volatile LAS unsigned* MISC; gu32* ctl;
    int tid, lane, wave, vcu, G;
    const float* const* in; float* out; unsigned char* ws;
};
typedef float f32x2 __attribute__((ext_vector_type(2)));
typedef unsigned u32x2 __attribute__((ext_vector_type(2)));
__device__ __forceinline__ float bflo(unsigned u) { return __builtin_bit_cast(float, u << 16); }
__device__ __forceinline__ float bfhi(unsigned u) { return __builtin_bit_cast(float, u & 0xffff0000u); }
__device__ __forceinline__ float bf2f(bf16 h) { return __builtin_bit_cast(float, (unsigned)h << 16); }
__device__ __forceinline__ float fexp(float x) { return __builtin_amdgcn_exp2f(x * 1.4426950408889634f); }
__device__ __forceinline__ float sigm(float x) { return __builtin_amdgcn_rcpf(1.f + fexp(-x)); }
__device__ __forceinline__ float siluf(float x) { return x * sigm(x); }
__device__ __forceinline__ float wave_sum(float v) {
#pragma unroll
    for (int o = 1; o < 64; o <<= 1) v += __shfl_xor(v, o);
    return v;
}
__device__ __forceinline__ int mod_row(int m) { return m < MP ? 0 : 1 + ((m - MP) >> 6); }

__device__ __forceinline__ void transpose_item(const float* W, int ldw, int c0, int K, bf16* WT, int drow0, LAS float* scr, int k0, int lane) {
    f32x4 wv[8];
#pragma unroll
    for (int i = 0; i < 8; ++i) wv[i] = *(const f32x4*)(W + (size_t)(k0 + 8 * i + (lane >> 3)) * ldw + c0 + 4 * (lane & 7));
#pragma unroll
    for (int i = 0; i < 8; ++i) { LAS float* d = scr + (8 * i + (lane >> 3)) * 33 + 4 * (lane & 7); d[0] = wv[i].x; d[1] = wv[i].y; d[2] = wv[i].z; d[3] = wv[i].w; }
    LDS_WAIT(); asm volatile("" ::: "memory");
    const int c = lane & 7;
#pragma unroll
    for (int j = 0; j < 4; ++j) { const int n = (lane >> 3) + 8 * j; const LAS float* s = scr + (8 * c) * 33 + n;
        v4u o; o.x = pk2(s[0 * 33], s[1 * 33]); o.y = pk2(s[2 * 33], s[3 * 33]); o.z = pk2(s[4 * 33], s[5 * 33]); o.w = pk2(s[6 * 33], s[7 * 33]);
        *(GAS v4u*)(WT + (size_t)(drow0 + n) * K + k0 + 8 * c) = o; }
    LDS_WAIT(); asm volatile("" ::: "memory");
}
__device__ __forceinline__ void convert_ffn(Frame& F, const float* w_in, const float* w_out, bf16* dst_in, bf16* dst_out, int gw, int NGW) {
    LAS float* scr = (LAS float*)(F.lds + F.wave * 16384);
    constexpr int I_IN = 16 * 176, I_OUT = 44 * 32;
    if (dst_in) for (int it = gw; it < I_IN; it += NGW) { const int kb = it / 176, nb = it % 176, c0 = 32 * nb; const int j0 = c0 < DFF ? c0 : c0 - DFF;
        const int drow0 = (j0 >> 7) * 256 + (c0 < DFF ? 0 : 128) + (j0 & 127);
        transpose_item(w_in, 2 * DFF, c0, D, dst_in, drow0, scr, 64 * kb, F.lane); }
    if (dst_out) for (int r = gw; r < I_OUT; r += NGW) { const int kb = r / 32, nb = r % 32; transpose_item(w_out, D, 32 * nb, DFF, dst_out, 32 * nb, scr, 64 * kb, F.lane); }
}
__device__ __forceinline__ void convert_mixer(Frame& F, int part, int gw, int NGW) {
    LAS float* scr = (LAS float*)(F.lds + F.wave * 16384);
    constexpr int NB0 = 4352 / 32, NB1 = (7424 - 4352) / 32, I_SQ = 16 * 32;
    const int nb_n = part == 0 ? NB0 : NB1, i_in = 16 * nb_n, i_tot = part == 0 ? i_in : i_in + 3 * I_SQ;
    for (int it = gw; it < i_tot; it += NGW) {
        if (it < i_in) { const int kb = it / nb_n, nb = it % nb_n, dr = 32 * nb + (part == 0 ? 0 : 4352);
            const int c0 = dr < 3072 ? dr : dr < 4352 ? 4112 + (dr - 3072) : dr < 5376 ? 3072 + (dr - 4352) : 5392 + (dr - 5376);
            transpose_item((F.in[12]), INCOLS, c0, D, ((bf16*)(F.ws + WS_W)) + W_IN, dr, scr, 64 * kb, F.lane); }
        else { int r = it - i_in; const int which = r / I_SQ; r %= I_SQ; const int kb = r / 32, nb = r % 32;
            const float* src = which == 0 ? (F.in[19]) : which == 1 ? (F.in[20]) : (F.in[21]); bf16* dst = ((bf16*)(F.ws + WS_W)) + (which == 0 ? W_A : which == 1 ? W_B : W_O);
            transpose_item(src, D, 32 * nb, D, dst, 32 * nb, scr, 64 * kb, F.lane); }
    }
}
__device__ __forceinline__ int ada_row_off(int s) { return s < 31 ? s * 4112 : 131584 + (s - 31) * 4112; }
__device__ __forceinline__ void split_bf(float a, float b, unsigned& hi, unsigned& lo) {
    hi = pk2(a, b); lo = pk2(a - __builtin_bit_cast(float, hi << 16), b - __builtin_bit_cast(float, hi & 0xffff0000u)); }
__device__ __forceinline__ void ada_item(Frame& F, int item) {
    for (int idx = F.tid; idx < 33 * 1024; idx += 512) { const int b = idx >> 10, k = idx & 1023;
        const float c = (b == 0) ? (F.in[6])[k] : (F.in[7])[(b - 1) * 1024 + k]; *(LAS float*)(F.lds + ada_row_off(b == 0 ? 32 : b - 1) + 4 * k) = c / (1.f + __expf(-c)); }
    __syncthreads();
    const int i16 = F.lane & 15, kg = F.lane >> 4, k0 = F.wave * 128;
    const float* wp = (F.in[25]) + (size_t)(k0 + 8 * kg) * ADAW + item * 64 + 4 * i16;
    f32x4 acc[3][4], ld[2][8];
#pragma unroll
    for (int mt = 0; mt < 3; ++mt)
#pragma unroll
        for (int t = 0; t < 4; ++t) acc[mt][t] = (f32x4){0.f, 0.f, 0.f, 0.f};
#pragma unroll
    for (int j = 0; j < 8; ++j) ld[0][j] = *(const f32x4*)(wp + (size_t)j * ADAW);
#pragma unroll
    for (int j = 0; j < 8; ++j) ld[1][j] = *(const f32x4*)(wp + (size_t)(32 + j) * ADAW);
#pragma unroll
    for (int ks = 0; ks < 4; ++ks) {
        bf16x8 bh[4], bl[4];
#pragma unroll
        for (int t = 0; t < 4; ++t) { unsigned h0, h1, h2, h3, l0, l1, l2, l3; split_bf(ld[ks & 1][0][t], ld[ks & 1][1][t], h0, l0); split_bf(ld[ks & 1][2][t], ld[ks & 1][3][t], h1, l1);
            split_bf(ld[ks & 1][4][t], ld[ks & 1][5][t], h2, l2); split_bf(ld[ks & 1][6][t], ld[ks & 1][7][t], h3, l3); bh[t] = __builtin_bit_cast(bf16x8, (v4u){h0, h1, h2, h3}); bl[t] = __builtin_bit_cast(bf16x8, (v4u){l0, l1, l2, l3}); }
        if (ks + 2 < 4) {
#pragma unroll
            for (int j = 0; j < 8; ++j) ld[ks & 1][j] = *(const f32x4*)(wp + (size_t)(32 * (ks + 2) + j) * ADAW); }
#pragma unroll
        for (int mt = 0; mt < 3; ++mt) { const LAS float* ap = (const LAS float*)(F.lds + ada_row_off(mt < 2 ? 16 * mt + i16 : 32)) + k0 + 32 * ks + 8 * kg;
            const f32x4 a0 = *(const LAS f32x4*)ap, a1 = *(const LAS f32x4*)(ap + 4); unsigned h0, h1, h2, h3, l0, l1, l2, l3;
            split_bf(a0.x, a0.y, h0, l0); split_bf(a0.z, a0.w, h1, l1); split_bf(a1.x, a1.y, h2, l2); split_bf(a1.z, a1.w, h3, l3);
            const bf16x8 ah = __builtin_bit_cast(bf16x8, (v4u){h0, h1, h2, h3}), al = __builtin_bit_cast(bf16x8, (v4u){l0, l1, l2, l3});
#pragma unroll
            for (int t = 0; t < 4; ++t) { acc[mt][t] = __builtin_amdgcn_mfma_f32_16x16x32_bf16(ah, bh[t], acc[mt][t], 0, 0, 0);
                acc[mt][t] = __builtin_amdgcn_mfma_f32_16x16x32_bf16(ah, bl[t], acc[mt][t], 0, 0, 0); acc[mt][t] = __builtin_amdgcn_mfma_f32_16x16x32_bf16(al, bh[t], acc[mt][t], 0, 0, 0); } }
    }
    __syncthreads();
    LAS float* red = (LAS float*)F.lds;
#pragma unroll
    for (int mt = 0; mt < 2; ++mt)
#pragma unroll
        for (int i = 0; i < 4; ++i) *(LAS f32x4*)(red + (F.wave * 33 + 16 * mt + 4 * kg + i + 1) * 64 + 4 * i16) = (f32x4){acc[mt][0][i], acc[mt][1][i], acc[mt][2][i], acc[mt][3][i]};
    if (kg == 0) *(LAS f32x4*)(red + (F.wave * 33) * 64 + 4 * i16) = (f32x4){acc[2][0][0], acc[2][1][0], acc[2][2][0], acc[2][3][0]};
    __syncthreads();
    for (int idx = F.tid; idx < 33 * 64; idx += 512) { const int b = idx >> 6, l = idx & 63; float s = 0.f;
#pragma unroll
        for (int w = 0; w < 8; ++w) s += red[(w * 33 + b) * 64 + l];
        ((float*)(F.ws + WS_ADA))[(size_t)b * ADAW + item * 64 + l] = s + (F.in[26])[item * 64 + l]; }
    __syncthreads();
}
__device__ __forceinline__ void convert_ffn_range(Frame& F, const float* w_in, const float* w_out, bf16* dst_in, bf16* dst_out, int lo, int hi) {
    LAS float* scr = (LAS float*)(F.lds + F.wave * 16384);
    constexpr int I_IN = 16 * 176, I_OUT = 44 * 32;
    if (hi > I_IN + I_OUT) hi = I_IN + I_OUT;
    for (int it = lo + F.wave; it < hi; it += NWAVES) {
        if (it < I_IN) { const int kb = it / 176, nb = it % 176, c0 = 32 * nb; const int j0 = c0 < DFF ? c0 : c0 - DFF;
            const int drow0 = (j0 >> 7) * 256 + (c0 < DFF ? 0 : 128) + (j0 & 127);
            transpose_item(w_in, 2 * DFF, c0, D, dst_in, drow0, scr, 64 * kb, F.lane); }
        else { const int r = it - I_IN; const int kb = r / 32, nb = r % 32; transpose_item(w_out, D, 32 * nb, DFF, dst_out, 32 * nb, scr, 64 * kb, F.lane); } }
}
__device__ __forceinline__ int left_index(int pm, int pn) { return pm >= 64 ? (pm - 64) * 4 + pn : -1; }
struct Leftover { const bf16* part; bool base_in; int gi; float scale; };
__device__ __forceinline__ void load_row(Frame& F, int m, bool from_in, const Leftover& LO, f32x4 (&v)[4]) {
    const float* irow = m < MP ? (F.in[0]) + (size_t)m * D : (F.in[1]) + (size_t)(m - MP) * D;
    GAS u32x2* xb = (GAS u32x2*)((bf16*)F.out + (size_t)m * 2048) + F.lane;
#pragma unroll
    for (int j = 0; j < 4; ++j) { const int li = LO.part ? left_index(m >> 8, j) : -1;
        if (li < 0) { if (from_in) v[j] = *((const GAS f32x4*)irow + 64 * j + F.lane); else { const u32x2 w = xb[64 * j]; v[j] = (f32x4){bflo(w.x), bfhi(w.x), bflo(w.y), bfhi(w.y)}; } }
        else { f32x4 bs; if (LO.base_in) bs = *((const GAS f32x4*)irow + 64 * j + F.lane); else { const u32x2 w = xb[64 * j]; bs = (f32x4){bflo(w.x), bfhi(w.x), bflo(w.y), bfhi(w.y)}; }
            const f32x4 gv = *((const GAS f32x4*)(((float*)(F.ws + WS_ADA)) + (size_t)mod_row(m) * ADAW + LO.gi * D) + 64 * j + F.lane);
            const GAS u32x2* pp = (const GAS u32x2*)(LO.part + (size_t)li * 8 * 65536 + (size_t)(m & 255) * 256) + F.lane; f32x4 s = (f32x4){0.f, 0.f, 0.f, 0.f};
#pragma unroll
            for (int p = 0; p < 8; ++p) { const u32x2 w = pp[(size_t)p * 16384]; s += (f32x4){bflo(w.x), bfhi(w.x), bflo(w.y), bfhi(w.y)}; }
            v[j] = bs + gv * s * LO.scale; xb[64 * j] = (u32x2){pk2(v[j].x, v[j].y), pk2(v[j].z, v[j].w)}; } }
}
struct RowBuf { f32x4 x[4], sc[4], sh[4]; };
__device__ __forceinline__ void rmsmod_row(const RowBuf& rb, const f32x4 (&gq)[4], bf16* orow, int lane, f32x4 (&hv)[4]) {
    float s = 0.f;
#pragma unroll
    for (int j = 0; j < 4; ++j) s += (rb.x[j].x * rb.x[j].x + rb.x[j].y * rb.x[j].y) + (rb.x[j].z * rb.x[j].z + rb.x[j].w * rb.x[j].w);
    const float r = __builtin_amdgcn_rsqf(wave_sum(s) * (1.f / D) + EPS);
    GAS u32x2* o8 = (GAS u32x2*)orow + lane;
#pragma unroll
    for (int j = 0; j < 4; ++j) { const f32x4 h = (rb.x[j] * r) * gq[j] * (rb.sc[j] + 1.f) + rb.sh[j]; hv[j] = h;
        u32x2 w; w.x = pk2(h.x, h.y); w.y = pk2(h.z, h.w); o8[64 * j] = w; }
}
template <bool WITH_BA>
__device__ __forceinline__ void rmsmod_rows(Frame& F, bool from_in, const float* g, int li, bf16* dst, const Leftover LO = Leftover{nullptr, false, 0, 0.f}, int dld = D) {
    const int gw = F.vcu * NWAVES + F.wave, NGW = F.G * NWAVES;
    LAS float* wba = (LAS float*)F.lds;
    if (WITH_BA) { for (int idx = F.tid; idx < 16 * 1024; idx += 512) { const int k = idx >> 4, j = idx & 15; wba[j * 1024 + k] = (F.in[12])[(size_t)k * INCOLS + 4096 + j]; } __syncthreads(); }
    f32x4 gq[4];
#pragma unroll
    for (int j = 0; j < 4; ++j) gq[j] = ((const GAS f32x4*)g)[64 * j + F.lane];
    RowBuf cur, nxt;
#define ROW_FETCH(mm, B) do { const float* ad_ = ((float*)(F.ws + WS_ADA)) + (size_t)mod_row(mm) * ADAW + (3 * li) * D; load_row(F, mm, from_in, LO, B.x); \
        _Pragma("unroll") for (int j = 0; j < 4; ++j) { B.sh[j] = ((const GAS f32x4*)ad_)[64 * j + F.lane]; B.sc[j] = ((const GAS f32x4*)(ad_ + D))[64 * j + F.lane]; } } while (0)
    if (gw < M) ROW_FETCH(gw, cur);
    for (int m = gw; m < M; m += NGW) {
        if (m + NGW < M) ROW_FETCH(m + NGW, nxt);
        f32x4 hv[4]; rmsmod_row(cur, gq, dst + (size_t)m * dld, F.lane, hv);
        if (WITH_BA) { float p[16];
#pragma unroll
            for (int j = 0; j < 16; ++j) { float s = 0.f;
#pragma unroll
                for (int jj = 0; jj < 4; ++jj) { const f32x4 w = *(const LAS f32x4*)(wba + j * 1024 + 256 * jj + 4 * F.lane); s += (hv[jj].x * w.x + hv[jj].y * w.y) + (hv[jj].z * w.z + hv[jj].w * w.w); }
                p[j] = s; if ((j & 3) == 3) asm volatile("" ::: "memory"); }
            { const bool up = F.lane & 32;
#pragma unroll
              for (int i = 0; i < 8; ++i) { const float snd = up ? p[i] : p[8 + i]; const float rcv = __shfl_xor(snd, 32); p[i] = (up ? p[8 + i] : p[i]) + rcv; } }
            { const bool up = F.lane & 16;
#pragma unroll
              for (int i = 0; i < 4; ++i) { const float snd = up ? p[i] : p[4 + i]; const float rcv = __shfl_xor(snd, 16); p[i] = (up ? p[4 + i] : p[i]) + rcv; } }
            { const bool up = F.lane & 8;
#pragma unroll
              for (int i = 0; i < 2; ++i) { const float snd = up ? p[i] : p[2 + i]; const float rcv = __shfl_xor(snd, 8); p[i] = (up ? p[2 + i] : p[i]) + rcv; } }
            { const bool up = F.lane & 4; const float snd = up ? p[0] : p[1]; const float rcv = __shfl_xor(snd, 4); p[0] = (up ? p[1] : p[0]) + rcv; }
            p[0] += __shfl_xor(p[0], 2); p[0] += __shfl_xor(p[0], 1);
            if ((F.lane & 3) == 0) ((float*)(F.ws + WS_BA))[(size_t)m * 16 + (((F.lane >> 5) & 1) * 8 + ((F.lane >> 4) & 1) * 4 + ((F.lane >> 3) & 1) * 2 + ((F.lane >> 2) & 1))] = p[0]; }
        cur = nxt;
    }
#undef ROW_FETCH
    if (WITH_BA) __syncthreads();
}
__device__ __forceinline__ void final_norm_rows(Frame& F, const Leftover LO) {
    const int gw = F.vcu * NWAVES + F.wave, NGW = F.G * NWAVES;
    f32x4 gq[4], cur[4], nxt[4];
#pragma unroll
    for (int j = 0; j < 4; ++j) gq[j] = ((const GAS f32x4*)(F.in[27]))[64 * j + F.lane];
    if (gw < M) load_row(F, gw, false, LO, cur);
    for (int m = gw; m < M; m += NGW) {
        if (m + NGW < M) load_row(F, m + NGW, false, LO, nxt);
        GAS f32x4* xr = (GAS f32x4*)(F.out + (size_t)m * D) + F.lane; float s = 0.f;
#pragma unroll
        for (int j = 0; j < 4; ++j) s += (cur[j].x * cur[j].x + cur[j].y * cur[j].y) + (cur[j].z * cur[j].z + cur[j].w * cur[j].w);
        const float r = __builtin_amdgcn_rsqf(wave_sum(s) * (1.f / D) + EPS);
#pragma unroll
        for (int j = 0; j < 4; ++j) { xr[64 * j] = (cur[j] * r) * gq[j]; cur[j] = nxt[j]; }
    }
}
typedef pg8::f32x4 pf4; typedef pg8::u32x4 pu4;
#ifndef WT_STORES
#define WT_STORES 0
#endif
__device__ __forceinline__ void st16(void* p, pu4 v) {
#if WT_STORES
    asm volatile("global_store_dwordx4 %0, %1, off sc1\n\ts_nop 1" :: "v"(p), "v"(v) : "memory");
#else
    *(pu4*)p = v;
#endif
}
__device__ __forceinline__ void st16f(void* p, pf4 v) { st16(p, __builtin_bit_cast(pu4, v)); }
typedef float pf2 __attribute__((ext_vector_type(2)));
__device__ __forceinline__ pf2 silu_mul2(pf2 g, pf2 u) { const pf2 s = g * (-1.4426950408889634f); pf2 e; e.x = __builtin_amdgcn_exp2f(s.x); e.y = __builtin_amdgcn_exp2f(s.y);
    const pf2 d = e + 1.0f; pf2 r; r.x = __builtin_amdgcn_rcpf(d.x); r.y = __builtin_amdgcn_rcpf(d.y); return (g * r) * u; }
__device__ __forceinline__ pf4 silu_mul4(pf4 g, pf4 u) { const pf2 a = silu_mul2((pf2){g.x, g.y}, (pf2){u.x, u.y}), b = silu_mul2((pf2){g.z, g.w}, (pf2){u.z, u.w}); return (pf4){a.x, a.y, b.x, b.y}; }
__device__ __forceinline__ pu4 pack8(pf4 a, pf4 b) { pu4 w; w.x = pg8::cvt_pk_bf16(a.x, a.y); w.y = pg8::cvt_pk_bf16(a.z, a.w); w.z = pg8::cvt_pk_bf16(b.x, b.y); w.w = pg8::cvt_pk_bf16(b.z, b.w); return w; }
struct EpiSwiglu {
    static constexpr bool PERM = true, AFTER_DRAIN = false; bf16* O;
    __device__ __forceinline__ void operator()(const pf4 (&acc)[2][2][4][2], const pg8::Unit& u, int wr, int wc, int fr, int fq) const {
        const int row0 = u.pm * 256 + wr * 64 + fr, col0 = u.pn * 128 + wc * 32 + 8 * fq;
#pragma unroll
        for (int ai = 0; ai < 2; ++ai)
#pragma unroll
            for (int m = 0; m < 4; ++m) { bf16* p = O + (size_t)(row0 + ai * 128 + m * 16) * DFF + col0;
                const pf4 h0 = silu_mul4(acc[ai][0][m][0], acc[ai][1][m][0]), h1 = silu_mul4(acc[ai][0][m][1], acc[ai][1][m][1]);
                st16(p, pack8(h0, h1)); }
    }
};
template <bool BASE_IN> struct EpiResid {
    static constexpr bool PERM = true, AFTER_DRAIN = false; const float* in0; const float* in1; bf16* xb; const float* ada; int gi; float scale; bf16* part;
    __device__ __forceinline__ void operator()(const pf4 (&acc)[2][2][4][2], const pg8::Unit& u, int wr, int wc, int fr, int fq) const {
        if (u.piece) {
            char* pb = (char*)(part + ((size_t)u.lidx * 8 + (u.piece - 1)) * 65536);
#pragma unroll
            for (int ai = 0; ai < 2; ++ai)
#pragma unroll
                for (int bj = 0; bj < 2; ++bj) { unsigned off = (unsigned)((ai * 128 + wr * 64 + fr) * 256 + wc * 32 + 8 * fq + bj * 128) * 2u; asm volatile("" : "+v"(off));
#pragma unroll
                    for (int m = 0; m < 4; ++m) { *(pu4*)(pb + (size_t)off) = pack8(acc[ai][bj][m][0], acc[ai][bj][m][1]); off += 16u * 256u * 2u; }
                    asm volatile("" ::: "memory"); }
            return; }
        const int rowt = u.pm * 256, col0 = u.pn * 256 + wc * 32 + 8 * fq;
        const char* ib = (const char*)(rowt < MP ? in0 + (size_t)rowt * D : in1 + (size_t)(rowt - MP) * D); char* xo = (char*)(xb + (size_t)rowt * 2048);
#pragma unroll
        for (int ai = 0; ai < 2; ++ai) {
            const int b = rowt < MP ? 0 : 1 + ((rowt - MP) >> 6) + ai * 2 + wr; const char* ga = (const char*)(ada + (size_t)b * ADAW + gi * D);
#pragma unroll
            for (int bj = 0; bj < 2; ++bj) { unsigned co = (unsigned)(col0 + bj * 128); asm volatile("" : "+v"(co));
                const pf4 g0 = *(const pf4*)(ga + (size_t)co * 4u) * scale, g1 = *(const pf4*)(ga + (size_t)co * 4u + 16) * scale;
                unsigned r = (unsigned)(ai * 128 + wr * 64 + fr);
#pragma unroll
                for (int m = 0; m < 4; ++m) { pf4 b0, b1;
                    if (BASE_IN) { const char* p = ib + ((size_t)r * D + co) * 4u; b0 = *(const pf4*)p; b1 = *(const pf4*)(p + 16); }
                    else { const pu4 w = *(const pu4*)(xo + ((size_t)r * 2048 + co) * 2u); b0 = (pf4){bflo(w.x), bfhi(w.x), bflo(w.y), bfhi(w.y)}; b1 = (pf4){bflo(w.z), bfhi(w.z), bflo(w.w), bfhi(w.w)}; }
                    *(pu4*)(xo + ((size_t)r * 2048 + co) * 2u) = pack8(b0 + g0 * acc[ai][bj][m][0], b1 + g1 * acc[ai][bj][m][1]); r += 16u; }
                asm volatile("" ::: "memory"); }
        }
    }
};
struct EpiPart {
    static constexpr bool PERM = true, AFTER_DRAIN = false; bf16* part;
    __device__ __forceinline__ void operator()(const pf4 (&acc)[2][2][4][2], const pg8::Unit& u, int wr, int wc, int fr, int fq) const {
        char* pb = (char*)(part + ((size_t)u.lidx * 8 + (u.piece - 1)) * 65536);
#pragma unroll
        for (int ai = 0; ai < 2; ++ai)
#pragma unroll
            for (int bj = 0; bj < 2; ++bj) { unsigned off = (unsigned)((ai * 128 + wr * 64 + fr) * 256 + wc * 32 + 8 * fq + bj * 128) * 2u; asm volatile("" : "+v"(off));
#pragma unroll
                for (int m = 0; m < 4; ++m) { *(pu4*)(pb + (size_t)off) = pack8(acc[ai][bj][m][0], acc[ai][bj][m][1]); off += 16u * 256u * 2u; }
                asm volatile("" ::: "memory"); }
    }
};
struct EpiF1 {
    static constexpr bool PERM = true, AFTER_DRAIN = false; bf16 *U1, *U2, *U3, *U4, *KV, *TAIL; float* out;
    __device__ __forceinline__ void operator()(const pf4 (&acc)[2][2][4][2], const pg8::Unit& u, int wr, int wc, int fr, int fq) const {
        const int pn = u.pn, dcol = wc * 32 + 8 * fq;
        if (pn < 12) {
            char* Ub = (char*)U1 + (size_t)((pn >> 2) == 0 ? 4 : (pn >> 2)) * (36u << 20);
#pragma unroll
            for (int ai = 0; ai < 2; ++ai) { const int cn = u.pm * 4 + ai * 2 + wr;
#pragma unroll
                for (int bj = 0; bj < 2; ++bj) { unsigned off = (unsigned)(((cn * 8 + (pn & 3) * 2 + bj) * 64 + fr) * 128 + dcol) * 2u; asm volatile("" : "+v"(off));
#pragma unroll
                    for (int m = 0; m < 4; ++m) { st16(Ub + (size_t)off, pack8(acc[ai][bj][m][0], acc[ai][bj][m][1])); off += 16u * 128u * 2u; }
                    asm volatile("" ::: "memory"); } }
            if (fr >= 13) {
#pragma unroll
                for (int ai = 0; ai < 2; ++ai) { const int cn = u.pm * 4 + ai * 2 + wr;
#pragma unroll
                    for (int bj = 0; bj < 2; ++bj) { const int j = fr - 13, qc = pn * 256 + bj * 128 + dcol; const pf4 v0 = acc[ai][bj][3][0], v1 = acc[ai][bj][3][1];
                        *(pu4*)(TAIL + ((size_t)cn * 3 + j) * 3072 + qc) = pack8(v0, v1);
                        if (cn >= 255) { float* o = out + (cn == 255 ? OFF_PCONV + (size_t)j * 3072 : OFF_SCONV + ((size_t)(cn - 256) * 3 + j) * 3072) + qc; *(pf4*)o = v0; *(pf4*)(o + 4) = v1; } } } }
        } else if (pn < 16) {
#pragma unroll
            for (int ai = 0; ai < 2; ++ai)
#pragma unroll
                for (int bj = 0; bj < 2; ++bj) { unsigned off = (unsigned)((u.pm * 256 + ai * 128 + wr * 64 + fr) * D + (pn - 12) * 256 + bj * 128 + dcol) * 2u; asm volatile("" : "+v"(off));
#pragma unroll
                    for (int m = 0; m < 4; ++m) { st16((char*)U4 + (size_t)off, pack8(acc[ai][bj][m][0], acc[ai][bj][m][1])); off += 16u * D * 2u; }
                    asm volatile("" ::: "memory"); }
        } else {
#pragma unroll
            for (int ai = 0; ai < 2; ++ai) { const int cn = u.pm * 4 + ai * 2 + wr;
#pragma unroll
                for (int bj = 0; bj < 2; ++bj) { unsigned off = (unsigned)((cn * 64 + fr) * 256 + bj * 128 + dcol) * 2u; asm volatile("" : "+v"(off));
#pragma unroll
                    for (int m = 0; m < 4; ++m) { st16((char*)KV + (size_t)off, pack8(acc[ai][bj][m][0], acc[ai][bj][m][1])); off += 16u * 256u * 2u; }
                    asm volatile("" ::: "memory");
                    if (cn >= 254) {
                        float* ob = cn < 256 ? out + (bj == 0 ? OFF_PK : OFF_PV) + (size_t)((cn - 254) * 64 + fr) * 128 + dcol
                                             : out + (bj == 0 ? OFF_SK : OFF_SV) + (size_t)(cn - 256) * 16384 + (size_t)(64 + fr) * 128 + dcol;
#pragma unroll
                        for (int m = 0; m < 4; ++m) { *(pf4*)(ob + m * 16 * 128) = acc[ai][bj][m][0]; *(pf4*)(ob + m * 16 * 128 + 4) = acc[ai][bj][m][1]; }
                        asm volatile("" ::: "memory"); } } }
        }
    }
};
struct EpiF2 {
    static constexpr bool PERM = true, AFTER_DRAIN = false; bf16 *Z, *GA, *GB;
    __device__ __forceinline__ void operator()(const pf4 (&acc)[2][2][4][2], const pg8::Unit& u, int wr, int wc, int fr, int fq) const {
        const int t_ = u.pn >> 2; bf16* Ob = (bf16*)((char*)Z + (size_t)(108 * t_ - 72 * (t_ >> 1)) * (1u << 20)); const int col0 = (u.pn & 3) * 256 + wc * 32 + 8 * fq, row0 = u.pm * 256 + wr * 64 + fr;
#pragma unroll
        for (int ai = 0; ai < 2; ++ai)
#pragma unroll
            for (int m = 0; m < 4; ++m)
#pragma unroll
                for (int bj = 0; bj < 2; ++bj) st16(Ob + (size_t)(row0 + ai * 128 + m * 16) * D + col0 + bj * 128, pack8(acc[ai][bj][m][0], acc[ai][bj][m][1]));
    }
};
template <int MODE> struct EpiGate {
    static constexpr bool PERM = true, AFTER_DRAIN = false; bf16* T; const bf16* G2;
    __device__ __forceinline__ void operator()(const pf4 (&acc)[2][2][4][2], const pg8::Unit& u, int wr, int wc, int fr, int fq) const {
        const int col0 = u.pn * 256 + wc * 32 + 8 * fq, row0 = u.pm * 256 + wr * 64 + fr;
#pragma unroll
        for (int ai = 0; ai < 2; ++ai)
#pragma unroll
            for (int m = 0; m < 4; ++m)
#pragma unroll
                for (int bj = 0; bj < 2; ++bj) { const size_t off = (size_t)(row0 + ai * 128 + m * 16) * D + col0 + bj * 128;
                    const pu4 gv = *(const pu4*)((MODE == 0 ? (const bf16*)T : G2) + off); pu4 tv = (pu4){0u, 0u, 0u, 0u}; if (MODE == 1) tv = *(const pu4*)(T + off);
                    const pf4 a0 = acc[ai][bj][m][0], a1 = acc[ai][bj][m][1]; pf4 o0, o1;
                    o0.x = bflo(tv.x) + sigm(bflo(gv.x)) * a0.x; o0.y = bfhi(tv.x) + sigm(bfhi(gv.x)) * a0.y; o0.z = bflo(tv.y) + sigm(bflo(gv.y)) * a0.z; o0.w = bfhi(tv.y) + sigm(bfhi(gv.y)) * a0.w;
                    o1.x = bflo(tv.z) + sigm(bflo(gv.z)) * a1.x; o1.y = bfhi(tv.z) + sigm(bfhi(gv.z)) * a1.y; o1.z = bflo(tv.w) + sigm(bflo(gv.w)) * a1.z; o1.w = bfhi(tv.w) + sigm(bfhi(gv.w)) * a1.w;
                    st16(T + off, pack8(o0, o1)); }
    }
};
typedef short s16x8 __attribute__((ext_vector_type(8)));
constexpr int PR_RHST = 0, PR_QB = 69632, PR_KB = 87040, PR_AM = 104448, PR_TB = 121856, PR_SC = 126976, PR_IL = 132096, PR_CW = 141312;
static_assert(PR_IL + 64 * 72 * 2 <= PR_CW && PR_CW + 12 * 128 * 4 <= LDS_BYTES, "prep LDS map (IL, CW)");
static_assert(PR_SC + 2 * 1536 <= RING_BYTES, "prep LDS map");
constexpr size_t WS_GATES = 242 * MiB;
struct PrepRegs { v4u raw[3][5]; float gate; };
__device__ __forceinline__ void prep_fetch(Frame& F, int it, int ch8, int rg, PrepRegs& P) {
    const int cn = it >> 3, h = it & 7; const size_t blk = (size_t)(cn * 8 + h) * 64 * 128;
    P.gate = ((const float*)(F.ws + WS_GATES))[(size_t)it * 256 + ((rg * 16 + ch8) & 255)];
#pragma unroll
    for (int t = 0; t < 3; ++t) { const int ch = t * 1024 + h * 128 + 8 * ch8; const bf16* Ub = (t == 0 ? ((bf16*)(F.ws + WS_U5)) : t == 1 ? ((bf16*)(F.ws + WS_U2)) : ((bf16*)(F.ws + WS_U3))) + blk + 8 * ch8;
#pragma unroll
        for (int j = 0; j < 5; ++j) { const int rr = 2 * rg - 3 + j;
            if (rr >= 0) P.raw[t][j] = *(const v4u*)(Ub + rr * 128);
            else if (cn > 0 && cn < 256) P.raw[t][j] = *(const v4u*)(((bf16*)(F.ws + WS_TAIL)) + ((size_t)(cn - 1) * 3 + (3 + rr)) * 3072 + ch);
            else if (cn == 0) P.raw[t][j] = (v4u){0u, 0u, 0u, 0u};
            else { const float* p = (F.in[2]) + ((size_t)(cn - 256) * 3 + (3 + rr)) * 3072 + ch; const f32x4 a = *(const f32x4*)p, b = *(const f32x4*)(p + 4);
                P.raw[t][j] = (v4u){pk2(a.x, a.y), pk2(a.z, a.w), pk2(b.x, b.y), pk2(b.z, b.w)}; } } }
}
__device__ __forceinline__ void prep_gates(Frame& F, int it, int lane) {
    const int cn = it >> 3, h = it & 7, row = cn * 64 + lane; const float braw = ((float*)(F.ws + WS_BA))[(size_t)row * 16 + h], araw = ((float*)(F.ws + WS_BA))[(size_t)row * 16 + 8 + h];
    const float beta = 1.f / (1.f + expf(-braw)); const float xx = araw + (F.in[15])[h]; const float sp = xx > 20.f ? xx : log1pf(expf(xx)); const float g = -expf((F.in[14])[h]) * sp;
    float gcs = g;
#pragma unroll
    for (int o = 1; o < 64; o <<= 1) { const float t = __shfl_up(gcs, o); if (lane >= o) gcs += t; }
    const float glast = __shfl(gcs, 63);
    float* G = (float*)(F.ws + WS_GATES) + (size_t)it * 256;
    G[lane] = beta; G[64 + lane] = gcs; G[128 + lane] = expf(gcs); G[192 + lane] = expf(glast - gcs);
    if (lane == 63) ((float*)(F.ws + WS_GL))[it] = expf(glast);
}
#if defined(PROBE_PS)
#define PS_MARK(k) do { if (blockIdx.x == 0 && F.tid == 0) { const unsigned long long t_ = __builtin_amdgcn_s_memrealtime(); volatile LAS unsigned long long* a_ = (volatile LAS unsigned long long*)(F.lds + LDSCTL_OFF + 768); a_[(k)] += t_ - a_[15]; a_[15] = t_; } } while (0)
#else
#define PS_MARK(k) do {} while (0)
#endif
template <bool DRY, int SKIP = 0> __device__ __forceinline__ void gdn_prep_unit(Frame& F, int cn, int h, PrepRegs& P, int it_next, int par) {
    const int tid = F.tid, lane = F.lane, wave = F.wave, ch8 = tid & 15, rg = tid >> 4;
    LAS float* RHST = (LAS float*)(F.lds + PR_RHST); LAS bf16* QB = (LAS bf16*)(F.lds + PR_QB); LAS bf16* KB = (LAS bf16*)(F.lds + PR_KB);
    LAS float* AM = (LAS float*)(F.lds + PR_AM); LAS bf16* TB = (LAS bf16*)(F.lds + PR_TB);
    LAS float* SC = (LAS float*)(F.lds + PR_SC + (par ? 1536 : 0)); LAS float *S_BETA = SC, *S_GC = SC + 64, *S_EG = SC + 128, *S_EK = SC + 192;
    const size_t blk = (size_t)(cn * 8 + h) * 64 * 128;
    PS_MARK(0);
    const float gate_rec = P.gate;
    float y[3][2][8]; int ch8v = ch8, rgv = rg; asm volatile("" : "+v"(ch8v), "+v"(rgv));
#pragma unroll
    for (int t = 0; t < 3; ++t) { const int ch = t * 1024 + h * 128 + 8 * ch8v;
        float x[5][8];
#pragma unroll
        for (int j = 0; j < 5; ++j) { const v4u w = P.raw[t][j]; x[j][0] = bflo(w.x); x[j][1] = bfhi(w.x); x[j][2] = bflo(w.y); x[j][3] = bfhi(w.y); x[j][4] = bflo(w.z); x[j][5] = bfhi(w.z); x[j][6] = bflo(w.w); x[j][7] = bfhi(w.w); }
        const LAS float* cw = (const LAS float*)(F.lds + PR_CW) + t * 512 + 8 * ch8v;
#pragma unroll
        for (int hh = 0; hh < 2; ++hh) { const f32x4 w0 = *(const LAS f32x4*)(cw + 4 * hh), w1 = *(const LAS f32x4*)(cw + 128 + 4 * hh), w2 = *(const LAS f32x4*)(cw + 256 + 4 * hh), w3 = *(const LAS f32x4*)(cw + 384 + 4 * hh);
#pragma unroll
            for (int i = 0; i < 4; ++i)
#pragma unroll
                for (int r2 = 0; r2 < 2; ++r2) { const int ii = 4 * hh + i; if (SKIP & 8) y[t][r2][ii] = x[r2 + 3][ii] + w0[i]; else y[t][r2][ii] = siluf((w0[i] * x[r2][ii] + w1[i] * x[r2 + 1][ii]) + (w2[i] * x[r2 + 2][ii] + w3[i] * x[r2 + 3][ii])); } }
        asm volatile("" ::: "memory"); }
    float rn[2][2];
#pragma unroll
    for (int t = 0; t < 2; ++t)
#pragma unroll
        for (int r2 = 0; r2 < 2; ++r2) { float s = 0.f;
#pragma unroll
            for (int i = 0; i < 8; ++i) s += y[t][r2][i] * y[t][r2][i];
            s += __shfl_xor(s, 1); s += __shfl_xor(s, 2); s += __shfl_xor(s, 4); s += __shfl_xor(s, 8);
            rn[t][r2] = __builtin_amdgcn_rsqf(s + EPS) * (t == 0 ? 0.08838834764831845f : 1.f); }
    if (tid < 256) SC[tid] = gate_rec;
    LDS_WAIT(); __builtin_amdgcn_s_barrier();
    PS_MARK(1);
    if (SKIP & 16) { asm volatile("" :: "v"(y[0][0][0]), "v"(y[1][1][7]), "v"(y[2][0][3]), "v"(rn[0][0]), "v"(rn[1][1])); } else
    { int c8 = 8 * ch8, r0 = 2 * rg; asm volatile("" : "+v"(c8), "+v"(r0));
      float be[2], eg[2], ek[2];
#pragma unroll
      for (int r2 = 0; r2 < 2; ++r2) { be[r2] = S_BETA[r0 + r2]; eg[r2] = S_EG[r0 + r2]; ek[r2] = S_EK[r0 + r2]; }
#pragma unroll
      for (int r2 = 0; r2 < 2; ++r2) { float q[8], k[8];
#pragma unroll
          for (int i = 0; i < 8; ++i) { q[i] = y[0][r2][i] * rn[0][r2]; k[i] = y[1][r2][i] * rn[1][r2]; }
          const int row = r0 + r2;
          *(LAS v4u*)(QB + row * 136 + c8) = (v4u){pk2(q[0], q[1]), pk2(q[2], q[3]), pk2(q[4], q[5]), pk2(q[6], q[7])};
          *(LAS v4u*)(KB + row * 136 + c8) = (v4u){pk2(k[0], k[1]), pk2(k[2], k[3]), pk2(k[4], k[5]), pk2(k[6], k[7])};
          if (!DRY) *(v4u*)(((bf16*)(F.ws + WS_U5)) + blk + row * 128 + c8) = (v4u){pk2(q[0] * eg[r2], q[1] * eg[r2]), pk2(q[2] * eg[r2], q[3] * eg[r2]), pk2(q[4] * eg[r2], q[5] * eg[r2]), pk2(q[6] * eg[r2], q[7] * eg[r2])};
#pragma unroll
          for (int i = 0; i < 8; ++i) {
              y[1][r2][i] = k[i] * be[r2] * eg[r2]; y[2][r2][i] = y[2][r2][i] * be[r2]; } }
#pragma unroll
      for (int i = 0; i < 8; ++i) {
          const int rs = (r0 + (c8 >> 1)) & 63;
          *(LAS f32x2*)(RHST + (c8 + i) * 68 + rs) = (f32x2){y[2][0][i], y[2][1][i]};
          *(LAS f32x2*)(RHST + (128 + c8 + i) * 68 + rs) = (f32x2){y[1][0][i], y[1][1][i]}; } }
    LDS_WAIT(); __builtin_amdgcn_s_barrier();
    PS_MARK(2);
    if (!(SKIP & 2)) { int l4 = lane; asm volatile("" : "+v"(l4)); const int ti = wave & 3, fr = l4 & 15, fq = l4 >> 4; const LAS bf16* Ab = (wave < 4 ? KB : QB) + (16 * ti + fr) * 136 + 8 * fq;
      s16x8 a[4];
#pragma unroll
      for (int s = 0; s < 4; ++s) a[s] = *(const LAS s16x8*)(Ab + 32 * s);
      LAS bf16* IL = (LAS bf16*)(F.lds + PR_IL);
#pragma unroll
      for (int tj = 0; tj < 4; ++tj) { if (wave < 4 && tj > ti) continue;
          f32x4 acc = (f32x4){0.f, 0.f, 0.f, 0.f}; const LAS bf16* Bb = KB + (16 * tj + fr) * 136 + 8 * fq;
#pragma unroll
          for (int s = 0; s < 4; ++s) { const s16x8 b = *(const LAS s16x8*)(Bb + 32 * s); acc = __builtin_amdgcn_mfma_f32_16x16x32_bf16(a[s], b, acc, 0, 0, 0); }
          const int j = 16 * tj + fr; const float gj = S_GC[j];
#pragma unroll
          for (int r = 0; r < 4; ++r) { const int i = 16 * ti + 4 * fq + r; const float dec = fexp(fminf(S_GC[i] - gj, 0.f));
              if (wave < 4) AM[i * 68 + j] = (i > j) ? -(S_BETA[i] * acc[r] * dec) : 0.f;
              else { const unsigned iv = f2bf((i >= j) ? acc[r] * dec : 0.f); IL[i * 72 + j] = (bf16)iv; } } }
      if (wave < 4) {
          LDS_WAIT(); asm volatile("" ::: "memory");
          const int j = l4 & 15; int zv = 0; asm volatile("" : "+v"(zv)); const LAS float* Ad = AM + zv + (16 * ti) * 68 + 16 * ti; float t[16];
          f32x4 ar[16][4];
#pragma unroll
          for (int i = 1; i < 16; ++i)
#pragma unroll
              for (int k4 = 0; k4 < (i + 3) / 4; ++k4) ar[i][k4] = *(const LAS f32x4*)(Ad + i * 68 + 4 * k4);
#pragma unroll
          for (int i = 0; i < 16; ++i) { float acc = (i == j) ? 1.f : 0.f;
#pragma unroll
              for (int k = 0; k < i; ++k) acc += ar[i][k >> 2][k & 3] * t[k];
              t[i] = acc; }
          if (l4 < 16) {
#pragma unroll
              for (int i = 0; i < 16; ++i) TB[(16 * ti + i) * 16 + j] = (bf16)f2bf(t[i]); } } }
    LDS_WAIT(); __builtin_amdgcn_s_barrier();
    PS_MARK(3);
    if (!(SKIP & 4)) { int l6 = lane; asm volatile("" : "+v"(l6)); const int n = l6 & 15, g = l6 >> 4; f32x4 R[4][2];
#pragma unroll
      for (int b = 0; b < 4; ++b)
#pragma unroll
          for (int nt = 0; nt < 2; ++nt) { const int col = 32 * wave + 16 * nt + n; R[b][nt] = *(const LAS f32x4*)(RHST + col * 68 + ((16 * b + 4 * g + 4 * ((col >> 3) & 15)) & 63)); }
      LDS_WAIT(); __builtin_amdgcn_s_barrier();
      const LAS bf16* tb = TB + n * 16 + 4 * g; const LAS float* am = AM + n * 68 + 4 * g;
#pragma unroll
      for (int b = 0; b < 4; ++b) {
          const u32x2 tw = *(const LAS u32x2*)(tb + (16 * b) * 16); const s16x8 ta = __builtin_bit_cast(s16x8, (v4u){tw.x, tw.y, 0u, 0u});
          s16x8 xb[2];
#pragma unroll
          for (int nt = 0; nt < 2; ++nt) { const s16x8 rb = __builtin_bit_cast(s16x8, (v4u){pk2(R[b][nt].x, R[b][nt].y), pk2(R[b][nt].z, R[b][nt].w), 0u, 0u});
              R[b][nt] = __builtin_amdgcn_mfma_f32_16x16x32_bf16(ta, rb, (f32x4){0.f, 0.f, 0.f, 0.f}, 0, 0, 0);
              xb[nt] = __builtin_bit_cast(s16x8, (v4u){pk2(R[b][nt].x, R[b][nt].y), pk2(R[b][nt].z, R[b][nt].w), 0u, 0u}); }
#pragma unroll
          for (int b2 = b + 1; b2 < 4; ++b2) { const f32x4 av = *(const LAS f32x4*)(am + (16 * b2) * 68 + 16 * b); const s16x8 aa = __builtin_bit_cast(s16x8, (v4u){pk2(av.x, av.y), pk2(av.z, av.w), 0u, 0u});
              R[b2][0] = __builtin_amdgcn_mfma_f32_16x16x32_bf16(aa, xb[0], R[b2][0], 0, 0, 0); R[b2][1] = __builtin_amdgcn_mfma_f32_16x16x32_bf16(aa, xb[1], R[b2][1], 0, 0, 0); } }
      if (wave < 4) { LAS bf16* UL = (LAS bf16*)(F.lds + PR_RHST) + (32 * wave + n) * 72 + 4 * g;
#pragma unroll
          for (int b = 0; b < 4; ++b)
#pragma unroll
              for (int nt = 0; nt < 2; ++nt) *(LAS u32x2*)(UL + nt * 16 * 72 + 16 * b) = (u32x2){pk2(R[b][nt].x, R[b][nt].y), pk2(R[b][nt].z, R[b][nt].w)}; }
      else { LAS bf16* WL = QB + (4 * g) * 136 + 32 * (wave - 4) + n;
#pragma unroll
          for (int b = 0; b < 4; ++b)
#pragma unroll
              for (int nt = 0; nt < 2; ++nt)
#pragma unroll
                  for (int r = 0; r < 4; ++r) WL[(16 * b + r) * 136 + 16 * nt] = (bf16)f2bf(-R[b][nt][r]); } }
    LDS_WAIT(); __builtin_amdgcn_s_barrier();
    PS_MARK(5);
    if (it_next >= 0) { int c9 = ch8, r9 = rg; asm volatile("" : "+v"(c9), "+v"(r9)); prep_fetch(F, it_next, c9, r9, P); }
    if (!DRY) { int t5 = tid; asm volatile("" : "+v"(t5));
#pragma unroll
        for (int i = 0; i < 2; ++i) { const int id = t5 + 512 * i, row = id >> 4, q = id & 15; *(v4u*)(((bf16*)(F.ws + WS_U1)) + blk + row * 128 + 8 * q) = *(const LAS v4u*)(QB + row * 136 + 8 * q); }
        { const int row = t5 >> 3, q = t5 & 7; *(v4u*)(((bf16*)(F.ws + WS_INTRA)) + (size_t)(cn * 8 + h) * 4096 + row * 64 + 8 * q) = *(const LAS v4u*)((LAS bf16*)(F.lds + PR_IL) + row * 72 + 8 * q); }
#pragma unroll
        for (int i = 0; i < 2; ++i) { const int id = t5 + 512 * i, row = id >> 3, q = id & 7;
            *(v4u*)(((bf16*)(F.ws + WS_U3)) + blk + row * 64 + 8 * q) = *(const LAS v4u*)((LAS bf16*)(F.lds + PR_RHST) + row * 72 + 8 * q);
            float kv[8];
#pragma unroll
            for (int j = 0; j < 8; ++j) kv[j] = bf2f(KB[(8 * q + j) * 136 + row]) * S_EK[8 * q + j];
            *(v4u*)(((bf16*)(F.ws + WS_U2)) + blk + row * 64 + 8 * q) = (v4u){pk2(kv[0], kv[1]), pk2(kv[2], kv[3]), pk2(kv[4], kv[5]), pk2(kv[6], kv[7])}; } }
    PS_MARK(6);
    LDS_WAIT();
}
typedef float f32x16 __attribute__((ext_vector_type(16)));
constexpr int SW_KS = 0, SW_VT = 27648, SW_TB = 53248;
__device__ __forceinline__ int t5_bucket(int rel) { const int n = rel < 0 ? -rel : rel;
    const int b = n < 8 ? n : n < 12 ? 8 : n < 16 ? 9 : n < 23 ? 10 : n < 32 ? 11 : n < 46 ? 12 : n < 64 ? 13 : n < 91 ? 14 : 15; return (rel > 0 ? 16 : 0) + b; }
template <bool DRY> __device__ __forceinline__ void swa_unit(Frame& F, int cn, int kh) {
    const int tid = F.tid, lane = F.lane, wave = F.wave, r32 = lane & 31, hi = lane >> 5;
    LAS bf16* KS = (LAS bf16*)(F.lds + SW_KS); LAS bf16* VT = (LAS bf16*)(F.lds + SW_VT); LAS float* TB = (LAS float*)(F.lds + SW_TB);
    const bool smp = cn >= 256; const int b = cn - 256;
#pragma unroll
    for (int it = 0; it < 3; ++it) { const int id = tid + 512 * it, row = id >> 3, dq = id & 7;
        v4u kw = (v4u){0u, 0u, 0u, 0u}, vw = kw;
        if (smp && row < 128) { const size_t so = ((size_t)(b * 128 + row) * 2 + kh) * 64 + dq * 8;
            const f32x4 k0 = *(const f32x4*)((F.in[4]) + so), k1 = *(const f32x4*)((F.in[4]) + so + 4), v0 = *(const f32x4*)((F.in[5]) + so), v1 = *(const f32x4*)((F.in[5]) + so + 4);
            kw = (v4u){pk2(k0.x, k0.y), pk2(k0.z, k0.w), pk2(k1.x, k1.y), pk2(k1.z, k1.w)}; vw = (v4u){pk2(v0.x, v0.y), pk2(v0.z, v0.w), pk2(v1.x, v1.y), pk2(v1.z, v1.w)};
            if (row >= 64 && !DRY) { float* ok = F.out + OFF_SK + (size_t)b * 16384 + (size_t)(row - 64) * 128 + kh * 64 + dq * 8; float* ov = F.out + OFF_SV + (size_t)b * 16384 + (size_t)(row - 64) * 128 + kh * 64 + dq * 8;
                *(f32x4*)ok = k0; *(f32x4*)(ok + 4) = k1; *(f32x4*)ov = v0; *(f32x4*)(ov + 4) = v1; } }
        else { const int kp = smp ? (MP + b * 64 + row - 128) : (cn * 64 - 128 + row);
            if (kp >= 0) { const bf16* src = ((bf16*)(F.ws + WS_KV)) + (size_t)kp * 256 + kh * 64 + dq * 8; kw = *(const v4u*)src; vw = *(const v4u*)(src + 128); } }
        *(LAS v4u*)(KS + row * 72 + dq * 8) = kw;
        LAS bf16* vt = VT + (dq * 8) * 200 + row;
        vt[0] = (bf16)(vw.x & 0xffffu); vt[200] = (bf16)(vw.x >> 16); vt[400] = (bf16)(vw.y & 0xffffu); vt[600] = (bf16)(vw.y >> 16);
        vt[800] = (bf16)(vw.z & 0xffffu); vt[1000] = (bf16)(vw.z >> 16); vt[1200] = (bf16)(vw.w & 0xffffu); vt[1400] = (bf16)(vw.w >> 16); }
    for (int id = tid; id < 8 * 256; id += 512) { const int hl = id >> 8, ix = id & 255; TB[id] = ix < 255 ? (F.in[18])[t5_bucket(ix - 191) * 16 + kh * 8 + hl] : 0.f; }
    __syncthreads();
    const int head = kh * 8 + wave; const float sink = (F.in[17])[head];
    bf16* Qg = ((bf16*)(F.ws + WS_U4)) + (size_t)(cn * 64) * D + head * 64;
    const LAS float* tb = TB + wave * 256;
#pragma unroll 1
    for (int qt = 0; qt < 2; ++qt) {
        s16x8 qf[4];
#pragma unroll
        for (int s = 0; s < 4; ++s) qf[s] = *(const s16x8*)(Qg + (size_t)(32 * qt + r32) * D + 16 * s + 8 * hi);
        f32x16 P[6]; const int qi = 32 * qt + r32; float mx = -INFINITY;
#pragma unroll
        for (int kt = 0; kt < 6; ++kt) { f32x16 acc = {};
#pragma unroll
            for (int s = 0; s < 4; ++s) { const s16x8 a = *(const LAS s16x8*)(KS + (32 * kt + r32) * 72 + 16 * s + 8 * hi); acc = __builtin_amdgcn_mfma_f32_32x32x16_bf16(a, qf[s], acc, 0, 0, 0); }
#pragma unroll
            for (int r = 0; r < 16; ++r) { const int j = 32 * kt + (r & 3) + 8 * (r >> 2) + 4 * hi; float l = acc[r] * 0.125f + tb[j - qi + 63];
                if (!smp && cn * 64 + j < 128) l = -INFINITY; acc[r] = l; mx = fmaxf(mx, l); }
            P[kt] = acc; asm volatile("" ::: "memory"); }
        mx = fmaxf(mx, __shfl_xor(mx, 32)); mx = fmaxf(mx, sink);
        float sum = 0.f;
#pragma unroll
        for (int kt = 0; kt < 6; ++kt)
#pragma unroll
            for (int r = 0; r < 16; ++r) { const float p = fexp(P[kt][r] - mx); P[kt][r] = p; sum += p; }
        sum += __shfl_xor(sum, 32);
        const float inv = 1.f / (sum + fexp(sink - mx));
        f32x16 O[2]; O[0] = (f32x16){}; O[1] = (f32x16){};
#pragma unroll
        for (int kt = 0; kt < 6; ++kt) {
#pragma unroll
            for (int s2 = 0; s2 < 2; ++s2) { v4u pw; pw.x = pk2(P[kt][8 * s2] * inv, P[kt][8 * s2 + 1] * inv); pw.y = pk2(P[kt][8 * s2 + 2] * inv, P[kt][8 * s2 + 3] * inv);
                pw.z = pk2(P[kt][8 * s2 + 4] * inv, P[kt][8 * s2 + 5] * inv); pw.w = pk2(P[kt][8 * s2 + 6] * inv, P[kt][8 * s2 + 7] * inv);
                const s16x8 pa = __builtin_bit_cast(s16x8, pw);
#pragma unroll
                for (int dt = 0; dt < 2; ++dt) { const LAS bf16* vp = VT + (32 * dt + r32) * 200 + 32 * kt + 16 * s2 + 4 * hi;
                    const u32x2 lo = *(const LAS u32x2*)vp, hh = *(const LAS u32x2*)(vp + 8);
                    const s16x8 vb = __builtin_bit_cast(s16x8, (v4u){lo.x, lo.y, hh.x, hh.y});
                    O[dt] = __builtin_amdgcn_mfma_f32_32x32x16_bf16(pa, vb, O[dt], 0, 0, 0); } }
            asm volatile("" ::: "memory"); }
#pragma unroll
        for (int dt = 0; dt < 2; ++dt)
#pragma unroll
            for (int r = 0; r < 16; ++r) { const int q = 32 * qt + (r & 3) + 8 * (r >> 2) + 4 * hi; const unsigned ov = f2bf(O[dt][r]); if (!DRY) Qg[(size_t)q * D + 32 * dt + r32] = (bf16)ov; else asm volatile("" :: "v"(ov)); }
    }
    __syncthreads();
}
constexpr int SC_WN = 0, SC_QP = 16384, SC_KPT = 32768, SC_IN = 49152, SC_STAGE = 57344;
template <int C, int NCHUNK> __device__ __forceinline__ void tile_rq(int lt, int i, int& row, int& q) {
    const int l = lt & 63, lw = lt >> 6, grp = l >> 4, s = NCHUNK * lw + i;
    const int rb = (C == 128) ? (s >> 1) : s, qb = (C == 128) ? 8 * (s & 1) : 0;
    row = 8 * rb + (l & 7); q = qb + 4 * (grp >> 1) + (grp & 1) + 2 * ((l >> 3) & 1);
}
template <int C, int NCHUNK> __device__ __forceinline__ void ld_tile(const bf16* src, int lt, v4u (&reg)[NCHUNK]) {
#pragma unroll
    for (int i = 0; i < NCHUNK; ++i) { int row, q; tile_rq<C, NCHUNK>(lt, i, row, q); reg[i] = *(const v4u*)(src + (size_t)row * C + 8 * q); }
}
template <int C, int NCHUNK> __device__ __forceinline__ void st_tile(LAS unsigned char* base, int lt, const v4u (&reg)[NCHUNK]) {
#pragma unroll
    for (int i = 0; i < NCHUNK; ++i) { int row, q; tile_rq<C, NCHUNK>(lt, i, row, q); const int ks = q >> 2, qq = q & 3;
        LAS unsigned char* d0 = base + ((row >> 4) * (C / 32) + ks) * 1024 + ((2 * (qq & 1)) * 16 + (row & 15)) * 16 + (qq >> 1) * 8;
        *(LAS u32x2*)d0 = (u32x2){reg[i].x, reg[i].y}; *(LAS u32x2*)(d0 + 256) = (u32x2){reg[i].z, reg[i].w}; }
}
__device__ __forceinline__ s16x8 pack_b(f32x4 a, f32x4 b) { v4u w; w.x = pk2(a.x, a.y); w.y = pk2(a.z, a.w); w.z = pk2(b.x, b.y); w.w = pk2(b.z, b.w); return __builtin_bit_cast(s16x8, w); }
#define MF16(a, b, c) __builtin_amdgcn_mfma_f32_16x16x32_bf16(a, b, c, 0, 0, 0)
template <bool DRY, int SKIP = 0> __device__ __forceinline__ void scan_task(Frame& F, int cn0, int nchunk, int h, int hf, const float* s0, float* sout, bool write_s) {
    const int lane = F.lane, wave = F.wave, e = lane & 15, g = lane >> 4;
    LAS unsigned char* ring = F.lds;
    if (wave >= 4) {
#ifndef SCAN_NO_LOADER
        const int lt = F.tid - 256; v4u rw[4], rq[4], rk[4], ri[2], sw[4], sq[4], sk[4], si[2];
#define LD_SET(cn, W, Q, K, I) do { const size_t blk_ = (size_t)((cn) * 8 + h) * 8192; ld_tile<128, 4>(((bf16*)(F.ws + WS_U1)) + blk_, lt, W); ld_tile<128, 4>(((bf16*)(F.ws + WS_U5)) + blk_, lt, Q); ld_tile<64, 4>(((bf16*)(F.ws + WS_U2)) + blk_, lt, K); ld_tile<64, 2>(((bf16*)(F.ws + WS_INTRA)) + (size_t)((cn) * 8 + h) * 4096, lt, I); } while (0)
#define ST_SET(st, W, Q, K, I) do { LAS unsigned char* b_ = ring + (st) * SC_STAGE; st_tile<128, 4>(b_ + SC_WN, lt, W); st_tile<128, 4>(b_ + SC_QP, lt, Q); st_tile<64, 4>(b_ + SC_KPT, lt, K); st_tile<64, 2>(b_ + SC_IN, lt, I); } while (0)
        if (!(SKIP & 1)) { LD_SET(cn0, rw, rq, rk, ri); ST_SET(0, rw, rq, rk, ri); if (nchunk > 1) LD_SET(cn0 + 1, sw, sq, sk, si); if (nchunk > 2) LD_SET(cn0 + 2, rw, rq, rk, ri); }
        LDS_WAIT(); __builtin_amdgcn_s_barrier();
#pragma unroll 1
        for (int n = 0; n < nchunk; ++n) {
            if (n + 1 < nchunk && !(SKIP & 1)) {
                if (n & 1) { ST_SET(0, rw, rq, rk, ri); if (n + 3 < nchunk) LD_SET(cn0 + n + 3, rw, rq, rk, ri); }
                else { ST_SET(1, sw, sq, sk, si); if (n + 3 < nchunk) LD_SET(cn0 + n + 3, sw, sq, sk, si); } }
            LDS_WAIT(); __builtin_amdgcn_s_barrier();
        }
#undef LD_SET
#undef ST_SET
#endif
    } else {
#ifndef SCAN_NO_SCAN
        const int e0 = 64 * hf + 16 * wave + e;
        f32x4 S[8];
#pragma unroll
        for (int dt = 0; dt < 8; ++dt) { const float* p = (const float*)((const char*)s0 + (size_t)((unsigned)((16 * dt + 4 * g) * 128 + e0) * 4u)); S[dt] = (f32x4){p[0], p[128], p[256], p[384]}; }
        u32x2 ucur[4], unext[4];
        { const bf16* up = ((bf16*)(F.ws + WS_U3)) + ((size_t)(cn0 * 8 + h) * 128 + e0) * 64 + 4 * g;
#pragma unroll
          for (int mt = 0; mt < 4; ++mt) ucur[mt] = *(const u32x2*)(up + 16 * mt); }
        __builtin_amdgcn_s_barrier();
#pragma unroll 1
        for (int n = 0; n < nchunk; ++n) {
            const int cn = cn0 + n; const LAS unsigned char* st = ring + (n & 1) * SC_STAGE + lane * 16;
            const float gl = ((float*)(F.ws + WS_GL))[cn * 8 + h];
            bf16* op = ((bf16*)(F.ws + WS_U3)) + ((size_t)(cn * 8 + h) * 128 + e0) * 64 + 4 * g;
            if (n + 1 < nchunk) {
#pragma unroll
                for (int mt = 0; mt < 4; ++mt) unext[mt] = *(const u32x2*)(op + 8 * 128 * 64 + 16 * mt); }
            if (SKIP & 2) { LDS_WAIT(); __builtin_amdgcn_s_barrier(); continue; }
            s16x8 Sb[4];
#pragma unroll
            for (int ks = 0; ks < 4; ++ks) Sb[ks] = pack_b(S[2 * ks], S[2 * ks + 1]);
            f32x4 Vn[4], O[4];
#pragma unroll
            for (int mt = 0; mt < 4; ++mt) { Vn[mt] = (f32x4){bflo(ucur[mt].x), bfhi(ucur[mt].x), bflo(ucur[mt].y), bfhi(ucur[mt].y)}; O[mt] = (f32x4){0.f, 0.f, 0.f, 0.f}; }
            s16x8 fa[8], fb[8];
#define FENCE() asm volatile("" ::: "memory")
#define LD_WQ(dst, mt) do { _Pragma("unroll") for (int ks = 0; ks < 4; ++ks) { dst[ks] = *(const LAS s16x8*)(st + SC_WN + ((mt) * 4 + ks) * 1024); dst[4 + ks] = *(const LAS s16x8*)(st + SC_QP + ((mt) * 4 + ks) * 1024); } } while (0)
#define MM_WQ(src, mt) do { _Pragma("unroll") for (int ks = 0; ks < 4; ++ks) { Vn[mt] = MF16(src[ks], Sb[ks], Vn[mt]); O[mt] = MF16(src[4 + ks], Sb[ks], O[mt]); } } while (0)
#define LD_4(dst, off, a) do { _Pragma("unroll") for (int i_ = 0; i_ < 4; ++i_) dst[i_] = *(const LAS s16x8*)(st + (off) + ((a) * 4 + i_) * 1024); } while (0)
#define MM_IN(src, mp) do { O[2 * (mp)] = MF16(src[0], Vb[0], O[2 * (mp)]); O[2 * (mp)] = MF16(src[1], Vb[1], O[2 * (mp)]); O[2 * (mp) + 1] = MF16(src[2], Vb[0], O[2 * (mp) + 1]); O[2 * (mp) + 1] = MF16(src[3], Vb[1], O[2 * (mp) + 1]); } while (0)
#define MM_KP(src, dp) do { S[2 * (dp)] = MF16(src[0], Vb[0], S[2 * (dp)]); S[2 * (dp)] = MF16(src[1], Vb[1], S[2 * (dp)]); S[2 * (dp) + 1] = MF16(src[2], Vb[0], S[2 * (dp) + 1]); S[2 * (dp) + 1] = MF16(src[3], Vb[1], S[2 * (dp) + 1]); } while (0)
            LD_WQ(fa, 0); FENCE(); LD_WQ(fb, 1); MM_WQ(fa, 0); FENCE(); LD_WQ(fa, 2); MM_WQ(fb, 1); FENCE(); LD_WQ(fb, 3); MM_WQ(fa, 2); FENCE(); LD_4(fa, SC_IN, 0); MM_WQ(fb, 3); FENCE();
#pragma unroll
            for (int dt = 0; dt < 8; ++dt) S[dt] = S[dt] * gl;
            s16x8 Vb[2];
#pragma unroll
            for (int k2 = 0; k2 < 2; ++k2) Vb[k2] = pack_b(Vn[2 * k2], Vn[2 * k2 + 1]);
            LD_4(fb, SC_IN, 1); MM_IN(fa, 0); FENCE(); LD_4(fa, SC_KPT, 0); MM_IN(fb, 1); FENCE(); LD_4(fb, SC_KPT, 1); MM_KP(fa, 0); FENCE(); LD_4(fa, SC_KPT, 2); MM_KP(fb, 1); FENCE(); LD_4(fb, SC_KPT, 3); MM_KP(fa, 2); FENCE(); MM_KP(fb, 3);
#undef FENCE
#undef LD_WQ
#undef MM_WQ
#undef LD_4
#undef MM_IN
#undef MM_KP
#pragma unroll
            for (int mt = 0; mt < 4; ++mt) { u32x2 w; w.x = pk2(O[mt].x, O[mt].y); w.y = pk2(O[mt].z, O[mt].w); if (!DRY) *(u32x2*)(op + 16 * mt) = w; else asm volatile("" :: "v"(w.x), "v"(w.y)); ucur[mt] = unext[mt]; }
            LDS_WAIT(); __builtin_amdgcn_s_barrier();
        }
        { unsigned so = (unsigned)((4 * g) * 128 + e0) * 4u; asm volatile("" : "+v"(so));
#pragma unroll
          for (int dt = 0; dt < 8; ++dt) { float* p = (float*)((char*)sout + (size_t)(so + dt * 8192u)); if (!DRY && write_s) { p[0] = S[dt].x; p[128] = S[dt].y; p[256] = S[dt].z; p[384] = S[dt].w; } else asm volatile("" :: "v"(S[dt].x), "v"(S[dt].y), "v"(S[dt].z), "v"(S[dt].w)); } }
#endif
    }
}

__device__ __forceinline__ void scanA_task(Frame& F, int cn0, int nchunk, int h, int hf, float* sout, bf16* mout) {
    const int lane = F.lane, wave = F.wave, e = lane & 15, g = lane >> 4;
    LAS unsigned char* ring = F.lds;
    if (wave >= 4) {
        const int lt = F.tid - 256; v4u rw[4], rk[4];
#define LD_A(cn) do { const size_t blk_ = (size_t)((cn) * 8 + h) * 8192; ld_tile<128, 4>(((bf16*)(F.ws + WS_U1)) + blk_, lt, rw); ld_tile<64, 4>(((bf16*)(F.ws + WS_U2)) + blk_, lt, rk); } while (0)
#define ST_A(st) do { LAS unsigned char* b_ = ring + (st) * SC_STAGE; st_tile<128, 4>(b_ + SC_WN, lt, rw); st_tile<64, 4>(b_ + SC_KPT, lt, rk); } while (0)
        LD_A(cn0); ST_A(0); if (nchunk > 1) LD_A(cn0 + 1);
        LDS_WAIT(); __builtin_amdgcn_s_barrier();
#pragma unroll 1
        for (int n = 0; n < nchunk; ++n) {
            if (n + 1 < nchunk) { ST_A((n + 1) & 1); if (n + 2 < nchunk) LD_A(cn0 + n + 2); }
            LDS_WAIT(); __builtin_amdgcn_s_barrier();
        }
#undef LD_A
#undef ST_A
    } else {
        const int e0 = 64 * hf + 16 * wave + e;
        f32x4 S[8], X[8];
#pragma unroll
        for (int dt = 0; dt < 8; ++dt) { S[dt] = (f32x4){0.f, 0.f, 0.f, 0.f}; const int d0 = 16 * dt + 4 * g;
            X[dt] = (f32x4){d0 == e0 ? 1.f : 0.f, d0 + 1 == e0 ? 1.f : 0.f, d0 + 2 == e0 ? 1.f : 0.f, d0 + 3 == e0 ? 1.f : 0.f}; }
        u32x2 ucur[4], unext[4];
        { const bf16* up = ((bf16*)(F.ws + WS_U3)) + ((size_t)(cn0 * 8 + h) * 128 + e0) * 64 + 4 * g;
#pragma unroll
          for (int mt = 0; mt < 4; ++mt) ucur[mt] = *(const u32x2*)(up + 16 * mt); }
        __builtin_amdgcn_s_barrier();
#pragma unroll 1
        for (int n = 0; n < nchunk; ++n) {
            const int cn = cn0 + n; const LAS unsigned char* st = ring + (n & 1) * SC_STAGE + lane * 16;
            const float gl = ((float*)(F.ws + WS_GL))[cn * 8 + h];
            const bf16* op = ((bf16*)(F.ws + WS_U3)) + ((size_t)(cn * 8 + h) * 128 + e0) * 64 + 4 * g;
            if (n + 1 < nchunk) {
#pragma unroll
                for (int mt = 0; mt < 4; ++mt) unext[mt] = *(const u32x2*)(op + 8 * 128 * 64 + 16 * mt); }
            s16x8 Sb[4], Xb[4];
#pragma unroll
            for (int ks = 0; ks < 4; ++ks) { Sb[ks] = pack_b(S[2 * ks], S[2 * ks + 1]); Xb[ks] = pack_b(X[2 * ks], X[2 * ks + 1]); }
            f32x4 Vn[4], Vx[4];
#pragma unroll
            for (int mt = 0; mt < 4; ++mt) { Vn[mt] = (f32x4){bflo(ucur[mt].x), bfhi(ucur[mt].x), bflo(ucur[mt].y), bfhi(ucur[mt].y)}; Vx[mt] = (f32x4){0.f, 0.f, 0.f, 0.f}; }
#pragma unroll
            for (int mt = 0; mt < 4; ++mt)
#pragma unroll
                for (int ks = 0; ks < 4; ++ks) { const s16x8 aw = *(const LAS s16x8*)(st + SC_WN + (mt * 4 + ks) * 1024);
                    Vn[mt] = MF16(aw, Sb[ks], Vn[mt]); Vx[mt] = MF16(aw, Xb[ks], Vx[mt]); if (ks == 3) asm volatile("" ::: "memory"); }
#pragma unroll
            for (int dt = 0; dt < 8; ++dt) { S[dt] = S[dt] * gl; X[dt] = X[dt] * gl; }
            s16x8 Vb[2], Wb[2];
#pragma unroll
            for (int k2 = 0; k2 < 2; ++k2) { Vb[k2] = pack_b(Vn[2 * k2], Vn[2 * k2 + 1]); Wb[k2] = pack_b(Vx[2 * k2], Vx[2 * k2 + 1]); }
#pragma unroll
            for (int dt = 0; dt < 8; ++dt)
#pragma unroll
                for (int k2 = 0; k2 < 2; ++k2) { const s16x8 ak = *(const LAS s16x8*)(st + SC_KPT + (dt * 2 + k2) * 1024); S[dt] = MF16(ak, Vb[k2], S[dt]); X[dt] = MF16(ak, Wb[k2], X[dt]); if (k2 == 1 && (dt & 1)) asm volatile("" ::: "memory"); }
#pragma unroll
            for (int mt = 0; mt < 4; ++mt) ucur[mt] = unext[mt];
            LDS_WAIT(); __builtin_amdgcn_s_barrier();
        }
        { unsigned so = (unsigned)((4 * g) * 128 + e0); asm volatile("" : "+v"(so));
#pragma unroll
          for (int dt = 0; dt < 8; ++dt) { float* p = sout + so + dt * 2048u; p[0] = S[dt].x; p[128] = S[dt].y; p[256] = S[dt].z; p[384] = S[dt].w;
              bf16* q = mout + so + dt * 2048u; q[0] = (bf16)f2bf(X[dt].x); q[128] = (bf16)f2bf(X[dt].y); q[256] = (bf16)f2bf(X[dt].z); q[384] = (bf16)f2bf(X[dt].w); } }
    }
}
template <int NGR, int N, int FL> __device__ __forceinline__ void scanB_step(Frame& F, int h, int cb, int rq, size_t roff, const bf16* MG, const float* SG, v4u (&rm)[3][4], f32x4 (&Bq)[3][2], f32x4 (&So)[FL][2]) {
    constexpr int J = N % 3, n = N;
    LAS unsigned char* ring = F.lds; LAS unsigned char* XB = ring + 2 * SC_STAGE; const int lane = F.lane;
    const LAS unsigned char* st = ring + (n & 1) * SC_STAGE + lane * 16;
    const LAS unsigned char* xr = XB + (((n & 1) * 2 + cb) * 4) * 1024 + lane * 16;
    s16x8 Sb[4];
#pragma unroll
    for (int ks = 0; ks < 4; ++ks) Sb[ks] = *(const LAS s16x8*)(xr + ks * 1024);
#pragma unroll
    for (int dt = 0; dt < 2; ++dt) { f32x4 acc = Bq[J][dt];
#pragma unroll
        for (int ks = 0; ks < 4; ++ks) { const s16x8 am = *(const LAS s16x8*)(st + ((2 * rq + dt) * 4 + ks) * 1024); acc = MF16(am, Sb[ks], acc); }
        So[N % FL][dt] = acc; }
    *(LAS s16x8*)(XB + (((((n + 1) & 1) * 2 + cb) * 4) + rq) * 1024 + lane * 16) = pack_b(So[N % FL][0], So[N % FL][1]);
    st_tile<128, 4>(ring + ((n + 1) & 1) * SC_STAGE, F.tid, rm[(J + 1) % 3]);
    { constexpr int nm = n + 4 < NGR ? n + 4 : NGR - 1; ld_tile<128, 4>(MG + (size_t)(nm * 8 + h) * 16384, F.tid, rm[(J + 1) % 3]); }
    { constexpr int nb = n + 3 < NGR ? n + 3 : NGR - 1; const float* bq = SG + (size_t)(nb * 8 + h) * 16384 + roff;
#pragma unroll
      for (int dt = 0; dt < 2; ++dt) { const float* p = bq + dt * 2048; Bq[J][dt] = (f32x4){p[0], p[128], p[256], p[384]}; } }
    LDS_WAIT(); __builtin_amdgcn_s_barrier();
}
template <int FL> __device__ __forceinline__ void scanB_flush(int n_first, int count, int h, size_t roff, float* SG, const f32x4 (&So)[FL][2]) {
#pragma unroll
    for (int i = 0; i < FL; ++i) if (i < count) { float* bp = SG + (size_t)((n_first + i) * 8 + h) * 16384 + roff;
#pragma unroll
        for (int dt = 0; dt < 2; ++dt) { float* p = bp + dt * 2048; p[0] = So[i][dt].x; p[128] = So[i][dt].y; p[256] = So[i][dt].z; p[384] = So[i][dt].w; } }
}
template <int NGR> __device__ __forceinline__ void scanB_task(Frame& F, int h, int cq, const bf16* MG, float* SG) {
    static_assert(NGR == 15, "pass B is written out for 15 steps");
    constexpr int FL = 8;
    const int lane = F.lane, e = lane & 15, g4 = lane >> 4, cb = F.wave & 1, rq = F.wave >> 1;
    LAS unsigned char* ring = F.lds; LAS unsigned char* XB = ring + 2 * SC_STAGE;
    const int e0 = 32 * cq + 16 * cb + e; const size_t roff = (size_t)(32 * rq + 4 * g4) * 128 + e0;
    v4u rm[3][4]; f32x4 Bq[3][2], So[FL][2];
    ld_tile<128, 4>(MG + (size_t)h * 16384, F.tid, rm[0]); st_tile<128, 4>(ring, F.tid, rm[0]);
    ld_tile<128, 4>(MG + (size_t)(1 * 8 + h) * 16384, F.tid, rm[1]);
    ld_tile<128, 4>(MG + (size_t)(2 * 8 + h) * 16384, F.tid, rm[2]);
    ld_tile<128, 4>(MG + (size_t)(3 * 8 + h) * 16384, F.tid, rm[0]);
#pragma unroll
    for (int q = 0; q < 3; ++q) { const float* bp0 = SG + (size_t)(q * 8 + h) * 16384 + roff;
#pragma unroll
        for (int dt = 0; dt < 2; ++dt) { const float* p = bp0 + dt * 2048; Bq[q][dt] = (f32x4){p[0], p[128], p[256], p[384]}; } }
    *(LAS v4u*)(XB + (cb * 4 + rq) * 1024 + lane * 16) = (v4u){0u, 0u, 0u, 0u};
    LDS_WAIT(); __builtin_amdgcn_s_barrier();
#define SB_STEP(N) scanB_step<NGR, N, FL>(F, h, cb, rq, roff, MG, SG, rm, Bq, So)
#if defined(PROBE_SB)
    const unsigned long long tq0 = __builtin_amdgcn_s_memrealtime();
#endif
    SB_STEP(0); SB_STEP(1); SB_STEP(2); SB_STEP(3); SB_STEP(4); SB_STEP(5); SB_STEP(6); SB_STEP(7);
#if defined(PROBE_SB)
    if (blockIdx.x == 0 && F.tid == 0) ((volatile LAS unsigned long long*)(F.lds + LDSCTL_OFF + 768))[13] = __builtin_amdgcn_s_memrealtime() - tq0;
#endif
    scanB_flush<FL>(0, 8, h, roff, SG, So);
    SB_STEP(8); SB_STEP(9); SB_STEP(10); SB_STEP(11); SB_STEP(12); SB_STEP(13); SB_STEP(14);
    scanB_flush<FL>(8, 7, h, roff, SG, So);
#undef SB_STEP
}
#undef MF16
constexpr int SCAN_NG = 16, SCAN_GC = 16;
constexpr size_t WS_MG = 242 * MiB, WS_SG = 246 * MiB;
__device__ __forceinline__ void scanA_phase(Frame& F) {
    const int bx = blockIdx.x; bf16* MG = (bf16*)(F.ws + WS_MG); float* SG = (float*)(F.ws + WS_SG);
    if (bx < (SCAN_NG - 1) * 16) { const int gq = bx >> 4, h = bx & 7, hf = (bx >> 3) & 1;
        scanA_task(F, gq * SCAN_GC, SCAN_GC, h, hf, SG + (size_t)(gq * 8 + h) * 16384, MG + (size_t)(gq * 8 + h) * 16384); }
    for (int t = (bx + 16) % F.G; t < 512; t += F.G) { const int b = t >> 4, h = t & 7, hf = (t >> 3) & 1;
        scan_task<false>(F, 256 + b, 1, h, hf, ((const float*)(F.in[3])) + (size_t)(b * 8 + h) * 16384, F.out + OFF_SS + (size_t)(b * 8 + h) * 16384, true); }
}
constexpr int SCANB_WGS = 32;
__device__ __forceinline__ void scanB_phase(Frame& F) { const int bx = blockIdx.x;
#if defined(PROBE_SB)
    const unsigned long long tsb0 = __builtin_amdgcn_s_memrealtime();
#endif
    for (int t = bx; t < SCANB_WGS; t += F.G) { scanB_task<SCAN_NG - 1>(F, t & 7, t >> 3, (const bf16*)(F.ws + WS_MG), (float*)(F.ws + WS_SG)); __syncthreads(); }
#if defined(PROBE_SB)
    if (bx == 0 && F.tid == 0) ((volatile LAS unsigned long long*)(F.lds + LDSCTL_OFF + 768))[PROBE_SB] = __builtin_amdgcn_s_memrealtime() - tsb0;
#endif
}
template <bool DRY, int SKIP = 0> __device__ __forceinline__ void scanC_phase(Frame& F) {
    const int bx = blockIdx.x;
    for (int t = bx; t < SCAN_NG * 16; t += F.G) { const int gq = t >> 4, h = t & 7, hf = (t >> 3) & 1;
        const float* s0 = gq == 0 ? (const float*)(F.ws + WS_CTL + 512 * 1024) : (const float*)(F.ws + WS_SG) + (size_t)((gq - 1) * 8 + h) * 16384;
        scan_task<DRY, SKIP>(F, gq * SCAN_GC, SCAN_GC, h, hf, s0, F.out + OFF_PS + (size_t)h * 16384, gq == SCAN_NG - 1); }
}
struct NgRegs { unsigned short o[16]; v4u z0, z1; };
__device__ __forceinline__ void ng_load(Frame& F, int it, int c, int eg, NgRegs& r) {
    const int cn = it >> 3, h = it & 7;
    const bf16* op = ((bf16*)(F.ws + WS_U3)) + ((size_t)(cn * 8 + h) * 128 + 16 * eg) * 64 + c;
#pragma unroll
    for (int i = 0; i < 16; ++i) r.o[i] = op[i * 64];
    const size_t ro = (size_t)(cn * 64 + c) * D + h * 128 + 16 * eg;
    r.z0 = *(const v4u*)(((bf16*)(F.ws + WS_U2)) + ro); r.z1 = *(const v4u*)(((bf16*)(F.ws + WS_U2)) + ro + 8);
}
__device__ __forceinline__ void normgate_phase(Frame& F) {
    const int tid = F.tid, c = tid & 63, eg = F.wave; LAS float* red = (LAS float*)F.lds;
    int it = F.vcu; if (it >= NCH * 8) return;
    NgRegs cur, nxt; ng_load(F, it, c, eg, cur); int par = 0;
    const float* nw = (F.in[16]) + 16 * eg;
#pragma unroll 1
    for (; it < NCH * 8; it += F.G) {
        const bool has_next = it + F.G < NCH * 8;
        if (has_next) ng_load(F, it + F.G, c, eg, nxt);
        float o[16]; float ss = 0.f;
#pragma unroll
        for (int i = 0; i < 16; ++i) { o[i] = bf2f(cur.o[i]); ss += o[i] * o[i]; }
        LAS float* rd = red + par * 512; rd[eg * 64 + c] = ss;
        __syncthreads();
        float tot = 0.f;
#pragma unroll
        for (int w = 0; w < 8; ++w) tot += rd[w * 64 + c];
        const float ri = __builtin_amdgcn_rsqf(tot * (1.f / 128.f) + EPS);
        const unsigned zz[8] = {cur.z0.x, cur.z0.y, cur.z0.z, cur.z0.w, cur.z1.x, cur.z1.y, cur.z1.z, cur.z1.w}; unsigned w[8];
#pragma unroll
        for (int i = 0; i < 8; ++i) w[i] = pk2(o[2 * i] * ri * nw[2 * i] * siluf(bflo(zz[i])), o[2 * i + 1] * ri * nw[2 * i + 1] * siluf(bfhi(zz[i])));
        const int cn = it >> 3, h = it & 7;
        bf16* dst = ((bf16*)(F.ws + WS_U1)) + (size_t)(cn * 64 + c) * D + h * 128 + 16 * eg;
        *(v4u*)dst = (v4u){w[0], w[1], w[2], w[3]}; *(v4u*)(dst + 8) = (v4u){w[4], w[5], w[6], w[7]};
        cur = nxt; par ^= 1;
    }
}
#ifndef PREP_STAGGER
#define PREP_STAGGER 3
#endif
#ifndef PREP_DROP
#define PREP_DROP 2
#endif
__device__ __forceinline__ int prep_unit_id(const Frame& F, int i) {
    if (F.G != 256) { const long it = (long)F.vcu + (long)i * F.G; return it < NCH * 8 ? (int)it : -1; }
    const int v = F.vcu;
    if (v < 64) return i < 9 - PREP_DROP ? v + 256 * i : -1;
    if (i < 9) return v + 256 * i;
    const int e = (v - 64) >> 3;
    return (i == 9 && e < 8 * PREP_DROP) ? 8 * (e & 7) + (v & 7) + 256 * (9 - PREP_DROP + (e >> 3)) : -1;
}
#ifndef CONV1_H2
#define CONV1_H2 0
#endif
#ifndef PROBE_AMP
#define PROBE_AMP 1
#endif
#ifndef ADA_NA
#define ADA_NA 5
#endif
enum Phase { PH_P0 = 0, PH_H1, PH_G1, PH_G2, PH_H2, PH_F1, PH_PREP, PH_SCAN, PH_SCANB, PH_SCANC, PH_F2, PH_NG, PH_G4A, PH_G4B, PH_G5, PH_H3, PH_G6, PH_G7, PH_FIN, PH_COUNT };
struct Args { const float* in[28]; float* out; unsigned char* ws; int ph_lo, ph_hi; };
static_assert(sizeof(Args) == 28 * 8 + 8 + 8 + 8, "Args has no padding");

#ifdef ONLY_PH
#define PHON(x) ((x) == ONLY_PH)
#else
#define PHON(x) true
#endif
template <class Epi> __device__ __forceinline__ void run_gemm(Frame& F, const bf16* A, const bf16* Bt, int N, int K, const Epi& E, int lda = 0) {
    pg8::Gemm g{A, Bt, M, N, K, lda}; pg8::StaticOrder S; S.init(M, N, F.G, (int)blockIdx.x); S.ntf = K / 64;
    pg8::gemm_phase<Epi, pg8::StaticOrder, PG8_ALIGN, PG8_SP2>(F.lds, g, S, E);
}

struct SplitOrder : pg8::StaticOrder {
    bool split; int probe2 = 0; bool only_first = false;
    __device__ __forceinline__ bool next(int i, pg8::Unit& u) const {
        if (!split) return pg8::StaticOrder::next(i, u);
        if (only_first && i > 0) return false;
        if (probe2) { if (i > 0) return false; i = 1; }
        if (i > 1) return false;
        const int x = c & 7, j = c >> 3;
        if (i == 0) { u.pm = 8 * x + (j & 7); u.pn = j >> 3; u.k0 = 0; u.nt = ntf; u.piece = 0; u.lidx = 0; return true; }
        const int P = 8, pc = x, pairs = ntf / 2, base = pairs / P, extra = pairs - base * P;
        u.pm = 64 + (j & 7); u.pn = j >> 3; u.lidx = (j & 7) * 4 + (j >> 3);
        u.k0 = 2 * (pc * base + (pc < extra ? pc : extra)); u.nt = 2 * (base + (pc < extra ? 1 : 0)); u.piece = pc + 1; if (probe2 == 2) u.nt = 2; return true;
    }
};
struct PiecesAB : pg8::StaticOrder {
    __device__ __forceinline__ bool next(int i, pg8::Unit& u) const {
        if (i > 0) return false;
        const int x = c & 7, j = c >> 3;
        u.pm = 64 + (j & 7); u.pn = j >> 3; u.lidx = (j & 7) * 4 + (j >> 3); u.k0 = 4 * (x & 3); u.nt = 4; u.piece = x + 1; return true;
    }
};
__device__ __forceinline__ void branch_fixup_rows(Frame& F, const bf16* part) {
    const int gw = F.vcu * NWAVES + F.wave, NGW = F.G * NWAVES;
    for (int m = MP + gw; m < M; m += NGW) {
        GAS u32x2* ga = (GAS u32x2*)(((bf16*)(F.ws + WS_U5)) + (size_t)m * D) + F.lane; const GAS u32x2* gb = (const GAS u32x2*)(((bf16*)(F.ws + WS_U6)) + (size_t)m * D) + F.lane;
#pragma unroll
        for (int j = 0; j < 4; ++j) { const int li = ((m >> 8) - 64) * 4 + j;
            const GAS u32x2* pp = (const GAS u32x2*)(part + (size_t)li * 8 * 65536 + (size_t)(m & 255) * 256) + F.lane; f32x4 sa = (f32x4){0.f, 0.f, 0.f, 0.f}, sb = sa;
#pragma unroll
            for (int p = 0; p < 4; ++p) { const u32x2 w = pp[(size_t)p * 16384]; sa += (f32x4){bflo(w.x), bfhi(w.x), bflo(w.y), bfhi(w.y)}; }
#pragma unroll
            for (int p = 4; p < 8; ++p) { const u32x2 w = pp[(size_t)p * 16384]; sb += (f32x4){bflo(w.x), bfhi(w.x), bflo(w.y), bfhi(w.y)}; }
            const u32x2 a = ga[64 * j], b = gb[64 * j];
            const f32x4 o = (f32x4){sigm(bflo(a.x)) * sa.x + sigm(bflo(b.x)) * sb.x, sigm(bfhi(a.x)) * sa.y + sigm(bfhi(b.x)) * sb.y, sigm(bflo(a.y)) * sa.z + sigm(bflo(b.y)) * sb.z, sigm(bfhi(a.y)) * sa.w + sigm(bfhi(b.y)) * sb.w};
            ga[64 * j] = (u32x2){pk2(o.x, o.y), pk2(o.z, o.w)}; }
    }
}
template <class Epi> __device__ __forceinline__ void run_gemm_split(Frame& F, const bf16* A, const bf16* Bt, int N, int K, const Epi& E, int probe = 0) {
    pg8::Gemm g{A, Bt, M, N, K, 0}; SplitOrder S; S.init(M, N, F.G, (int)blockIdx.x); S.ntf = K / 64; S.split = (F.G == 256); S.only_first = (probe == 2); S.probe2 = probe >= 3 ? probe - 2 : 0;
    pg8::gemm_phase<Epi, SplitOrder, PG8_ALIGN, PG8_SP2>(F.lds, g, S, E);
}
__global__ void __launch_bounds__(NWAVES * 64, 2) mega_fwd(Args args) {
    extern __shared__ __attribute__((aligned(16))) unsigned char lds[];
    Frame F;
    F.lds = (LAS unsigned char*)lds; F.MISC = (volatile LAS unsigned*)(F.lds + MISC_OFF);
    F.tid = threadIdx.x; F.lane = F.tid & 63; F.wave = __builtin_amdgcn_readfirstlane(F.tid >> 6);
    F.G = gridDim.x; { const int bx = blockIdx.x; F.vcu = (F.G % 8 == 0) ? (bx % 8) * (F.G / 8) + bx / 8 : bx; }
    unsigned char* ws = args.ws; F.ctl = (gu32*)(ws + WS_CTL);
    F.in = args.in; F.out = args.out; F.ws = ws;
    for (int u = F.tid; u < (LDS_BYTES - LDSCTL_OFF) / 4; u += NWAVES * 64) ((LAS unsigned*)(F.lds + LDSCTL_OFF))[u] = 0u;
    __syncthreads();
    XcdBarrier bar; bar.bar = (unsigned*)(F.ctl + CW_BAR); bar.x = 0; bar.st = nullptr;
    const bool multi = args.ph_hi - args.ph_lo > 1;
    if (multi) bar = xcd_barrier_post((unsigned*)(F.ctl + CW_BAR), F.MISC + 8);

    const int lo = args.ph_lo, hi = args.ph_hi;
#if defined(PROBE_TS)
    if (blockIdx.x == 0 && F.tid == 0) ((volatile LAS unsigned long long*)(F.lds + LDSCTL_OFF + 512))[0] = __builtin_amdgcn_s_memrealtime();
#endif
#define IN(k) (PHON(k) && lo <= (k) && (k) < hi)
#define SEAM(k) do { if (lo <= (k) && (k) + 1 < hi) xcd_barrier(bar); } while (0)
#if defined(PROBE_TS)
#undef SEAM
#define SEAM(k) do { if (lo <= (k) && (k) + 1 < hi) xcd_barrier(bar); if (blockIdx.x == 0 && F.tid == 0) ((volatile LAS unsigned long long*)(F.lds + LDSCTL_OFF + 512))[(k) + 1] = __builtin_amdgcn_s_memrealtime(); } while (0)
#endif
#if defined(PROBE_P0)
    if (IN(PH_P0)) { { { const bool sp = F.G >= 160; const int nB = sp ? (4224 - 144 * ADA_NA + F.G - 145) / (F.G - 144) : (4224 + F.G - 1) / F.G; const int tlo = !sp ? F.vcu * nB : F.vcu < 144 ? F.vcu * ADA_NA : 144 * ADA_NA + (F.vcu - 144) * nB; const int thi = tlo + ((sp && F.vcu < 144) ? ADA_NA : nB);
        for (int it = F.vcu; it < 144; it += F.G) ada_item(F, it); convert_ffn_range(F, (F.in[9]), (F.in[10]), ((bf16*)(F.ws + WS_W)) + W_FIN, ((bf16*)(F.ws + WS_W)) + W_FOUT, tlo, thi); } }  xcd_barrier(bar); }
#endif
    if (IN(PH_P0)) { { { const bool sp = F.G >= 160; const int nB = sp ? (4224 - 144 * ADA_NA + F.G - 145) / (F.G - 144) : (4224 + F.G - 1) / F.G; const int tlo = !sp ? F.vcu * nB : F.vcu < 144 ? F.vcu * ADA_NA : 144 * ADA_NA + (F.vcu - 144) * nB; const int thi = tlo + ((sp && F.vcu < 144) ? ADA_NA : nB);
        for (int it = F.vcu; it < 144; it += F.G) ada_item(F, it); convert_ffn_range(F, (F.in[9]), (F.in[10]), ((bf16*)(F.ws + WS_W)) + W_FIN, ((bf16*)(F.ws + WS_W)) + W_FOUT, tlo, thi); } } }
    SEAM(PH_P0);
#if defined(PROBE_H1)
#if defined(PROBE_BAR)
    if (IN(PH_H1)) { for (int i_ = 0; i_ < 10; ++i_) xcd_barrier(bar); }
#endif
    if (IN(PH_H1)) { rmsmod_rows<false>(F, true, (F.in[8]), 0, ((bf16*)(F.ws + WS_U1)));  xcd_barrier(bar); }
#endif
    if (IN(PH_H1)) { rmsmod_rows<false>(F, true, (F.in[8]), 0, ((bf16*)(F.ws + WS_U1))); }
    SEAM(PH_H1);
#if defined(PROBE_G1)
    if (IN(PH_G1)) { run_gemm(F, ((bf16*)(F.ws + WS_U1)), ((bf16*)(F.ws + WS_W)) + W_FIN, 2 * DFF, D, EpiSwiglu{((bf16*)(F.ws + WS_U2))});  xcd_barrier(bar); }
#endif
    if (IN(PH_G1)) { run_gemm(F, ((bf16*)(F.ws + WS_U1)), ((bf16*)(F.ws + WS_W)) + W_FIN, 2 * DFF, D, EpiSwiglu{((bf16*)(F.ws + WS_U2))}); }
    SEAM(PH_G1);
#if defined(PROBE_G2)
    if (IN(PH_G2)) { run_gemm_split(F, ((bf16*)(F.ws + WS_U2)), ((bf16*)(F.ws + WS_W)) + W_FOUT, D, DFF, EpiResid<true>{(F.in[0]), (F.in[1]), (bf16*)F.out, ((float*)(F.ws + WS_ADA)), 2, 0.5f, (bf16*)(F.ws + WS_U5)}, PROBE_G2);  xcd_barrier(bar); }
#endif
    if (IN(PH_G2)) { run_gemm_split(F, ((bf16*)(F.ws + WS_U2)), ((bf16*)(F.ws + WS_W)) + W_FOUT, D, DFF, EpiResid<true>{(F.in[0]), (F.in[1]), (bf16*)F.out, ((float*)(F.ws + WS_ADA)), 2, 0.5f, (bf16*)(F.ws + WS_U5)}); }
    SEAM(PH_G2);
#if defined(PROBE_H2)
    if (IN(PH_H2)) { { if (PROBE_H2 & 1) convert_mixer(F, 0, F.vcu * NWAVES + F.wave, F.G * NWAVES); __syncthreads(); if (PROBE_H2 & 2) rmsmod_rows<true>(F, false, (F.in[11]), 1, (bf16*)F.out + 1024, Leftover{F.G == 256 ? (const bf16*)(F.ws + WS_U5) : nullptr, true, 2, 0.5f}, 2048); if (PROBE_H2 & 4) rmsmod_rows<false>(F, false, (F.in[11]), 1, (bf16*)F.out + 1024, Leftover{F.G == 256 ? (const bf16*)(F.ws + WS_U5) : nullptr, true, 2, 0.5f}, 2048); }  xcd_barrier(bar); }
#endif
    if (IN(PH_H2)) { { convert_mixer(F, 0, F.vcu * NWAVES + F.wave, F.G * NWAVES); if (F.G != 256 || CONV1_H2) convert_mixer(F, 1, F.vcu * NWAVES + F.wave, F.G * NWAVES); __syncthreads(); rmsmod_rows<true>(F, false, (F.in[11]), 1, (bf16*)F.out + 1024, Leftover{F.G == 256 ? (const bf16*)(F.ws + WS_U5) : nullptr, true, 2, 0.5f}, 2048); } }
    SEAM(PH_H2);
#if defined(PROBE_F1)
    if (IN(PH_F1)) { run_gemm(F, (bf16*)F.out + 1024, ((bf16*)(F.ws + WS_W)) + W_IN, 4352, D, EpiF1{((bf16*)(F.ws + WS_U1)), ((bf16*)(F.ws + WS_U2)), ((bf16*)(F.ws + WS_U3)), ((bf16*)(F.ws + WS_U4)), ((bf16*)(F.ws + WS_KV)), ((bf16*)(F.ws + WS_TAIL)), F.out}, 2048);  xcd_barrier(bar); }
#endif
    if (IN(PH_F1)) { run_gemm(F, (bf16*)F.out + 1024, ((bf16*)(F.ws + WS_W)) + W_IN, 4352, D, EpiF1{((bf16*)(F.ws + WS_U1)), ((bf16*)(F.ws + WS_U2)), ((bf16*)(F.ws + WS_U3)), ((bf16*)(F.ws + WS_U4)), ((bf16*)(F.ws + WS_KV)), ((bf16*)(F.ws + WS_TAIL)), F.out}, 2048); }
    SEAM(PH_F1);
#if defined(PROBE_PREP)
    if (IN(PH_PREP)) { PrepRegs PR; int it = F.vcu; if (it < NCH * 8) prep_fetch(F, it, F.tid & 15, F.tid >> 4, PR); for (int par = 0; it < NCH * 8; it += F.G, par ^= 1) gdn_prep_unit<true, PROBE_PREP>(F, it >> 3, it & 7, PR, it + F.G < NCH * 8 ? it + F.G : -1, par); xcd_barrier(bar); }
#endif
#if defined(PROBE_SWA)
    if (IN(PH_PREP)) { for (int it = F.vcu; it < NCH * 2; it += F.G) swa_unit<true>(F, it >> 1, it & 1); xcd_barrier(bar); }
#endif
    if (IN(PH_PREP)) {
                        const int nsw0 = (F.G == 256) ? ((F.vcu >> 3) % PREP_STAGGER) : 0;
#ifndef NO_SWA
                        for (int k = 0; k < nsw0; ++k) { const int it = F.vcu + k * F.G; if (it < NCH * 2) swa_unit<false>(F, it >> 1, it & 1); }
#endif
#ifndef NO_PREP
                        for (int k = F.wave; prep_unit_id(F, k) >= 0; k += NWAVES) prep_gates(F, prep_unit_id(F, k), F.lane);
                        for (int i = F.tid; i < 12 * 128; i += NWAVES * 64) { const int tj = i >> 7, cc = i & 127; ((LAS float*)(F.lds + PR_CW))[i] = (F.in[13])[(tj & 3) * 3072 + (tj >> 2) * 1024 + (F.vcu & 7) * 128 + cc]; }
                        asm volatile("s_waitcnt vmcnt(0)" ::: "memory"); __syncthreads();
#if defined(PROBE_PS)
                        if (blockIdx.x == 0 && F.tid == 0) ((volatile LAS unsigned long long*)(F.lds + LDSCTL_OFF + 768))[15] = __builtin_amdgcn_s_memrealtime();
#endif
                        { PrepRegs PR; int it = prep_unit_id(F, 0); if (it >= 0) prep_fetch(F, it, F.tid & 15, F.tid >> 4, PR);
                          for (int i = 0; it >= 0; ++i) { const int itn = prep_unit_id(F, i + 1); gdn_prep_unit<false>(F, it >> 3, it & 7, PR, itn, i & 1); it = itn; } }
#endif
#ifndef NO_SWA
                        for (int it = F.vcu + nsw0 * F.G; it < NCH * 2; it += F.G) swa_unit<false>(F, it >> 1, it & 1);
#endif
                      }
    SEAM(PH_PREP);
#if defined(PROBE_SCANA)
    if (IN(PH_SCAN)) { scanA_phase(F); xcd_barrier(bar); }
#endif
    if (IN(PH_SCAN)) { scanA_phase(F); }
    SEAM(PH_SCAN);
    if (IN(PH_SCANB)) { scanB_phase(F); if (F.G == 256 && !CONV1_H2 && blockIdx.x >= SCANB_WGS) convert_mixer(F, 1, ((int)blockIdx.x - SCANB_WGS) * NWAVES + F.wave, (256 - SCANB_WGS) * NWAVES); }
    SEAM(PH_SCANB);
#if defined(PROBE_SCANC)
    if (IN(PH_SCANC)) { scanC_phase<true, PROBE_SCANC>(F); xcd_barrier(bar); }
#endif
    if (IN(PH_SCANC)) { scanC_phase<false>(F); }
    SEAM(PH_SCANC);
#if defined(PROBE_F2)
    if (IN(PH_F2)) { run_gemm(F, (bf16*)F.out + 1024, ((bf16*)(F.ws + WS_W)) + W_IN + (size_t)4352 * D, 3072, D, EpiF2{((bf16*)(F.ws + WS_U2)), ((bf16*)(F.ws + WS_U5)), ((bf16*)(F.ws + WS_U6))}, 2048);  xcd_barrier(bar); }
#endif
    if (IN(PH_F2)) { run_gemm(F, (bf16*)F.out + 1024, ((bf16*)(F.ws + WS_W)) + W_IN + (size_t)4352 * D, 3072, D, EpiF2{((bf16*)(F.ws + WS_U2)), ((bf16*)(F.ws + WS_U5)), ((bf16*)(F.ws + WS_U6))}, 2048);  if (F.G == 256 && blockIdx.x >= 96) { __syncthreads(); convert_ffn(F, (F.in[23]), (F.in[24]), (bf16*)(F.ws + WS_MG), nullptr, ((int)blockIdx.x - 96) * NWAVES + F.wave, 160 * NWAVES); } }
    SEAM(PH_F2);
#if defined(PROBE_NG)
    if (IN(PH_NG)) { normgate_phase(F);  xcd_barrier(bar); }
#endif
    if (IN(PH_NG)) { normgate_phase(F); }
    SEAM(PH_NG);
    if (IN(PH_G4A)) { if (F.G == 256) run_gemm_split(F, ((bf16*)(F.ws + WS_U1)), ((bf16*)(F.ws + WS_W)) + W_A, D, D, EpiGate<0>{((bf16*)(F.ws + WS_U5)), nullptr}, 2);
                      else run_gemm(F, ((bf16*)(F.ws + WS_U1)), ((bf16*)(F.ws + WS_W)) + W_A, D, D, EpiGate<0>{((bf16*)(F.ws + WS_U5)), nullptr}); }
    SEAM(PH_G4A);
    if (IN(PH_G4B)) { if (F.G == 256) { run_gemm_split(F, ((bf16*)(F.ws + WS_U4)), ((bf16*)(F.ws + WS_W)) + W_B, D, D, EpiGate<1>{((bf16*)(F.ws + WS_U5)), ((bf16*)(F.ws + WS_U6))}, 2);
                          const bool sb_ = ((blockIdx.x & 7) >> 2) != 0;
                          pg8::Gemm g{sb_ ? ((const bf16*)(F.ws + WS_U4)) : ((const bf16*)(F.ws + WS_U1)), ((const bf16*)(F.ws + WS_W)) + (sb_ ? W_B : W_A), M, D, D, 0}; PiecesAB S; S.init(M, D, F.G, (int)blockIdx.x); S.ntf = 16;
                          pg8::gemm_phase<EpiPart, PiecesAB, PG8_ALIGN, PG8_SP2>(F.lds, g, S, EpiPart{(bf16*)(F.ws + WS_U2)}); }
                      else run_gemm(F, ((bf16*)(F.ws + WS_U4)), ((bf16*)(F.ws + WS_W)) + W_B, D, D, EpiGate<1>{((bf16*)(F.ws + WS_U5)), ((bf16*)(F.ws + WS_U6))}); }
    SEAM(PH_G4B);
    if (IN(PH_G5) && F.G == 256) { branch_fixup_rows(F, (const bf16*)(F.ws + WS_U2)); xcd_barrier(bar); }
    if (IN(PH_G5)) { run_gemm_split(F, ((bf16*)(F.ws + WS_U5)), ((bf16*)(F.ws + WS_W)) + W_O, D, D, EpiResid<false>{nullptr, nullptr, (bf16*)F.out, ((float*)(F.ws + WS_ADA)), 5, 1.0f, (bf16*)(F.ws + WS_U2)}); }
    SEAM(PH_G5);
#if defined(PROBE_H3)
    if (IN(PH_H3)) { { convert_ffn(F, (F.in[23]), (F.in[24]), F.G == 256 ? nullptr : (bf16*)(F.ws + WS_MG), ((bf16*)(F.ws + WS_W)) + W_FOUT, F.vcu * NWAVES + F.wave, F.G * NWAVES); rmsmod_rows<false>(F, false, (F.in[22]), 2, ((bf16*)(F.ws + WS_U1)), Leftover{F.G == 256 ? (const bf16*)(F.ws + WS_U2) : nullptr, false, 5, 1.0f}); }  xcd_barrier(bar); }
#endif
    if (IN(PH_H3)) { { convert_ffn(F, (F.in[23]), (F.in[24]), F.G == 256 ? nullptr : (bf16*)(F.ws + WS_MG), ((bf16*)(F.ws + WS_W)) + W_FOUT, F.vcu * NWAVES + F.wave, F.G * NWAVES); rmsmod_rows<false>(F, false, (F.in[22]), 2, ((bf16*)(F.ws + WS_U1)), Leftover{F.G == 256 ? (const bf16*)(F.ws + WS_U2) : nullptr, false, 5, 1.0f}); } }
    SEAM(PH_H3);
#if defined(PROBE_G6)
    if (IN(PH_G6)) { run_gemm(F, ((bf16*)(F.ws + WS_U1)), ((bf16*)(F.ws + WS_W)) + W_FIN, 2 * DFF, D, EpiSwiglu{((bf16*)(F.ws + WS_U2))});  xcd_barrier(bar); }
#endif
    if (IN(PH_G6)) { run_gemm(F, ((bf16*)(F.ws + WS_U1)), (const bf16*)(F.ws + WS_MG), 2 * DFF, D, EpiSwiglu{((bf16*)(F.ws + WS_U2))}); }
    SEAM(PH_G6);
    if (IN(PH_G7)) { run_gemm_split(F, ((bf16*)(F.ws + WS_U2)), ((bf16*)(F.ws + WS_W)) + W_FOUT, D, DFF, EpiResid<false>{nullptr, nullptr, (bf16*)F.out, ((float*)(F.ws + WS_ADA)), 8, 0.5f, (bf16*)(F.ws + WS_U5)}); }
    SEAM(PH_G7);
    if (IN(PH_FIN)) { final_norm_rows(F, Leftover{F.G == 256 ? (const bf16*)(F.ws + WS_U5) : nullptr, false, 8, 0.5f}); }
    SEAM(PH_FIN);
#if defined(PROBE_TS)
    if (blockIdx.x == 0 && F.tid == 0) { volatile LAS unsigned long long* ts = (volatile LAS unsigned long long*)(F.lds + LDSCTL_OFF + 512); unsigned long long tot = 0;
        for (int k = 0; k < PH_COUNT; ++k) if ((PROBE_TS >> k) & 1) tot += ts[k + 1] - ts[k];
#if defined(PROBE_PS)
        tot += ((volatile LAS unsigned long long*)(F.lds + LDSCTL_OFF + 768))[PROBE_PS];
#endif
        tot *= PROBE_AMP;
        const unsigned long long t0 = __builtin_amdgcn_s_memrealtime(); while (__builtin_amdgcn_s_memrealtime() - t0 < tot) __builtin_amdgcn_s_sleep(8); }
#endif
#undef IN
#undef SEAM
}

extern "C" void kernel_launch(void* const* d_in, const int* in_sizes, int n_in, void* d_out, int out_size, void* d_ws, size_t ws_size, hipStream_t stream) {
    static int grid = 0;
    if (grid == 0) {
        if (n_in != 28 || in_sizes[0] != MP * D || (size_t)out_size != OUT_TOTAL || ws_size < WS_END) { fprintf(stderr, "kernel_launch: unexpected shapes (n_in %d, in0 %d, out %d, ws %zu); nothing launched\n", n_in, n_in > 0 ? in_sizes[0] : -1, out_size, ws_size); grid = -1; return; }
        int dev = 0, cus = 0, per_cu = 0;
        if (hipGetDevice(&dev) != hipSuccess || hipDeviceGetAttribute(&cus, hipDeviceAttributeMultiprocessorCount, dev) != hipSuccess) { grid = -1; return; }
        if (hipFuncSetAttribute((const void*)mega_fwd, hipFuncAttributeMaxDynamicSharedMemorySize, LDS_BYTES) != hipSuccess) { fprintf(stderr, "kernel_launch: hipFuncSetAttribute failed\n"); grid = -1; return; }
        if (hipOccupancyMaxActiveBlocksPerMultiprocessor(&per_cu, (const void*)mega_fwd, NWAVES * 64, LDS_BYTES) != hipSuccess || per_cu < 1) fprintf(stderr, "kernel_launch: occupancy query reports %d\n", per_cu);
        (void)hipGetLastError();
        grid = cus;
    }
    if (grid < 0) return;
    if (hipMemsetAsync((char*)d_ws + WS_CTL, 0, CTL_ZERO_BYTES, stream) != hipSuccess) return;
    Args a{};
    for (int i = 0; i < 28; ++i) a.in[i] = (const float*)d_in[i];
    a.out = (float*)d_out; a.ws = (unsigned char*)d_ws;
#if MK_PER_PHASE
    for (int ph = 0; ph < PH_COUNT; ++ph) { a.ph_lo = ph; a.ph_hi = ph + 1; hipLaunchKernelGGL(mega_fwd, dim3(grid), dim3(NWAVES * 64), LDS_BYTES, stream, a); }
#else
    a.ph_lo = 0; a.ph_hi = PH_COUNT; hipLaunchKernelGGL(mega_fwd, dim3(grid), dim3(NWAVES * 64), LDS_BYTES, stream, a);
#endif
    const hipError_t le = hipPeekAtLastError();
    if (le != hipSuccess) fprintf(stderr, "kernel_launch: launch failed: %s\n", hipGetErrorName(le));
}
```

```cpp
#include <hip/hip_runtime.h>
#include <cstdio>
#include <cstdint>
namespace pg8 {
#define PG8_LAS __attribute__((address_space(3)))
typedef unsigned short bf16_t;
typedef short bf16x8 __attribute__((ext_vector_type(8)));
typedef float f32x4 __attribute__((ext_vector_type(4)));
typedef unsigned u32x4 __attribute__((ext_vector_type(4)));
constexpr int BM = 256, BK = 64, HALF = 128, HTB = HALF * BK * 2  , STAGE_BYTES = 8 * HTB, NXCD = 8, WGM = 8;

__host__ __device__ __forceinline__ int lds_byte(int r, int c) { const int st = (r >> 4) * 2 + (c >> 5), rr = r & 15, cc = c & 31, ob = rr * 64 + cc * 2; return st * 1024 + (ob ^ (((ob >> 9) & 1) << 5)); }
__host__ __device__ __forceinline__ void stage_rc(int b, int& R, int& C) { const int st = b / 1024, sb = b % 1024, swz = sb ^ (((sb >> 9) & 1) << 5); R = (st >> 1) * 16 + swz / 64; C = (st & 1) * 32 + (swz % 64) / 2; }
__host__ __device__ __forceinline__ int perm32(int rho) { const int n = rho >> 4, i = rho & 15; return 8 * (i >> 2) + 4 * n + (i & 3); }

struct Unit { int pm, pn, k0, nt, piece, lidx; };
struct Gemm { const bf16_t* A; const bf16_t* Bt; int M, N, K; int lda; };

struct StaticOrder {
    int nM, nN, nwg, G, c, ntf;
    __host__ __device__ void init(int M, int N, int G_, int c_) { nM = M / BM; nN = N / BM; nwg = nM * nN; G = G_; c = c_; }
    __host__ __device__ bool next(int i, Unit& u) const {
        const long L = (long)i * G + c; if (L >= nwg) return false;
        int wgid = (int)L; { const int q = nwg / NXCD, r = nwg % NXCD, xcd = wgid % NXCD, off = wgid / NXCD; wgid = (xcd < r ? xcd * (q + 1) : r * (q + 1) + (xcd - r) * q) + off; }
        const int nig = WGM * nN, gid = wgid / nig, fm = gid * WGM, gsz = (nM - fm) < WGM ? (nM - fm) : WGM;
        u.pm = fm + ((wgid % nig) % gsz); u.pn = (wgid % nig) / gsz; u.k0 = 0; u.nt = ntf; u.piece = 0; u.lidx = 0; return true;
    }
    __device__ __forceinline__ void a_ready(const Unit&) const {}
    __device__ __forceinline__ void done(const Unit&) const {}
};

__device__ __forceinline__ unsigned cvt_pk_bf16(float lo, float hi) { unsigned r; asm volatile("v_cvt_pk_bf16_f32 %0, %1, %2" : "=v"(r) : "v"(lo), "v"(hi)); return r; }

template <class Epi, class Sched, bool ALIGN_EPI = false, bool SP2 = false>
__device__ __forceinline__ void gemm_phase(PG8_LAS unsigned char* lds, const Gemm g, const Sched& S, const Epi& E) {
    const int tid = threadIdx.x, wid = __builtin_amdgcn_readfirstlane(tid >> 6), lane = tid & 63, wr = wid >> 2, wc = wid & 3, fr = lane & 15, fq = lane >> 4;
    const int K = g.K, lda = g.lda ? g.lda : g.K;
    unsigned voffA[2], voffB[2];
#pragma unroll
    for (int i = 0; i < 2; ++i) { int R, C; stage_rc(tid * 16 + i * 8192, R, C); const int Rb = Epi::PERM ? ((R & ~31) + perm32(R & 31)) : R;
        voffA[i] = (unsigned)(R * lda + C) * 2u; voffB[i] = (unsigned)(Rb * K + C) * 2u; }
    const size_t kstep = (size_t)(BK * 2);
    const size_t hstep = (size_t)HALF * K * 2;
    const size_t tstep = 2 * hstep;
    const size_t hstepA = (size_t)HALF * lda * 2, tstepA = 2 * hstepA;
    const unsigned ldsw = (unsigned)wid * 1024u;
    const int aoff = lds_byte(wr * 64 + fr, fq * 8), boff = lds_byte(wc * 32 + fr, fq * 8);
#define PG8_SA(b, h) (((b) * 2 + (h)) * HTB)
#define PG8_SB(b, h) ((4 + (b) * 2 + (h)) * HTB)
#define PG8_STAGE(bufoff, gbase, voff) do { _Pragma("unroll") for (int _i = 0; _i < 2; ++_i) \
        __builtin_amdgcn_global_load_lds((const unsigned*)((const char*)(gbase) + (voff)[_i]), (PG8_LAS unsigned*)(lds + (bufoff) + ldsw + _i * 8192), 16, 0, 0); } while (0)
#define PG8_LDA(dst, b, h) do { _Pragma("unroll") for (int m = 0; m < 4; ++m) _Pragma("unroll") for (int k = 0; k < 2; ++k) dst[m][k] = *(const PG8_LAS bf16x8*)(lds + PG8_SA(b, h) + aoff + m * 2048 + k * 1024); } while (0)
#define PG8_LDB(dst, b, h) do { _Pragma("unroll") for (int n = 0; n < 2; ++n) _Pragma("unroll") for (int k = 0; k < 2; ++k) dst[n][k] = *(const PG8_LAS bf16x8*)(lds + PG8_SB(b, h) + boff + n * 2048 + k * 1024); } while (0)
#define PG8_MMA(ai, bj, At, Bt) do { __builtin_amdgcn_s_setprio(1); _Pragma("unroll") for (int m = 0; m < 4; ++m) _Pragma("unroll") for (int n = 0; n < 2; ++n) _Pragma("unroll") for (int k = 0; k < 2; ++k) \
        acc[ai][bj][m][n] = __builtin_amdgcn_mfma_f32_16x16x32_bf16(Bt[n][k], At[m][k], acc[ai][bj][m][n], 0, 0, 0); __builtin_amdgcn_s_setprio(0); } while (0)
#define PG8_WAIT_V(n) asm volatile("s_waitcnt vmcnt(" #n ")" ::: "memory")
#define PG8_WAIT_L(n) asm volatile("s_waitcnt lgkmcnt(" #n ")" ::: "memory")
#define PG8_BAR __builtin_amdgcn_s_barrier()
#define PG8_SCHED __builtin_amdgcn_sched_barrier(0)
    Unit cur, nxt; int ui = 0;
    if (!S.next(0, cur)) return;
    f32x4 acc[2][2][4][2];
#pragma unroll
    for (int a = 0; a < 2; ++a)
#pragma unroll
        for (int b = 0; b < 2; ++b)
#pragma unroll
            for (int m = 0; m < 4; ++m)
#pragma unroll
                for (int n = 0; n < 2; ++n) acc[a][b][m][n] = (f32x4){0.f, 0.f, 0.f, 0.f};
    bf16x8 At[4][2], B0[2][2], B1[2][2];
    const char* cA = (const char*)g.A + (size_t)cur.pm * tstepA + (size_t)cur.k0 * kstep; const char* cB = (const char*)g.Bt + (size_t)cur.pn * tstep + (size_t)cur.k0 * kstep;
    S.a_ready(cur);
    if constexpr (SP2) {
        PG8_STAGE(PG8_SB(0, 0), cB, voffB); PG8_STAGE(PG8_SB(0, 1), cB + hstep, voffB); PG8_STAGE(PG8_SA(0, 0), cA, voffA); PG8_STAGE(PG8_SA(0, 1), cA + hstepA, voffA);
        if (wr == 1) PG8_BAR;
        PG8_WAIT_V(2); PG8_BAR;
        PG8_STAGE(PG8_SB(1, 0), cB + kstep, voffB); PG8_STAGE(PG8_SA(1, 0), cA + kstep, voffA); PG8_STAGE(PG8_SB(1, 1), cB + hstep + kstep, voffB);
        PG8_WAIT_V(6); PG8_BAR;
    } else {
        PG8_STAGE(PG8_SB(0, 0), cB, voffB); PG8_STAGE(PG8_SA(0, 0), cA, voffA); PG8_STAGE(PG8_SB(0, 1), cB + hstep, voffB); PG8_STAGE(PG8_SA(0, 1), cA + hstepA, voffA);
        if (wr == 1) PG8_BAR;
        PG8_WAIT_V(4); PG8_BAR;
        PG8_STAGE(PG8_SB(1, 0), cB + kstep, voffB); PG8_STAGE(PG8_SA(1, 0), cA + kstep, voffA); PG8_STAGE(PG8_SB(1, 1), cB + hstep + kstep, voffB);
        PG8_WAIT_V(6); PG8_BAR;
    }
    for (;;) {
        const bool has_next = S.next(ui + 1, nxt);
        const char* nA = has_next ? (const char*)g.A + (size_t)nxt.pm * tstepA + (size_t)nxt.k0 * kstep : cA; const char* nB = has_next ? (const char*)g.Bt + (size_t)nxt.pn * tstep + (size_t)nxt.k0 * kstep : cB;
        const int cnt = cur.nt;
        for (int t = 0; t < cnt; t += 2) {
            const bool last = (t == cnt - 2);
            const char* a1 = cA + (size_t)(t + 1) * kstep;
            const char* a2 = last ? nA : cA + (size_t)(t + 2) * kstep; const char* b2 = last ? nB : cB + (size_t)(t + 2) * kstep;
            const char* a3 = a2 + kstep; const char* b3 = b2 + kstep;
            if (last && has_next) S.a_ready(nxt);
            if constexpr (SP2) {
            PG8_LDB(B0, 0, 0); PG8_LDB(B1, 0, 1); PG8_SCHED; PG8_LDA(At, 0, 0); PG8_STAGE(PG8_SA(1, 1), a1 + hstepA, voffA);
            PG8_WAIT_V(8); PG8_WAIT_L(0); PG8_BAR; PG8_MMA(0, 0, At, B0); PG8_MMA(0, 1, At, B1); PG8_BAR; PG8_SCHED;
            PG8_LDA(At, 0, 1); PG8_STAGE(PG8_SB(0, 0), b2, voffB); PG8_STAGE(PG8_SB(0, 1), b2 + hstep, voffB); PG8_STAGE(PG8_SA(0, 0), a2, voffA);
            PG8_WAIT_V(8); PG8_WAIT_L(0); PG8_BAR; PG8_MMA(1, 0, At, B0); PG8_MMA(1, 1, At, B1); PG8_BAR; PG8_SCHED;
            PG8_LDB(B0, 1, 0); PG8_LDB(B1, 1, 1); PG8_SCHED; PG8_LDA(At, 1, 0); PG8_STAGE(PG8_SA(0, 1), a2 + hstepA, voffA);
            PG8_WAIT_V(8); PG8_WAIT_L(0); PG8_BAR; PG8_MMA(0, 0, At, B0); PG8_MMA(0, 1, At, B1); PG8_BAR; PG8_SCHED;
            PG8_LDA(At, 1, 1); PG8_STAGE(PG8_SB(1, 0), b3, voffB); PG8_STAGE(PG8_SB(1, 1), b3 + hstep, voffB); PG8_STAGE(PG8_SA(1, 0), a3, voffA);
            PG8_WAIT_V(8); PG8_WAIT_L(0); PG8_BAR; PG8_MMA(1, 0, At, B0); PG8_MMA(1, 1, At, B1); PG8_BAR; PG8_SCHED;
            } else {
            PG8_LDB(B0, 0, 0); PG8_SCHED; PG8_LDA(At, 0, 0); PG8_STAGE(PG8_SA(1, 1), a1 + hstepA, voffA);
            PG8_WAIT_L(8); PG8_BAR; PG8_WAIT_L(0); PG8_MMA(0, 0, At, B0); PG8_BAR; PG8_SCHED;
            PG8_LDB(B1, 0, 1); PG8_STAGE(PG8_SB(0, 0), b2, voffB);
            PG8_BAR; PG8_WAIT_L(0); PG8_MMA(0, 1, At, B1); PG8_BAR;
            PG8_LDA(At, 0, 1); PG8_STAGE(PG8_SA(0, 0), a2, voffA);
            PG8_BAR; PG8_WAIT_L(0); PG8_MMA(1, 0, At, B0); PG8_BAR; PG8_SCHED;
            PG8_STAGE(PG8_SB(0, 1), b2 + hstep, voffB);
            PG8_WAIT_V(6); PG8_BAR; PG8_MMA(1, 1, At, B1); PG8_BAR;
            PG8_LDB(B0, 1, 0); PG8_SCHED; PG8_LDA(At, 1, 0); PG8_STAGE(PG8_SA(0, 1), a2 + hstepA, voffA);
            PG8_WAIT_L(8); PG8_BAR; PG8_WAIT_L(0); PG8_MMA(0, 0, At, B0); PG8_BAR; PG8_SCHED;
            PG8_LDB(B1, 1, 1); PG8_STAGE(PG8_SB(1, 0), b3, voffB);
            PG8_BAR; PG8_WAIT_L(0); PG8_MMA(0, 1, At, B1); PG8_BAR;
            PG8_LDA(At, 1, 1); PG8_STAGE(PG8_SA(1, 0), a3, voffA);
            PG8_BAR; PG8_WAIT_L(0); PG8_MMA(1, 0, At, B0); PG8_BAR; PG8_SCHED;
            PG8_STAGE(PG8_SB(1, 1), b3 + hstep, voffB);
            PG8_WAIT_V(6); PG8_BAR; PG8_MMA(1, 1, At, B1); PG8_BAR;
            }
        }
        if constexpr (ALIGN_EPI) { if (wr == 0) PG8_BAR; }
        if constexpr (!Epi::AFTER_DRAIN) { E(acc, cur, wr, wc, fr, fq); S.done(cur); }
        if (!has_next) break;
#pragma unroll
        for (int a = 0; a < 2; ++a)
#pragma unroll
            for (int b = 0; b < 2; ++b)
#pragma unroll
                for (int m = 0; m < 4; ++m)
#pragma unroll
                    for (int n = 0; n < 2; ++n) acc[a][b][m][n] = (f32x4){0.f, 0.f, 0.f, 0.f};
        cur = nxt; cA = nA; cB = nB; ++ui;
        if constexpr (ALIGN_EPI) { if (wr == 1) PG8_BAR; }
    }
    PG8_WAIT_V(0);
    if constexpr (!ALIGN_EPI) { if (wr == 0) PG8_BAR; }
    PG8_BAR;
    if constexpr (Epi::AFTER_DRAIN) { E.fused(acc, cur, wr, wc, fr, fq, lds, wid, lane); S.done(cur); }
#undef PG8_SA
#undef PG8_SB
#undef PG8_STAGE
#undef PG8_LDA
#undef PG8_LDB
#undef PG8_MMA
#undef PG8_WAIT_V
#undef PG8_WAIT_L
#undef PG8_BAR
#undef PG8_SCHED
}
}

#ifndef PG8_SP2
#define PG8_SP2 true
#endif
#define GAS __attribute__((address_space(1)))
#define LAS __attribute__((address_space(3)))
typedef unsigned short bf16;
typedef unsigned v4u __attribute__((ext_vector_type(4)));
typedef float f32x4 __attribute__((ext_vector_type(4)));
typedef short bf16x8 __attribute__((ext_vector_type(8)));
typedef GAS unsigned gu32;
typedef GAS unsigned long long gu64;
#define RLX_AGENT __ATOMIC_RELAXED, __HIP_MEMORY_SCOPE_AGENT
#define LDS_WAIT() asm volatile("s_waitcnt lgkmcnt(0)" ::: "memory")
#define VM_WAIT() asm volatile("s_waitcnt vmcnt(0)" ::: "memory")
__device__ __forceinline__ unsigned long long rt() { return __builtin_amdgcn_s_memrealtime(); }
typedef float pkf2_t __attribute__((ext_vector_type(2))); typedef __bf16 pkb2_t __attribute__((ext_vector_type(2)));
__device__ __forceinline__ unsigned pk2(float lo, float hi) { pkf2_t v = {lo, hi}; pkb2_t b = __builtin_convertvector(v, pkb2_t); return __builtin_bit_cast(unsigned, b); }
__device__ __forceinline__ unsigned f2bf(float f) { return pk2(f, 0.f) & 0xffffu; }

#define XB_TMO      128
#define XB_XCNT(j)  (256  + 64 * (j))
#define XB_XSUB(j)  (1280 + 64 * (j))
#define XB_XGEN(j)  (2304 + 64 * (j))
#define XB_TOP      3328
#define XB_TOPGEN   3392
#define XCD_BAR_WORDS 3456
#define XB_SPIN_CAP (1u << 18)

__device__ __forceinline__ unsigned xb_ld(unsigned* p)              { return __hip_atomic_load(p, __ATOMIC_RELAXED, __HIP_MEMORY_SCOPE_AGENT); }
__device__ __forceinline__ unsigned xb_add(unsigned* p, unsigned v) { return __hip_atomic_fetch_add(p, v, __ATOMIC_RELAXED, __HIP_MEMORY_SCOPE_AGENT); }
__device__ __forceinline__ unsigned xb_xcc_id() { return (unsigned)__builtin_amdgcn_s_getreg((3 << 11) | 20) & 0xFu; }
#define XB_SPIN(cond, bar) do { unsigned _sp = 0; while (cond) { __builtin_amdgcn_s_sleep(1); \
    if ((++_sp & 255u) == 0u) { if (xb_ld(&(bar)[XB_TMO])) break; if (_sp > XB_SPIN_CAP) { atomicAdd(&(bar)[XB_TMO], 1u); break; } } } } while (0)

struct XcdBarrier {
    unsigned* bar; unsigned x;
    volatile LAS unsigned* st;
};

__device__ __forceinline__ XcdBarrier xcd_barrier_post(unsigned* bar, volatile LAS unsigned* st) {
    XcdBarrier b; b.bar = bar; b.x = xb_xcc_id(); b.st = st;
    if (threadIdx.x == 0) (void)xb_add(&bar[XB_XCNT(b.x)], 1u);
    return b;
}
__device__ __forceinline__ void xcd_barrier_complete(unsigned* bar, unsigned x, unsigned& nloc, unsigned& nx) {
    const unsigned G = gridDim.x * gridDim.y * gridDim.z;
    unsigned sum, cnt, mine, sp = 0u;
    for (;;) {
        sum = 0u; cnt = 0u; mine = 0u;
#pragma unroll
        for (unsigned j = 0; j < 16; ++j) { const unsigned c = xb_ld(&bar[XB_XCNT(j)]); sum += c; cnt += (c > 0u) ? 1u : 0u; mine = (j == x) ? c : mine; }
        if (sum == G) break;
        __builtin_amdgcn_s_sleep(1);
        if ((++sp & 255u) == 0u) { if (xb_ld(&bar[XB_TMO])) break; if (sp > XB_SPIN_CAP) { atomicAdd(&bar[XB_TMO], 1u); break; } }
    }
    nloc = mine > 0u ? mine : 1u; nx = cnt > 0u ? cnt : 1u;
}

__device__ __forceinline__ void xcd_barrier(const XcdBarrier& b) {
    asm volatile("s_waitcnt vmcnt(0)" ::: "memory");
    __syncthreads();
    if (threadIdx.x == 0) {
        unsigned* bar = b.bar;
        __builtin_amdgcn_s_waitcnt(0);
        unsigned nloc = b.st[0], nx = b.st[1];
        if (nloc == 0u) { xcd_barrier_complete(bar, b.x, nloc, nx); b.st[0] = nloc; b.st[1] = nx; }
        const unsigned old = xb_add(&bar[XB_XSUB(b.x)], 1u);
        const unsigned gen = old / nloc;
        if (old + 1u == (gen + 1u) * nloc) {
            __builtin_amdgcn_fence(__ATOMIC_RELEASE, "agent");
            asm volatile("s_waitcnt vmcnt(0)" ::: "memory");
            const unsigned og = xb_add(&bar[XB_TOP], 1u);
            const unsigned tg = og / nx;
            if (og + 1u == (tg + 1u) * nx) xb_add(&bar[XB_TOPGEN], 1u);
            else XB_SPIN(xb_ld(&bar[XB_TOPGEN]) == tg, bar);
            __builtin_amdgcn_fence(__ATOMIC_ACQUIRE, "agent");
            xb_add(&bar[XB_XGEN(b.x)], 1u);
            asm volatile("s_waitcnt vmcnt(0)" ::: "memory");
        } else {
            XB_SPIN(xb_ld(&bar[XB_XGEN(b.x)]) == gen, bar);
            __builtin_amdgcn_fence(__ATOMIC_ACQUIRE, "agent");
            asm volatile("s_waitcnt vmcnt(0)" ::: "memory");
        }
    }
    __syncthreads();
}
#ifndef PG8_ALIGN
#define PG8_ALIGN true
#endif
constexpr int NWAVES = 8;
#ifndef MK_PER_PHASE
#define MK_PER_PHASE 0
#endif
constexpr int D = 1024, MP = 16384, MSMP = 2048, M = MP + MSMP, NCH = M / 64, DFF = 2816, INCOLS = 7440, NB = 33, ADAW = 9 * D;
constexpr float EPS = 1e-6f;
constexpr size_t OFF_Y = 0, OFF_PCONV = (size_t)M * D, OFF_PS = OFF_PCONV + 3 * 3072, OFF_PK = OFF_PS + 8 * 128 * 128, OFF_PV = OFF_PK + 128 * 128,
                 OFF_SCONV = OFF_PV + 128 * 128, OFF_SS = OFF_SCONV + 32 * 3 * 3072, OFF_SK = OFF_SS + (size_t)32 * 8 * 128 * 128, OFF_SV = OFF_SK + 32 * 128 * 128, OUT_TOTAL = OFF_SV + 32 * 128 * 128;
constexpr size_t MiB = 1u << 20;
constexpr size_t WS_CTL = 0, CTL_ZERO_BYTES = 1 * MiB, WS_ADA = 1 * MiB, WS_BA = 5 * MiB / 2, WS_GL = 4 * MiB, WS_W = 5 * MiB;
constexpr size_t WS_U1 = 26 * MiB, WS_U2 = 62 * MiB, WS_U3 = 98 * MiB, WS_U4 = 134 * MiB, WS_U5 = 170 * MiB, WS_U6 = 206 * MiB;
constexpr size_t WS_INTRA = 206 * MiB, WS_KV = 224 * MiB, WS_TAIL = 233 * MiB, WS_END = 254 * MiB;
static_assert((size_t)M * D * 2 == 36 * MiB && (size_t)NB * ADAW * 4 <= 3 * MiB / 2 && (size_t)M * 16 * 4 <= 3 * MiB / 2, "ws map");
static_assert((size_t)NCH * 8 * 64 * 64 * 2 == 18 * MiB && (size_t)M * 256 * 2 == 9 * MiB && WS_TAIL + (size_t)NCH * 3 * 3072 * 2 <= WS_END && (size_t)M * DFF * 2 <= 108 * MiB, "ws map 2");
constexpr size_t W_FIN = 0, W_FOUT = (size_t)2 * DFF * D;
constexpr size_t W_IN = 0, W_A = (size_t)7424 * D, W_B = W_A + (size_t)D * D, W_O = W_B + (size_t)D * D;
static_assert((W_O + (size_t)D * D) * 2 <= 21 * MiB, "w slot");
constexpr int CW_TMO = 0, CW_BAR = 4096;
constexpr int RING_BYTES = 131072, LDSCTL_OFF = RING_BYTES, MISC_OFF = LDSCTL_OFF + 320, LDS_BYTES = 147456;

struct Frame {
    LAS unsigned char* lds; volatile LAS unsigned* MISC; gu32* ctl;
    int tid, lane, wave, vcu, G;
    const float* const* in; float* out; unsigned char* ws;
};
typedef float f32x2 __attribute__((ext_vector_type(2)));
typedef unsigned u32x2 __attribute__((ext_vector_type(2)));
__device__ __forceinline__ float bflo(unsigned u) { return __builtin_bit_cast(float, u << 16); }
__device__ __forceinline__ float bfhi(unsigned u) { return __builtin_bit_cast(float, u & 0xffff0000u); }
__device__ __forceinline__ float bf2f(bf16 h) { return __builtin_bit_cast(float, (unsigned)h << 16); }
__device__ __forceinline__ float fexp(float x) { return __builtin_amdgcn_exp2f(x * 1.4426950408889634f); }
__device__ __forceinline__ float sigm(float x) { return __builtin_amdgcn_rcpf(1.f + fexp(-x)); }
__device__ __forceinline__ float siluf(float x) { return x * sigm(x); }
__device__ __forceinline__ float wave_sum(float v) {
#pragma unroll
    for (int o = 1; o < 64; o <<= 1) v += __shfl_xor(v, o);
    return v;
}
__device__ __forceinline__ int mod_row(int m) { return m < MP ? 0 : 1 + ((m - MP) >> 6); }

__device__ __forceinline__ void transpose_item(const float* W, int ldw, int c0, int K, bf16* WT, int drow0, LAS float* scr, int k0, int lane) {
    f32x4 wv[8];
#pragma unroll
    for (int i = 0; i < 8; ++i) wv[i] = *(const f32x4*)(W + (size_t)(k0 + 8 * i + (lane >> 3)) * ldw + c0 + 4 * (lane & 7));
#pragma unroll
    for (int i = 0; i < 8; ++i) { LAS float* d = scr + (8 * i + (lane >> 3)) * 33 + 4 * (lane & 7); d[0] = wv[i].x; d[1] = wv[i].y; d[2] = wv[i].z; d[3] = wv[i].w; }
    LDS_WAIT(); asm volatile("" ::: "memory");
    const int c = lane & 7;
#pragma unroll
    for (int j = 0; j < 4; ++j) { const int n = (lane >> 3) + 8 * j; const LAS float* s = scr + (8 * c) * 33 + n;
        v4u o; o.x = pk2(s[0 * 33], s[1 * 33]); o.y = pk2(s[2 * 33], s[3 * 33]); o.z = pk2(s[4 * 33], s[5 * 33]); o.w = pk2(s[6 * 33], s[7 * 33]);
        *(GAS v4u*)(WT + (size_t)(drow0 + n) * K + k0 + 8 * c) = o; }
    LDS_WAIT(); asm volatile("" ::: "memory");
}
__device__ __forceinline__ void convert_ffn(Frame& F, const float* w_in, const float* w_out, bf16* dst_in, bf16* dst_out, int gw, int NGW) {
    LAS float* scr = (LAS float*)(F.lds + F.wave * 16384);
    constexpr int I_IN = 16 * 176, I_OUT = 44 * 32;
    if (dst_in) for (int it = gw; it < I_IN; it += NGW) { const int kb = it / 176, nb = it % 176, c0 = 32 * nb; const int j0 = c0 < DFF ? c0 : c0 - DFF;
        const int drow0 = (j0 >> 7) * 256 + (c0 < DFF ? 0 : 128) + (j0 & 127);
        transpose_item(w_in, 2 * DFF, c0, D, dst_in, drow0, scr, 64 * kb, F.lane); }
    if (dst_out) for (int r = gw; r < I_OUT; r += NGW) { const int kb = r / 32, nb = r % 32; transpose_item(w_out, D, 32 * nb, DFF, dst_out, 32 * nb, scr, 64 * kb, F.lane); }
}
__device__ __forceinline__ void convert_mixer(Frame& F, int part, int gw, int NGW) {
    LAS float* scr = (LAS float*)(F.lds + F.wave * 16384);
    constexpr int NB0 = 4352 / 32, NB1 = (7424 - 4352) / 32, I_SQ = 16 * 32;
    const int nb_n = part == 0 ? NB0 : NB1, i_in = 16 * nb_n, i_tot = part == 0 ? i_in : i_in + 3 * I_SQ;
    for (int it = gw; it < i_tot; it += NGW) {
        if (it < i_in) { const int kb = it / nb_n, nb = it % nb_n, dr = 32 * nb + (part == 0 ? 0 : 4352);
            const int c0 = dr < 3072 ? dr : dr < 4352 ? 4112 + (dr - 3072) : dr < 5376 ? 3072 + (dr - 4352) : 5392 + (dr - 5376);
            transpose_item((F.in[12]), INCOLS, c0, D, ((bf16*)(F.ws + WS_W)) + W_IN, dr, scr, 64 * kb, F.lane); }
        else { int r = it - i_in; const int which = r / I_SQ; r %= I_SQ; const int kb = r / 32, nb = r % 32;
            const float* src = which == 0 ? (F.in[19]) : which == 1 ? (F.in[20]) : (F.in[21]); bf16* dst = ((bf16*)(F.ws + WS_W)) + (which == 0 ? W_A : which == 1 ? W_B : W_O);
            transpose_item(src, D, 32 * nb, D, dst, 32 * nb, scr, 64 * kb, F.lane); }
    }
}
__device__ __forceinline__ int ada_row_off(int s) { return s < 31 ? s * 4112 : 131584 + (s - 31) * 4112; }
__device__ __forceinline__ void split_bf(float a, float b, unsigned& hi, unsigned& lo) {
    hi = pk2(a, b); lo = pk2(a - __builtin_bit_cast(float, hi << 16), b - __builtin_bit_cast(float, hi & 0xffff0000u)); }
__device__ __forceinline__ void ada_item(Frame& F, int item) {
    for (int idx = F.tid; idx < 33 * 1024; idx += 512) { const int b = idx >> 10, k = idx & 1023;
        const float c = (b == 0) ? (F.in[6])[k] : (F.in[7])[(b - 1) * 1024 + k]; *(LAS float*)(F.lds + ada_row_off(b == 0 ? 32 : b - 1) + 4 * k) = c / (1.f + __expf(-c)); }
    __syncthreads();
    const int i16 = F.lane & 15, kg = F.lane >> 4, k0 = F.wave * 128;
    const float* wp = (F.in[25]) + (size_t)(k0 + 8 * kg) * ADAW + item * 64 + 4 * i16;
    f32x4 acc[3][4], ld[2][8];
#pragma unroll
    for (int mt = 0; mt < 3; ++mt)
#pragma unroll
        for (int t = 0; t < 4; ++t) acc[mt][t] = (f32x4){0.f, 0.f, 0.f, 0.f};
#pragma unroll
    for (int j = 0; j < 8; ++j) ld[0][j] = *(const f32x4*)(wp + (size_t)j * ADAW);
#pragma unroll
    for (int j = 0; j < 8; ++j) ld[1][j] = *(const f32x4*)(wp + (size_t)(32 + j) * ADAW);
#pragma unroll
    for (int ks = 0; ks < 4; ++ks) {
        bf16x8 bh[4], bl[4];
#pragma unroll
        for (int t = 0; t < 4; ++t) { unsigned h0, h1, h2, h3, l0, l1, l2, l3; split_bf(ld[ks & 1][0][t], ld[ks & 1][1][t], h0, l0); split_bf(ld[ks & 1][2][t], ld[ks & 1][3][t], h1, l1);
            split_bf(ld[ks & 1][4][t], ld[ks & 1][5][t], h2, l2); split_bf(ld[ks & 1][6][t], ld[ks & 1][7][t], h3, l3); bh[t] = __builtin_bit_cast(bf16x8, (v4u){h0, h1, h2, h3}); bl[t] = __builtin_bit_cast(bf16x8, (v4u){l0, l1, l2, l3}); }
        if (ks + 2 < 4) {
#pragma unroll
            for (int j = 0; j < 8; ++j) ld[ks & 1][j] = *(const f32x4*)(wp + (size_t)(32 * (ks + 2) + j) * ADAW); }
#pragma unroll
        for (int mt = 0; mt < 3; ++mt) { const LAS float* ap = (const LAS float*)(F.lds + ada_row_off(mt < 2 ? 16 * mt + i16 : 32)) + k0 + 32 * ks + 8 * kg;
            const f32x4 a0 = *(const LAS f32x4*)ap, a1 = *(const LAS f32x4*)(ap + 4); unsigned h0, h1, h2, h3, l0, l1, l2, l3;
            split_bf(a0.x, a0.y, h0, l0); split_bf(a0.z, a0.w, h1, l1); split_bf(a1.x, a1.y, h2, l2); split_bf(a1.z, a1.w, h3, l3);
            const bf16x8 ah = __builtin_bit_cast(bf16x8, (v4u){h0, h1, h2, h3}), al = __builtin_bit_cast(bf16x8, (v4u){l0, l1, l2, l3});
#pragma unroll
            for (int t = 0; t < 4; ++t) { acc[mt][t] = __builtin_amdgcn_mfma_f32_16x16x32_bf16(ah, bh[t], acc[mt][t], 0, 0, 0);
                acc[mt][t] = __builtin_amdgcn_mfma_f32_16x16x32_bf16(ah, bl[t], acc[mt][t], 0, 0, 0); acc[mt][t] = __builtin_amdgcn_mfma_f32_16x16x32_bf16(al, bh[t], acc[mt][t], 0, 0, 0); } }
    }
    __syncthreads();
    LAS float* red = (LAS float*)F.lds;
#pragma unroll
    for (int mt = 0; mt < 2; ++mt)
#pragma unroll
        for (int i = 0; i < 4; ++i) *(LAS f32x4*)(red + (F.wave * 33 + 16 * mt + 4 * kg + i + 1) * 64 + 4 * i16) = (f32x4){acc[mt][0][i], acc[mt][1][i], acc[mt][2][i], acc[mt][3][i]};
    if (kg == 0) *(LAS f32x4*)(red + (F.wave * 33) * 64 + 4 * i16) = (f32x4){acc[2][0][0], acc[2][1][0], acc[2][2][0], acc[2][3][0]};
    __syncthreads();
    for (int idx = F.tid; idx < 33 * 64; idx += 512) { const int b = idx >> 6, l = idx & 63; float s = 0.f;
#pragma unroll
        for (int w = 0; w < 8; ++w) s += red[(w * 33 + b) * 64 + l];
        ((float*)(F.ws + WS_ADA))[(size_t)b * ADAW + item * 64 + l] = s + (F.in[26])[item * 64 + l]; }
    __syncthreads();
}
__device__ __forceinline__ void convert_ffn_range(Frame& F, const float* w_in, const float* w_out, bf16* dst_in, bf16* dst_out, int lo, int hi) {
    LAS float* scr = (LAS float*)(F.lds + F.wave * 16384);
    constexpr int I_IN = 16 * 176, I_OUT = 44 * 32;
    if (hi > I_IN + I_OUT) hi = I_IN + I_OUT;
    for (int it = lo + F.wave; it < hi; it += NWAVES) {
        if (it < I_IN) { const int kb = it / 176, nb = it % 176, c0 = 32 * nb; const int j0 = c0 < DFF ? c0 : c0 - DFF;
            const int drow0 = (j0 >> 7) * 256 + (c0 < DFF ? 0 : 128) + (j0 & 127);
            transpose_item(w_in, 2 * DFF, c0, D, dst_in, drow0, scr, 64 * kb, F.lane); }
        else { const int r = it - I_IN; const int kb = r / 32, nb = r % 32; transpose_item(w_out, D, 32 * nb, DFF, dst_out, 32 * nb, scr, 64 * kb, F.lane); } }
}
__device__ __forceinline__ int left_index(int pm, int pn) { return pm >= 64 ? (pm - 64) * 4 + pn : -1; }
struct Leftover { const bf16* part; bool base_in; int gi; float scale; };
__device__ __forceinline__ void load_row(Frame& F, int m, bool from_in, const Leftover& LO, f32x4 (&v)[4]) {
    const float* irow = m < MP ? (F.in[0]) + (size_t)m * D : (F.in[1]) + (size_t)(m - MP) * D;
    GAS u32x2* xb = (GAS u32x2*)((bf16*)F.out + (size_t)m * 2048) + F.lane;
#pragma unroll
    for (int j = 0; j < 4; ++j) { const int li = LO.part ? left_index(m >> 8, j) : -1;
        if (li < 0) { if (from_in) v[j] = *((const GAS f32x4*)irow + 64 * j + F.lane); else { const u32x2 w = xb[64 * j]; v[j] = (f32x4){bflo(w.x), bfhi(w.x), bflo(w.y), bfhi(w.y)}; } }
        else { f32x4 bs; if (LO.base_in) bs = *((const GAS f32x4*)irow + 64 * j + F.lane); else { const u32x2 w = xb[64 * j]; bs = (f32x4){bflo(w.x), bfhi(w.x), bflo(w.y), bfhi(w.y)}; }
            const f32x4 gv = *((const GAS f32x4*)(((float*)(F.ws + WS_ADA)) + (size_t)mod_row(m) * ADAW + LO.gi * D) + 64 * j + F.lane);
            const GAS u32x2* pp = (const GAS u32x2*)(LO.part + (size_t)li * 8 * 65536 + (size_t)(m & 255) * 256) + F.lane; f32x4 s = (f32x4){0.f, 0.f, 0.f, 0.f};
#pragma unroll
            for (int p = 0; p < 8; ++p) { const u32x2 w = pp[(size_t)p * 16384]; s += (f32x4){bflo(w.x), bfhi(w.x), bflo(w.y), bfhi(w.y)}; }
            v[j] = bs + gv * s * LO.scale; xb[64 * j] = (u32x2){pk2(v[j].x, v[j].y), pk2(v[j].z, v[j].w)}; } }
}
struct RowBuf { f32x4 x[4], sc[4], sh[4]; };
__device__ __forceinline__ void rmsmod_row(const RowBuf& rb, const f32x4 (&gq)[4], bf16* orow, int lane, f32x4 (&hv)[4]) {
    float s = 0.f;
#pragma unroll
    for (int j = 0; j < 4; ++j) s += (rb.x[j].x * rb.x[j].x + rb.x[j].y * rb.x[j].y) + (rb.x[j].z * rb.x[j].z + rb.x[j].w * rb.x[j].w);
    const float r = __builtin_amdgcn_rsqf(wave_sum(s) * (1.f / D) + EPS);
    GAS u32x2* o8 = (GAS u32x2*)orow + lane;
#pragma unroll
    for (int j = 0; j < 4; ++j) { const f32x4 h = (rb.x[j] * r) * gq[j] * (rb.sc[j] + 1.f) + rb.sh[j]; hv[j] = h;
        u32x2 w; w.x = pk2(h.x, h.y); w.y = pk2(h.z, h.w); o8[64 * j] = w; }
}
template <bool WITH_BA>
__device__ __forceinline__ void rmsmod_rows(Frame& F, bool from_in, const float* g, int li, bf16* dst, const Leftover LO = Leftover{nullptr, false, 0, 0.f}, int dld = D) {
    const int gw = F.vcu * NWAVES + F.wave, NGW = F.G * NWAVES;
    LAS float* wba = (LAS float*)F.lds;
    if (WITH_BA) { for (int idx = F.tid; idx < 16 * 1024; idx += 512) { const int k = idx >> 4, j = idx & 15; wba[j * 1024 + k] = (F.in[12])[(size_t)k * INCOLS + 4096 + j]; } __syncthreads(); }
    f32x4 gq[4];
#pragma unroll
    for (int j = 0; j < 4; ++j) gq[j] = ((const GAS f32x4*)g)[64 * j + F.lane];
    RowBuf cur, nxt;
#define ROW_FETCH(mm, B) do { const float* ad_ = ((float*)(F.ws + WS_ADA)) + (size_t)mod_row(mm) * ADAW + (3 * li) * D; load_row(F, mm, from_in, LO, B.x); \
        _Pragma("unroll") for (int j = 0; j < 4; ++j) { B.sh[j] = ((const GAS f32x4*)ad_)[64 * j + F.lane]; B.sc[j] = ((const GAS f32x4*)(ad_ + D))[64 * j + F.lane]; } } while (0)
    if (gw < M) ROW_FETCH(gw, cur);
    for (int m = gw; m < M; m += NGW) {
        if (m + NGW < M) ROW_FETCH(m + NGW, nxt);
        f32x4 hv[4]; rmsmod_row(cur, gq, dst + (size_t)m * dld, F.lane, hv);
        if (WITH_BA) { float p[16];
#pragma unroll
            for (int j = 0; j < 16; ++j) { float s = 0.f;
#pragma unroll
                for (int jj = 0; jj < 4; ++jj) { const f32x4 w = *(const LAS f32x4*)(wba + j * 1024 + 256 * jj + 4 * F.lane); s += (hv[jj].x * w.x + hv[jj].y * w.y) + (hv[jj].z * w.z + hv[jj].w * w.w); }
                p[j] = s; if ((j & 3) == 3) asm volatile("" ::: "memory"); }
            { const bool up = F.lane & 32;
#pragma unroll
              for (int i = 0; i < 8; ++i) { const float snd = up ? p[i] : p[8 + i]; const float rcv = __shfl_xor(snd, 32); p[i] = (up ? p[8 + i] : p[i]) + rcv; } }
            { const bool up = F.lane & 16;
#pragma unroll
              for (int i = 0; i < 4; ++i) { const float snd = up ? p[i] : p[4 + i]; const float rcv = __shfl_xor(snd, 16); p[i] = (up ? p[4 + i] : p[i]) + rcv; } }
            { const bool up = F.lane & 8;
#pragma unroll
              for (int i = 0; i < 2; ++i) { const float snd = up ? p[i] : p[2 + i]; const float rcv = __shfl_xor(snd, 8); p[i] = (up ? p[2 + i] : p[i]) + rcv; } }
            { const bool up = F.lane & 4; const float snd = up ? p[0] : p[1]; const float rcv = __shfl_xor(snd, 4); p[0] = (up ? p[1] : p[0]) + rcv; }
            p[0] += __shfl_xor(p[0], 2); p[0] += __shfl_xor(p[0], 1);
            if ((F.lane & 3) == 0) ((float*)(F.ws + WS_BA))[(size_t)m * 16 + (((F.lane >> 5) & 1) * 8 + ((F.lane >> 4) & 1) * 4 + ((F.lane >> 3) & 1) * 2 + ((F.lane >> 2) & 1))] = p[0]; }
        cur = nxt;
    }
#undef ROW_FETCH
    if (WITH_BA) __syncthreads();
}
__device__ __forceinline__ void rmsmod_apply(const f32x4 (&x)[4], const f32x4 (&sc)[4], const f32x4 (&sh)[4], const f32x4 (&gq)[4], bf16* orow, int lane, f32x4 (&hv)[4]) {
    float s = 0.f;
#pragma unroll
    for (int j = 0; j < 4; ++j) s += (x[j].x * x[j].x + x[j].y * x[j].y) + (x[j].z * x[j].z + x[j].w * x[j].w);
    const float r = __builtin_amdgcn_rsqf(wave_sum(s) * (1.f / D) + EPS);
    GAS u32x2* o8 = (GAS u32x2*)orow + lane;
#pragma unroll
    for (int j = 0; j < 4; ++j) { const f32x4 h = (x[j] * r) * gq[j] * (sc[j] + 1.f) + sh[j]; hv[j] = h;
        u32x2 w; w.x = pk2(h.x, h.y); w.y = pk2(h.z, h.w); o8[64 * j] = w; }
}
__device__ __forceinline__ void ba_project(Frame& F, const f32x4 (&hv)[4], int m, const LAS float* wba) {
    float p[16];
#pragma unroll
    for (int j = 0; j < 16; ++j) { float s = 0.f;
#pragma unroll
        for (int jj = 0; jj < 4; ++jj) { const f32x4 w = *(const LAS f32x4*)(wba + j * 1024 + 256 * jj + 4 * F.lane); s += (hv[jj].x * w.x + hv[jj].y * w.y) + (hv[jj].z * w.z + hv[jj].w * w.w); }
        p[j] = s; if ((j & 3) == 3) asm volatile("" ::: "memory"); }
    { const bool up = F.lane & 32;
#pragma unroll
      for (int i = 0; i < 8; ++i) { const float snd = up ? p[i] : p[8 + i]; const float rcv = __shfl_xor(snd, 32); p[i] = (up ? p[8 + i] : p[i]) + rcv; } }
    { const bool up = F.lane & 16;
#pragma unroll
      for (int i = 0; i < 4; ++i) { const float snd = up ? p[i] : p[4 + i]; const float rcv = __shfl_xor(snd, 16); p[i] = (up ? p[4 + i] : p[i]) + rcv; } }
    { const bool up = F.lane & 8;
#pragma unroll
      for (int i = 0; i < 2; ++i) { const float snd = up ? p[i] : p[2 + i]; const float rcv = __shfl_xor(snd, 8); p[i] = (up ? p[2 + i] : p[i]) + rcv; } }
    { const bool up = F.lane & 4; const float snd = up ? p[0] : p[1]; const float rcv = __shfl_xor(snd, 4); p[0] = (up ? p[1] : p[0]) + rcv; }
    p[0] += __shfl_xor(p[0], 2); p[0] += __shfl_xor(p[0], 1);
    if ((F.lane & 3) == 0) ((float*)(F.ws + WS_BA))[(size_t)m * 16 + (((F.lane >> 5) & 1) * 8 + ((F.lane >> 4) & 1) * 4 + ((F.lane >> 3) & 1) * 2 + ((F.lane >> 2) & 1))] = p[0];
}
template <bool BASE_IN, bool WRITE_XB> __device__ __forceinline__ void sample_row_complete(Frame& F, int m, const Leftover& LO, f32x4 (&v)[4]) {
    const float* irow = (F.in[1]) + (size_t)(m - MP) * D;
    GAS u32x2* xb = (GAS u32x2*)((bf16*)F.out + (size_t)m * 2048) + F.lane;
    f32x4 bsf[4]; u32x2 bsb[4]; f32x4 gv[4]; u32x2 pw[4][8];
#pragma unroll
    for (int j = 0; j < 4; ++j) { if (BASE_IN) bsf[j] = *((const GAS f32x4*)irow + 64 * j + F.lane); else bsb[j] = xb[64 * j];
        gv[j] = *((const GAS f32x4*)(((float*)(F.ws + WS_ADA)) + (size_t)mod_row(m) * ADAW + LO.gi * D) + 64 * j + F.lane); }
#pragma unroll
    for (int j = 0; j < 4; ++j) { const int li = ((m >> 8) - 64) * 4 + j; const GAS u32x2* pp = (const GAS u32x2*)(LO.part + (size_t)li * 8 * 65536 + (size_t)(m & 255) * 256) + F.lane;
#pragma unroll
        for (int p = 0; p < 8; ++p) pw[j][p] = pp[(size_t)p * 16384]; }
#pragma unroll
    for (int j = 0; j < 4; ++j) { f32x4 s = (f32x4){0.f, 0.f, 0.f, 0.f};
#pragma unroll
        for (int p = 0; p < 8; ++p) { const u32x2 w = pw[j][p]; s += (f32x4){bflo(w.x), bfhi(w.x), bflo(w.y), bfhi(w.y)}; }
        const f32x4 bs = BASE_IN ? bsf[j] : (f32x4){bflo(bsb[j].x), bfhi(bsb[j].x), bflo(bsb[j].y), bfhi(bsb[j].y)};
        v[j] = bs + gv[j] * s * LO.scale; if (WRITE_XB) xb[64 * j] = (u32x2){pk2(v[j].x, v[j].y), pk2(v[j].z, v[j].w)}; }
}
template <bool WITH_BA, bool FROM_IN, bool HAS_LO, bool BASE_IN, int NB>
__device__ __forceinline__ void rmsmod_rows_256(Frame& F, const float* g, int li, bf16* dst, const Leftover LO, int dld) {
    static_assert(8 % NB == 0, "prompt rows per wave come in batches");
    const int gw = F.vcu * NWAVES + F.wave;
    LAS float* wba = (LAS float*)F.lds;
    if (WITH_BA) { for (int idx = F.tid; idx < 16 * 1024; idx += 512) { const int k = idx >> 4, j = idx & 15; wba[j * 1024 + k] = (F.in[12])[(size_t)k * INCOLS + 4096 + j]; } __syncthreads(); }
    f32x4 gq[4], sc0[4], sh0[4];
    { const float* ad = ((float*)(F.ws + WS_ADA)) + (3 * li) * D;
#pragma unroll
      for (int j = 0; j < 4; ++j) { gq[j] = ((const GAS f32x4*)g)[64 * j + F.lane]; sh0[j] = ((const GAS f32x4*)ad)[64 * j + F.lane]; sc0[j] = ((const GAS f32x4*)(ad + D))[64 * j + F.lane]; } }
#pragma unroll 1
    for (int it = 0; it < 8 / NB; ++it) {
        f32x4 rf[FROM_IN ? NB : 1][4]; u32x2 rb[FROM_IN ? 1 : NB][4];
#pragma unroll
        for (int r = 0; r < NB; ++r) { const int m = gw + 2048 * (NB * it + r);
#pragma unroll
            for (int j = 0; j < 4; ++j) { if (FROM_IN) rf[r][j] = *((const GAS f32x4*)((F.in[0]) + (size_t)m * D) + 64 * j + F.lane); else rb[r][j] = ((const GAS u32x2*)((bf16*)F.out + (size_t)m * 2048) + F.lane)[64 * j]; } }
#pragma unroll
        for (int r = 0; r < NB; ++r) { const int m = gw + 2048 * (NB * it + r); f32x4 x[4], hv[4];
#pragma unroll
            for (int j = 0; j < 4; ++j) { if (FROM_IN) x[j] = rf[r][j]; else { const u32x2 w = rb[r][j]; x[j] = (f32x4){bflo(w.x), bfhi(w.x), bflo(w.y), bfhi(w.y)}; } }
            rmsmod_apply(x, sc0, sh0, gq, dst + (size_t)m * dld, F.lane, hv);
            if (WITH_BA) ba_project(F, hv, m, wba); }
    }
    { const int m = MP + gw; f32x4 x[4], hv[4], scs[4], shs[4];
      const float* ad = ((float*)(F.ws + WS_ADA)) + (size_t)mod_row(m) * ADAW + (3 * li) * D;
#pragma unroll
      for (int j = 0; j < 4; ++j) { shs[j] = ((const GAS f32x4*)ad)[64 * j + F.lane]; scs[j] = ((const GAS f32x4*)(ad + D))[64 * j + F.lane]; }
      if (HAS_LO) sample_row_complete<BASE_IN, true>(F, m, LO, x);
      else {
#pragma unroll
          for (int j = 0; j < 4; ++j) x[j] = *((const GAS f32x4*)((F.in[1]) + (size_t)(m - MP) * D) + 64 * j + F.lane); }
      rmsmod_apply(x, scs, shs, gq, dst + (size_t)m * dld, F.lane, hv);
      if (WITH_BA) ba_project(F, hv, m, wba); }
    if (WITH_BA) __syncthreads();
}
template <int NB> __device__ __forceinline__ void final_norm_rows_256(Frame& F, const Leftover LO) {
    const int gw = F.vcu * NWAVES + F.wave;
    f32x4 gq[4];
#pragma unroll
    for (int j = 0; j < 4; ++j) gq[j] = ((const GAS f32x4*)(F.in[27]))[64 * j + F.lane];
#pragma unroll 1
    for (int it = 0; it < 8 / NB; ++it) {
        u32x2 rb[NB][4];
#pragma unroll
        for (int r = 0; r < NB; ++r) { const int m = gw + 2048 * (NB * it + r);
#pragma unroll
            for (int j = 0; j < 4; ++j) rb[r][j] = ((const GAS u32x2*)((bf16*)F.out + (size_t)m * 2048) + F.lane)[64 * j]; }
#pragma unroll
        for (int r = 0; r < NB; ++r) { const int m = gw + 2048 * (NB * it + r); f32x4 x[4]; float s = 0.f;
#pragma unroll
            for (int j = 0; j < 4; ++j) { const u32x2 w = rb[r][j]; x[j] = (f32x4){bflo(w.x), bfhi(w.x), bflo(w.y), bfhi(w.y)}; s += (x[j].x * x[j].x + x[j].y * x[j].y) + (x[j].z * x[j].z + x[j].w * x[j].w); }
            const float rr = __builtin_amdgcn_rsqf(wave_sum(s) * (1.f / D) + EPS); GAS f32x4* xr = (GAS f32x4*)(F.out + (size_t)m * D) + F.lane;
#pragma unroll
            for (int j = 0; j < 4; ++j) xr[64 * j] = (x[j] * rr) * gq[j]; }
    }
    { const int m = MP + gw; f32x4 x[4]; float s = 0.f;
      sample_row_complete<false, false>(F, m, LO, x);
#pragma unroll
      for (int j = 0; j < 4; ++j) s += (x[j].x * x[j].x + x[j].y * x[j].y) + (x[j].z * x[j].z + x[j].w * x[j].w);
      const float rr = __builtin_amdgcn_rsqf(wave_sum(s) * (1.f / D) + EPS); GAS f32x4* xr = (GAS f32x4*)(F.out + (size_t)m * D) + F.lane;
#pragma unroll
      for (int j = 0; j < 4; ++j) xr[64 * j] = (x[j] * rr) * gq[j]; }
}
__device__ __forceinline__ void final_norm_rows(Frame& F, const Leftover LO) {
    const int gw = F.vcu * NWAVES + F.wave, NGW = F.G * NWAVES;
    f32x4 gq[4], cur[4], nxt[4];
#pragma unroll
    for (int j = 0; j < 4; ++j) gq[j] = ((const GAS f32x4*)(F.in[27]))[64 * j + F.lane];
    if (gw < M) load_row(F, gw, false, LO, cur);
    for (int m = gw; m < M; m += NGW) {
        if (m + NGW < M) load_row(F, m + NGW, false, LO, nxt);
        GAS f32x4* xr = (GAS f32x4*)(F.out + (size_t)m * D) + F.lane; float s = 0.f;
#pragma unroll
        for (int j = 0; j < 4; ++j) s += (cur[j].x * cur[j].x + cur[j].y * cur[j].y) + (cur[j].z * cur[j].z + cur[j].w * cur[j].w);
        const float r = __builtin_amdgcn_rsqf(wave_sum(s) * (1.f / D) + EPS);
#pragma unroll
        for (int j = 0; j < 4; ++j) { xr[64 * j] = (cur[j] * r) * gq[j]; cur[j] = nxt[j]; }
    }
}
typedef pg8::f32x4 pf4; typedef pg8::u32x4 pu4;
#ifndef WT_STORES
#define WT_STORES 0
#endif
__device__ __forceinline__ void st16(void* p, pu4 v) {
#if WT_STORES
    asm volatile("global_store_dwordx4 %0, %1, off sc1\n\ts_nop 1" :: "v"(p), "v"(v) : "memory");
#else
    *(pu4*)p = v;
#endif
}
__device__ __forceinline__ void st16f(void* p, pf4 v) { st16(p, __builtin_bit_cast(pu4, v)); }
typedef float pf2 __attribute__((ext_vector_type(2)));
__device__ __forceinline__ pf2 silu_mul2(pf2 g, pf2 u) { const pf2 s = g * (-1.4426950408889634f); pf2 e; e.x = __builtin_amdgcn_exp2f(s.x); e.y = __builtin_amdgcn_exp2f(s.y);
    const pf2 d = e + 1.0f; pf2 r; r.x = __builtin_amdgcn_rcpf(d.x); r.y = __builtin_amdgcn_rcpf(d.y); return (g * r) * u; }
__device__ __forceinline__ pf4 silu_mul4(pf4 g, pf4 u) { const pf2 a = silu_mul2((pf2){g.x, g.y}, (pf2){u.x, u.y}), b = silu_mul2((pf2){g.z, g.w}, (pf2){u.z, u.w}); return (pf4){a.x, a.y, b.x, b.y}; }
__device__ __forceinline__ pu4 pack8(pf4 a, pf4 b) { pu4 w; w.x = pg8::cvt_pk_bf16(a.x, a.y); w.y = pg8::cvt_pk_bf16(a.z, a.w); w.z = pg8::cvt_pk_bf16(b.x, b.y); w.w = pg8::cvt_pk_bf16(b.z, b.w); return w; }
struct EpiSwiglu {
    static constexpr bool PERM = true, AFTER_DRAIN = false; bf16* O;
    __device__ __forceinline__ void operator()(const pf4 (&acc)[2][2][4][2], const pg8::Unit& u, int wr, int wc, int fr, int fq) const {
        const int row0 = u.pm * 256 + wr * 64 + fr, col0 = u.pn * 128 + wc * 32 + 8 * fq;
#pragma unroll
        for (int ai = 0; ai < 2; ++ai)
#pragma unroll
            for (int m = 0; m < 4; ++m) { bf16* p = O + (size_t)(row0 + ai * 128 + m * 16) * DFF + col0;
                const pf4 h0 = silu_mul4(acc[ai][0][m][0], acc[ai][1][m][0]), h1 = silu_mul4(acc[ai][0][m][1], acc[ai][1][m][1]);
                st16(p, pack8(h0, h1)); }
    }
};
template <bool BASE_IN> struct EpiResid {
    static constexpr bool PERM = true, AFTER_DRAIN = false; const float* in0; const float* in1; bf16* xb; const float* ada; int gi; float scale; bf16* part;
    __device__ __forceinline__ void operator()(const pf4 (&acc)[2][2][4][2], const pg8::Unit& u, int wr, int wc, int fr, int fq) const {
        if (u.piece) {
            char* pb = (char*)(part + ((size_t)u.lidx * 8 + (u.piece - 1)) * 65536);
#pragma unroll
            for (int ai = 0; ai < 2; ++ai)
#pragma unroll
                for (int bj = 0; bj < 2; ++bj) { unsigned off = (unsigned)((ai * 128 + wr * 64 + fr) * 256 + wc * 32 + 8 * fq + bj * 128) * 2u; asm volatile("" : "+v"(off));
#pragma unroll
                    for (int m = 0; m < 4; ++m) { *(pu4*)(pb + (size_t)off) = pack8(acc[ai][bj][m][0], acc[ai][bj][m][1]); off += 16u * 256u * 2u; }
                    asm volatile("" ::: "memory"); }
            return; }
        const int rowt = u.pm * 256, col0 = u.pn * 256 + wc * 32 + 8 * fq;
        const char* ib = (const char*)(rowt < MP ? in0 + (size_t)rowt * D : in1 + (size_t)(rowt - MP) * D); char* xo = (char*)(xb + (size_t)rowt * 2048);
#pragma unroll
        for (int ai = 0; ai < 2; ++ai) {
            const int b = rowt < MP ? 0 : 1 + ((rowt - MP) >> 6) + ai * 2 + wr; const char* ga = (const char*)(ada + (size_t)b * ADAW + gi * D);
#pragma unroll
            for (int bj = 0; bj < 2; ++bj) { unsigned co = (unsigned)(col0 + bj * 128); asm volatile("" : "+v"(co));
                const pf4 g0 = *(const pf4*)(ga + (size_t)co * 4u) * scale, g1 = *(const pf4*)(ga + (size_t)co * 4u + 16) * scale;
                unsigned r = (unsigned)(ai * 128 + wr * 64 + fr);
#pragma unroll
                for (int m = 0; m < 4; ++m) { pf4 b0, b1;
                    if (BASE_IN) { const char* p = ib + ((size_t)r * D + co) * 4u; b0 = *(const pf4*)p; b1 = *(const pf4*)(p + 16); }
                    else { const pu4 w = *(const pu4*)(xo + ((size_t)r * 2048 + co) * 2u); b0 = (pf4){bflo(w.x), bfhi(w.x), bflo(w.y), bfhi(w.y)}; b1 = (pf4){bflo(w.z), bfhi(w.z), bflo(w.w), bfhi(w.w)}; }
                    *(pu4*)(xo + ((size_t)r * 2048 + co) * 2u) = pack8(b0 + g0 * acc[ai][bj][m][0], b1 + g1 * acc[ai][bj][m][1]); r += 16u; }
                asm volatile("" ::: "memory"); }
        }
    }
};
struct EpiPart {
    static constexpr bool PERM = true, AFTER_DRAIN = false; bf16* part;
    __device__ __forceinline__ void operator()(const pf4 (&acc)[2][2][4][2], const pg8::Unit& u, int wr, int wc, int fr, int fq) const {
        char* pb = (char*)(part + ((size_t)u.lidx * 8 + (u.piece - 1)) * 65536);
#pragma unroll
        for (int ai = 0; ai < 2; ++ai)
#pragma unroll
            for (int bj = 0; bj < 2; ++bj) { unsigned off = (unsigned)((ai * 128 + wr * 64 + fr) * 256 + wc * 32 + 8 * fq + bj * 128) * 2u; asm volatile("" : "+v"(off));
#pragma unroll
                for (int m = 0; m < 4; ++m) { *(pu4*)(pb + (size_t)off) = pack8(acc[ai][bj][m][0], acc[ai][bj][m][1]); off += 16u * 256u * 2u; }
                asm volatile("" ::: "memory"); }
    }
};
struct EpiF1 {
    static constexpr bool PERM = true, AFTER_DRAIN = false; bf16 *U1, *U2, *U3, *U4, *KV, *TAIL; float* out;
    __device__ __forceinline__ void operator()(const pf4 (&acc)[2][2][4][2], const pg8::Unit& u, int wr, int wc, int fr, int fq) const {
        const int pn = u.pn, dcol = wc * 32 + 8 * fq;
        if (pn < 12) {
            char* Ub = (char*)U1 + (size_t)((pn >> 2) == 0 ? 4 : (pn >> 2)) * (36u << 20);
#pragma unroll
            for (int ai = 0; ai < 2; ++ai) { const int cn = u.pm * 4 + ai * 2 + wr;
#pragma unroll
                for (int bj = 0; bj < 2; ++bj) { unsigned off = (unsigned)(((cn * 8 + (pn & 3) * 2 + bj) * 64 + fr) * 128 + dcol) * 2u; asm volatile("" : "+v"(off));
#pragma unroll
                    for (int m = 0; m < 4; ++m) { st16(Ub + (size_t)off, pack8(acc[ai][bj][m][0], acc[ai][bj][m][1])); off += 16u * 128u * 2u; }
                    asm volatile("" ::: "memory"); } }
            if (fr >= 13) {
#pragma unroll
                for (int ai = 0; ai < 2; ++ai) { const int cn = u.pm * 4 + ai * 2 + wr;
#pragma unroll
                    for (int bj = 0; bj < 2; ++bj) { const int j = fr - 13, qc = pn * 256 + bj * 128 + dcol; const pf4 v0 = acc[ai][bj][3][0], v1 = acc[ai][bj][3][1];
                        *(pu4*)(TAIL + ((size_t)cn * 3 + j) * 3072 + qc) = pack8(v0, v1);
                        if (cn >= 255) { float* o = out + (cn == 255 ? OFF_PCONV + (size_t)j * 3072 : OFF_SCONV + ((size_t)(cn - 256) * 3 + j) * 3072) + qc; *(pf4*)o = v0; *(pf4*)(o + 4) = v1; } } } }
        } else if (pn < 16) {
#pragma unroll
            for (int ai = 0; ai < 2; ++ai)
#pragma unroll
                for (int bj = 0; bj < 2; ++bj) { unsigned off = (unsigned)((u.pm * 256 + ai * 128 + wr * 64 + fr) * D + (pn - 12) * 256 + bj * 128 + dcol) * 2u; asm volatile("" : "+v"(off));
#pragma unroll
                    for (int m = 0; m < 4; ++m) { st16((char*)U4 + (size_t)off, pack8(acc[ai][bj][m][0], acc[ai][bj][m][1])); off += 16u * D * 2u; }
                    asm volatile("" ::: "memory"); }
        } else {
#pragma unroll
            for (int ai = 0; ai < 2; ++ai) { const int cn = u.pm * 4 + ai * 2 + wr;
#pragma unroll
                for (int bj = 0; bj < 2; ++bj) { unsigned off = (unsigned)((cn * 64 + fr) * 256 + bj * 128 + dcol) * 2u; asm volatile("" : "+v"(off));
#pragma unroll
                    for (int m = 0; m < 4; ++m) { st16((char*)KV + (size_t)off, pack8(acc[ai][bj][m][0], acc[ai][bj][m][1])); off += 16u * 256u * 2u; }
                    asm volatile("" ::: "memory");
                    if (cn >= 254) {
                        float* ob = cn < 256 ? out + (bj == 0 ? OFF_PK : OFF_PV) + (size_t)((cn - 254) * 64 + fr) * 128 + dcol
                                             : out + (bj == 0 ? OFF_SK : OFF_SV) + (size_t)(cn - 256) * 16384 + (size_t)(64 + fr) * 128 + dcol;
#pragma unroll
                        for (int m = 0; m < 4; ++m) { *(pf4*)(ob + m * 16 * 128) = acc[ai][bj][m][0]; *(pf4*)(ob + m * 16 * 128 + 4) = acc[ai][bj][m][1]; }
                        asm volatile("" ::: "memory"); } } }
        }
    }
};
struct EpiF2 {
    static constexpr bool PERM = true, AFTER_DRAIN = false; bf16 *Z, *GA, *GB;
    __device__ __forceinline__ void operator()(const pf4 (&acc)[2][2][4][2], const pg8::Unit& u, int wr, int wc, int fr, int fq) const {
        const int t_ = u.pn >> 2; bf16* Ob = (bf16*)((char*)Z + (size_t)(108 * t_ - 72 * (t_ >> 1)) * (1u << 20)); const int col0 = (u.pn & 3) * 256 + wc * 32 + 8 * fq, row0 = u.pm * 256 + wr * 64 + fr;
#pragma unroll
        for (int ai = 0; ai < 2; ++ai)
#pragma unroll
            for (int m = 0; m < 4; ++m)
#pragma unroll
                for (int bj = 0; bj < 2; ++bj) st16(Ob + (size_t)(row0 + ai * 128 + m * 16) * D + col0 + bj * 128, pack8(acc[ai][bj][m][0], acc[ai][bj][m][1]));
    }
};
template <int MODE> struct EpiGate {
    static constexpr bool PERM = true, AFTER_DRAIN = false; bf16* T; const bf16* G2;
    __device__ __forceinline__ void operator()(const pf4 (&acc)[2][2][4][2], const pg8::Unit& u, int wr, int wc, int fr, int fq) const {
        const int col0 = u.pn * 256 + wc * 32 + 8 * fq, row0 = u.pm * 256 + wr * 64 + fr;
#pragma unroll
        for (int ai = 0; ai < 2; ++ai)
#pragma unroll
            for (int m = 0; m < 4; ++m)
#pragma unroll
                for (int bj = 0; bj < 2; ++bj) { const size_t off = (size_t)(row0 + ai * 128 + m * 16) * D + col0 + bj * 128;
                    const pu4 gv = *(const pu4*)((MODE == 0 ? (const bf16*)T : G2) + off); pu4 tv = (pu4){0u, 0u, 0u, 0u}; if (MODE == 1) tv = *(const pu4*)(T + off);
                    const pf4 a0 = acc[ai][bj][m][0], a1 = acc[ai][bj][m][1]; pf4 o0, o1;
                    o0.x = bflo(tv.x) + sigm(bflo(gv.x)) * a0.x; o0.y = bfhi(tv.x) + sigm(bfhi(gv.x)) * a0.y; o0.z = bflo(tv.y) + sigm(bflo(gv.y)) * a0.z; o0.w = bfhi(tv.y) + sigm(bfhi(gv.y)) * a0.w;
                    o1.x = bflo(tv.z) + sigm(bflo(gv.z)) * a1.x; o1.y = bfhi(tv.z) + sigm(bfhi(gv.z)) * a1.y; o1.z = bflo(tv.w) + sigm(bflo(gv.w)) * a1.z; o1.w = bfhi(tv.w) + sigm(bfhi(gv.w)) * a1.w;
                    st16(T + off, pack8(o0, o1)); }
    }
};
typedef short s16x8 __attribute__((ext_vector_type(8)));
constexpr int PR_RHST = 0, PR_QB = 69632, PR_KB = 87040, PR_AM = 104448, PR_TB = 121856, PR_SC = 126976, PR_IL = 132096, PR_CW = 141312;
static_assert(PR_IL + 64 * 72 * 2 <= PR_CW && PR_CW + 12 * 128 * 4 <= LDS_BYTES, "prep LDS map (IL, CW)");
static_assert(PR_SC + 2 * 1536 <= RING_BYTES, "prep LDS map");
constexpr size_t WS_GATES = 242 * MiB;
struct PrepRegs { v4u raw[3][5]; float gate; };
__device__ __forceinline__ void prep_fetch(Frame& F, int it, int ch8, int rg, PrepRegs& P) {
    const int cn = it >> 3, h = it & 7; const size_t blk = (size_t)(cn * 8 + h) * 64 * 128;
    P.gate = ((const float*)(F.ws + WS_GATES))[(size_t)it * 256 + ((rg * 16 + ch8) & 255)];
#pragma unroll
    for (int t = 0; t < 3; ++t) { const int ch = t * 1024 + h * 128 + 8 * ch8; const bf16* Ub = (t == 0 ? ((bf16*)(F.ws + WS_U5)) : t == 1 ? ((bf16*)(F.ws + WS_U2)) : ((bf16*)(F.ws + WS_U3))) + blk + 8 * ch8;
#pragma unroll
        for (int j = 0; j < 5; ++j) { const int rr = 2 * rg - 3 + j;
            if (rr >= 0) P.raw[t][j] = *(const v4u*)(Ub + rr * 128);
            else if (cn > 0 && cn < 256) P.raw[t][j] = *(const v4u*)(((bf16*)(F.ws + WS_TAIL)) + ((size_t)(cn - 1) * 3 + (3 + rr)) * 3072 + ch);
            else if (cn == 0) P.raw[t][j] = (v4u){0u, 0u, 0u, 0u};
            else { const float* p = (F.in[2]) + ((size_t)(cn - 256) * 3 + (3 + rr)) * 3072 + ch; const f32x4 a = *(const f32x4*)p, b = *(const f32x4*)(p + 4);
                P.raw[t][j] = (v4u){pk2(a.x, a.y), pk2(a.z, a.w), pk2(b.x, b.y), pk2(b.z, b.w)}; } } }
}
__device__ __forceinline__ void prep_gates(Frame& F, int it, int lane) {
    const int cn = it >> 3, h = it & 7, row = cn * 64 + lane; const float braw = ((float*)(F.ws + WS_BA))[(size_t)row * 16 + h], araw = ((float*)(F.ws + WS_BA))[(size_t)row * 16 + 8 + h];
    const float beta = 1.f / (1.f + expf(-braw)); const float xx = araw + (F.in[15])[h]; const float sp = xx > 20.f ? xx : log1pf(expf(xx)); const float g = -expf((F.in[14])[h]) * sp;
    float gcs = g;
#pragma unroll
    for (int o = 1; o < 64; o <<= 1) { const float t = __shfl_up(gcs, o); if (lane >= o) gcs += t; }
    const float glast = __shfl(gcs, 63);
    float* G = (float*)(F.ws + WS_GATES) + (size_t)it * 256;
    G[lane] = beta; G[64 + lane] = gcs; G[128 + lane] = expf(gcs); G[192 + lane] = expf(glast - gcs);
    if (lane == 63) ((float*)(F.ws + WS_GL))[it] = expf(glast);
}
#if defined(PROBE_PS)
#define PS_MARK(k) do { if (blockIdx.x == 0 && F.tid == 0) { const unsigned long long t_ = __builtin_amdgcn_s_memrealtime(); volatile LAS unsigned long long* a_ = (volatile LAS unsigned long long*)(F.lds + LDSCTL_OFF + 768); a_[(k)] += t_ - a_[15]; a_[15] = t_; } } while (0)
#else
#define PS_MARK(k) do {} while (0)
#endif
template <bool DRY, int SKIP = 0> __device__ __forceinline__ void gdn_prep_unit(Frame& F, int cn, int h, PrepRegs& P, int it_next, int par) {
    const int tid = F.tid, lane = F.lane, wave = F.wave, ch8 = tid & 15, rg = tid >> 4;
    LAS float* RHST = (LAS float*)(F.lds + PR_RHST); LAS bf16* QB = (LAS bf16*)(F.lds + PR_QB); LAS bf16* KB = (LAS bf16*)(F.lds + PR_KB);
    LAS float* AM = (LAS float*)(F.lds + PR_AM); LAS bf16* TB = (LAS bf16*)(F.lds + PR_TB);
    LAS float* SC = (LAS float*)(F.lds + PR_SC + (par ? 1536 : 0)); LAS float *S_BETA = SC, *S_GC = SC + 64, *S_EG = SC + 128, *S_EK = SC + 192;
    const size_t blk = (size_t)(cn * 8 + h) * 64 * 128;
    PS_MARK(0);
    const float gate_rec = P.gate;
    float y[3][2][8]; int ch8v = ch8, rgv = rg; asm volatile("" : "+v"(ch8v), "+v"(rgv));
#pragma unroll
    for (int t = 0; t < 3; ++t) { const int ch = t * 1024 + h * 128 + 8 * ch8v;
        float x[5][8];
#pragma unroll
        for (int j = 0; j < 5; ++j) { const v4u w = P.raw[t][j]; x[j][0] = bflo(w.x); x[j][1] = bfhi(w.x); x[j][2] = bflo(w.y); x[j][3] = bfhi(w.y); x[j][4] = bflo(w.z); x[j][5] = bfhi(w.z); x[j][6] = bflo(w.w); x[j][7] = bfhi(w.w); }
        const LAS float* cw = (const LAS float*)(F.lds + PR_CW) + t * 512 + 8 * ch8v;
#pragma unroll
        for (int hh = 0; hh < 2; ++hh) { const f32x4 w0 = *(const LAS f32x4*)(cw + 4 * hh), w1 = *(const LAS f32x4*)(cw + 128 + 4 * hh), w2 = *(const LAS f32x4*)(cw + 256 + 4 * hh), w3 = *(const LAS f32x4*)(cw + 384 + 4 * hh);
#pragma unroll
            for (int i = 0; i < 4; ++i)
#pragma unroll
                for (int r2 = 0; r2 < 2; ++r2) { const int ii = 4 * hh + i; if (SKIP & 8) y[t][r2][ii] = x[r2 + 3][ii] + w0[i]; else y[t][r2][ii] = siluf((w0[i] * x[r2][ii] + w1[i] * x[r2 + 1][ii]) + (w2[i] * x[r2 + 2][ii] + w3[i] * x[r2 + 3][ii])); } }
        asm volatile("" ::: "memory"); }
    float rn[2][2];
#pragma unroll
    for (int t = 0; t < 2; ++t)
#pragma unroll
        for (int r2 = 0; r2 < 2; ++r2) { float s = 0.f;
#pragma unroll
            for (int i = 0; i < 8; ++i) s += y[t][r2][i] * y[t][r2][i];
            s += __shfl_xor(s, 1); s += __shfl_xor(s, 2); s += __shfl_xor(s, 4); s += __shfl_xor(s, 8);
            rn[t][r2] = __builtin_amdgcn_rsqf(s + EPS) * (t == 0 ? 0.08838834764831845f : 1.f); }
    if (tid < 256) SC[tid] = gate_rec;
    LDS_WAIT(); __builtin_amdgcn_s_barrier();
    PS_MARK(1);
    if (SKIP & 16) { asm volatile("" :: "v"(y[0][0][0]), "v"(y[1][1][7]), "v"(y[2][0][3]), "v"(rn[0][0]), "v"(rn[1][1])); } else
    { int c8 = 8 * ch8, r0 = 2 * rg; asm volatile("" : "+v"(c8), "+v"(r0));
      float be[2], eg[2], ek[2];
#pragma unroll
      for (int r2 = 0; r2 < 2; ++r2) { be[r2] = S_BETA[r0 + r2]; eg[r2] = S_EG[r0 + r2]; ek[r2] = S_EK[r0 + r2]; }
#pragma unroll
      for (int r2 = 0; r2 < 2; ++r2) { float q[8], k[8];
#pragma unroll
          for (int i = 0; i < 8; ++i) { q[i] = y[0][r2][i] * rn[0][r2]; k[i] = y[1][r2][i] * rn[1][r2]; }
          const int row = r0 + r2;
          *(LAS v4u*)(QB + row * 136 + c8) = (v4u){pk2(q[0], q[1]), pk2(q[2], q[3]), pk2(q[4], q[5]), pk2(q[6], q[7])};
          *(LAS v4u*)(KB + row * 136 + c8) = (v4u){pk2(k[0], k[1]), pk2(k[2], k[3]), pk2(k[4], k[5]), pk2(k[6], k[7])};
          if (!DRY) *(v4u*)(((bf16*)(F.ws + WS_U5)) + blk + row * 128 + c8) = (v4u){pk2(q[0] * eg[r2], q[1] * eg[r2]), pk2(q[2] * eg[r2], q[3] * eg[r2]), pk2(q[4] * eg[r2], q[5] * eg[r2]), pk2(q[6] * eg[r2], q[7] * eg[r2])};
#pragma unroll
          for (int i = 0; i < 8; ++i) {
              y[1][r2][i] = k[i] * be[r2] * eg[r2]; y[2][r2][i] = y[2][r2][i] * be[r2]; } }
#pragma unroll
      for (int i = 0; i < 8; ++i) {
          const int rs = (r0 + (c8 >> 1)) & 63;
          *(LAS f32x2*)(RHST + (c8 + i) * 68 + rs) = (f32x2){y[2][0][i], y[2][1][i]};
          *(LAS f32x2*)(RHST + (128 + c8 + i) * 68 + rs) = (f32x2){y[1][0][i], y[1][1][i]}; } }
    LDS_WAIT(); __builtin_amdgcn_s_barrier();
    PS_MARK(2);
    if (!(SKIP & 2)) { int l4 = lane; asm volatile("" : "+v"(l4)); const int ti = wave & 3, fr = l4 & 15, fq = l4 >> 4; const LAS bf16* Ab = (wave < 4 ? KB : QB) + (16 * ti + fr) * 136 + 8 * fq;
      s16x8 a[4];
#pragma unroll
      for (int s = 0; s < 4; ++s) a[s] = *(const LAS s16x8*)(Ab + 32 * s);
      LAS bf16* IL = (LAS bf16*)(F.lds + PR_IL);
#pragma unroll
      for (int tj = 0; tj < 4; ++tj) { if (wave < 4 && tj > ti) continue;
          f32x4 acc = (f32x4){0.f, 0.f, 0.f, 0.f}; const LAS bf16* Bb = KB + (16 * tj + fr) * 136 + 8 * fq;
#pragma unroll
          for (int s = 0; s < 4; ++s) { const s16x8 b = *(const LAS s16x8*)(Bb + 32 * s); acc = __builtin_amdgcn_mfma_f32_16x16x32_bf16(a[s], b, acc, 0, 0, 0); }
          const int j = 16 * tj + fr; const float gj = S_GC[j];
#pragma unroll
          for (int r = 0; r < 4; ++r) { const int i = 16 * ti + 4 * fq + r; const float dec = fexp(fminf(S_GC[i] - gj, 0.f));
              if (wave < 4) AM[i * 68 + j] = (i > j) ? -(S_BETA[i] * acc[r] * dec) : 0.f;
              else { const unsigned iv = f2bf((i >= j) ? acc[r] * dec : 0.f); IL[i * 72 + j] = (bf16)iv; } } }
      if (wave < 4) {
          LDS_WAIT(); asm volatile("" ::: "memory");
          const int j = l4 & 15; int zv = 0; asm volatile("" : "+v"(zv)); const LAS float* Ad = AM + zv + (16 * ti) * 68 + 16 * ti; float t[16];
          f32x4 ar[16][4];
#pragma unroll
          for (int i = 1; i < 16; ++i)
#pragma unroll
              for (int k4 = 0; k4 < (i + 3) / 4; ++k4) ar[i][k4] = *(const LAS f32x4*)(Ad + i * 68 + 4 * k4);
#pragma unroll
          for (int i = 0; i < 16; ++i) { float acc = (i == j) ? 1.f : 0.f;
#pragma unroll
              for (int k = 0; k < i; ++k) acc += ar[i][k >> 2][k & 3] * t[k];
              t[i] = acc; }
          if (l4 < 16) {
#pragma unroll
              for (int i = 0; i < 16; ++i) TB[(16 * ti + i) * 16 + j] = (bf16)f2bf(t[i]); } } }
    LDS_WAIT(); __builtin_amdgcn_s_barrier();
    PS_MARK(3);
    if (!(SKIP & 4)) { int l6 = lane; asm volatile("" : "+v"(l6)); const int n = l6 & 15, g = l6 >> 4; f32x4 R[4][2];
#pragma unroll
      for (int b = 0; b < 4; ++b)
#pragma unroll
          for (int nt = 0; nt < 2; ++nt) { const int col = 32 * wave + 16 * nt + n; R[b][nt] = *(const LAS f32x4*)(RHST + col * 68 + ((16 * b + 4 * g + 4 * ((col >> 3) & 15)) & 63)); }
      LDS_WAIT(); __builtin_amdgcn_s_barrier();
      const LAS bf16* tb = TB + n * 16 + 4 * g; const LAS float* am = AM + n * 68 + 4 * g;
#pragma unroll
      for (int b = 0; b < 4; ++b) {
          const u32x2 tw = *(const LAS u32x2*)(tb + (16 * b) * 16); const s16x8 ta = __builtin_bit_cast(s16x8, (v4u){tw.x, tw.y, 0u, 0u});
          s16x8 xb[2];
#pragma unroll
          for (int nt = 0; nt < 2; ++nt) { const s16x8 rb = __builtin_bit_cast(s16x8, (v4u){pk2(R[b][nt].x, R[b][nt].y), pk2(R[b][nt].z, R[b][nt].w), 0u, 0u});
              R[b][nt] = __builtin_amdgcn_mfma_f32_16x16x32_bf16(ta, rb, (f32x4){0.f, 0.f, 0.f, 0.f}, 0, 0, 0);
              xb[nt] = __builtin_bit_cast(s16x8, (v4u){pk2(R[b][nt].x, R[b][nt].y), pk2(R[b][nt].z, R[b][nt].w), 0u, 0u}); }
#pragma unroll
          for (int b2 = b + 1; b2 < 4; ++b2) { const f32x4 av = *(const LAS f32x4*)(am + (16 * b2) * 68 + 16 * b); const s16x8 aa = __builtin_bit_cast(s16x8, (v4u){pk2(av.x, av.y), pk2(av.z, av.w), 0u, 0u});
              R[b2][0] = __builtin_amdgcn_mfma_f32_16x16x32_bf16(aa, xb[0], R[b2][0], 0, 0, 0); R[b2][1] = __builtin_amdgcn_mfma_f32_16x16x32_bf16(aa, xb[1], R[b2][1], 0, 0, 0); } }
      if (wave < 4) { LAS bf16* UL = (LAS bf16*)(F.lds + PR_RHST) + (32 * wave + n) * 72 + 4 * g;
#pragma unroll
          for (int b = 0; b < 4; ++b)
#pragma unroll
              for (int nt = 0; nt < 2; ++nt) *(LAS u32x2*)(UL + nt * 16 * 72 + 16 * b) = (u32x2){pk2(R[b][nt].x, R[b][nt].y), pk2(R[b][nt].z, R[b][nt].w)}; }
      else { LAS bf16* WL = QB + (4 * g) * 136 + 32 * (wave - 4) + n;
#pragma unroll
          for (int b = 0; b < 4; ++b)
#pragma unroll
              for (int nt = 0; nt < 2; ++nt)
#pragma unroll
                  for (int r = 0; r < 4; ++r) WL[(16 * b + r) * 136 + 16 * nt] = (bf16)f2bf(-R[b][nt][r]); } }
    LDS_WAIT(); __builtin_amdgcn_s_barrier();
    PS_MARK(5);
    if (it_next >= 0) { int c9 = ch8, r9 = rg; asm volatile("" : "+v"(c9), "+v"(r9)); prep_fetch(F, it_next, c9, r9, P); }
    if (!DRY) { int t5 = tid; asm volatile("" : "+v"(t5));
#pragma unroll
        for (int i = 0; i < 2; ++i) { const int id = t5 + 512 * i, row = id >> 4, q = id & 15; *(v4u*)(((bf16*)(F.ws + WS_U1)) + blk + row * 128 + 8 * q) = *(const LAS v4u*)(QB + row * 136 + 8 * q); }
        { const int row = t5 >> 3, q = t5 & 7; *(v4u*)(((bf16*)(F.ws + WS_INTRA)) + (size_t)(cn * 8 + h) * 4096 + row * 64 + 8 * q) = *(const LAS v4u*)((LAS bf16*)(F.lds + PR_IL) + row * 72 + 8 * q); }
#pragma unroll
        for (int i = 0; i < 2; ++i) { const int id = t5 + 512 * i, row = id >> 3, q = id & 7;
            *(v4u*)(((bf16*)(F.ws + WS_U3)) + blk + row * 64 + 8 * q) = *(const LAS v4u*)((LAS bf16*)(F.lds + PR_RHST) + row * 72 + 8 * q);
            float kv[8];
#pragma unroll
            for (int j = 0; j < 8; ++j) kv[j] = bf2f(KB[(8 * q + j) * 136 + row]) * S_EK[8 * q + j];
            *(v4u*)(((bf16*)(F.ws + WS_U2)) + blk + row * 64 + 8 * q) = (v4u){pk2(kv[0], kv[1]), pk2(kv[2], kv[3]), pk2(kv[4], kv[5]), pk2(kv[6], kv[7])}; } }
    PS_MARK(6);
    LDS_WAIT();
}
typedef float f32x16 __attribute__((ext_vector_type(16)));
constexpr int SW_KS = 0, SW_VT = 27648, SW_TB = 53248;
__device__ __forceinline__ int t5_bucket(int rel) { const int n = rel < 0 ? -rel : rel;
    const int b = n < 8 ? n : n < 12 ? 8 : n < 16 ? 9 : n < 23 ? 10 : n < 32 ? 11 : n < 46 ? 12 : n < 64 ? 13 : n < 91 ? 14 : 15; return (rel > 0 ? 16 : 0) + b; }
template <bool DRY> __device__ __forceinline__ void swa_unit(Frame& F, int cn, int kh) {
    const int tid = F.tid, lane = F.lane, wave = F.wave, r32 = lane & 31, hi = lane >> 5;
    LAS bf16* KS = (LAS bf16*)(F.lds + SW_KS); LAS bf16* VT = (LAS bf16*)(F.lds + SW_VT); LAS float* TB = (LAS float*)(F.lds + SW_TB);
    const bool smp = cn >= 256; const int b = cn - 256;
#pragma unroll
    for (int it = 0; it < 3; ++it) { const int id = tid + 512 * it, row = id >> 3, dq = id & 7;
        v4u kw = (v4u){0u, 0u, 0u, 0u}, vw = kw;
        if (smp && row < 128) { const size_t so = ((size_t)(b * 128 + row) * 2 + kh) * 64 + dq * 8;
            const f32x4 k0 = *(const f32x4*)((F.in[4]) + so), k1 = *(const f32x4*)((F.in[4]) + so + 4), v0 = *(const f32x4*)((F.in[5]) + so), v1 = *(const f32x4*)((F.in[5]) + so + 4);
            kw = (v4u){pk2(k0.x, k0.y), pk2(k0.z, k0.w), pk2(k1.x, k1.y), pk2(k1.z, k1.w)}; vw = (v4u){pk2(v0.x, v0.y), pk2(v0.z, v0.w), pk2(v1.x, v1.y), pk2(v1.z, v1.w)};
            if (row >= 64 && !DRY) { float* ok = F.out + OFF_SK + (size_t)b * 16384 + (size_t)(row - 64) * 128 + kh * 64 + dq * 8; float* ov = F.out + OFF_SV + (size_t)b * 16384 + (size_t)(row - 64) * 128 + kh * 64 + dq * 8;
                *(f32x4*)ok = k0; *(f32x4*)(ok + 4) = k1; *(f32x4*)ov = v0; *(f32x4*)(ov + 4) = v1; } }
        else { const int kp = smp ? (MP + b * 64 + row - 128) : (cn * 64 - 128 + row);
            if (kp >= 0) { const bf16* src = ((bf16*)(F.ws + WS_KV)) + (size_t)kp * 256 + kh * 64 + dq * 8; kw = *(const v4u*)src; vw = *(const v4u*)(src + 128); } }
        *(LAS v4u*)(KS + row * 72 + dq * 8) = kw;
        LAS bf16* vt = VT + (dq * 8) * 200 + row;
        vt[0] = (bf16)(vw.x & 0xffffu); vt[200] = (bf16)(vw.x >> 16); vt[400] = (bf16)(vw.y & 0xffffu); vt[600] = (bf16)(vw.y >> 16);
        vt[800] = (bf16)(vw.z & 0xffffu); vt[1000] = (bf16)(vw.z >> 16); vt[1200] = (bf16)(vw.w & 0xffffu); vt[1400] = (bf16)(vw.w >> 16); }
    for (int id = tid; id < 8 * 256; id += 512) { const int hl = id >> 8, ix = id & 255; TB[id] = ix < 255 ? (F.in[18])[t5_bucket(ix - 191) * 16 + kh * 8 + hl] : 0.f; }
    __syncthreads();
    const int head = kh * 8 + wave; const float sink = (F.in[17])[head];
    bf16* Qg = ((bf16*)(F.ws + WS_U4)) + (size_t)(cn * 64) * D + head * 64;
    const LAS float* tb = TB + wave * 256;
#pragma unroll 1
    for (int qt = 0; qt < 2; ++qt) {
        s16x8 qf[4];
#pragma unroll
        for (int s = 0; s < 4; ++s) qf[s] = *(const s16x8*)(Qg + (size_t)(32 * qt + r32) * D + 16 * s + 8 * hi);
        f32x16 P[6]; const int qi = 32 * qt + r32; float mx = -INFINITY;
#pragma unroll
        for (int kt = 0; kt < 6; ++kt) { f32x16 acc = {};
#pragma unroll
            for (int s = 0; s < 4; ++s) { const s16x8 a = *(const LAS s16x8*)(KS + (32 * kt + r32) * 72 + 16 * s + 8 * hi); acc = __builtin_amdgcn_mfma_f32_32x32x16_bf16(a, qf[s], acc, 0, 0, 0); }
#pragma unroll
            for (int r = 0; r < 16; ++r) { const int j = 32 * kt + (r & 3) + 8 * (r >> 2) + 4 * hi; float l = acc[r] * 0.125f + tb[j - qi + 63];
                if (!smp && cn * 64 + j < 128) l = -INFINITY; acc[r] = l; mx = fmaxf(mx, l); }
            P[kt] = acc; asm volatile("" ::: "memory"); }
        mx = fmaxf(mx, __shfl_xor(mx, 32)); mx = fmaxf(mx, sink);
        float sum = 0.f;
#pragma unroll
        for (int kt = 0; kt < 6; ++kt)
#pragma unroll
            for (int r = 0; r < 16; ++r) { const float p = fexp(P[kt][r] - mx); P[kt][r] = p; sum += p; }
        sum += __shfl_xor(sum, 32);
        const float inv = 1.f / (sum + fexp(sink - mx));
        f32x16 O[2]; O[0] = (f32x16){}; O[1] = (f32x16){};
#pragma unroll
        for (int kt = 0; kt < 6; ++kt) {
#pragma unroll
            for (int s2 = 0; s2 < 2; ++s2) { v4u pw; pw.x = pk2(P[kt][8 * s2] * inv, P[kt][8 * s2 + 1] * inv); pw.y = pk2(P[kt][8 * s2 + 2] * inv, P[kt][8 * s2 + 3] * inv);
                pw.z = pk2(P[kt][8 * s2 + 4] * inv, P[kt][8 * s2 + 5] * inv); pw.w = pk2(P[kt][8 * s2 + 6] * inv, P[kt][8 * s2 + 7] * inv);
                const s16x8 pa = __builtin_bit_cast(s16x8, pw);
#pragma unroll
                for (int dt = 0; dt < 2; ++dt) { const LAS bf16* vp = VT + (32 * dt + r32) * 200 + 32 * kt + 16 * s2 + 4 * hi;
                    const u32x2 lo = *(const LAS u32x2*)vp, hh = *(const LAS u32x2*)(vp + 8);
                    const s16x8 vb = __builtin_bit_cast(s16x8, (v4u){lo.x, lo.y, hh.x, hh.y});
                    O[dt] = __builtin_amdgcn_mfma_f32_32x32x16_bf16(pa, vb, O[dt], 0, 0, 0); } }
            asm volatile("" ::: "memory"); }
#pragma unroll
        for (int dt = 0; dt < 2; ++dt)
#pragma unroll
            for (int r = 0; r < 16; ++r) { const int q = 32 * qt + (r & 3) + 8 * (r >> 2) + 4 * hi; const unsigned ov = f2bf(O[dt][r]); if (!DRY) Qg[(size_t)q * D + 32 * dt + r32] = (bf16)ov; else asm volatile("" :: "v"(ov)); }
    }
    __syncthreads();
}
constexpr int SC_WN = 0, SC_QP = 16384, SC_KPT = 32768, SC_IN = 49152, SC_STAGE = 57344;
template <int C, int NCHUNK> __device__ __forceinline__ void tile_rq(int lt, int i, int& row, int& q) {
    const int l = lt & 63, lw = lt >> 6, grp = l >> 4, s = NCHUNK * lw + i;
    const int rb = (C == 128) ? (s >> 1) : s, qb = (C == 128) ? 8 * (s & 1) : 0;
    row = 8 * rb + (l & 7); q = qb + 4 * (grp >> 1) + (grp & 1) + 2 * ((l >> 3) & 1);
}
template <int C, int NCHUNK> __device__ __forceinline__ void ld_tile(const bf16* src, int lt, v4u (&reg)[NCHUNK]) {
#pragma unroll
    for (int i = 0; i < NCHUNK; ++i) { int row, q; tile_rq<C, NCHUNK>(lt, i, row, q); reg[i] = *(const v4u*)(src + (size_t)row * C + 8 * q); }
}
template <int C, int NCHUNK> __device__ __forceinline__ void st_tile(LAS unsigned char* base, int lt, const v4u (&reg)[NCHUNK]) {
#pragma unroll
    for (int i = 0; i < NCHUNK; ++i) { int row, q; tile_rq<C, NCHUNK>(lt, i, row, q); const int ks = q >> 2, qq = q & 3;
        LAS unsigned char* d0 = base + ((row >> 4) * (C / 32) + ks) * 1024 + ((2 * (qq & 1)) * 16 + (row & 15)) * 16 + (qq >> 1) * 8;
        *(LAS u32x2*)d0 = (u32x2){reg[i].x, reg[i].y}; *(LAS u32x2*)(d0 + 256) = (u32x2){reg[i].z, reg[i].w}; }
}
__device__ __forceinline__ s16x8 pack_b(f32x4 a, f32x4 b) { v4u w; w.x = pk2(a.x, a.y); w.y = pk2(a.z, a.w); w.z = pk2(b.x, b.y); w.w = pk2(b.z, b.w); return __builtin_bit_cast(s16x8, w); }
#define MF16(a, b, c) __builtin_amdgcn_mfma_f32_16x16x32_bf16(a, b, c, 0, 0, 0)
template <bool DRY, int SKIP = 0> __device__ __forceinline__ void scan_task(Frame& F, int cn0, int nchunk, int h, int hf, const float* s0, float* sout, bool write_s) {
    const int lane = F.lane, wave = F.wave, e = lane & 15, g = lane >> 4;
    LAS unsigned char* ring = F.lds;
    if (wave >= 4) {
#ifndef SCAN_NO_LOADER
        const int lt = F.tid - 256; v4u rw[4], rq[4], rk[4], ri[2], sw[4], sq[4], sk[4], si[2];
#define LD_SET(cn, W, Q, K, I) do { const size_t blk_ = (size_t)((cn) * 8 + h) * 8192; ld_tile<128, 4>(((bf16*)(F.ws + WS_U1)) + blk_, lt, W); ld_tile<128, 4>(((bf16*)(F.ws + WS_U5)) + blk_, lt, Q); ld_tile<64, 4>(((bf16*)(F.ws + WS_U2)) + blk_, lt, K); ld_tile<64, 2>(((bf16*)(F.ws + WS_INTRA)) + (size_t)((cn) * 8 + h) * 4096, lt, I); } while (0)
#define ST_SET(st, W, Q, K, I) do { LAS unsigned char* b_ = ring + (st) * SC_STAGE; st_tile<128, 4>(b_ + SC_WN, lt, W); st_tile<128, 4>(b_ + SC_QP, lt, Q); st_tile<64, 4>(b_ + SC_KPT, lt, K); st_tile<64, 2>(b_ + SC_IN, lt, I); } while (0)
        if (!(SKIP & 1)) { LD_SET(cn0, rw, rq, rk, ri); ST_SET(0, rw, rq, rk, ri); if (nchunk > 1) LD_SET(cn0 + 1, sw, sq, sk, si); if (nchunk > 2) LD_SET(cn0 + 2, rw, rq, rk, ri); }
        LDS_WAIT(); __builtin_amdgcn_s_barrier();
#pragma unroll 1
        for (int n = 0; n < nchunk; ++n) {
            if (n + 1 < nchunk && !(SKIP & 1)) {
                if (n & 1) { ST_SET(0, rw, rq, rk, ri); if (n + 3 < nchunk) LD_SET(cn0 + n + 3, rw, rq, rk, ri); }
                else { ST_SET(1, sw, sq, sk, si); if (n + 3 < nchunk) LD_SET(cn0 + n + 3, sw, sq, sk, si); } }
            LDS_WAIT(); __builtin_amdgcn_s_barrier();
        }
#undef LD_SET
#undef ST_SET
#endif
    } else {
#ifndef SCAN_NO_SCAN
        const int e0 = 64 * hf + 16 * wave + e;
        f32x4 S[8];
#pragma unroll
        for (int dt = 0; dt < 8; ++dt) { const float* p = (const float*)((const char*)s0 + (size_t)((unsigned)((16 * dt + 4 * g) * 128 + e0) * 4u)); S[dt] = (f32x4){p[0], p[128], p[256], p[384]}; }
        u32x2 ucur[4], unext[4];
        { const bf16* up = ((bf16*)(F.ws + WS_U3)) + ((size_t)(cn0 * 8 + h) * 128 + e0) * 64 + 4 * g;
#pragma unroll
          for (int mt = 0; mt < 4; ++mt) ucur[mt] = *(const u32x2*)(up + 16 * mt); }
        __builtin_amdgcn_s_barrier();
#pragma unroll 1
        for (int n = 0; n < nchunk; ++n) {
            const int cn = cn0 + n; const LAS unsigned char* st = ring + (n & 1) * SC_STAGE + lane * 16;
            const float gl = ((float*)(F.ws + WS_GL))[cn * 8 + h];
            bf16* op = ((bf16*)(F.ws + WS_U3)) + ((size_t)(cn * 8 + h) * 128 + e0) * 64 + 4 * g;
            if (n + 1 < nchunk) {
#pragma unroll
                for (int mt = 0; mt < 4; ++mt) unext[mt] = *(const u32x2*)(op + 8 * 128 * 64 + 16 * mt); }
            if (SKIP & 2) { LDS_WAIT(); __builtin_amdgcn_s_barrier(); continue; }
            s16x8 Sb[4];
#pragma unroll
            for (int ks = 0; ks < 4; ++ks) Sb[ks] = pack_b(S[2 * ks], S[2 * ks + 1]);
            f32x4 Vn[4], O[4];
#pragma unroll
            for (int mt = 0; mt < 4; ++mt) { Vn[mt] = (f32x4){bflo(ucur[mt].x), bfhi(ucur[mt].x), bflo(ucur[mt].y), bfhi(ucur[mt].y)}; O[mt] = (f32x4){0.f, 0.f, 0.f, 0.f}; }
            s16x8 fa[8], fb[8];
#define FENCE() asm volatile("" ::: "memory")
#define LD_WQ(dst, mt) do { _Pragma("unroll") for (int ks = 0; ks < 4; ++ks) { dst[ks] = *(const LAS s16x8*)(st + SC_WN + ((mt) * 4 + ks) * 1024); dst[4 + ks] = *(const LAS s16x8*)(st + SC_QP + ((mt) * 4 + ks) * 1024); } } while (0)
#define MM_WQ(src, mt) do { _Pragma("unroll") for (int ks = 0; ks < 4; ++ks) { Vn[mt] = MF16(src[ks], Sb[ks], Vn[mt]); O[mt] = MF16(src[4 + ks], Sb[ks], O[mt]); } } while (0)
#define LD_4(dst, off, a) do { _Pragma("unroll") for (int i_ = 0; i_ < 4; ++i_) dst[i_] = *(const LAS s16x8*)(st + (off) + ((a) * 4 + i_) * 1024); } while (0)
#define MM_IN(src, mp) do { O[2 * (mp)] = MF16(src[0], Vb[0], O[2 * (mp)]); O[2 * (mp)] = MF16(src[1], Vb[1], O[2 * (mp)]); O[2 * (mp) + 1] = MF16(src[2], Vb[0], O[2 * (mp) + 1]); O[2 * (mp) + 1] = MF16(src[3], Vb[1], O[2 * (mp) + 1]); } while (0)
#define MM_KP(src, dp) do { S[2 * (dp)] = MF16(src[0], Vb[0], S[2 * (dp)]); S[2 * (dp)] = MF16(src[1], Vb[1], S[2 * (dp)]); S[2 * (dp) + 1] = MF16(src[2], Vb[0], S[2 * (dp) + 1]); S[2 * (dp) + 1] = MF16(src[3], Vb[1], S[2 * (dp) + 1]); } while (0)
            LD_WQ(fa, 0); FENCE(); LD_WQ(fb, 1); MM_WQ(fa, 0); FENCE(); LD_WQ(fa, 2); MM_WQ(fb, 1); FENCE(); LD_WQ(fb, 3); MM_WQ(fa, 2); FENCE(); LD_4(fa, SC_IN, 0); MM_WQ(fb, 3); FENCE();
#pragma unroll
            for (int dt = 0; dt < 8; ++dt) S[dt] = S[dt] * gl;
            s16x8 Vb[2];
#pragma unroll
            for (int k2 = 0; k2 < 2; ++k2) Vb[k2] = pack_b(Vn[2 * k2], Vn[2 * k2 + 1]);
            LD_4(fb, SC_IN, 1); MM_IN(fa, 0); FENCE(); LD_4(fa, SC_KPT, 0); MM_IN(fb, 1); FENCE(); LD_4(fb, SC_KPT, 1); MM_KP(fa, 0); FENCE(); LD_4(fa, SC_KPT, 2); MM_KP(fb, 1); FENCE(); LD_4(fb, SC_KPT, 3); MM_KP(fa, 2); FENCE(); MM_KP(fb, 3);
#undef FENCE
#undef LD_WQ
#undef MM_WQ
#undef LD_4
#undef MM_IN
#undef MM_KP
#pragma unroll
            for (int mt = 0; mt < 4; ++mt) { u32x2 w; w.x = pk2(O[mt].x, O[mt].y); w.y = pk2(O[mt].z, O[mt].w); if (!DRY) *(u32x2*)(op + 16 * mt) = w; else asm volatile("" :: "v"(w.x), "v"(w.y)); ucur[mt] = unext[mt]; }
            LDS_WAIT(); __builtin_amdgcn_s_barrier();
        }
        { unsigned so = (unsigned)((4 * g) * 128 + e0) * 4u; asm volatile("" : "+v"(so));
#pragma unroll
          for (int dt = 0; dt < 8; ++dt) { float* p = (float*)((char*)sout + (size_t)(so + dt * 8192u)); if (!DRY && write_s) { p[0] = S[dt].x; p[128] = S[dt].y; p[256] = S[dt].z; p[384] = S[dt].w; } else asm volatile("" :: "v"(S[dt].x), "v"(S[dt].y), "v"(S[dt].z), "v"(S[dt].w)); } }
#endif
    }
}

__device__ __forceinline__ void scanA_task(Frame& F, int cn0, int nchunk, int h, int hf, float* sout, bf16* mout) {
    const int lane = F.lane, wave = F.wave, e = lane & 15, g = lane >> 4;
    LAS unsigned char* ring = F.lds;
    if (wave >= 4) {
        const int lt = F.tid - 256; v4u rw[4], rk[4];
#define LD_A(cn) do { const size_t blk_ = (size_t)((cn) * 8 + h) * 8192; ld_tile<128, 4>(((bf16*)(F.ws + WS_U1)) + blk_, lt, rw); ld_tile<64, 4>(((bf16*)(F.ws + WS_U2)) + blk_, lt, rk); } while (0)
#define ST_A(st) do { LAS unsigned char* b_ = ring + (st) * SC_STAGE; st_tile<128, 4>(b_ + SC_WN, lt, rw); st_tile<64, 4>(b_ + SC_KPT, lt, rk); } while (0)
        LD_A(cn0); ST_A(0); if (nchunk > 1) LD_A(cn0 + 1);
        LDS_WAIT(); __builtin_amdgcn_s_barrier();
#pragma unroll 1
        for (int n = 0; n < nchunk; ++n) {
            if (n + 1 < nchunk) { ST_A((n + 1) & 1); if (n + 2 < nchunk) LD_A(cn0 + n + 2); }
            LDS_WAIT(); __builtin_amdgcn_s_barrier();
        }
#undef LD_A
#undef ST_A
    } else {
        const int e0 = 64 * hf + 16 * wave + e;
        f32x4 S[8], X[8];
#pragma unroll
        for (int dt = 0; dt < 8; ++dt) { S[dt] = (f32x4){0.f, 0.f, 0.f, 0.f}; const int d0 = 16 * dt + 4 * g;
            X[dt] = (f32x4){d0 == e0 ? 1.f : 0.f, d0 + 1 == e0 ? 1.f : 0.f, d0 + 2 == e0 ? 1.f : 0.f, d0 + 3 == e0 ? 1.f : 0.f}; }
        u32x2 ucur[4], unext[4];
        { const bf16* up = ((bf16*)(F.ws + WS_U3)) + ((size_t)(cn0 * 8 + h) * 128 + e0) * 64 + 4 * g;
#pragma unroll
          for (int mt = 0; mt < 4; ++mt) ucur[mt] = *(const u32x2*)(up + 16 * mt); }
        __builtin_amdgcn_s_barrier();
#pragma unroll 1
        for (int n = 0; n < nchunk; ++n) {
            const int cn = cn0 + n; const LAS unsigned char* st = ring + (n & 1) * SC_STAGE + lane * 16;
            const float gl = ((float*)(F.ws + WS_GL))[cn * 8 + h];
            const bf16* op = ((bf16*)(F.ws + WS_U3)) + ((size_t)(cn * 8 + h) * 128 + e0) * 64 + 4 * g;
            if (n + 1 < nchunk) {
#pragma unroll
                for (int mt = 0; mt < 4; ++mt) unext[mt] = *(const u32x2*)(op + 8 * 128 * 64 + 16 * mt); }
            s16x8 Sb[4], Xb[4];
#pragma unroll
            for (int ks = 0; ks < 4; ++ks) { Sb[ks] = pack_b(S[2 * ks], S[2 * ks + 1]); Xb[ks] = pack_b(X[2 * ks], X[2 * ks + 1]); }
            f32x4 Vn[4], Vx[4];
#pragma unroll
            for (int mt = 0; mt < 4; ++mt) { Vn[mt] = (f32x4){bflo(ucur[mt].x), bfhi(ucur[mt].x), bflo(ucur[mt].y), bfhi(ucur[mt].y)}; Vx[mt] = (f32x4){0.f, 0.f, 0.f, 0.f}; }
#pragma unroll
            for (int mt = 0; mt < 4; ++mt)
#pragma unroll
                for (int ks = 0; ks < 4; ++ks) { const s16x8 aw = *(const LAS s16x8*)(st + SC_WN + (mt * 4 + ks) * 1024);
                    Vn[mt] = MF16(aw, Sb[ks], Vn[mt]); Vx[mt] = MF16(aw, Xb[ks], Vx[mt]); if (ks == 3) asm volatile("" ::: "memory"); }
#pragma unroll
            for (int dt = 0; dt < 8; ++dt) { S[dt] = S[dt] * gl; X[dt] = X[dt] * gl; }
            s16x8 Vb[2], Wb[2];
#pragma unroll
            for (int k2 = 0; k2 < 2; ++k2) { Vb[k2] = pack_b(Vn[2 * k2], Vn[2 * k2 + 1]); Wb[k2] = pack_b(Vx[2 * k2], Vx[2 * k2 + 1]); }
#pragma unroll
            for (int dt = 0; dt < 8; ++dt)
#pragma unroll
                for (int k2 = 0; k2 < 2; ++k2) { const s16x8 ak = *(const LAS s16x8*)(st + SC_KPT + (dt * 2 + k2) * 1024); S[dt] = MF16(ak, Vb[k2], S[dt]); X[dt] = MF16(ak, Wb[k2], X[dt]); if (k2 == 1 && (dt & 1)) asm volatile("" ::: "memory"); }
#pragma unroll
            for (int mt = 0; mt < 4; ++mt) ucur[mt] = unext[mt];
            LDS_WAIT(); __builtin_amdgcn_s_barrier();
        }
        { unsigned so = (unsigned)((4 * g) * 128 + e0); asm volatile("" : "+v"(so));
#pragma unroll
          for (int dt = 0; dt < 8; ++dt) { float* p = sout + so + dt * 2048u; p[0] = S[dt].x; p[128] = S[dt].y; p[256] = S[dt].z; p[384] = S[dt].w;
              bf16* q = mout + so + dt * 2048u; q[0] = (bf16)f2bf(X[dt].x); q[128] = (bf16)f2bf(X[dt].y); q[256] = (bf16)f2bf(X[dt].z); q[384] = (bf16)f2bf(X[dt].w); } }
    }
}
template <int NGR, int N, int FL> __device__ __forceinline__ void scanB_step(Frame& F, int h, int cb, int rq, size_t roff, const bf16* MG, const float* SG, v4u (&rm)[3][4], f32x4 (&Bq)[3][2], f32x4 (&So)[FL][2]) {
    constexpr int J = N % 3, n = N;
    LAS unsigned char* ring = F.lds; LAS unsigned char* XB = ring + 2 * SC_STAGE; const int lane = F.lane;
    const LAS unsigned char* st = ring + (n & 1) * SC_STAGE + lane * 16;
    const LAS unsigned char* xr = XB + (((n & 1) * 2 + cb) * 4) * 1024 + lane * 16;
    s16x8 Sb[4];
#pragma unroll
    for (int ks = 0; ks < 4; ++ks) Sb[ks] = *(const LAS s16x8*)(xr + ks * 1024);
#pragma unroll
    for (int dt = 0; dt < 2; ++dt) { f32x4 acc = Bq[J][dt];
#pragma unroll
        for (int ks = 0; ks < 4; ++ks) { const s16x8 am = *(const LAS s16x8*)(st + ((2 * rq + dt) * 4 + ks) * 1024); acc = MF16(am, Sb[ks], acc); }
        So[N % FL][dt] = acc; }
    *(LAS s16x8*)(XB + (((((n + 1) & 1) * 2 + cb) * 4) + rq) * 1024 + lane * 16) = pack_b(So[N % FL][0], So[N % FL][1]);
    st_tile<128, 4>(ring + ((n + 1) & 1) * SC_STAGE, F.tid, rm[(J + 1) % 3]);
    { constexpr int nm = n + 4 < NGR ? n + 4 : NGR - 1; ld_tile<128, 4>(MG + (size_t)(nm * 8 + h) * 16384, F.tid, rm[(J + 1) % 3]); }
    { constexpr int nb = n + 3 < NGR ? n + 3 : NGR - 1; const float* bq = SG + (size_t)(nb * 8 + h) * 16384 + roff;
#pragma unroll
      for (int dt = 0; dt < 2; ++dt) { const float* p = bq + dt * 2048; Bq[J][dt] = (f32x4){p[0], p[128], p[256], p[384]}; } }
    LDS_WAIT(); __builtin_amdgcn_s_barrier();
}
template <int FL> __device__ __forceinline__ void scanB_flush(int n_first, int count, int h, size_t roff, float* SG, const f32x4 (&So)[FL][2]) {
#pragma unroll
    for (int i = 0; i < FL; ++i) if (i < count) { float* bp = SG + (size_t)((n_first + i) * 8 + h) * 16384 + roff;
#pragma unroll
        for (int dt = 0; dt < 2; ++dt) { float* p = bp + dt * 2048; p[0] = So[i][dt].x; p[128] = So[i][dt].y; p[256] = So[i][dt].z; p[384] = So[i][dt].w; } }
}
template <int NGR> __device__ __forceinline__ void scanB_task(Frame& F, int h, int cq, const bf16* MG, float* SG) {
    static_assert(NGR == 15, "pass B is written out for 15 steps");
    constexpr int FL = 8;
    const int lane = F.lane, e = lane & 15, g4 = lane >> 4, cb = F.wave & 1, rq = F.wave >> 1;
    LAS unsigned char* ring = F.lds; LAS unsigned char* XB = ring + 2 * SC_STAGE;
    const int e0 = 32 * cq + 16 * cb + e; const size_t roff = (size_t)(32 * rq + 4 * g4) * 128 + e0;
    v4u rm[3][4]; f32x4 Bq[3][2], So[FL][2];
    ld_tile<128, 4>(MG + (size_t)h * 16384, F.tid, rm[0]); st_tile<128, 4>(ring, F.tid, rm[0]);
    ld_tile<128, 4>(MG + (size_t)(1 * 8 + h) * 16384, F.tid, rm[1]);
    ld_tile<128, 4>(MG + (size_t)(2 * 8 + h) * 16384, F.tid, rm[2]);
    ld_tile<128, 4>(MG + (size_t)(3 * 8 + h) * 16384, F.tid, rm[0]);
#pragma unroll
    for (int q = 0; q < 3; ++q) { const float* bp0 = SG + (size_t)(q * 8 + h) * 16384 + roff;
#pragma unroll
        for (int dt = 0; dt < 2; ++dt) { const float* p = bp0 + dt * 2048; Bq[q][dt] = (f32x4){p[0], p[128], p[256], p[384]}; } }
    *(LAS v4u*)(XB + (cb * 4 + rq) * 1024 + lane * 16) = (v4u){0u, 0u, 0u, 0u};
    LDS_WAIT(); __builtin_amdgcn_s_barrier();
#define SB_STEP(N) scanB_step<NGR, N, FL>(F, h, cb, rq, roff, MG, SG, rm, Bq, So)
#if defined(PROBE_SB)
    const unsigned long long tq0 = __builtin_amdgcn_s_memrealtime();
#endif
    SB_STEP(0); SB_STEP(1); SB_STEP(2); SB_STEP(3); SB_STEP(4); SB_STEP(5); SB_STEP(6); SB_STEP(7);
#if defined(PROBE_SB)
    if (blockIdx.x == 0 && F.tid == 0) ((volatile LAS unsigned long long*)(F.lds + LDSCTL_OFF + 768))[13] = __builtin_amdgcn_s_memrealtime() - tq0;
#endif
    scanB_flush<FL>(0, 8, h, roff, SG, So);
    SB_STEP(8); SB_STEP(9); SB_STEP(10); SB_STEP(11); SB_STEP(12); SB_STEP(13); SB_STEP(14);
    scanB_flush<FL>(8, 7, h, roff, SG, So);
#undef SB_STEP
}
#undef MF16
constexpr int SCAN_NG = 16, SCAN_GC = 16;
constexpr size_t WS_MG = 242 * MiB, WS_SG = 246 * MiB;
__device__ __forceinline__ void scanA_phase(Frame& F) {
    const int bx = blockIdx.x; bf16* MG = (bf16*)(F.ws + WS_MG); float* SG = (float*)(F.ws + WS_SG);
    if (bx < (SCAN_NG - 1) * 16) { const int gq = bx >> 4, h = bx & 7, hf = (bx >> 3) & 1;
        scanA_task(F, gq * SCAN_GC, SCAN_GC, h, hf, SG + (size_t)(gq * 8 + h) * 16384, MG + (size_t)(gq * 8 + h) * 16384); }
    for (int t = (bx + 16) % F.G; t < 512; t += F.G) { const int b = t >> 4, h = t & 7, hf = (t >> 3) & 1;
        scan_task<false>(F, 256 + b, 1, h, hf, ((const float*)(F.in[3])) + (size_t)(b * 8 + h) * 16384, F.out + OFF_SS + (size_t)(b * 8 + h) * 16384, true); }
}
constexpr int SCANB_WGS = 32;
__device__ __forceinline__ void scanB_phase(Frame& F) { const int bx = blockIdx.x;
#if defined(PROBE_SB)
    const unsigned long long tsb0 = __builtin_amdgcn_s_memrealtime();
#endif
    for (int t = bx; t < SCANB_WGS; t += F.G) { scanB_task<SCAN_NG - 1>(F, t & 7, t >> 3, (const bf16*)(F.ws + WS_MG), (float*)(F.ws + WS_SG)); __syncthreads(); }
#if defined(PROBE_SB)
    if (bx == 0 && F.tid == 0) ((volatile LAS unsigned long long*)(F.lds + LDSCTL_OFF + 768))[PROBE_SB] = __builtin_amdgcn_s_memrealtime() - tsb0;
#endif
}
template <bool DRY, int SKIP = 0> __device__ __forceinline__ void scanC_phase(Frame& F) {
    const int bx = blockIdx.x;
    for (int t = bx; t < SCAN_NG * 16; t += F.G) { const int gq = t >> 4, h = t & 7, hf = (t >> 3) & 1;
        const float* s0 = gq == 0 ? (const float*)(F.ws + WS_CTL + 512 * 1024) : (const float*)(F.ws + WS_SG) + (size_t)((gq - 1) * 8 + h) * 16384;
        scan_task<DRY, SKIP>(F, gq * SCAN_GC, SCAN_GC, h, hf, s0, F.out + OFF_PS + (size_t)h * 16384, gq == SCAN_NG - 1); }
}
struct NgRegs { unsigned short o[16]; v4u z0, z1; };
__device__ __forceinline__ void ng_load(Frame& F, int it, int c, int eg, NgRegs& r) {
    const int cn = it >> 3, h = it & 7;
    const bf16* op = ((bf16*)(F.ws + WS_U3)) + ((size_t)(cn * 8 + h) * 128 + 16 * eg) * 64 + c;
#pragma unroll
    for (int i = 0; i < 16; ++i) r.o[i] = op[i * 64];
    const size_t ro = (size_t)(cn * 64 + c) * D + h * 128 + 16 * eg;
    r.z0 = *(const v4u*)(((bf16*)(F.ws + WS_U2)) + ro); r.z1 = *(const v4u*)(((bf16*)(F.ws + WS_U2)) + ro + 8);
}
__device__ __forceinline__ void normgate_phase(Frame& F) {
    const int tid = F.tid, c = tid & 63, eg = F.wave; LAS float* red = (LAS float*)F.lds;
    int it = F.vcu; if (it >= NCH * 8) return;
    NgRegs cur, nxt; ng_load(F, it, c, eg, cur); int par = 0;
    const float* nw = (F.in[16]) + 16 * eg;
#pragma unroll 1
    for (; it < NCH * 8; it += F.G) {
        const bool has_next = it + F.G < NCH * 8;
        if (has_next) ng_load(F, it + F.G, c, eg, nxt);
        float o[16]; float ss = 0.f;
#pragma unroll
        for (int i = 0; i < 16; ++i) { o[i] = bf2f(cur.o[i]); ss += o[i] * o[i]; }
        LAS float* rd = red + par * 512; rd[eg * 64 + c] = ss;
        __syncthreads();
        float tot = 0.f;
#pragma unroll
        for (int w = 0; w < 8; ++w) tot += rd[w * 64 + c];
        const float ri = __builtin_amdgcn_rsqf(tot * (1.f / 128.f) + EPS);
        const unsigned zz[8] = {cur.z0.x, cur.z0.y, cur.z0.z, cur.z0.w, cur.z1.x, cur.z1.y, cur.z1.z, cur.z1.w}; unsigned w[8];
#pragma unroll
        for (int i = 0; i < 8; ++i) w[i] = pk2(o[2 * i] * ri * nw[2 * i] * siluf(bflo(zz[i])), o[2 * i + 1] * ri * nw[2 * i + 1] * siluf(bfhi(zz[i])));
        const int cn = it >> 3, h = it & 7;
        bf16* dst = ((bf16*)(F.ws + WS_U1)) + (size_t)(cn * 64 + c) * D + h * 128 + 16 * eg;
        *(v4u*)dst = (v4u){w[0], w[1], w[2], w[3]}; *(v4u*)(dst + 8) = (v4u){w[4], w[5], w[6], w[7]};
        cur = nxt; par ^= 1;
    }
}
#ifndef PREP_STAGGER
#define PREP_STAGGER 3
#endif
#ifndef PREP_DROP
#define PREP_DROP 2
#endif
__device__ __forceinline__ int prep_unit_id(const Frame& F, int i) {
    if (F.G != 256) { const long it = (long)F.vcu + (long)i * F.G; return it < NCH * 8 ? (int)it : -1; }
    const int v = F.vcu;
    if (v < 64) return i < 9 - PREP_DROP ? v + 256 * i : -1;
    if (i < 9) return v + 256 * i;
    const int e = (v - 64) >> 3;
    return (i == 9 && e < 8 * PREP_DROP) ? 8 * (e & 7) + (v & 7) + 256 * (9 - PREP_DROP + (e >> 3)) : -1;
}
#ifndef CONV1_H2
#define CONV1_H2 0
#endif
#ifndef PROBE_AMP
#define PROBE_AMP 1
#endif
#ifndef ADA_NA
#define ADA_NA 5
#endif
enum Phase { PH_P0 = 0, PH_H1, PH_G1, PH_G2, PH_H2, PH_F1, PH_PREP, PH_SCAN, PH_SCANB, PH_SCANC, PH_F2, PH_NG, PH_G4A, PH_G4B, PH_G5, PH_H3, PH_G6, PH_G7, PH_FIN, PH_COUNT };
struct Args { const float* in[28]; float* out; unsigned char* ws; int ph_lo, ph_hi; };
static_assert(sizeof(Args) == 28 * 8 + 8 + 8 + 8, "Args has no padding");

#ifdef ONLY_PH
#define PHON(x) ((x) == ONLY_PH)
#else
#define PHON(x) true
#endif
template <class Epi> __device__ __forceinline__ void run_gemm(Frame& F, const bf16* A, const bf16* Bt, int N, int K, const Epi& E, int lda = 0) {
    pg8::Gemm g{A, Bt, M, N, K, lda}; pg8::StaticOrder S; S.init(M, N, F.G, (int)blockIdx.x); S.ntf = K / 64;
    pg8::gemm_phase<Epi, pg8::StaticOrder, PG8_ALIGN, PG8_SP2>(F.lds, g, S, E);
}

struct SplitOrder : pg8::StaticOrder {
    bool split; int probe2 = 0; bool only_first = false;
    __device__ __forceinline__ bool next(int i, pg8::Unit& u) const {
        if (!split) return pg8::StaticOrder::next(i, u);
        if (only_first && i > 0) return false;
        if (probe2) { if (i > 0) return false; i = 1; }
        if (i > 1) return false;
        const int x = c & 7, j = c >> 3;
        if (i == 0) { u.pm = 8 * x + (j & 7); u.pn = j >> 3; u.k0 = 0; u.nt = ntf; u.piece = 0; u.lidx = 0; return true; }
        const int P = 8, pc = x, pairs = ntf / 2, base = pairs / P, extra = pairs - base * P;
        u.pm = 64 + (j & 7); u.pn = j >> 3; u.lidx = (j & 7) * 4 + (j >> 3);
        u.k0 = 2 * (pc * base + (pc < extra ? pc : extra)); u.nt = 2 * (base + (pc < extra ? 1 : 0)); u.piece = pc + 1; if (probe2 == 2) u.nt = 2; return true;
    }
};
struct PiecesAB : pg8::StaticOrder {
    __device__ __forceinline__ bool next(int i, pg8::Unit& u) const {
        if (i > 0) return false;
        const int x = c & 7, j = c >> 3;
        u.pm = 64 + (j & 7); u.pn = j >> 3; u.lidx = (j & 7) * 4 + (j >> 3); u.k0 = 4 * (x & 3); u.nt = 4; u.piece = x + 1; return true;
    }
};
__device__ __forceinline__ void branch_fixup_rows(Frame& F, const bf16* part) {
    const int gw = F.vcu * NWAVES + F.wave, NGW = F.G * NWAVES;
    for (int m = MP + gw; m < M; m += NGW) {
        GAS u32x2* ga = (GAS u32x2*)(((bf16*)(F.ws + WS_U5)) + (size_t)m * D) + F.lane; const GAS u32x2* gb = (const GAS u32x2*)(((bf16*)(F.ws + WS_U6)) + (size_t)m * D) + F.lane;
#pragma unroll
        for (int j = 0; j < 4; ++j) { const int li = ((m >> 8) - 64) * 4 + j;
            const GAS u32x2* pp = (const GAS u32x2*)(part + (size_t)li * 8 * 65536 + (size_t)(m & 255) * 256) + F.lane; f32x4 sa = (f32x4){0.f, 0.f, 0.f, 0.f}, sb = sa;
#pragma unroll
            for (int p = 0; p < 4; ++p) { const u32x2 w = pp[(size_t)p * 16384]; sa += (f32x4){bflo(w.x), bfhi(w.x), bflo(w.y), bfhi(w.y)}; }
#pragma unroll
            for (int p = 4; p < 8; ++p) { const u32x2 w = pp[(size_t)p * 16384]; sb += (f32x4){bflo(w.x), bfhi(w.x), bflo(w.y), bfhi(w.y)}; }
            const u32x2 a = ga[64 * j], b = gb[64 * j];
            const f32x4 o = (f32x4){sigm(bflo(a.x)) * sa.x + sigm(bflo(b.x)) * sb.x, sigm(bfhi(a.x)) * sa.y + sigm(bfhi(b.x)) * sb.y, sigm(bflo(a.y)) * sa.z + sigm(bflo(b.y)) * sb.z, sigm(bfhi(a.y)) * sa.w + sigm(bfhi(b.y)) * sb.w};
            ga[64 * j] = (u32x2){pk2(o.x, o.y), pk2(o.z, o.w)}; }
    }
}
template <class Epi> __device__ __forceinline__ void run_gemm_split(Frame& F, const bf16* A, const bf16* Bt, int N, int K, const Epi& E, int probe = 0) {
    pg8::Gemm g{A, Bt, M, N, K, 0}; SplitOrder S; S.init(M, N, F.G, (int)blockIdx.x); S.ntf = K / 64; S.split = (F.G == 256); S.only_first = (probe == 2); S.probe2 = probe >= 3 ? probe - 2 : 0;
    pg8::gemm_phase<Epi, SplitOrder, PG8_ALIGN, PG8_SP2>(F.lds, g, S, E);
}
__global__ void __launch_bounds__(NWAVES * 64, 2) mega_fwd(Args args) {
    extern __shared__ __attribute__((aligned(16))) unsigned char lds[];
    Frame F;
    F.lds = (LAS unsigned char*)lds; F.MISC = (volatile LAS unsigned*)(F.lds + MISC_OFF);
    F.tid = threadIdx.x; F.lane = F.tid & 63; F.wave = __builtin_amdgcn_readfirstlane(F.tid >> 6);
    F.G = gridDim.x; { const int bx = blockIdx.x; F.vcu = (F.G % 8 == 0) ? (bx % 8) * (F.G / 8) + bx / 8 : bx; }
    unsigned char* ws = args.ws; F.ctl = (gu32*)(ws + WS_CTL);
    F.in = args.in; F.out = args.out; F.ws = ws;
    for (int u = F.tid; u < (LDS_BYTES - LDSCTL_OFF) / 4; u += NWAVES * 64) ((LAS unsigned*)(F.lds + LDSCTL_OFF))[u] = 0u;
    __syncthreads();
    XcdBarrier bar; bar.bar = (unsigned*)(F.ctl + CW_BAR); bar.x = 0; bar.st = nullptr;
    const bool multi = args.ph_hi - args.ph_lo > 1;
    if (multi) bar = xcd_barrier_post((unsigned*)(F.ctl + CW_BAR), F.MISC + 8);

    const int lo = args.ph_lo, hi = args.ph_hi;
#if defined(PROBE_TS)
    if (blockIdx.x == 0 && F.tid == 0) ((volatile LAS unsigned long long*)(F.lds + LDSCTL_OFF + 512))[0] = __builtin_amdgcn_s_memrealtime();
#endif
#define IN(k) (PHON(k) && lo <= (k) && (k) < hi)
#define SEAM(k) do { if (lo <= (k) && (k) + 1 < hi) xcd_barrier(bar); } while (0)
#if defined(PROBE_TS)
#undef SEAM
#define SEAM(k) do { if (lo <= (k) && (k) + 1 < hi) xcd_barrier(bar); if (blockIdx.x == 0 && F.tid == 0) ((volatile LAS unsigned long long*)(F.lds + LDSCTL_OFF + 512))[(k) + 1] = __builtin_amdgcn_s_memrealtime(); } while (0)
#endif
#if defined(PROBE_P0)
    if (IN(PH_P0)) { { { const bool sp = F.G >= 160; const int nB = sp ? (4224 - 144 * ADA_NA + F.G - 145) / (F.G - 144) : (4224 + F.G - 1) / F.G; const int tlo = !sp ? F.vcu * nB : F.vcu < 144 ? F.vcu * ADA_NA : 144 * ADA_NA + (F.vcu - 144) * nB; const int thi = tlo + ((sp && F.vcu < 144) ? ADA_NA : nB);
        for (int it = F.vcu; it < 144; it += F.G) ada_item(F, it); convert_ffn_range(F, (F.in[9]), (F.in[10]), ((bf16*)(F.ws + WS_W)) + W_FIN, ((bf16*)(F.ws + WS_W)) + W_FOUT, tlo, thi); } }  xcd_barrier(bar); }
#endif
    if (IN(PH_P0)) { { { const bool sp = F.G >= 160; const int nB = sp ? (4224 - 144 * ADA_NA + F.G - 145) / (F.G - 144) : (4224 + F.G - 1) / F.G; const int tlo = !sp ? F.vcu * nB : F.vcu < 144 ? F.vcu * ADA_NA : 144 * ADA_NA + (F.vcu - 144) * nB; const int thi = tlo + ((sp && F.vcu < 144) ? ADA_NA : nB);
        for (int it = F.vcu; it < 144; it += F.G) ada_item(F, it); convert_ffn_range(F, (F.in[9]), (F.in[10]), ((bf16*)(F.ws + WS_W)) + W_FIN, ((bf16*)(F.ws + WS_W)) + W_FOUT, tlo, thi); } } }
    SEAM(PH_P0);
#if defined(PROBE_H1)
#if defined(PROBE_BAR)
    if (IN(PH_H1)) { for (int i_ = 0; i_ < 10; ++i_) xcd_barrier(bar); }
#endif
    if (IN(PH_H1)) { rmsmod_rows<false>(F, true, (F.in[8]), 0, ((bf16*)(F.ws + WS_U1)));  xcd_barrier(bar); }
#endif
    if (IN(PH_H1)) { if (F.G == 256) rmsmod_rows_256<false, true, false, false, 4>(F, (F.in[8]), 0, ((bf16*)(F.ws + WS_U1)), Leftover{nullptr, false, 0, 0.f}, D); else rmsmod_rows<false>(F, true, (F.in[8]), 0, ((bf16*)(F.ws + WS_U1))); }
    SEAM(PH_H1);
#if defined(PROBE_G1)
    if (IN(PH_G1)) { run_gemm(F, ((bf16*)(F.ws + WS_U1)), ((bf16*)(F.ws + WS_W)) + W_FIN, 2 * DFF, D, EpiSwiglu{((bf16*)(F.ws + WS_U2))});  xcd_barrier(bar); }
#endif
    if (IN(PH_G1)) { run_gemm(F, ((bf16*)(F.ws + WS_U1)), ((bf16*)(F.ws + WS_W)) + W_FIN, 2 * DFF, D, EpiSwiglu{((bf16*)(F.ws + WS_U2))}); }
    SEAM(PH_G1);
#if defined(PROBE_G2)
    if (IN(PH_G2)) { run_gemm_split(F, ((bf16*)(F.ws + WS_U2)), ((bf16*)(F.ws + WS_W)) + W_FOUT, D, DFF, EpiResid<true>{(F.in[0]), (F.in[1]), (bf16*)F.out, ((float*)(F.ws + WS_ADA)), 2, 0.5f, (bf16*)(F.ws + WS_U5)}, PROBE_G2);  xcd_barrier(bar); }
#endif
    if (IN(PH_G2)) { run_gemm_split(F, ((bf16*)(F.ws + WS_U2)), ((bf16*)(F.ws + WS_W)) + W_FOUT, D, DFF, EpiResid<true>{(F.in[0]), (F.in[1]), (bf16*)F.out, ((float*)(F.ws + WS_ADA)), 2, 0.5f, (bf16*)(F.ws + WS_U5)}); }
    SEAM(PH_G2);
#if defined(PROBE_H2)
    if (IN(PH_H2)) { { if (PROBE_H2 & 1) convert_mixer(F, 0, F.vcu * NWAVES + F.wave, F.G * NWAVES); __syncthreads(); if (PROBE_H2 & 2) rmsmod_rows<true>(F, false, (F.in[11]), 1, (bf16*)F.out + 1024, Leftover{F.G == 256 ? (const bf16*)(F.ws + WS_U5) : nullptr, true, 2, 0.5f}, 2048); if (PROBE_H2 & 4) rmsmod_rows<false>(F, false, (F.in[11]), 1, (bf16*)F.out + 1024, Leftover{F.G == 256 ? (const bf16*)(F.ws + WS_U5) : nullptr, true, 2, 0.5f}, 2048); }  xcd_barrier(bar); }
#endif
    if (IN(PH_H2)) { { convert_mixer(F, 0, F.vcu * NWAVES + F.wave, F.G * NWAVES); if (F.G != 256 || CONV1_H2) convert_mixer(F, 1, F.vcu * NWAVES + F.wave, F.G * NWAVES); __syncthreads(); if (F.G == 256) rmsmod_rows_256<true, false, true, true, 4>(F, (F.in[11]), 1, (bf16*)F.out + 1024, Leftover{(const bf16*)(F.ws + WS_U5), true, 2, 0.5f}, 2048); else rmsmod_rows<true>(F, false, (F.in[11]), 1, (bf16*)F.out + 1024, Leftover{nullptr, true, 2, 0.5f}, 2048); } }
    SEAM(PH_H2);
#if defined(PROBE_F1)
    if (IN(PH_F1)) { run_gemm(F, (bf16*)F.out + 1024, ((bf16*)(F.ws + WS_W)) + W_IN, 4352, D, EpiF1{((bf16*)(F.ws + WS_U1)), ((bf16*)(F.ws + WS_U2)), ((bf16*)(F.ws + WS_U3)), ((bf16*)(F.ws + WS_U4)), ((bf16*)(F.ws + WS_KV)), ((bf16*)(F.ws + WS_TAIL)), F.out}, 2048);  xcd_barrier(bar); }
#endif
    if (IN(PH_F1)) { run_gemm(F, (bf16*)F.out + 1024, ((bf16*)(F.ws + WS_W)) + W_IN, 4352, D, EpiF1{((bf16*)(F.ws + WS_U1)), ((bf16*)(F.ws + WS_U2)), ((bf16*)(F.ws + WS_U3)), ((bf16*)(F.ws + WS_U4)), ((bf16*)(F.ws + WS_KV)), ((bf16*)(F.ws + WS_TAIL)), F.out}, 2048); }
    SEAM(PH_F1);
#if defined(PROBE_PREP)
    if (IN(PH_PREP)) { PrepRegs PR; int it = F.vcu; if (it < NCH * 8) prep_fetch(F, it, F.tid & 15, F.tid >> 4, PR); for (int par = 0; it < NCH * 8; it += F.G, par ^= 1) gdn_prep_unit<true, PROBE_PREP>(F, it >> 3, it & 7, PR, it + F.G < NCH * 8 ? it + F.G : -1, par); xcd_barrier(bar); }
#endif
#if defined(PROBE_SWA)
    if (IN(PH_PREP)) { for (int it = F.vcu; it < NCH * 2; it += F.G) swa_unit<true>(F, it >> 1, it & 1); xcd_barrier(bar); }
#endif
    if (IN(PH_PREP)) {
                        const int nsw0 = (F.G == 256) ? ((F.vcu >> 3) % PREP_STAGGER) : 0;
#ifndef NO_SWA
                        for (int k = 0; k < nsw0; ++k) { const int it = F.vcu + k * F.G; if (it < NCH * 2) swa_unit<false>(F, it >> 1, it & 1); }
#endif
#ifndef NO_PREP
                        for (int k = F.wave; prep_unit_id(F, k) >= 0; k += NWAVES) prep_gates(F, prep_unit_id(F, k), F.lane);
                        for (int i = F.tid; i < 12 * 128; i += NWAVES * 64) { const int tj = i >> 7, cc = i & 127; ((LAS float*)(F.lds + PR_CW))[i] = (F.in[13])[(tj & 3) * 3072 + (tj >> 2) * 1024 + (F.vcu & 7) * 128 + cc]; }
                        asm volatile("s_waitcnt vmcnt(0)" ::: "memory"); __syncthreads();
#if defined(PROBE_PS)
                        if (blockIdx.x == 0 && F.tid == 0) ((volatile LAS unsigned long long*)(F.lds + LDSCTL_OFF + 768))[15] = __builtin_amdgcn_s_memrealtime();
#endif
                        { PrepRegs PR; int it = prep_unit_id(F, 0); if (it >= 0) prep_fetch(F, it, F.tid & 15, F.tid >> 4, PR);
                          for (int i = 0; it >= 0; ++i) { const int itn = prep_unit_id(F, i + 1); gdn_prep_unit<false>(F, it >> 3, it & 7, PR, itn, i & 1); it = itn; } }
#endif
#ifndef NO_SWA
                        for (int it = F.vcu + nsw0 * F.G; it < NCH * 2; it += F.G) swa_unit<false>(F, it >> 1, it & 1);
#endif
                      }
    SEAM(PH_PREP);
#if defined(PROBE_SCANA)
    if (IN(PH_SCAN)) { scanA_phase(F); xcd_barrier(bar); }
#endif
    if (IN(PH_SCAN)) { scanA_phase(F); }
    SEAM(PH_SCAN);
    if (IN(PH_SCANB)) { scanB_phase(F); if (F.G == 256 && !CONV1_H2 && blockIdx.x >= SCANB_WGS) convert_mixer(F, 1, ((int)blockIdx.x - SCANB_WGS) * NWAVES + F.wave, (256 - SCANB_WGS) * NWAVES); }
    SEAM(PH_SCANB);
#if defined(PROBE_SCANC)
    if (IN(PH_SCANC)) { scanC_phase<true, PROBE_SCANC>(F); xcd_barrier(bar); }
#endif
    if (IN(PH_SCANC)) { scanC_phase<false>(F); }
    SEAM(PH_SCANC);
#if defined(PROBE_F2)
    if (IN(PH_F2)) { run_gemm(F, (bf16*)F.out + 1024, ((bf16*)(F.ws + WS_W)) + W_IN + (size_t)4352 * D, 3072, D, EpiF2{((bf16*)(F.ws + WS_U2)), ((bf16*)(F.ws + WS_U5)), ((bf16*)(F.ws + WS_U6))}, 2048);  xcd_barrier(bar); }
#endif
    if (IN(PH_F2)) { run_gemm(F, (bf16*)F.out + 1024, ((bf16*)(F.ws + WS_W)) + W_IN + (size_t)4352 * D, 3072, D, EpiF2{((bf16*)(F.ws + WS_U2)), ((bf16*)(F.ws + WS_U5)), ((bf16*)(F.ws + WS_U6))}, 2048);  if (F.G == 256 && blockIdx.x >= 96) { __syncthreads(); convert_ffn(F, (F.in[23]), (F.in[24]), (bf16*)(F.ws + WS_MG), nullptr, ((int)blockIdx.x - 96) * NWAVES + F.wave, 160 * NWAVES); } }
    SEAM(PH_F2);
#if defined(PROBE_NG)
    if (IN(PH_NG)) { normgate_phase(F);  xcd_barrier(bar); }
#endif
    if (IN(PH_NG)) { normgate_phase(F); }
    SEAM(PH_NG);
    if (IN(PH_G4A)) { if (F.G == 256) run_gemm_split(F, ((bf16*)(F.ws + WS_U1)), ((bf16*)(F.ws + WS_W)) + W_A, D, D, EpiGate<0>{((bf16*)(F.ws + WS_U5)), nullptr}, 2);
                      else run_gemm(F, ((bf16*)(F.ws + WS_U1)), ((bf16*)(F.ws + WS_W)) + W_A, D, D, EpiGate<0>{((bf16*)(F.ws + WS_U5)), nullptr}); }
    SEAM(PH_G4A);
    if (IN(PH_G4B)) { if (F.G == 256) { run_gemm_split(F, ((bf16*)(F.ws + WS_U4)), ((bf16*)(F.ws + WS_W)) + W_B, D, D, EpiGate<1>{((bf16*)(F.ws + WS_U5)), ((bf16*)(F.ws + WS_U6))}, 2);
                          const bool sb_ = ((blockIdx.x & 7) >> 2) != 0;
                          pg8::Gemm g{sb_ ? ((const bf16*)(F.ws + WS_U4)) : ((const bf16*)(F.ws + WS_U1)), ((const bf16*)(F.ws + WS_W)) + (sb_ ? W_B : W_A), M, D, D, 0}; PiecesAB S; S.init(M, D, F.G, (int)blockIdx.x); S.ntf = 16;
                          pg8::gemm_phase<EpiPart, PiecesAB, PG8_ALIGN, PG8_SP2>(F.lds, g, S, EpiPart{(bf16*)(F.ws + WS_U2)}); }
                      else run_gemm(F, ((bf16*)(F.ws + WS_U4)), ((bf16*)(F.ws + WS_W)) + W_B, D, D, EpiGate<1>{((bf16*)(F.ws + WS_U5)), ((bf16*)(F.ws + WS_U6))}); }
    SEAM(PH_G4B);
    if (IN(PH_G5) && F.G == 256) { branch_fixup_rows(F, (const bf16*)(F.ws + WS_U2)); xcd_barrier(bar); }
    if (IN(PH_G5)) { run_gemm_split(F, ((bf16*)(F.ws + WS_U5)), ((bf16*)(F.ws + WS_W)) + W_O, D, D, EpiResid<false>{nullptr, nullptr, (bf16*)F.out, ((float*)(F.ws + WS_ADA)), 5, 1.0f, (bf16*)(F.ws + WS_U2)}); }
    SEAM(PH_G5);
#if defined(PROBE_H3)
    if (IN(PH_H3)) { { convert_ffn(F, (F.in[23]), (F.in[24]), F.G == 256 ? nullptr : (bf16*)(F.ws + WS_MG), ((bf16*)(F.ws + WS_W)) + W_FOUT, F.vcu * NWAVES + F.wave, F.G * NWAVES); rmsmod_rows<false>(F, false, (F.in[22]), 2, ((bf16*)(F.ws + WS_U1)), Leftover{F.G == 256 ? (const bf16*)(F.ws + WS_U2) : nullptr, false, 5, 1.0f}); }  xcd_barrier(bar); }
#endif
    if (IN(PH_H3)) { { convert_ffn(F, (F.in[23]), (F.in[24]), F.G == 256 ? nullptr : (bf16*)(F.ws + WS_MG), ((bf16*)(F.ws + WS_W)) + W_FOUT, F.vcu * NWAVES + F.wave, F.G * NWAVES); if (F.G == 256) rmsmod_rows_256<false, false, true, false, 8>(F, (F.in[22]), 2, ((bf16*)(F.ws + WS_U1)), Leftover{(const bf16*)(F.ws + WS_U2), false, 5, 1.0f}, D); else rmsmod_rows<false>(F, false, (F.in[22]), 2, ((bf16*)(F.ws + WS_U1)), Leftover{nullptr, false, 5, 1.0f}); } }
    SEAM(PH_H3);
#if defined(PROBE_G6)
    if (IN(PH_G6)) { run_gemm(F, ((bf16*)(F.ws + WS_U1)), ((bf16*)(F.ws + WS_W)) + W_FIN, 2 * DFF, D, EpiSwiglu{((bf16*)(F.ws + WS_U2))});  xcd_barrier(bar); }
#endif
    if (IN(PH_G6)) { run_gemm(F, ((bf16*)(F.ws + WS_U1)), (const bf16*)(F.ws + WS_MG), 2 * DFF, D, EpiSwiglu{((bf16*)(F.ws + WS_U2))}); }
    SEAM(PH_G6);
    if (IN(PH_G7)) { run_gemm_split(F, ((bf16*)(F.ws + WS_U2)), ((bf16*)(F.ws + WS_W)) + W_FOUT, D, DFF, EpiResid<false>{nullptr, nullptr, (bf16*)F.out, ((float*)(F.ws + WS_ADA)), 8, 0.5f, (bf16*)(F.ws + WS_U5)}); }
    SEAM(PH_G7);
    if (IN(PH_FIN)) { if (F.G == 256) final_norm_rows_256<8>(F, Leftover{(const bf16*)(F.ws + WS_U5), false, 8, 0.5f}); else final_norm_rows(F, Leftover{nullptr, false, 8, 0.5f}); }
    SEAM(PH_FIN);
#if defined(PROBE_TS)
    if (blockIdx.x == 0 && F.tid == 0) { volatile LAS unsigned long long* ts = (volatile LAS unsigned long long*)(F.lds + LDSCTL_OFF + 512); unsigned long long tot = 0;
        for (int k = 0; k < PH_COUNT; ++k) if ((PROBE_TS >> k) & 1) tot += ts[k + 1] - ts[k];
#if defined(PROBE_PS)
        tot += ((volatile LAS unsigned long long*)(F.lds + LDSCTL_OFF + 768))[PROBE_PS];
#endif
        tot *= PROBE_AMP;
        const unsigned long long t0 = __builtin_amdgcn_s_memrealtime(); while (__builtin_amdgcn_s_memrealtime() - t0 < tot) __builtin_amdgcn_s_sleep(8); }
#endif
#undef IN
#undef SEAM
}

extern "C" void kernel_launch(void* const* d_in, const int* in_sizes, int n_in, void* d_out, int out_size, void* d_ws, size_t ws_size, hipStream_t stream) {
    static int grid = 0;
    if (grid == 0) {
        if (n_in != 28 || in_sizes[0] != MP * D || (size_t)out_size != OUT_TOTAL || ws_size < WS_END) { fprintf(stderr, "kernel_launch: unexpected shapes (n_in %d, in0 %d, out %d, ws %zu); nothing launched\n", n_in, n_in > 0 ? in_sizes[0] : -1, out_size, ws_size); grid = -1; return; }
        int dev = 0, cus = 0, per_cu = 0;
        if (hipGetDevice(&dev) != hipSuccess || hipDeviceGetAttribute(&cus, hipDeviceAttributeMultiprocessorCount, dev) != hipSuccess) { grid = -1; return; }
        if (hipFuncSetAttribute((const void*)mega_fwd, hipFuncAttributeMaxDynamicSharedMemorySize, LDS_BYTES) != hipSuccess) { fprintf(stderr, "kernel_launch: hipFuncSetAttribute failed\n"); grid = -1; return; }
        if (hipOccupancyMaxActiveBlocksPerMultiprocessor(&per_cu, (const void*)mega_fwd, NWAVES * 64, LDS_BYTES) != hipSuccess || per_cu < 1) fprintf(stderr, "kernel_launch: occupancy query reports %d\n", per_cu);
        (void)hipGetLastError();
        grid = cus;
    }
    if (grid < 0) return;
    if (hipMemsetAsync((char*)d_ws + WS_CTL, 0, CTL_ZERO_BYTES, stream) != hipSuccess) return;
    Args a{};
    for (int i = 0; i < 28; ++i) a.in[i] = (const float*)d_in[i];
    a.out = (float*)d_out; a.ws = (unsigned char*)d_ws;
#if MK_PER_PHASE
    for (int ph = 0; ph < PH_COUNT; ++ph) { a.ph_lo = ph; a.ph_hi = ph + 1; hipLaunchKernelGGL(mega_fwd, dim3(grid), dim3(NWAVES * 64), LDS_BYTES, stream, a); }
#else
    a.ph_lo = 0; a.ph_hi = PH_COUNT; hipLaunchKernelGGL(mega_fwd, dim3(grid), dim3(NWAVES * 64), LDS_BYTES, stream, a);
#endif
    const hipError_t le = hipPeekAtLastError();
    if (le != hipSuccess) fprintf(stderr, "kernel_launch: launch failed: %s\n", hipGetErrorName(le));
}
```

```cpp
#include <hip/hip_runtime.h>
#include <cstdio>
#include <cstdint>
namespace pg8 {
#define PG8_LAS __attribute__((address_space(3)))
typedef unsigned short bf16_t;
typedef short bf16x8 __attribute__((ext_vector_type(8)));
typedef float f32x4 __attribute__((ext_vector_type(4)));
typedef unsigned u32x4 __attribute__((ext_vector_type(4)));
constexpr int BM = 256, BK = 64, HALF = 128, HTB = HALF * BK * 2  , STAGE_BYTES = 8 * HTB, NXCD = 8, WGM = 8;

__host__ __device__ __forceinline__ int lds_byte(int r, int c) { const int st = (r >> 4) * 2 + (c >> 5), rr = r & 15, cc = c & 31, ob = rr * 64 + cc * 2; return st * 1024 + (ob ^ (((ob >> 9) & 1) << 5)); }
__host__ __device__ __forceinline__ void stage_rc(int b, int& R, int& C) { const int st = b / 1024, sb = b % 1024, swz = sb ^ (((sb >> 9) & 1) << 5); R = (st >> 1) * 16 + swz / 64; C = (st & 1) * 32 + (swz % 64) / 2; }
__host__ __device__ __forceinline__ int perm32(int rho) { const int n = rho >> 4, i = rho & 15; return 8 * (i >> 2) + 4 * n + (i & 3); }

struct Unit { int pm, pn, k0, nt, piece, lidx; };
struct Gemm { const bf16_t* A; const bf16_t* Bt; int M, N, K; int lda; };

struct StaticOrder {
    int nM, nN, nwg, G, c, ntf;
    __host__ __device__ void init(int M, int N, int G_, int c_) { nM = M / BM; nN = N / BM; nwg = nM * nN; G = G_; c = c_; }
    __host__ __device__ bool next(int i, Unit& u) const {
        const long L = (long)i * G + c; if (L >= nwg) return false;
        int wgid = (int)L; { const int q = nwg / NXCD, r = nwg % NXCD, xcd = wgid % NXCD, off = wgid / NXCD; wgid = (xcd < r ? xcd * (q + 1) : r * (q + 1) + (xcd - r) * q) + off; }
        const int nig = WGM * nN, gid = wgid / nig, fm = gid * WGM, gsz = (nM - fm) < WGM ? (nM - fm) : WGM;
        u.pm = fm + ((wgid % nig) % gsz); u.pn = (wgid % nig) / gsz; u.k0 = 0; u.nt = ntf; u.piece = 0; u.lidx = 0; return true;
    }
    __device__ __forceinline__ void a_ready(const Unit&) const {}
    __device__ __forceinline__ void done(const Unit&) const {}
};

__device__ __forceinline__ unsigned cvt_pk_bf16(float lo, float hi) { unsigned r; asm volatile("v_cvt_pk_bf16_f32 %0, %1, %2" : "=v"(r) : "v"(lo), "v"(hi)); return r; }

template <class Epi, class Sched, bool ALIGN_EPI = false, bool SP2 = false>
__device__ __forceinline__ void gemm_phase(PG8_LAS unsigned char* lds, const Gemm g, const Sched& S, const Epi& E) {
    const int tid = threadIdx.x, wid = __builtin_amdgcn_readfirstlane(tid >> 6), lane = tid & 63, wr = wid >> 2, wc = wid & 3, fr = lane & 15, fq = lane >> 4;
    const int K = g.K, lda = g.lda ? g.lda : g.K;
    unsigned voffA[2], voffB[2];
#pragma unroll
    for (int i = 0; i < 2; ++i) { int R, C; stage_rc(tid * 16 + i * 8192, R, C); const int Rb = Epi::PERM ? ((R & ~31) + perm32(R & 31)) : R;
        voffA[i] = (unsigned)(R * lda + C) * 2u; voffB[i] = (unsigned)(Rb * K + C) * 2u; }
    const size_t kstep = (size_t)(BK * 2);
    const size_t hstep = (size_t)HALF * K * 2;
    const size_t tstep = 2 * hstep;
    const size_t hstepA = (size_t)HALF * lda * 2, tstepA = 2 * hstepA;
    const unsigned ldsw = (unsigned)wid * 1024u;
    const int aoff = lds_byte(wr * 64 + fr, fq * 8), boff = lds_byte(wc * 32 + fr, fq * 8);
#define PG8_SA(b, h) (((b) * 2 + (h)) * HTB)
#define PG8_SB(b, h) ((4 + (b) * 2 + (h)) * HTB)
#define PG8_STAGE(bufoff, gbase, voff) do { _Pragma("unroll") for (int _i = 0; _i < 2; ++_i) \
        __builtin_amdgcn_global_load_lds((const unsigned*)((const char*)(gbase) + (voff)[_i]), (PG8_LAS unsigned*)(lds + (bufoff) + ldsw + _i * 8192), 16, 0, 0); } while (0)
#define PG8_LDA(dst, b, h) do { _Pragma("unroll") for (int m = 0; m < 4; ++m) _Pragma("unroll") for (int k = 0; k < 2; ++k) dst[m][k] = *(const PG8_LAS bf16x8*)(lds + PG8_SA(b, h) + aoff + m * 2048 + k * 1024); } while (0)
#define PG8_LDB(dst, b, h) do { _Pragma("unroll") for (int n = 0; n < 2; ++n) _Pragma("unroll") for (int k = 0; k < 2; ++k) dst[n][k] = *(const PG8_LAS bf16x8*)(lds + PG8_SB(b, h) + boff + n * 2048 + k * 1024); } while (0)
#define PG8_MMA(ai, bj, At, Bt) do { __builtin_amdgcn_s_setprio(1); _Pragma("unroll") for (int m = 0; m < 4; ++m) _Pragma("unroll") for (int n = 0; n < 2; ++n) _Pragma("unroll") for (int k = 0; k < 2; ++k) \
        acc[ai][bj][m][n] = __builtin_amdgcn_mfma_f32_16x16x32_bf16(Bt[n][k], At[m][k], acc[ai][bj][m][n], 0, 0, 0); __builtin_amdgcn_s_setprio(0); } while (0)
#define PG8_WAIT_V(n) asm volatile("s_waitcnt vmcnt(" #n ")" ::: "memory")
#define PG8_WAIT_L(n) asm volatile("s_waitcnt lgkmcnt(" #n ")" ::: "memory")
#define PG8_BAR __builtin_amdgcn_s_barrier()
#define PG8_SCHED __builtin_amdgcn_sched_barrier(0)
    Unit cur, nxt; int ui = 0;
    if (!S.next(0, cur)) return;
    f32x4 acc[2][2][4][2];
#pragma unroll
    for (int a = 0; a < 2; ++a)
#pragma unroll
        for (int b = 0; b < 2; ++b)
#pragma unroll
            for (int m = 0; m < 4; ++m)
#pragma unroll
                for (int n = 0; n < 2; ++n) acc[a][b][m][n] = (f32x4){0.f, 0.f, 0.f, 0.f};
    bf16x8 At[4][2], B0[2][2], B1[2][2];
    const char* cA = (const char*)g.A + (size_t)cur.pm * tstepA + (size_t)cur.k0 * kstep; const char* cB = (const char*)g.Bt + (size_t)cur.pn * tstep + (size_t)cur.k0 * kstep;
    S.a_ready(cur);
    if constexpr (SP2) {
        PG8_STAGE(PG8_SB(0, 0), cB, voffB); PG8_STAGE(PG8_SB(0, 1), cB + hstep, voffB); PG8_STAGE(PG8_SA(0, 0), cA, voffA); PG8_STAGE(PG8_SA(0, 1), cA + hstepA, voffA);
        if (wr == 1) PG8_BAR;
        PG8_WAIT_V(2); PG8_BAR;
        PG8_STAGE(PG8_SB(1, 0), cB + kstep, voffB); PG8_STAGE(PG8_SA(1, 0), cA + kstep, voffA); PG8_STAGE(PG8_SB(1, 1), cB + hstep + kstep, voffB);
        PG8_WAIT_V(6); PG8_BAR;
    } else {
        PG8_STAGE(PG8_SB(0, 0), cB, voffB); PG8_STAGE(PG8_SA(0, 0), cA, voffA); PG8_STAGE(PG8_SB(0, 1), cB + hstep, voffB); PG8_STAGE(PG8_SA(0, 1), cA + hstepA, voffA);
        if (wr == 1) PG8_BAR;
        PG8_WAIT_V(4); PG8_BAR;
        PG8_STAGE(PG8_SB(1, 0), cB + kstep, voffB); PG8_STAGE(PG8_SA(1, 0), cA + kstep, voffA); PG8_STAGE(PG8_SB(1, 1), cB + hstep + kstep, voffB);
        PG8_WAIT_V(6); PG8_BAR;
    }
    for (;;) {
        const bool has_next = S.next(ui + 1, nxt);
        const char* nA = has_next ? (const char*)g.A + (size_t)nxt.pm * tstepA + (size_t)nxt.k0 * kstep : cA; const char* nB = has_next ? (const char*)g.Bt + (size_t)nxt.pn * tstep + (size_t)nxt.k0 * kstep : cB;
        const int cnt = cur.nt;
        for (int t = 0; t < cnt; t += 2) {
            const bool last = (t == cnt - 2);
            const char* a1 = cA + (size_t)(t + 1) * kstep;
            const char* a2 = last ? nA : cA + (size_t)(t + 2) * kstep; const char* b2 = last ? nB : cB + (size_t)(t + 2) * kstep;
            const char* a3 = a2 + kstep; const char* b3 = b2 + kstep;
            if (last && has_next) S.a_ready(nxt);
            if constexpr (SP2) {
            PG8_LDB(B0, 0, 0); PG8_LDB(B1, 0, 1); PG8_SCHED; PG8_LDA(At, 0, 0); PG8_STAGE(PG8_SA(1, 1), a1 + hstepA, voffA);
            PG8_WAIT_V(8); PG8_WAIT_L(0); PG8_BAR; PG8_MMA(0, 0, At, B0); PG8_MMA(0, 1, At, B1); PG8_BAR; PG8_SCHED;
            PG8_LDA(At, 0, 1); PG8_STAGE(PG8_SB(0, 0), b2, voffB); PG8_STAGE(PG8_SB(0, 1), b2 + hstep, voffB); PG8_STAGE(PG8_SA(0, 0), a2, voffA);
            PG8_WAIT_V(8); PG8_WAIT_L(0); PG8_BAR; PG8_MMA(1, 0, At, B0); PG8_MMA(1, 1, At, B1); PG8_BAR; PG8_SCHED;
            PG8_LDB(B0, 1, 0); PG8_LDB(B1, 1, 1); PG8_SCHED; PG8_LDA(At, 1, 0); PG8_STAGE(PG8_SA(0, 1), a2 + hstepA, voffA);
            PG8_WAIT_V(8); PG8_WAIT_L(0); PG8_BAR; PG8_MMA(0, 0, At, B0); PG8_MMA(0, 1, At, B1); PG8_BAR; PG8_SCHED;
            PG8_LDA(At, 1, 1); PG8_STAGE(PG8_SB(1, 0), b3, voffB); PG8_STAGE(PG8_SB(1, 1), b3 + hstep, voffB); PG8_STAGE(PG8_SA(1, 0), a3, voffA);
            PG8_WAIT_V(8); PG8_WAIT_L(0); PG8_BAR; PG8_MMA(1, 0, At, B0); PG8_MMA(1, 1, At, B1); PG8_BAR; PG8_SCHED;
            } else {
            PG8_LDB(B0, 0, 0); PG8_SCHED; PG8_LDA(At, 0, 0); PG8_STAGE(PG8_SA(1, 1), a1 + hstepA, voffA);
            PG8_WAIT_L(8); PG8_BAR; PG8_WAIT_L(0); PG8_MMA(0, 0, At, B0); PG8_BAR; PG8_SCHED;
            PG8_LDB(B1, 0, 1); PG8_STAGE(PG8_SB(0, 0), b2, voffB);
            PG8_BAR; PG8_WAIT_L(0); PG8_MMA(0, 1, At, B1); PG8_BAR;
            PG8_LDA(At, 0, 1); PG8_STAGE(PG8_SA(0, 0), a2, voffA);
            PG8_BAR; PG8_WAIT_L(0); PG8_MMA(1, 0, At, B0); PG8_BAR; PG8_SCHED;
            PG8_STAGE(PG8_SB(0, 1), b2 + hstep, voffB);
            PG8_WAIT_V(6); PG8_BAR; PG8_MMA(1, 1, At, B1); PG8_BAR;
            PG8_LDB(B0, 1, 0); PG8_SCHED; PG8_LDA(At, 1, 0); PG8_STAGE(PG8_SA(0, 1), a2 + hstepA, voffA);
            PG8_WAIT_L(8); PG8_BAR; PG8_WAIT_L(0); PG8_MMA(0, 0, At, B0); PG8_BAR; PG8_SCHED;
            PG8_LDB(B1, 1, 1); PG8_STAGE(PG8_SB(1, 0), b3, voffB);
            PG8_BAR; PG8_WAIT_L(0); PG8_MMA(0, 1, At, B1); PG8_BAR;
            PG8_LDA(At, 1, 1); PG8_STAGE(PG8_SA(1, 0), a3, voffA);
            PG8_BAR; PG8_WAIT_L(0); PG8_MMA(1, 0, At, B0); PG8_BAR; PG8_SCHED;
            PG8_STAGE(PG8_SB(1, 1), b3 + hstep, voffB);
            PG8_WAIT_V(6); PG8_BAR; PG8_MMA(1, 1, At, B1); PG8_BAR;
            }
        }
        if constexpr (ALIGN_EPI) { if (wr == 0) PG8_BAR; }
        if constexpr (!Epi::AFTER_DRAIN) { E(acc, cur, wr, wc, fr, fq); S.done(cur); }
        if (!has_next) break;
#pragma unroll
        for (int a = 0; a < 2; ++a)
#pragma unroll
            for (int b = 0; b < 2; ++b)
#pragma unroll
                for (int m = 0; m < 4; ++m)
#pragma unroll
                    for (int n = 0; n < 2; ++n) acc[a][b][m][n] = (f32x4){0.f, 0.f, 0.f, 0.f};
        cur = nxt; cA = nA; cB = nB; ++ui;
        if constexpr (ALIGN_EPI) { if (wr == 1) PG8_BAR; }
    }
    PG8_WAIT_V(0);
    if constexpr (!ALIGN_EPI) { if (wr == 0) PG8_BAR; }
    PG8_BAR;
    if constexpr (Epi::AFTER_DRAIN) { E.fused(acc, cur, wr, wc, fr, fq, lds, wid, lane); S.done(cur); }
#undef PG8_SA
#undef PG8_SB
#undef PG8_STAGE
#undef PG8_LDA
#undef PG8_LDB
#undef PG8_MMA
#undef PG8_WAIT_V
#undef PG8_WAIT_L
#undef PG8_BAR
#undef PG8_SCHED
}
}

#ifndef PG8_SP2
#define PG8_SP2 true
#endif
#define GAS __attribute__((address_space(1)))
#define LAS __attribute__((address_space(3)))
typedef unsigned short bf16;
typedef unsigned v4u __attribute__((ext_vector_type(4)));
typedef float f32x4 __attribute__((ext_vector_type(4)));
typedef short bf16x8 __attribute__((ext_vector_type(8)));
typedef GAS unsigned gu32;
typedef GAS unsigned long long gu64;
#define RLX_AGENT __ATOMIC_RELAXED, __HIP_MEMORY_SCOPE_AGENT
#define LDS_WAIT() asm volatile("s_waitcnt lgkmcnt(0)" ::: "memory")
#define VM_WAIT() asm volatile("s_waitcnt vmcnt(0)" ::: "memory")
__device__ __forceinline__ unsigned long long rt() { return __builtin_amdgcn_s_memrealtime(); }
typedef float pkf2_t __attribute__((ext_vector_type(2))); typedef __bf16 pkb2_t __attribute__((ext_vector_type(2)));
__device__ __forceinline__ unsigned pk2(float lo, float hi) { pkf2_t v = {lo, hi}; pkb2_t b = __builtin_convertvector(v, pkb2_t); return __builtin_bit_cast(unsigned, b); }
__device__ __forceinline__ unsigned f2bf(float f) { return pk2(f, 0.f) & 0xffffu; }

#define XB_TMO      128
#define XB_XCNT(j)  (256  + 64 * (j))
#define XB_XSUB(j)  (1280 + 64 * (j))
#define XB_XGEN(j)  (2304 + 64 * (j))
#define XB_TOP      3328
#define XB_TOPGEN   3392
#define XCD_BAR_WORDS 3456
#define XB_SPIN_CAP (1u << 18)

__device__ __forceinline__ unsigned xb_ld(unsigned* p)              { return __hip_atomic_load(p, __ATOMIC_RELAXED, __HIP_MEMORY_SCOPE_AGENT); }
__device__ __forceinline__ unsigned xb_add(unsigned* p, unsigned v) { return __hip_atomic_fetch_add(p, v, __ATOMIC_RELAXED, __HIP_MEMORY_SCOPE_AGENT); }
__device__ __forceinline__ unsigned xb_xcc_id() { return (unsigned)__builtin_amdgcn_s_getreg((3 << 11) | 20) & 0xFu; }
#define XB_SPIN(cond, bar) do { unsigned _sp = 0; while (cond) { __builtin_amdgcn_s_sleep(1); \
    if ((++_sp & 255u) == 0u) { if (xb_ld(&(bar)[XB_TMO])) break; if (_sp > XB_SPIN_CAP) { atomicAdd(&(bar)[XB_TMO], 1u); break; } } } } while (0)

struct XcdBarrier {
    unsigned* bar; unsigned x;
    volatile LAS unsigned* st;
};

__device__ __forceinline__ XcdBarrier xcd_barrier_post(unsigned* bar, volatile LAS unsigned* st) {
    XcdBarrier b; b.bar = bar; b.x = xb_xcc_id(); b.st = st;
    if (threadIdx.x == 0) (void)xb_add(&bar[XB_XCNT(b.x)], 1u);
    return b;
}
__device__ __forceinline__ void xcd_barrier_complete(unsigned* bar, unsigned x, unsigned& nloc, unsigned& nx) {
    const unsigned G = gridDim.x * gridDim.y * gridDim.z;
    unsigned sum, cnt, mine, sp = 0u;
    for (;;) {
        sum = 0u; cnt = 0u; mine = 0u;
#pragma unroll
        for (unsigned j = 0; j < 16; ++j) { const unsigned c = xb_ld(&bar[XB_XCNT(j)]); sum += c; cnt += (c > 0u) ? 1u : 0u; mine = (j == x) ? c : mine; }
        if (sum == G) break;
        __builtin_amdgcn_s_sleep(1);
        if ((++sp & 255u) == 0u) { if (xb_ld(&bar[XB_TMO])) break; if (sp > XB_SPIN_CAP) { atomicAdd(&bar[XB_TMO], 1u); break; } }
    }
    nloc = mine > 0u ? mine : 1u; nx = cnt > 0u ? cnt : 1u;
}

__device__ __forceinline__ void xcd_barrier(const XcdBarrier& b) {
    asm volatile("s_waitcnt vmcnt(0)" ::: "memory");
    __syncthreads();
    if (threadIdx.x == 0) {
        unsigned* bar = b.bar;
        __builtin_amdgcn_s_waitcnt(0);
        unsigned nloc = b.st[0], nx = b.st[1];
        if (nloc == 0u) { xcd_barrier_complete(bar, b.x, nloc, nx); b.st[0] = nloc; b.st[1] = nx; }
        const unsigned old = xb_add(&bar[XB_XSUB(b.x)], 1u);
        const unsigned gen = old / nloc;
        if (old + 1u == (gen + 1u) * nloc) {
            __builtin_amdgcn_fence(__ATOMIC_RELEASE, "agent");
            asm volatile("s_waitcnt vmcnt(0)" ::: "memory");
            const unsigned og = xb_add(&bar[XB_TOP], 1u);
            const unsigned tg = og / nx;
            if (og + 1u == (tg + 1u) * nx) xb_add(&bar[XB_TOPGEN], 1u);
            else XB_SPIN(xb_ld(&bar[XB_TOPGEN]) == tg, bar);
            __builtin_amdgcn_fence(__ATOMIC_ACQUIRE, "agent");
            xb_add(&bar[XB_XGEN(b.x)], 1u);
            asm volatile("s_waitcnt vmcnt(0)" ::: "memory");
        } else {
            XB_SPIN(xb_ld(&bar[XB_XGEN(b.x)]) == gen, bar);
            __builtin_amdgcn_fence(__ATOMIC_ACQUIRE, "agent");
            asm volatile("s_waitcnt vmcnt(0)" ::: "memory");
        }
    }
    __syncthreads();
}
#ifndef PG8_ALIGN
#define PG8_ALIGN true
#endif
constexpr int NWAVES = 8;
#ifndef MK_PER_PHASE
#define MK_PER_PHASE 0
#endif
constexpr int D = 1024, MP = 16384, MSMP = 2048, M = MP + MSMP, NCH = M / 64, DFF = 2816, INCOLS = 7440, NB = 33, ADAW = 9 * D;
constexpr float EPS = 1e-6f;
constexpr size_t OFF_Y = 0, OFF_PCONV = (size_t)M * D, OFF_PS = OFF_PCONV + 3 * 3072, OFF_PK = OFF_PS + 8 * 128 * 128, OFF_PV = OFF_PK + 128 * 128,
                 OFF_SCONV = OFF_PV + 128 * 128, OFF_SS = OFF_SCONV + 32 * 3 * 3072, OFF_SK = OFF_SS + (size_t)32 * 8 * 128 * 128, OFF_SV = OFF_SK + 32 * 128 * 128, OUT_TOTAL = OFF_SV + 32 * 128 * 128;
constexpr size_t MiB = 1u << 20;
constexpr size_t WS_CTL = 0, CTL_ZERO_BYTES = 1 * MiB, WS_ADA = 1 * MiB, WS_BA = 5 * MiB / 2, WS_GL = 4 * MiB, WS_W = 5 * MiB;
constexpr size_t WS_U1 = 26 * MiB, WS_U2 = 62 * MiB, WS_U3 = 98 * MiB, WS_U4 = 134 * MiB, WS_U5 = 170 * MiB, WS_U6 = 206 * MiB;
constexpr size_t WS_INTRA = 206 * MiB, WS_KV = 224 * MiB, WS_TAIL = 233 * MiB, WS_END = 254 * MiB;
static_assert((size_t)M * D * 2 == 36 * MiB && (size_t)NB * ADAW * 4 <= 3 * MiB / 2 && (size_t)M * 16 * 4 <= 3 * MiB / 2, "ws map");
static_assert((size_t)NCH * 8 * 64 * 64 * 2 == 18 * MiB && (size_t)M * 256 * 2 == 9 * MiB && WS_TAIL + (size_t)NCH * 3 * 3072 * 2 <= WS_END && (size_t)M * DFF * 2 <= 108 * MiB, "ws map 2");
constexpr size_t W_FIN = 0, W_FOUT = (size_t)2 * DFF * D;
constexpr size_t W_IN = 0, W_A = (size_t)7424 * D, W_B = W_A + (size_t)D * D, W_O = W_B + (size_t)D * D;
static_assert((W_O + (size_t)D * D) * 2 <= 21 * MiB, "w slot");
constexpr int CW_TMO = 0, CW_BAR = 4096;
constexpr int RING_BYTES = 131072, LDSCTL_OFF = RING_BYTES, MISC_OFF = LDSCTL_OFF + 320, LDS_BYTES = 147456;

struct Frame {
    LAS unsigned char* lds; volatile LAS unsigned* MISC; gu32* ctl;
    int tid, lane, wave, vcu, G;
    const float* const* in; float* out; unsigned char* ws;
};
typedef float f32x2 __attribute__((ext_vector_type(2)));
typedef unsigned u32x2 __attribute__((ext_vector_type(2)));
__device__ __forceinline__ float bflo(unsigned u) { return __builtin_bit_cast(float, u << 16); }
__device__ __forceinline__ float bfhi(unsigned u) { return __builtin_bit_cast(float, u & 0xffff0000u); }
__device__ __forceinline__ float bf2f(bf16 h) { return __builtin_bit_cast(float, (unsigned)h << 16); }
__device__ __forceinline__ float fexp(float x) { return __builtin_amdgcn_exp2f(x * 1.4426950408889634f); }
__device__ __forceinline__ float sigm(float x) { return __builtin_amdgcn_rcpf(1.f + fexp(-x)); }
__device__ __forceinline__ float siluf(float x) { return x * sigm(x); }
__device__ __forceinline__ float wave_sum(float v) {
#pragma unroll
    for (int o = 1; o < 64; o <<= 1) v += __shfl_xor(v, o);
    return v;
}
__device__ __forceinline__ int mod_row(int m) { return m < MP ? 0 : 1 + ((m - MP) >> 6); }

__device__ __forceinline__ void transpose_item(const float* W, int ldw, int c0, int K, bf16* WT, int drow0, LAS float* scr, int k0, int lane) {
    f32x4 wv[8];
#pragma unroll
    for (int i = 0; i < 8; ++i) wv[i] = *(const f32x4*)(W + (size_t)(k0 + 8 * i + (lane >> 3)) * ldw + c0 + 4 * (lane & 7));
#pragma unroll
    for (int i = 0; i < 8; ++i) { LAS float* d = scr + (8 * i + (lane >> 3)) * 33 + 4 * (lane & 7); d[0] = wv[i].x; d[1] = wv[i].y; d[2] = wv[i].z; d[3] = wv[i].w; }
    LDS_WAIT(); asm volatile("" ::: "memory");
    const int c = lane & 7;
#pragma unroll
    for (int j = 0; j < 4; ++j) { const int n = (lane >> 3) + 8 * j; const LAS float* s = scr + (8 * c) * 33 + n;
        v4u o; o.x = pk2(s[0 * 33], s[1 * 33]); o.y = pk2(s[2 * 33], s[3 * 33]); o.z = pk2(s[4 * 33], s[5 * 33]); o.w = pk2(s[6 * 33], s[7 * 33]);
        *(GAS v4u*)(WT + (size_t)(drow0 + n) * K + k0 + 8 * c) = o; }
    LDS_WAIT(); asm volatile("" ::: "memory");
}
__device__ __forceinline__ void convert_ffn(Frame& F, const float* w_in, const float* w_out, bf16* dst_in, bf16* dst_out, int gw, int NGW) {
    LAS float* scr = (LAS float*)(F.lds + F.wave * 16384);
    constexpr int I_IN = 16 * 176, I_OUT = 44 * 32;
    if (dst_in) for (int it = gw; it < I_IN; it += NGW) { const int kb = it / 176, nb = it % 176, c0 = 32 * nb; const int j0 = c0 < DFF ? c0 : c0 - DFF;
        const int drow0 = (j0 >> 7) * 256 + (c0 < DFF ? 0 : 128) + (j0 & 127);
        transpose_item(w_in, 2 * DFF, c0, D, dst_in, drow0, scr, 64 * kb, F.lane); }
    if (dst_out) for (int r = gw; r < I_OUT; r += NGW) { const int kb = r / 32, nb = r % 32; transpose_item(w_out, D, 32 * nb, DFF, dst_out, 32 * nb, scr, 64 * kb, F.lane); }
}
__device__ __forceinline__ void convert_mixer(Frame& F, int part, int gw, int NGW) {
    LAS float* scr = (LAS float*)(F.lds + F.wave * 16384);
    constexpr int NB0 = 4352 / 32, NB1 = (7424 - 4352) / 32, I_SQ = 16 * 32;
    const int nb_n = part == 0 ? NB0 : NB1, i_in = 16 * nb_n, i_tot = part == 0 ? i_in : i_in + 3 * I_SQ;
    for (int it = gw; it < i_tot; it += NGW) {
        if (it < i_in) { const int kb = it / nb_n, nb = it % nb_n, dr = 32 * nb + (part == 0 ? 0 : 4352);
            const int c0 = dr < 3072 ? dr : dr < 4352 ? 4112 + (dr - 3072) : dr < 5376 ? 3072 + (dr - 4352) : 5392 + (dr - 5376);
            transpose_item((F.in[12]), INCOLS, c0, D, ((bf16*)(F.ws + WS_W)) + W_IN, dr, scr, 64 * kb, F.lane); }
        else { int r = it - i_in; const int which = r / I_SQ; r %= I_SQ; const int kb = r / 32, nb = r % 32;
            const float* src = which == 0 ? (F.in[19]) : which == 1 ? (F.in[20]) : (F.in[21]); bf16* dst = ((bf16*)(F.ws + WS_W)) + (which == 0 ? W_A : which == 1 ? W_B : W_O);
            transpose_item(src, D, 32 * nb, D, dst, 32 * nb, scr, 64 * kb, F.lane); }
    }
}
__device__ __forceinline__ int ada_row_off(int s) { return s < 31 ? s * 4112 : 131584 + (s - 31) * 4112; }
__device__ __forceinline__ void split_bf(float a, float b, unsigned& hi, unsigned& lo) {
    hi = pk2(a, b); lo = pk2(a - __builtin_bit_cast(float, hi << 16), b - __builtin_bit_cast(float, hi & 0xffff0000u)); }
__device__ __forceinline__ void ada_item(Frame& F, int item) {
    for (int idx = F.tid; idx < 33 * 1024; idx += 512) { const int b = idx >> 10, k = idx & 1023;
        const float c = (b == 0) ? (F.in[6])[k] : (F.in[7])[(b - 1) * 1024 + k]; *(LAS float*)(F.lds + ada_row_off(b == 0 ? 32 : b - 1) + 4 * k) = c / (1.f + __expf(-c)); }
    __syncthreads();
    const int i16 = F.lane & 15, kg = F.lane >> 4, k0 = F.wave * 128;
    const float* wp = (F.in[25]) + (size_t)(k0 + 8 * kg) * ADAW + item * 64 + 4 * i16;
    f32x4 acc[3][4], ld[2][8];
#pragma unroll
    for (int mt = 0; mt < 3; ++mt)
#pragma unroll
        for (int t = 0; t < 4; ++t) acc[mt][t] = (f32x4){0.f, 0.f, 0.f, 0.f};
#pragma unroll
    for (int j = 0; j < 8; ++j) ld[0][j] = *(const f32x4*)(wp + (size_t)j * ADAW);
#pragma unroll
    for (int j = 0; j < 8; ++j) ld[1][j] = *(const f32x4*)(wp + (size_t)(32 + j) * ADAW);
#pragma unroll
    for (int ks = 0; ks < 4; ++ks) {
        bf16x8 bh[4], bl[4];
#pragma unroll
        for (int t = 0; t < 4; ++t) { unsigned h0, h1, h2, h3, l0, l1, l2, l3; split_bf(ld[ks & 1][0][t], ld[ks & 1][1][t], h0, l0); split_bf(ld[ks & 1][2][t], ld[ks & 1][3][t], h1, l1);
            split_bf(ld[ks & 1][4][t], ld[ks & 1][5][t], h2, l2); split_bf(ld[ks & 1][6][t], ld[ks & 1][7][t], h3, l3); bh[t] = __builtin_bit_cast(bf16x8, (v4u){h0, h1, h2, h3}); bl[t] = __builtin_bit_cast(bf16x8, (v4u){l0, l1, l2, l3}); }
        if (ks + 2 < 4) {
#pragma unroll
            for (int j = 0; j < 8; ++j) ld[ks & 1][j] = *(const f32x4*)(wp + (size_t)(32 * (ks + 2) + j) * ADAW); }
#pragma unroll
        for (int mt = 0; mt < 3; ++mt) { const LAS float* ap = (const LAS float*)(F.lds + ada_row_off(mt < 2 ? 16 * mt + i16 : 32)) + k0 + 32 * ks + 8 * kg;
            const f32x4 a0 = *(const LAS f32x4*)ap, a1 = *(const LAS f32x4*)(ap + 4); unsigned h0, h1, h2, h3, l0, l1, l2, l3;
            split_bf(a0.x, a0.y, h0, l0); split_bf(a0.z, a0.w, h1, l1); split_bf(a1.x, a1.y, h2, l2); split_bf(a1.z, a1.w, h3, l3);
            const bf16x8 ah = __builtin_bit_cast(bf16x8, (v4u){h0, h1, h2, h3}), al = __builtin_bit_cast(bf16x8, (v4u){l0, l1, l2, l3});
#pragma unroll
            for (int t = 0; t < 4; ++t) { acc[mt][t] = __builtin_amdgcn_mfma_f32_16x16x32_bf16(ah, bh[t], acc[mt][t], 0, 0, 0);
                acc[mt][t] = __builtin_amdgcn_mfma_f32_16x16x32_bf16(ah, bl[t], acc[mt][t], 0, 0, 0); acc[mt][t] = __builtin_amdgcn_mfma_f32_16x16x32_bf16(al, bh[t], acc[mt][t], 0, 0, 0); } }
    }
    __syncthreads();
    LAS float* red = (LAS float*)F.lds;
#pragma unroll
    for (int mt = 0; mt < 2; ++mt)
#pragma unroll
        for (int i = 0; i < 4; ++i) *(LAS f32x4*)(red + (F.wave * 33 + 16 * mt + 4 * kg + i + 1) * 64 + 4 * i16) = (f32x4){acc[mt][0][i], acc[mt][1][i], acc[mt][2][i], acc[mt][3][i]};
    if (kg == 0) *(LAS f32x4*)(red + (F.wave * 33) * 64 + 4 * i16) = (f32x4){acc[2][0][0], acc[2][1][0], acc[2][2][0], acc[2][3][0]};
    __syncthreads();
    for (int idx = F.tid; idx < 33 * 64; idx += 512) { const int b = idx >> 6, l = idx & 63; float s = 0.f;
#pragma unroll
        for (int w = 0; w < 8; ++w) s += red[(w * 33 + b) * 64 + l];
        ((float*)(F.ws + WS_ADA))[(size_t)b * ADAW + item * 64 + l] = s + (F.in[26])[item * 64 + l]; }
    __syncthreads();
}
__device__ __forceinline__ void convert_ffn_range(Frame& F, const float* w_in, const float* w_out, bf16* dst_in, bf16* dst_out, int lo, int hi) {
    LAS float* scr = (LAS float*)(F.lds + F.wave * 16384);
    constexpr int I_IN = 16 * 176, I_OUT = 44 * 32;
    if (hi > I_IN + I_OUT) hi = I_IN + I_OUT;
    for (int it = lo + F.wave; it < hi; it += NWAVES) {
        if (it < I_IN) { const int kb = it / 176, nb = it % 176, c0 = 32 * nb; const int j0 = c0 < DFF ? c0 : c0 - DFF;
            const int drow0 = (j0 >> 7) * 256 + (c0 < DFF ? 0 : 128) + (j0 & 127);
            transpose_item(w_in, 2 * DFF, c0, D, dst_in, drow0, scr, 64 * kb, F.lane); }
        else { const int r = it - I_IN; const int kb = r / 32, nb = r % 32; transpose_item(w_out, D, 32 * nb, DFF, dst_out, 32 * nb, scr, 64 * kb, F.lane); } }
}
__device__ __forceinline__ int left_index(int pm, int pn) { return pm >= 64 ? (pm - 64) * 4 + pn : -1; }
struct Leftover { const bf16* part; bool base_in; int gi; float scale; };
__device__ __forceinline__ void load_row(Frame& F, int m, bool from_in, const Leftover& LO, f32x4 (&v)[4]) {
    const float* irow = m < MP ? (F.in[0]) + (size_t)m * D : (F.in[1]) + (size_t)(m - MP) * D;
    GAS u32x2* xb = (GAS u32x2*)((bf16*)F.out + (size_t)m * 2048) + F.lane;
#pragma unroll
    for (int j = 0; j < 4; ++j) { const int li = LO.part ? left_index(m >> 8, j) : -1;
        if (li < 0) { if (from_in) v[j] = *((const GAS f32x4*)irow + 64 * j + F.lane); else { const u32x2 w = xb[64 * j]; v[j] = (f32x4){bflo(w.x), bfhi(w.x), bflo(w.y), bfhi(w.y)}; } }
        else { f32x4 bs; if (LO.base_in) bs = *((const GAS f32x4*)irow + 64 * j + F.lane); else { const u32x2 w = xb[64 * j]; bs = (f32x4){bflo(w.x), bfhi(w.x), bflo(w.y), bfhi(w.y)}; }
            const f32x4 gv = *((const GAS f32x4*)(((float*)(F.ws + WS_ADA)) + (size_t)mod_row(m) * ADAW + LO.gi * D) + 64 * j + F.lane);
            const GAS u32x2* pp = (const GAS u32x2*)(LO.part + (size_t)li * 8 * 65536 + (size_t)(m & 255) * 256) + F.lane; f32x4 s = (f32x4){0.f, 0.f, 0.f, 0.f};
#pragma unroll
            for (int p = 0; p < 8; ++p) { const u32x2 w = pp[(size_t)p * 16384]; s += (f32x4){bflo(w.x), bfhi(w.x), bflo(w.y), bfhi(w.y)}; }
            v[j] = bs + gv * s * LO.scale; xb[64 * j] = (u32x2){pk2(v[j].x, v[j].y), pk2(v[j].z, v[j].w)}; } }
}
struct RowBuf { f32x4 x[4], sc[4], sh[4]; };
__device__ __forceinline__ void rmsmod_row(const RowBuf& rb, const f32x4 (&gq)[4], bf16* orow, int lane, f32x4 (&hv)[4]) {
    float s = 0.f;
#pragma unroll
    for (int j = 0; j < 4; ++j) s += (rb.x[j].x * rb.x[j].x + rb.x[j].y * rb.x[j].y) + (rb.x[j].z * rb.x[j].z + rb.x[j].w * rb.x[j].w);
    const float r = __builtin_amdgcn_rsqf(wave_sum(s) * (1.f / D) + EPS);
    GAS u32x2* o8 = (GAS u32x2*)orow + lane;
#pragma unroll
    for (int j = 0; j < 4; ++j) { const f32x4 h = (rb.x[j] * r) * gq[j] * (rb.sc[j] + 1.f) + rb.sh[j]; hv[j] = h;
        u32x2 w; w.x = pk2(h.x, h.y); w.y = pk2(h.z, h.w); o8[64 * j] = w; }
}
template <bool WITH_BA>
__device__ __forceinline__ void rmsmod_rows(Frame& F, bool from_in, const float* g, int li, bf16* dst, const Leftover LO = Leftover{nullptr, false, 0, 0.f}, int dld = D) {
    const int gw = F.vcu * NWAVES + F.wave, NGW = F.G * NWAVES;
    LAS float* wba = (LAS float*)F.lds;
    if (WITH_BA) { for (int idx = F.tid; idx < 16 * 1024; idx += 512) { const int k = idx >> 4, j = idx & 15; wba[j * 1024 + k] = (F.in[12])[(size_t)k * INCOLS + 4096 + j]; } __syncthreads(); }
    f32x4 gq[4];
#pragma unroll
    for (int j = 0; j < 4; ++j) gq[j] = ((const GAS f32x4*)g)[64 * j + F.lane];
    RowBuf cur, nxt;
#define ROW_FETCH(mm, B) do { const float* ad_ = ((float*)(F.ws + WS_ADA)) + (size_t)mod_row(mm) * ADAW + (3 * li) * D; load_row(F, mm, from_in, LO, B.x); \
        _Pragma("unroll") for (int j = 0; j < 4; ++j) { B.sh[j] = ((const GAS f32x4*)ad_)[64 * j + F.lane]; B.sc[j] = ((const GAS f32x4*)(ad_ + D))[64 * j + F.lane]; } } while (0)
    if (gw < M) ROW_FETCH(gw, cur);
    for (int m = gw; m < M; m += NGW) {
        if (m + NGW < M) ROW_FETCH(m + NGW, nxt);
        f32x4 hv[4]; rmsmod_row(cur, gq, dst + (size_t)m * dld, F.lane, hv);
        if (WITH_BA) { float p[16];
#pragma unroll
            for (int j = 0; j < 16; ++j) { float s = 0.f;
#pragma unroll
                for (int jj = 0; jj < 4; ++jj) { const f32x4 w = *(const LAS f32x4*)(wba + j * 1024 + 256 * jj + 4 * F.lane); s += (hv[jj].x * w.x + hv[jj].y * w.y) + (hv[jj].z * w.z + hv[jj].w * w.w); }
                p[j] = s; if ((j & 3) == 3) asm volatile("" ::: "memory"); }
            { const bool up = F.lane & 32;
#pragma unroll
              for (int i = 0; i < 8; ++i) { const float snd = up ? p[i] : p[8 + i]; const float rcv = __shfl_xor(snd, 32); p[i] = (up ? p[8 + i] : p[i]) + rcv; } }
            { const bool up = F.lane & 16;
#pragma unroll
              for (int i = 0; i < 4; ++i) { const float snd = up ? p[i] : p[4 + i]; const float rcv = __shfl_xor(snd, 16); p[i] = (up ? p[4 + i] : p[i]) + rcv; } }
            { const bool up = F.lane & 8;
#pragma unroll
              for (int i = 0; i < 2; ++i) { const float snd = up ? p[i] : p[2 + i]; const float rcv = __shfl_xor(snd, 8); p[i] = (up ? p[2 + i] : p[i]) + rcv; } }
            { const bool up = F.lane & 4; const float snd = up ? p[0] : p[1]; const float rcv = __shfl_xor(snd, 4); p[0] = (up ? p[1] : p[0]) + rcv; }
            p[0] += __shfl_xor(p[0], 2); p[0] += __shfl_xor(p[0], 1);
            if ((F.lane & 3) == 0) ((float*)(F.ws + WS_BA))[(size_t)m * 16 + (((F.lane >> 5) & 1) * 8 + ((F.lane >> 4) & 1) * 4 + ((F.lane >> 3) & 1) * 2 + ((F.lane >> 2) & 1))] = p[0]; }
        cur = nxt;
    }
#undef ROW_FETCH
    if (WITH_BA) __syncthreads();
}
__device__ __forceinline__ void rmsmod_apply(const f32x4 (&x)[4], const f32x4 (&sc)[4], const f32x4 (&sh)[4], const f32x4 (&gq)[4], bf16* orow, int lane, f32x4 (&hv)[4]) {
    float s = 0.f;
#pragma unroll
    for (int j = 0; j < 4; ++j) s += (x[j].x * x[j].x + x[j].y * x[j].y) + (x[j].z * x[j].z + x[j].w * x[j].w);
    const float r = __builtin_amdgcn_rsqf(wave_sum(s) * (1.f / D) + EPS);
    GAS u32x2* o8 = (GAS u32x2*)orow + lane;
#pragma unroll
    for (int j = 0; j < 4; ++j) { const f32x4 h = (x[j] * r) * gq[j] * (sc[j] + 1.f) + sh[j]; hv[j] = h;
        u32x2 w; w.x = pk2(h.x, h.y); w.y = pk2(h.z, h.w); o8[64 * j] = w; }
}
__device__ __forceinline__ void ba_project(Frame& F, const f32x4 (&hv)[4], int m, const LAS float* wba) {
    float p[16];
#pragma unroll
    for (int j = 0; j < 16; ++j) { float s = 0.f;
#pragma unroll
        for (int jj = 0; jj < 4; ++jj) { const f32x4 w = *(const LAS f32x4*)(wba + j * 1024 + 256 * jj + 4 * F.lane); s += (hv[jj].x * w.x + hv[jj].y * w.y) + (hv[jj].z * w.z + hv[jj].w * w.w); }
        p[j] = s; if ((j & 3) == 3) asm volatile("" ::: "memory"); }
    { const bool up = F.lane & 32;
#pragma unroll
      for (int i = 0; i < 8; ++i) { const float snd = up ? p[i] : p[8 + i]; const float rcv = __shfl_xor(snd, 32); p[i] = (up ? p[8 + i] : p[i]) + rcv; } }
    { const bool up = F.lane & 16;
#pragma unroll
      for (int i = 0; i < 4; ++i) { const float snd = up ? p[i] : p[4 + i]; const float rcv = __shfl_xor(snd, 16); p[i] = (up ? p[4 + i] : p[i]) + rcv; } }
    { const bool up = F.lane & 8;
#pragma unroll
      for (int i = 0; i < 2; ++i) { const float snd = up ? p[i] : p[2 + i]; const float rcv = __shfl_xor(snd, 8); p[i] = (up ? p[2 + i] : p[i]) + rcv; } }
    { const bool up = F.lane & 4; const float snd = up ? p[0] : p[1]; const float rcv = __shfl_xor(snd, 4); p[0] = (up ? p[1] : p[0]) + rcv; }
    p[0] += __shfl_xor(p[0], 2); p[0] += __shfl_xor(p[0], 1);
    if ((F.lane & 3) == 0) ((float*)(F.ws + WS_BA))[(size_t)m * 16 + (((F.lane >> 5) & 1) * 8 + ((F.lane >> 4) & 1) * 4 + ((F.lane >> 3) & 1) * 2 + ((F.lane >> 2) & 1))] = p[0];
}
template <bool BASE_IN, bool WRITE_XB> __device__ __forceinline__ void sample_row_complete(Frame& F, int m, const Leftover& LO, f32x4 (&v)[4]) {
    const float* irow = (F.in[1]) + (size_t)(m - MP) * D;
    GAS u32x2* xb = (GAS u32x2*)((bf16*)F.out + (size_t)m * 2048) + F.lane;
    f32x4 bsf[4]; u32x2 bsb[4]; f32x4 gv[4]; u32x2 pw[4][8];
#pragma unroll
    for (int j = 0; j < 4; ++j) { if (BASE_IN) bsf[j] = *((const GAS f32x4*)irow + 64 * j + F.lane); else bsb[j] = xb[64 * j];
        gv[j] = *((const GAS f32x4*)(((float*)(F.ws + WS_ADA)) + (size_t)mod_row(m) * ADAW + LO.gi * D) + 64 * j + F.lane); }
#pragma unroll
    for (int j = 0; j < 4; ++j) { const int li = ((m >> 8) - 64) * 4 + j; const GAS u32x2* pp = (const GAS u32x2*)(LO.part + (size_t)li * 8 * 65536 + (size_t)(m & 255) * 256) + F.lane;
#pragma unroll
        for (int p = 0; p < 8; ++p) pw[j][p] = pp[(size_t)p * 16384]; }
#pragma unroll
    for (int j = 0; j < 4; ++j) { f32x4 s = (f32x4){0.f, 0.f, 0.f, 0.f};
#pragma unroll
        for (int p = 0; p < 8; ++p) { const u32x2 w = pw[j][p]; s += (f32x4){bflo(w.x), bfhi(w.x), bflo(w.y), bfhi(w.y)}; }
        const f32x4 bs = BASE_IN ? bsf[j] : (f32x4){bflo(bsb[j].x), bfhi(bsb[j].x), bflo(bsb[j].y), bfhi(bsb[j].y)};
        v[j] = bs + gv[j] * s * LO.scale; if (WRITE_XB) xb[64 * j] = (u32x2){pk2(v[j].x, v[j].y), pk2(v[j].z, v[j].w)}; }
}
template <bool WITH_BA, bool FROM_IN, bool HAS_LO, bool BASE_IN, int NB>
__device__ __forceinline__ void rmsmod_rows_256(Frame& F, const float* g, int li, bf16* dst, const Leftover LO, int dld) {
    static_assert(8 % NB == 0, "prompt rows per wave come in batches");
    const int gw = F.vcu * NWAVES + F.wave;
    LAS float* wba = (LAS float*)F.lds;
    if (WITH_BA) { for (int idx = F.tid; idx < 16 * 1024; idx += 512) { const int k = idx >> 4, j = idx & 15; wba[j * 1024 + k] = (F.in[12])[(size_t)k * INCOLS + 4096 + j]; } __syncthreads(); }
    f32x4 gq[4], sc0[4], sh0[4];
    { const float* ad = ((float*)(F.ws + WS_ADA)) + (3 * li) * D;
#pragma unroll
      for (int j = 0; j < 4; ++j) { gq[j] = ((const GAS f32x4*)g)[64 * j + F.lane]; sh0[j] = ((const GAS f32x4*)ad)[64 * j + F.lane]; sc0[j] = ((const GAS f32x4*)(ad + D))[64 * j + F.lane]; } }
#pragma unroll 1
    for (int it = 0; it < 8 / NB; ++it) {
        f32x4 rf[FROM_IN ? NB : 1][4]; u32x2 rb[FROM_IN ? 1 : NB][4];
#pragma unroll
        for (int r = 0; r < NB; ++r) { const int m = gw + 2048 * (NB * it + r);
#pragma unroll
            for (int j = 0; j < 4; ++j) { if (FROM_IN) rf[r][j] = *((const GAS f32x4*)((F.in[0]) + (size_t)m * D) + 64 * j + F.lane); else rb[r][j] = ((const GAS u32x2*)((bf16*)F.out + (size_t)m * 2048) + F.lane)[64 * j]; } }
#pragma unroll
        for (int r = 0; r < NB; ++r) { const int m = gw + 2048 * (NB * it + r); f32x4 x[4], hv[4];
#pragma unroll
            for (int j = 0; j < 4; ++j) { if (FROM_IN) x[j] = rf[r][j]; else { const u32x2 w = rb[r][j]; x[j] = (f32x4){bflo(w.x), bfhi(w.x), bflo(w.y), bfhi(w.y)}; } }
            rmsmod_apply(x, sc0, sh0, gq, dst + (size_t)m * dld, F.lane, hv);
            if (WITH_BA) ba_project(F, hv, m, wba); }
    }
    { const int m = MP + gw; f32x4 x[4], hv[4], scs[4], shs[4];
      const float* ad = ((float*)(F.ws + WS_ADA)) + (size_t)mod_row(m) * ADAW + (3 * li) * D;
#pragma unroll
      for (int j = 0; j < 4; ++j) { shs[j] = ((const GAS f32x4*)ad)[64 * j + F.lane]; scs[j] = ((const GAS f32x4*)(ad + D))[64 * j + F.lane]; }
      if (HAS_LO) sample_row_complete<BASE_IN, true>(F, m, LO, x);
      else {
#pragma unroll
          for (int j = 0; j < 4; ++j) x[j] = *((const GAS f32x4*)((F.in[1]) + (size_t)(m - MP) * D) + 64 * j + F.lane); }
      rmsmod_apply(x, scs, shs, gq, dst + (size_t)m * dld, F.lane, hv);
      if (WITH_BA) ba_project(F, hv, m, wba); }
    if (WITH_BA) __syncthreads();
}
template <int NB> __device__ __forceinline__ void final_norm_rows_256(Frame& F, const Leftover LO) {
    const int gw = F.vcu * NWAVES + F.wave;
    f32x4 gq[4];
#pragma unroll
    for (int j = 0; j < 4; ++j) gq[j] = ((const GAS f32x4*)(F.in[27]))[64 * j + F.lane];
#pragma unroll 1
    for (int it = 0; it < 8 / NB; ++it) {
        u32x2 rb[NB][4];
#pragma unroll
        for (int r = 0; r < NB; ++r) { const int m = gw + 2048 * (NB * it + r);
#pragma unroll
            for (int j = 0; j < 4; ++j) rb[r][j] = ((const GAS u32x2*)((bf16*)F.out + (size_t)m * 2048) + F.lane)[64 * j]; }
#pragma unroll
        for (int r = 0; r < NB; ++r) { const int m = gw + 2048 * (NB * it + r); f32x4 x[4]; float s = 0.f;
#pragma unroll
            for (int j = 0; j < 4; ++j) { const u32x2 w = rb[r][j]; x[j] = (f32x4){bflo(w.x), bfhi(w.x), bflo(w.y), bfhi(w.y)}; s += (x[j].x * x[j].x + x[j].y * x[j].y) + (x[j].z * x[j].z + x[j].w * x[j].w); }
            const float rr = __builtin_amdgcn_rsqf(wave_sum(s) * (1.f / D) + EPS); GAS f32x4* xr = (GAS f32x4*)(F.out + (size_t)m * D) + F.lane;
#pragma unroll
            for (int j = 0; j < 4; ++j) xr[64 * j] = (x[j] * rr) * gq[j]; }
    }
    { const int m = MP + gw; f32x4 x[4]; float s = 0.f;
      sample_row_complete<false, false>(F, m, LO, x);
#pragma unroll
      for (int j = 0; j < 4; ++j) s += (x[j].x * x[j].x + x[j].y * x[j].y) + (x[j].z * x[j].z + x[j].w * x[j].w);
      const float rr = __builtin_amdgcn_rsqf(wave_sum(s) * (1.f / D) + EPS); GAS f32x4* xr = (GAS f32x4*)(F.out + (size_t)m * D) + F.lane;
#pragma unroll
      for (int j = 0; j < 4; ++j) xr[64 * j] = (x[j] * rr) * gq[j]; }
}
__device__ __forceinline__ void final_norm_rows(Frame& F, const Leftover LO) {
    const int gw = F.vcu * NWAVES + F.wave, NGW = F.G * NWAVES;
    f32x4 gq[4], cur[4], nxt[4];
#pragma unroll
    for (int j = 0; j < 4; ++j) gq[j] = ((const GAS f32x4*)(F.in[27]))[64 * j + F.lane];
    if (gw < M) load_row(F, gw, false, LO, cur);
    for (int m = gw; m < M; m += NGW) {
        if (m + NGW < M) load_row(F, m + NGW, false, LO, nxt);
        GAS f32x4* xr = (GAS f32x4*)(F.out + (size_t)m * D) + F.lane; float s = 0.f;
#pragma unroll
        for (int j = 0; j < 4; ++j) s += (cur[j].x * cur[j].x + cur[j].y * cur[j].y) + (cur[j].z * cur[j].z + cur[j].w * cur[j].w);
        const float r = __builtin_amdgcn_rsqf(wave_sum(s) * (1.f / D) + EPS);
#pragma unroll
        for (int j = 0; j < 4; ++j) { xr[64 * j] = (cur[j] * r) * gq[j]; cur[j] = nxt[j]; }
    }
}
typedef pg8::f32x4 pf4; typedef pg8::u32x4 pu4;
#ifndef WT_STORES
#define WT_STORES 0
#endif
__device__ __forceinline__ void st16(void* p, pu4 v) {
#if WT_STORES
    asm volatile("global_store_dwordx4 %0, %1, off sc1\n\ts_nop 1" :: "v"(p), "v"(v) : "memory");
#else
    *(pu4*)p = v;
#endif
}
__device__ __forceinline__ void st16f(void* p, pf4 v) { st16(p, __builtin_bit_cast(pu4, v)); }
typedef float pf2 __attribute__((ext_vector_type(2)));
__device__ __forceinline__ pf2 silu_mul2(pf2 g, pf2 u) { const pf2 s = g * (-1.4426950408889634f); pf2 e; e.x = __builtin_amdgcn_exp2f(s.x); e.y = __builtin_amdgcn_exp2f(s.y);
    const pf2 d = e + 1.0f; pf2 r; r.x = __builtin_amdgcn_rcpf(d.x); r.y = __builtin_amdgcn_rcpf(d.y); return (g * r) * u; }
__device__ __forceinline__ pf4 silu_mul4(pf4 g, pf4 u) { const pf2 a = silu_mul2((pf2){g.x, g.y}, (pf2){u.x, u.y}), b = silu_mul2((pf2){g.z, g.w}, (pf2){u.z, u.w}); return (pf4){a.x, a.y, b.x, b.y}; }
__device__ __forceinline__ pu4 pack8(pf4 a, pf4 b) { pu4 w; w.x = pg8::cvt_pk_bf16(a.x, a.y); w.y = pg8::cvt_pk_bf16(a.z, a.w); w.z = pg8::cvt_pk_bf16(b.x, b.y); w.w = pg8::cvt_pk_bf16(b.z, b.w); return w; }
struct EpiSwiglu {
    static constexpr bool PERM = true, AFTER_DRAIN = false; bf16* O;
    __device__ __forceinline__ void operator()(const pf4 (&acc)[2][2][4][2], const pg8::Unit& u, int wr, int wc, int fr, int fq) const {
        const int row0 = u.pm * 256 + wr * 64 + fr, col0 = u.pn * 128 + wc * 32 + 8 * fq;
#pragma unroll
        for (int ai = 0; ai < 2; ++ai)
#pragma unroll
            for (int m = 0; m < 4; ++m) { bf16* p = O + (size_t)(row0 + ai * 128 + m * 16) * DFF + col0;
                const pf4 h0 = silu_mul4(acc[ai][0][m][0], acc[ai][1][m][0]), h1 = silu_mul4(acc[ai][0][m][1], acc[ai][1][m][1]);
                st16(p, pack8(h0, h1)); }
    }
};
template <bool BASE_IN> struct EpiResid {
    static constexpr bool PERM = true, AFTER_DRAIN = false; const float* in0; const float* in1; bf16* xb; const float* ada; int gi; float scale; bf16* part;
    __device__ __forceinline__ void operator()(const pf4 (&acc)[2][2][4][2], const pg8::Unit& u, int wr, int wc, int fr, int fq) const {
        if (u.piece) {
            char* pb = (char*)(part + ((size_t)u.lidx * 8 + (u.piece - 1)) * 65536);
#pragma unroll
            for (int ai = 0; ai < 2; ++ai)
#pragma unroll
                for (int bj = 0; bj < 2; ++bj) { unsigned off = (unsigned)((ai * 128 + wr * 64 + fr) * 256 + wc * 32 + 8 * fq + bj * 128) * 2u; asm volatile("" : "+v"(off));
#pragma unroll
                    for (int m = 0; m < 4; ++m) { *(pu4*)(pb + (size_t)off) = pack8(acc[ai][bj][m][0], acc[ai][bj][m][1]); off += 16u * 256u * 2u; }
                    asm volatile("" ::: "memory"); }
            return; }
        const int rowt = u.pm * 256, col0 = u.pn * 256 + wc * 32 + 8 * fq;
        const char* ib = (const char*)(rowt < MP ? in0 + (size_t)rowt * D : in1 + (size_t)(rowt - MP) * D); char* xo = (char*)(xb + (size_t)rowt * 2048);
#pragma unroll
        for (int ai = 0; ai < 2; ++ai) {
            const int b = rowt < MP ? 0 : 1 + ((rowt - MP) >> 6) + ai * 2 + wr; const char* ga = (const char*)(ada + (size_t)b * ADAW + gi * D);
#pragma unroll
            for (int bj = 0; bj < 2; ++bj) { unsigned co = (unsigned)(col0 + bj * 128); asm volatile("" : "+v"(co));
                const pf4 g0 = *(const pf4*)(ga + (size_t)co * 4u) * scale, g1 = *(const pf4*)(ga + (size_t)co * 4u + 16) * scale;
                unsigned r = (unsigned)(ai * 128 + wr * 64 + fr);
#pragma unroll
                for (int m = 0; m < 4; ++m) { pf4 b0, b1;
                    if (BASE_IN) { const char* p = ib + ((size_t)r * D + co) * 4u; b0 = *(const pf4*)p; b1 = *(const pf4*)(p + 16); }
                    else { const pu4 w = *(const pu4*)(xo + ((size_t)r * 2048 + co) * 2u); b0 = (pf4){bflo(w.x), bfhi(w.x), bflo(w.y), bfhi(w.y)}; b1 = (pf4){bflo(w.z), bfhi(w.z), bflo(w.w), bfhi(w.w)}; }
                    *(pu4*)(xo + ((size_t)r * 2048 + co) * 2u) = pack8(b0 + g0 * acc[ai][bj][m][0], b1 + g1 * acc[ai][bj][m][1]); r += 16u; }
                asm volatile("" ::: "memory"); }
        }
    }
};
struct EpiPart {
    static constexpr bool PERM = true, AFTER_DRAIN = false; bf16* part;
    __device__ __forceinline__ void operator()(const pf4 (&acc)[2][2][4][2], const pg8::Unit& u, int wr, int wc, int fr, int fq) const {
        char* pb = (char*)(part + ((size_t)u.lidx * 8 + (u.piece - 1)) * 65536);
#pragma unroll
        for (int ai = 0; ai < 2; ++ai)
#pragma unroll
            for (int bj = 0; bj < 2; ++bj) { unsigned off = (unsigned)((ai * 128 + wr * 64 + fr) * 256 + wc * 32 + 8 * fq + bj * 128) * 2u; asm volatile("" : "+v"(off));
#pragma unroll
                for (int m = 0; m < 4; ++m) { *(pu4*)(pb + (size_t)off) = pack8(acc[ai][bj][m][0], acc[ai][bj][m][1]); off += 16u * 256u * 2u; }
                asm volatile("" ::: "memory"); }
    }
};
struct EpiF1 {
    static constexpr bool PERM = true, AFTER_DRAIN = false; bf16 *U1, *U2, *U3, *U4, *KV, *TAIL; float* out;
    __device__ __forceinline__ void operator()(const pf4 (&acc)[2][2][4][2], const pg8::Unit& u, int wr, int wc, int fr, int fq) const {
        const int pn = u.pn, dcol = wc * 32 + 8 * fq;
        if (pn < 12) {
            char* Ub = (char*)U1 + (size_t)((pn >> 2) == 0 ? 4 : (pn >> 2)) * (36u << 20);
#pragma unroll
            for (int ai = 0; ai < 2; ++ai) { const int cn = u.pm * 4 + ai * 2 + wr;
#pragma unroll
                for (int bj = 0; bj < 2; ++bj) { unsigned off = (unsigned)(((cn * 8 + (pn & 3) * 2 + bj) * 64 + fr) * 128 + dcol) * 2u; asm volatile("" : "+v"(off));
#pragma unroll
                    for (int m = 0; m < 4; ++m) { st16(Ub + (size_t)off, pack8(acc[ai][bj][m][0], acc[ai][bj][m][1])); off += 16u * 128u * 2u; }
                    asm volatile("" ::: "memory"); } }
            if (fr >= 13) {
#pragma unroll
                for (int ai = 0; ai < 2; ++ai) { const int cn = u.pm * 4 + ai * 2 + wr;
#pragma unroll
                    for (int bj = 0; bj < 2; ++bj) { const int j = fr - 13, qc = pn * 256 + bj * 128 + dcol; const pf4 v0 = acc[ai][bj][3][0], v1 = acc[ai][bj][3][1];
                        *(pu4*)(TAIL + ((size_t)cn * 3 + j) * 3072 + qc) = pack8(v0, v1);
                        if (cn >= 255) { float* o = out + (cn == 255 ? OFF_PCONV + (size_t)j * 3072 : OFF_SCONV + ((size_t)(cn - 256) * 3 + j) * 3072) + qc; *(pf4*)o = v0; *(pf4*)(o + 4) = v1; } } } }
        } else if (pn < 16) {
#pragma unroll
            for (int ai = 0; ai < 2; ++ai)
#pragma unroll
                for (int bj = 0; bj < 2; ++bj) { unsigned off = (unsigned)((u.pm * 256 + ai * 128 + wr * 64 + fr) * D + (pn - 12) * 256 + bj * 128 + dcol) * 2u; asm volatile("" : "+v"(off));
#pragma unroll
                    for (int m = 0; m < 4; ++m) { st16((char*)U4 + (size_t)off, pack8(acc[ai][bj][m][0], acc[ai][bj][m][1])); off += 16u * D * 2u; }
                    asm volatile("" ::: "memory"); }
        } else {
#pragma unroll
            for (int ai = 0; ai < 2; ++ai) { const int cn = u.pm * 4 + ai * 2 + wr;
#pragma unroll
                for (int bj = 0; bj < 2; ++bj) { unsigned off = (unsigned)((cn * 64 + fr) * 256 + bj * 128 + dcol) * 2u; asm volatile("" : "+v"(off));
#pragma unroll
                    for (int m = 0; m < 4; ++m) { st16((char*)KV + (size_t)off, pack8(acc[ai][bj][m][0], acc[ai][bj][m][1])); off += 16u * 256u * 2u; }
                    asm volatile("" ::: "memory");
                    if (cn >= 254) {
                        float* ob = cn < 256 ? out + (bj == 0 ? OFF_PK : OFF_PV) + (size_t)((cn - 254) * 64 + fr) * 128 + dcol
                                             : out + (bj == 0 ? OFF_SK : OFF_SV) + (size_t)(cn - 256) * 16384 + (size_t)(64 + fr) * 128 + dcol;
#pragma unroll
                        for (int m = 0; m < 4; ++m) { *(pf4*)(ob + m * 16 * 128) = acc[ai][bj][m][0]; *(pf4*)(ob + m * 16 * 128 + 4) = acc[ai][bj][m][1]; }
                        asm volatile("" ::: "memory"); } } }
        }
    }
};
struct EpiF2 {
    static constexpr bool PERM = true, AFTER_DRAIN = false; bf16 *Z, *GA, *GB;
    __device__ __forceinline__ void operator()(const pf4 (&acc)[2][2][4][2], const pg8::Unit& u, int wr, int wc, int fr, int fq) const {
        const int t_ = u.pn >> 2; bf16* Ob = (bf16*)((char*)Z + (size_t)(108 * t_ - 72 * (t_ >> 1)) * (1u << 20)); const int col0 = (u.pn & 3) * 256 + wc * 32 + 8 * fq, row0 = u.pm * 256 + wr * 64 + fr;
#pragma unroll
        for (int ai = 0; ai < 2; ++ai)
#pragma unroll
            for (int m = 0; m < 4; ++m)
#pragma unroll
                for (int bj = 0; bj < 2; ++bj) st16(Ob + (size_t)(row0 + ai * 128 + m * 16) * D + col0 + bj * 128, pack8(acc[ai][bj][m][0], acc[ai][bj][m][1]));
    }
};
template <int MODE> struct EpiGate {
    static constexpr bool PERM = true, AFTER_DRAIN = false; bf16* T; const bf16* G2;
    __device__ __forceinline__ void operator()(const pf4 (&acc)[2][2][4][2], const pg8::Unit& u, int wr, int wc, int fr, int fq) const {
        const int col0 = u.pn * 256 + wc * 32 + 8 * fq, row0 = u.pm * 256 + wr * 64 + fr;
#pragma unroll
        for (int ai = 0; ai < 2; ++ai)
#pragma unroll
            for (int m = 0; m < 4; ++m)
#pragma unroll
                for (int bj = 0; bj < 2; ++bj) { const size_t off = (size_t)(row0 + ai * 128 + m * 16) * D + col0 + bj * 128;
                    const pu4 gv = *(const pu4*)((MODE == 0 ? (const bf16*)T : G2) + off); pu4 tv = (pu4){0u, 0u, 0u, 0u}; if (MODE == 1) tv = *(const pu4*)(T + off);
                    const pf4 a0 = acc[ai][bj][m][0], a1 = acc[ai][bj][m][1]; pf4 o0, o1;
                    o0.x = bflo(tv.x) + sigm(bflo(gv.x)) * a0.x; o0.y = bfhi(tv.x) + sigm(bfhi(gv.x)) * a0.y; o0.z = bflo(tv.y) + sigm(bflo(gv.y)) * a0.z; o0.w = bfhi(tv.y) + sigm(bfhi(gv.y)) * a0.w;
                    o1.x = bflo(tv.z) + sigm(bflo(gv.z)) * a1.x; o1.y = bfhi(tv.z) + sigm(bfhi(gv.z)) * a1.y; o1.z = bflo(tv.w) + sigm(bflo(gv.w)) * a1.z; o1.w = bfhi(tv.w) + sigm(bfhi(gv.w)) * a1.w;
                    st16(T + off, pack8(o0, o1)); }
    }
};
typedef short s16x8 __attribute__((ext_vector_type(8)));
constexpr int PR_RHST = 0, PR_QB = 69632, PR_KB = 87040, PR_AM = 104448, PR_TB = 121856, PR_SC = 126976, PR_IL = 132096, PR_CW = 141312;
static_assert(PR_IL + 64 * 72 * 2 <= PR_CW && PR_CW + 12 * 128 * 4 <= LDS_BYTES, "prep LDS map (IL, CW)");
static_assert(PR_SC + 2 * 1536 <= RING_BYTES, "prep LDS map");
constexpr size_t WS_GATES = 242 * MiB;
struct PrepRegs { v4u raw[3][5]; float gate; };
__device__ __forceinline__ void prep_fetch(Frame& F, int it, int ch8, int rg, PrepRegs& P) {
    const int cn = it >> 3, h = it & 7; const size_t blk = (size_t)(cn * 8 + h) * 64 * 128;
    P.gate = ((const float*)(F.ws + WS_GATES))[(size_t)it * 256 + ((rg * 16 + ch8) & 255)];
    const bf16* hist = cn == 0 ? (const bf16*)(F.ws + WS_CTL + 512 * 1024) : ((const bf16*)(F.ws + WS_TAIL)) + (size_t)(cn < 256 ? cn - 1 : cn + 32) * 3 * 3072;
#pragma unroll
    for (int t = 0; t < 3; ++t) { const int ch = t * 1024 + h * 128 + 8 * ch8; const bf16* Ub = (t == 0 ? ((bf16*)(F.ws + WS_U5)) : t == 1 ? ((bf16*)(F.ws + WS_U2)) : ((bf16*)(F.ws + WS_U3))) + blk + 8 * ch8;
#pragma unroll
        for (int j = 0; j < 5; ++j) { const int rr = 2 * rg - 3 + j;
            const bf16* p = (j >= 3 || rr >= 0) ? Ub + rr * 128 : hist + (size_t)(3 + rr) * 3072 + ch;
            P.raw[t][j] = *(const v4u*)p; } }
}
__device__ __forceinline__ void convert_conv_state(Frame& F) {
    for (int i = (F.vcu * (NWAVES * 64) + F.tid) * 8; i < 32 * 3 * 3072; i += F.G * NWAVES * 64 * 8) { const float* p = (F.in[2]) + i; const f32x4 a = *(const f32x4*)p, b = *(const f32x4*)(p + 4);
        *(v4u*)(((bf16*)(F.ws + WS_TAIL)) + (size_t)288 * 3 * 3072 + i) = (v4u){pk2(a.x, a.y), pk2(a.z, a.w), pk2(b.x, b.y), pk2(b.z, b.w)}; }
}
__device__ __forceinline__ void prep_gates(Frame& F, int it, int lane) {
    const int cn = it >> 3, h = it & 7, row = cn * 64 + lane; const float braw = ((float*)(F.ws + WS_BA))[(size_t)row * 16 + h], araw = ((float*)(F.ws + WS_BA))[(size_t)row * 16 + 8 + h];
    const float beta = 1.f / (1.f + expf(-braw)); const float xx = araw + (F.in[15])[h]; const float sp = xx > 20.f ? xx : log1pf(expf(xx)); const float g = -expf((F.in[14])[h]) * sp;
    float gcs = g;
#pragma unroll
    for (int o = 1; o < 64; o <<= 1) { const float t = __shfl_up(gcs, o); if (lane >= o) gcs += t; }
    const float glast = __shfl(gcs, 63);
    float* G = (float*)(F.ws + WS_GATES) + (size_t)it * 256;
    G[lane] = beta; G[64 + lane] = gcs; G[128 + lane] = expf(gcs); G[192 + lane] = expf(glast - gcs);
    if (lane == 63) ((float*)(F.ws + WS_GL))[it] = expf(glast);
}
#if defined(PROBE_PS)
#define PS_MARK(k) do { if (blockIdx.x == 0 && F.tid == 0) { const unsigned long long t_ = __builtin_amdgcn_s_memrealtime(); volatile LAS unsigned long long* a_ = (volatile LAS unsigned long long*)(F.lds + LDSCTL_OFF + 768); a_[(k)] += t_ - a_[15]; a_[15] = t_; } } while (0)
#else
#define PS_MARK(k) do {} while (0)
#endif
template <bool DRY, int SKIP = 0> __device__ __forceinline__ void gdn_prep_unit(Frame& F, int cn, int h, PrepRegs& P, int it_next, int par) {
    const int tid = F.tid, lane = F.lane, wave = F.wave, ch8 = tid & 15, rg = tid >> 4;
    LAS float* RHST = (LAS float*)(F.lds + PR_RHST); LAS bf16* QB = (LAS bf16*)(F.lds + PR_QB); LAS bf16* KB = (LAS bf16*)(F.lds + PR_KB);
    LAS float* AM = (LAS float*)(F.lds + PR_AM); LAS bf16* TB = (LAS bf16*)(F.lds + PR_TB);
    LAS float* SC = (LAS float*)(F.lds + PR_SC + (par ? 1536 : 0)); LAS float *S_BETA = SC, *S_GC = SC + 64, *S_EG = SC + 128, *S_EK = SC + 192;
    const size_t blk = (size_t)(cn * 8 + h) * 64 * 128;
    PS_MARK(0);
    const float gate_rec = P.gate;
    float y[3][2][8]; int ch8v = ch8, rgv = rg; asm volatile("" : "+v"(ch8v), "+v"(rgv));
#pragma unroll
    for (int t = 0; t < 3; ++t) { const int ch = t * 1024 + h * 128 + 8 * ch8v;
        float x[5][8];
#pragma unroll
        for (int j = 0; j < 5; ++j) { const v4u w = P.raw[t][j]; x[j][0] = bflo(w.x); x[j][1] = bfhi(w.x); x[j][2] = bflo(w.y); x[j][3] = bfhi(w.y); x[j][4] = bflo(w.z); x[j][5] = bfhi(w.z); x[j][6] = bflo(w.w); x[j][7] = bfhi(w.w); }
        const LAS float* cw = (const LAS float*)(F.lds + PR_CW) + t * 512 + 8 * ch8v;
#pragma unroll
        for (int hh = 0; hh < 2; ++hh) { const f32x4 w0 = *(const LAS f32x4*)(cw + 4 * hh), w1 = *(const LAS f32x4*)(cw + 128 + 4 * hh), w2 = *(const LAS f32x4*)(cw + 256 + 4 * hh), w3 = *(const LAS f32x4*)(cw + 384 + 4 * hh);
#pragma unroll
            for (int i = 0; i < 4; ++i)
#pragma unroll
                for (int r2 = 0; r2 < 2; ++r2) { const int ii = 4 * hh + i; if (SKIP & 8) y[t][r2][ii] = x[r2 + 3][ii] + w0[i]; else y[t][r2][ii] = siluf((w0[i] * x[r2][ii] + w1[i] * x[r2 + 1][ii]) + (w2[i] * x[r2 + 2][ii] + w3[i] * x[r2 + 3][ii])); } }
        asm volatile("" ::: "memory"); }
    float rn[2][2];
#pragma unroll
    for (int t = 0; t < 2; ++t)
#pragma unroll
        for (int r2 = 0; r2 < 2; ++r2) { float s = 0.f;
#pragma unroll
            for (int i = 0; i < 8; ++i) s += y[t][r2][i] * y[t][r2][i];
            s += __shfl_xor(s, 1); s += __shfl_xor(s, 2); s += __shfl_xor(s, 4); s += __shfl_xor(s, 8);
            rn[t][r2] = __builtin_amdgcn_rsqf(s + EPS) * (t == 0 ? 0.08838834764831845f : 1.f); }
    if (tid < 256) SC[tid] = gate_rec;
    LDS_WAIT(); __builtin_amdgcn_s_barrier();
    PS_MARK(1);
    if (SKIP & 16) { asm volatile("" :: "v"(y[0][0][0]), "v"(y[1][1][7]), "v"(y[2][0][3]), "v"(rn[0][0]), "v"(rn[1][1])); } else
    { int c8 = 8 * ch8, r0 = 2 * rg; asm volatile("" : "+v"(c8), "+v"(r0));
      float be[2], eg[2], ek[2];
#pragma unroll
      for (int r2 = 0; r2 < 2; ++r2) { be[r2] = S_BETA[r0 + r2]; eg[r2] = S_EG[r0 + r2]; ek[r2] = S_EK[r0 + r2]; }
#pragma unroll
      for (int r2 = 0; r2 < 2; ++r2) { float q[8], k[8];
#pragma unroll
          for (int i = 0; i < 8; ++i) { q[i] = y[0][r2][i] * rn[0][r2]; k[i] = y[1][r2][i] * rn[1][r2]; }
          const int row = r0 + r2;
          *(LAS v4u*)(QB + row * 136 + c8) = (v4u){pk2(q[0], q[1]), pk2(q[2], q[3]), pk2(q[4], q[5]), pk2(q[6], q[7])};
          *(LAS v4u*)(KB + row * 136 + c8) = (v4u){pk2(k[0], k[1]), pk2(k[2], k[3]), pk2(k[4], k[5]), pk2(k[6], k[7])};
          if (!DRY) *(v4u*)(((bf16*)(F.ws + WS_U5)) + blk + row * 128 + c8) = (v4u){pk2(q[0] * eg[r2], q[1] * eg[r2]), pk2(q[2] * eg[r2], q[3] * eg[r2]), pk2(q[4] * eg[r2], q[5] * eg[r2]), pk2(q[6] * eg[r2], q[7] * eg[r2])};
#pragma unroll
          for (int i = 0; i < 8; ++i) {
              y[1][r2][i] = k[i] * be[r2] * eg[r2]; y[2][r2][i] = y[2][r2][i] * be[r2]; } }
#pragma unroll
      for (int i = 0; i < 8; ++i) {
          const int rs = (r0 + (c8 >> 1)) & 63;
          *(LAS f32x2*)(RHST + (c8 + i) * 68 + rs) = (f32x2){y[2][0][i], y[2][1][i]};
          *(LAS f32x2*)(RHST + (128 + c8 + i) * 68 + rs) = (f32x2){y[1][0][i], y[1][1][i]}; } }
    LDS_WAIT(); __builtin_amdgcn_s_barrier();
    PS_MARK(2);
    if (!(SKIP & 2)) { int l4 = lane; asm volatile("" : "+v"(l4)); const int ti = wave & 3, fr = l4 & 15, fq = l4 >> 4; const LAS bf16* Ab = (wave < 4 ? KB : QB) + (16 * ti + fr) * 136 + 8 * fq;
      s16x8 a[4];
#pragma unroll
      for (int s = 0; s < 4; ++s) a[s] = *(const LAS s16x8*)(Ab + 32 * s);
      LAS bf16* IL = (LAS bf16*)(F.lds + PR_IL);
#pragma unroll
      for (int tj = 0; tj < 4; ++tj) { if (wave < 4 && tj > ti) continue;
          f32x4 acc = (f32x4){0.f, 0.f, 0.f, 0.f}; const LAS bf16* Bb = KB + (16 * tj + fr) * 136 + 8 * fq;
#pragma unroll
          for (int s = 0; s < 4; ++s) { const s16x8 b = *(const LAS s16x8*)(Bb + 32 * s); acc = __builtin_amdgcn_mfma_f32_16x16x32_bf16(a[s], b, acc, 0, 0, 0); }
          const int j = 16 * tj + fr; const float gj = S_GC[j];
#pragma unroll
          for (int r = 0; r < 4; ++r) { const int i = 16 * ti + 4 * fq + r; const float dec = fexp(fminf(S_GC[i] - gj, 0.f));
              if (wave < 4) AM[i * 68 + j] = (i > j) ? -(S_BETA[i] * acc[r] * dec) : 0.f;
              else { const unsigned iv = f2bf((i >= j) ? acc[r] * dec : 0.f); IL[i * 72 + j] = (bf16)iv; } } }
      if (wave < 4) {
          LDS_WAIT(); asm volatile("" ::: "memory");
          const int j = l4 & 15; int zv = 0; asm volatile("" : "+v"(zv)); const LAS float* Ad = AM + zv + (16 * ti) * 68 + 16 * ti; float t[16];
          f32x4 ar[16][4];
#pragma unroll
          for (int i = 1; i < 16; ++i)
#pragma unroll
              for (int k4 = 0; k4 < (i + 3) / 4; ++k4) ar[i][k4] = *(const LAS f32x4*)(Ad + i * 68 + 4 * k4);
#pragma unroll
          for (int i = 0; i < 16; ++i) { float acc = (i == j) ? 1.f : 0.f;
#pragma unroll
              for (int k = 0; k < i; ++k) acc += ar[i][k >> 2][k & 3] * t[k];
              t[i] = acc; }
          if (l4 < 16) {
#pragma unroll
              for (int i = 0; i < 16; ++i) TB[(16 * ti + i) * 16 + j] = (bf16)f2bf(t[i]); } } }
    LDS_WAIT(); __builtin_amdgcn_s_barrier();
    PS_MARK(3);
    if (!(SKIP & 4)) { int l6 = lane; asm volatile("" : "+v"(l6)); const int n = l6 & 15, g = l6 >> 4; f32x4 R[4][2];
#pragma unroll
      for (int b = 0; b < 4; ++b)
#pragma unroll
          for (int nt = 0; nt < 2; ++nt) { const int col = 32 * wave + 16 * nt + n; R[b][nt] = *(const LAS f32x4*)(RHST + col * 68 + ((16 * b + 4 * g + 4 * ((col >> 3) & 15)) & 63)); }
      LDS_WAIT(); __builtin_amdgcn_s_barrier();
      const LAS bf16* tb = TB + n * 16 + 4 * g; const LAS float* am = AM + n * 68 + 4 * g;
#pragma unroll
      for (int b = 0; b < 4; ++b) {
          const u32x2 tw = *(const LAS u32x2*)(tb + (16 * b) * 16); const s16x8 ta = __builtin_bit_cast(s16x8, (v4u){tw.x, tw.y, 0u, 0u});
          s16x8 xb[2];
#pragma unroll
          for (int nt = 0; nt < 2; ++nt) { const s16x8 rb = __builtin_bit_cast(s16x8, (v4u){pk2(R[b][nt].x, R[b][nt].y), pk2(R[b][nt].z, R[b][nt].w), 0u, 0u});
              R[b][nt] = __builtin_amdgcn_mfma_f32_16x16x32_bf16(ta, rb, (f32x4){0.f, 0.f, 0.f, 0.f}, 0, 0, 0);
              xb[nt] = __builtin_bit_cast(s16x8, (v4u){pk2(R[b][nt].x, R[b][nt].y), pk2(R[b][nt].z, R[b][nt].w), 0u, 0u}); }
#pragma unroll
          for (int b2 = b + 1; b2 < 4; ++b2) { const f32x4 av = *(const LAS f32x4*)(am + (16 * b2) * 68 + 16 * b); const s16x8 aa = __builtin_bit_cast(s16x8, (v4u){pk2(av.x, av.y), pk2(av.z, av.w), 0u, 0u});
              R[b2][0] = __builtin_amdgcn_mfma_f32_16x16x32_bf16(aa, xb[0], R[b2][0], 0, 0, 0); R[b2][1] = __builtin_amdgcn_mfma_f32_16x16x32_bf16(aa, xb[1], R[b2][1], 0, 0, 0); } }
      if (wave < 4) { LAS bf16* UL = (LAS bf16*)(F.lds + PR_RHST) + (32 * wave + n) * 72 + 4 * g;
#pragma unroll
          for (int b = 0; b < 4; ++b)
#pragma unroll
              for (int nt = 0; nt < 2; ++nt) *(LAS u32x2*)(UL + nt * 16 * 72 + 16 * b) = (u32x2){pk2(R[b][nt].x, R[b][nt].y), pk2(R[b][nt].z, R[b][nt].w)}; }
      else { LAS bf16* WL = QB + (4 * g) * 136 + 32 * (wave - 4) + n;
#pragma unroll
          for (int b = 0; b < 4; ++b)
#pragma unroll
              for (int nt = 0; nt < 2; ++nt)
#pragma unroll
                  for (int r = 0; r < 4; ++r) WL[(16 * b + r) * 136 + 16 * nt] = (bf16)f2bf(-R[b][nt][r]); } }
    LDS_WAIT(); __builtin_amdgcn_s_barrier();
    PS_MARK(5);
    { int c9 = ch8, r9 = rg; asm volatile("" : "+v"(c9), "+v"(r9)); prep_fetch(F, it_next >= 0 ? it_next : cn * 8 + h, c9, r9, P); }
    if (!DRY) { int t5 = tid; asm volatile("" : "+v"(t5));
#pragma unroll
        for (int i = 0; i < 2; ++i) { const int id = t5 + 512 * i, row = id >> 4, q = id & 15; *(v4u*)(((bf16*)(F.ws + WS_U1)) + blk + row * 128 + 8 * q) = *(const LAS v4u*)(QB + row * 136 + 8 * q); }
        { const int row = t5 >> 3, q = t5 & 7; *(v4u*)(((bf16*)(F.ws + WS_INTRA)) + (size_t)(cn * 8 + h) * 4096 + row * 64 + 8 * q) = *(const LAS v4u*)((LAS bf16*)(F.lds + PR_IL) + row * 72 + 8 * q); }
#pragma unroll
        for (int i = 0; i < 2; ++i) { const int id = t5 + 512 * i, row = id >> 3, q = id & 7;
            *(v4u*)(((bf16*)(F.ws + WS_U3)) + blk + row * 64 + 8 * q) = *(const LAS v4u*)((LAS bf16*)(F.lds + PR_RHST) + row * 72 + 8 * q);
            float kv[8];
#pragma unroll
            for (int j = 0; j < 8; ++j) kv[j] = bf2f(KB[(8 * q + j) * 136 + row]) * S_EK[8 * q + j];
            *(v4u*)(((bf16*)(F.ws + WS_U2)) + blk + row * 64 + 8 * q) = (v4u){pk2(kv[0], kv[1]), pk2(kv[2], kv[3]), pk2(kv[4], kv[5]), pk2(kv[6], kv[7])}; } }
    PS_MARK(6);
    LDS_WAIT();
}
typedef float f32x16 __attribute__((ext_vector_type(16)));
constexpr int SW_KS = 0, SW_VT = 27648, SW_TB = 53248;
__device__ __forceinline__ int t5_bucket(int rel) { const int n = rel < 0 ? -rel : rel;
    const int b = n < 8 ? n : n < 12 ? 8 : n < 16 ? 9 : n < 23 ? 10 : n < 32 ? 11 : n < 46 ? 12 : n < 64 ? 13 : n < 91 ? 14 : 15; return (rel > 0 ? 16 : 0) + b; }
template <bool DRY> __device__ __forceinline__ void swa_unit(Frame& F, int cn, int kh) {
    const int tid = F.tid, lane = F.lane, wave = F.wave, r32 = lane & 31, hi = lane >> 5;
    LAS bf16* KS = (LAS bf16*)(F.lds + SW_KS); LAS bf16* VT = (LAS bf16*)(F.lds + SW_VT); LAS float* TB = (LAS float*)(F.lds + SW_TB);
    const bool smp = cn >= 256; const int b = cn - 256;
#pragma unroll
    for (int it = 0; it < 3; ++it) { const int id = tid + 512 * it, row = id >> 3, dq = id & 7;
        v4u kw = (v4u){0u, 0u, 0u, 0u}, vw = kw;
        if (smp && row < 128) { const size_t so = ((size_t)(b * 128 + row) * 2 + kh) * 64 + dq * 8;
            const f32x4 k0 = *(const f32x4*)((F.in[4]) + so), k1 = *(const f32x4*)((F.in[4]) + so + 4), v0 = *(const f32x4*)((F.in[5]) + so), v1 = *(const f32x4*)((F.in[5]) + so + 4);
            kw = (v4u){pk2(k0.x, k0.y), pk2(k0.z, k0.w), pk2(k1.x, k1.y), pk2(k1.z, k1.w)}; vw = (v4u){pk2(v0.x, v0.y), pk2(v0.z, v0.w), pk2(v1.x, v1.y), pk2(v1.z, v1.w)};
            if (row >= 64 && !DRY) { float* ok = F.out + OFF_SK + (size_t)b * 16384 + (size_t)(row - 64) * 128 + kh * 64 + dq * 8; float* ov = F.out + OFF_SV + (size_t)b * 16384 + (size_t)(row - 64) * 128 + kh * 64 + dq * 8;
                *(f32x4*)ok = k0; *(f32x4*)(ok + 4) = k1; *(f32x4*)ov = v0; *(f32x4*)(ov + 4) = v1; } }
        else { const int kp = smp ? (MP + b * 64 + row - 128) : (cn * 64 - 128 + row);
            if (kp >= 0) { const bf16* src = ((bf16*)(F.ws + WS_KV)) + (size_t)kp * 256 + kh * 64 + dq * 8; kw = *(const v4u*)src; vw = *(const v4u*)(src + 128); } }
        *(LAS v4u*)(KS + row * 72 + dq * 8) = kw;
        LAS bf16* vt = VT + (dq * 8) * 200 + row;
        vt[0] = (bf16)(vw.x & 0xffffu); vt[200] = (bf16)(vw.x >> 16); vt[400] = (bf16)(vw.y & 0xffffu); vt[600] = (bf16)(vw.y >> 16);
        vt[800] = (bf16)(vw.z & 0xffffu); vt[1000] = (bf16)(vw.z >> 16); vt[1200] = (bf16)(vw.w & 0xffffu); vt[1400] = (bf16)(vw.w >> 16); }
    for (int id = tid; id < 8 * 256; id += 512) { const int hl = id >> 8, ix = id & 255; TB[id] = ix < 255 ? (F.in[18])[t5_bucket(ix - 191) * 16 + kh * 8 + hl] : 0.f; }
    __syncthreads();
    const int head = kh * 8 + wave; const float sink = (F.in[17])[head];
    bf16* Qg = ((bf16*)(F.ws + WS_U4)) + (size_t)(cn * 64) * D + head * 64;
    const LAS float* tb = TB + wave * 256;
#pragma unroll 1
    for (int qt = 0; qt < 2; ++qt) {
        s16x8 qf[4];
#pragma unroll
        for (int s = 0; s < 4; ++s) qf[s] = *(const s16x8*)(Qg + (size_t)(32 * qt + r32) * D + 16 * s + 8 * hi);
        f32x16 P[6]; const int qi = 32 * qt + r32; float mx = -INFINITY;
#pragma unroll
        for (int kt = 0; kt < 6; ++kt) { f32x16 acc = {};
#pragma unroll
            for (int s = 0; s < 4; ++s) { const s16x8 a = *(const LAS s16x8*)(KS + (32 * kt + r32) * 72 + 16 * s + 8 * hi); acc = __builtin_amdgcn_mfma_f32_32x32x16_bf16(a, qf[s], acc, 0, 0, 0); }
#pragma unroll
            for (int r = 0; r < 16; ++r) { const int j = 32 * kt + (r & 3) + 8 * (r >> 2) + 4 * hi; float l = acc[r] * 0.125f + tb[j - qi + 63];
                if (!smp && cn * 64 + j < 128) l = -INFINITY; acc[r] = l; mx = fmaxf(mx, l); }
            P[kt] = acc; asm volatile("" ::: "memory"); }
        mx = fmaxf(mx, __shfl_xor(mx, 32)); mx = fmaxf(mx, sink);
        float sum = 0.f;
#pragma unroll
        for (int kt = 0; kt < 6; ++kt)
#pragma unroll
            for (int r = 0; r < 16; ++r) { const float p = fexp(P[kt][r] - mx); P[kt][r] = p; sum += p; }
        sum += __shfl_xor(sum, 32);
        const float inv = 1.f / (sum + fexp(sink - mx));
        f32x16 O[2]; O[0] = (f32x16){}; O[1] = (f32x16){};
#pragma unroll
        for (int kt = 0; kt < 6; ++kt) {
#pragma unroll
            for (int s2 = 0; s2 < 2; ++s2) { v4u pw; pw.x = pk2(P[kt][8 * s2] * inv, P[kt][8 * s2 + 1] * inv); pw.y = pk2(P[kt][8 * s2 + 2] * inv, P[kt][8 * s2 + 3] * inv);
                pw.z = pk2(P[kt][8 * s2 + 4] * inv, P[kt][8 * s2 + 5] * inv); pw.w = pk2(P[kt][8 * s2 + 6] * inv, P[kt][8 * s2 + 7] * inv);
                const s16x8 pa = __builtin_bit_cast(s16x8, pw);
#pragma unroll
                for (int dt = 0; dt < 2; ++dt) { const LAS bf16* vp = VT + (32 * dt + r32) * 200 + 32 * kt + 16 * s2 + 4 * hi;
                    const u32x2 lo = *(const LAS u32x2*)vp, hh = *(const LAS u32x2*)(vp + 8);
                    const s16x8 vb = __builtin_bit_cast(s16x8, (v4u){lo.x, lo.y, hh.x, hh.y});
                    O[dt] = __builtin_amdgcn_mfma_f32_32x32x16_bf16(pa, vb, O[dt], 0, 0, 0); } }
            asm volatile("" ::: "memory"); }
#pragma unroll
        for (int dt = 0; dt < 2; ++dt)
#pragma unroll
            for (int r = 0; r < 16; ++r) { const int q = 32 * qt + (r & 3) + 8 * (r >> 2) + 4 * hi; const unsigned ov = f2bf(O[dt][r]); if (!DRY) Qg[(size_t)q * D + 32 * dt + r32] = (bf16)ov; else asm volatile("" :: "v"(ov)); }
    }
    __syncthreads();
}
constexpr int SC_WN = 0, SC_QP = 16384, SC_KPT = 32768, SC_IN = 49152, SC_STAGE = 57344;
template <int C, int NCHUNK> __device__ __forceinline__ void tile_rq(int lt, int i, int& row, int& q) {
    const int l = lt & 63, lw = lt >> 6, grp = l >> 4, s = NCHUNK * lw + i;
    const int rb = (C == 128) ? (s >> 1) : s, qb = (C == 128) ? 8 * (s & 1) : 0;
    row = 8 * rb + (l & 7); q = qb + 4 * (grp >> 1) + (grp & 1) + 2 * ((l >> 3) & 1);
}
template <int C, int NCHUNK> __device__ __forceinline__ void ld_tile(const bf16* src, int lt, v4u (&reg)[NCHUNK]) {
#pragma unroll
    for (int i = 0; i < NCHUNK; ++i) { int row, q; tile_rq<C, NCHUNK>(lt, i, row, q); reg[i] = *(const v4u*)(src + (size_t)row * C + 8 * q); }
}
template <int C, int NCHUNK> __device__ __forceinline__ void st_tile(LAS unsigned char* base, int lt, const v4u (&reg)[NCHUNK]) {
#pragma unroll
    for (int i = 0; i < NCHUNK; ++i) { int row, q; tile_rq<C, NCHUNK>(lt, i, row, q); const int ks = q >> 2, qq = q & 3;
        LAS unsigned char* d0 = base + ((row >> 4) * (C / 32) + ks) * 1024 + ((2 * (qq & 1)) * 16 + (row & 15)) * 16 + (qq >> 1) * 8;
        *(LAS u32x2*)d0 = (u32x2){reg[i].x, reg[i].y}; *(LAS u32x2*)(d0 + 256) = (u32x2){reg[i].z, reg[i].w}; }
}
__device__ __forceinline__ s16x8 pack_b(f32x4 a, f32x4 b) { v4u w; w.x = pk2(a.x, a.y); w.y = pk2(a.z, a.w); w.z = pk2(b.x, b.y); w.w = pk2(b.z, b.w); return __builtin_bit_cast(s16x8, w); }
#define MF16(a, b, c) __builtin_amdgcn_mfma_f32_16x16x32_bf16(a, b, c, 0, 0, 0)
template <bool DRY, int SKIP = 0> __device__ __forceinline__ void scan_task(Frame& F, int cn0, int nchunk, int h, int hf, const float* s0, float* sout, bool write_s) {
    const int lane = F.lane, wave = F.wave, e = lane & 15, g = lane >> 4;
    LAS unsigned char* ring = F.lds;
    if (wave >= 4) {
#ifndef SCAN_NO_LOADER
        const int lt = F.tid - 256; v4u rw[4], rq[4], rk[4], ri[2], sw[4], sq[4], sk[4], si[2];
#define LD_SET(cn, W, Q, K, I) do { const size_t blk_ = (size_t)((cn) * 8 + h) * 8192; ld_tile<128, 4>(((bf16*)(F.ws + WS_U1)) + blk_, lt, W); ld_tile<128, 4>(((bf16*)(F.ws + WS_U5)) + blk_, lt, Q); ld_tile<64, 4>(((bf16*)(F.ws + WS_U2)) + blk_, lt, K); ld_tile<64, 2>(((bf16*)(F.ws + WS_INTRA)) + (size_t)((cn) * 8 + h) * 4096, lt, I); } while (0)
#define ST_SET(st, W, Q, K, I) do { LAS unsigned char* b_ = ring + (st) * SC_STAGE; st_tile<128, 4>(b_ + SC_WN, lt, W); st_tile<128, 4>(b_ + SC_QP, lt, Q); st_tile<64, 4>(b_ + SC_KPT, lt, K); st_tile<64, 2>(b_ + SC_IN, lt, I); } while (0)
        if (!(SKIP & 1)) { LD_SET(cn0, rw, rq, rk, ri); ST_SET(0, rw, rq, rk, ri); if (nchunk > 1) LD_SET(cn0 + 1, sw, sq, sk, si); if (nchunk > 2) LD_SET(cn0 + 2, rw, rq, rk, ri); }
        LDS_WAIT(); __builtin_amdgcn_s_barrier();
#pragma unroll 1
        for (int n = 0; n < nchunk; ++n) {
            if (n + 1 < nchunk && !(SKIP & 1)) {
                if (n & 1) { ST_SET(0, rw, rq, rk, ri); if (n + 3 < nchunk) LD_SET(cn0 + n + 3, rw, rq, rk, ri); }
                else { ST_SET(1, sw, sq, sk, si); if (n + 3 < nchunk) LD_SET(cn0 + n + 3, sw, sq, sk, si); } }
            LDS_WAIT(); __builtin_amdgcn_s_barrier();
        }
#undef LD_SET
#undef ST_SET
#endif
    } else {
#ifndef SCAN_NO_SCAN
        const int e0 = 64 * hf + 16 * wave + e;
        f32x4 S[8];
#pragma unroll
        for (int dt = 0; dt < 8; ++dt) { const float* p = (const float*)((const char*)s0 + (size_t)((unsigned)((16 * dt + 4 * g) * 128 + e0) * 4u)); S[dt] = (f32x4){p[0], p[128], p[256], p[384]}; }
        u32x2 ucur[4], unext[4];
        { const bf16* up = ((bf16*)(F.ws + WS_U3)) + ((size_t)(cn0 * 8 + h) * 128 + e0) * 64 + 4 * g;
#pragma unroll
          for (int mt = 0; mt < 4; ++mt) ucur[mt] = *(const u32x2*)(up + 16 * mt); }
        __builtin_amdgcn_s_barrier();
#pragma unroll 1
        for (int n = 0; n < nchunk; ++n) {
            const int cn = cn0 + n; const LAS unsigned char* st = ring + (n & 1) * SC_STAGE + lane * 16;
            const float gl = ((float*)(F.ws + WS_GL))[cn * 8 + h];
            bf16* op = ((bf16*)(F.ws + WS_U3)) + ((size_t)(cn * 8 + h) * 128 + e0) * 64 + 4 * g;
            if (n + 1 < nchunk) {
#pragma unroll
                for (int mt = 0; mt < 4; ++mt) unext[mt] = *(const u32x2*)(op + 8 * 128 * 64 + 16 * mt); }
            if (SKIP & 2) { LDS_WAIT(); __builtin_amdgcn_s_barrier(); continue; }
            s16x8 Sb[4];
#pragma unroll
            for (int ks = 0; ks < 4; ++ks) Sb[ks] = pack_b(S[2 * ks], S[2 * ks + 1]);
            f32x4 Vn[4], O[4];
#pragma unroll
            for (int mt = 0; mt < 4; ++mt) { Vn[mt] = (f32x4){bflo(ucur[mt].x), bfhi(ucur[mt].x), bflo(ucur[mt].y), bfhi(ucur[mt].y)}; O[mt] = (f32x4){0.f, 0.f, 0.f, 0.f}; }
            s16x8 fa[8], fb[8];
#define FENCE() asm volatile("" ::: "memory")
#define LD_WQ(dst, mt) do { _Pragma("unroll") for (int ks = 0; ks < 4; ++ks) { dst[ks] = *(const LAS s16x8*)(st + SC_WN + ((mt) * 4 + ks) * 1024); dst[4 + ks] = *(const LAS s16x8*)(st + SC_QP + ((mt) * 4 + ks) * 1024); } } while (0)
#define MM_WQ(src, mt) do { _Pragma("unroll") for (int ks = 0; ks < 4; ++ks) { Vn[mt] = MF16(src[ks], Sb[ks], Vn[mt]); O[mt] = MF16(src[4 + ks], Sb[ks], O[mt]); } } while (0)
#define LD_4(dst, off, a) do { _Pragma("unroll") for (int i_ = 0; i_ < 4; ++i_) dst[i_] = *(const LAS s16x8*)(st + (off) + ((a) * 4 + i_) * 1024); } while (0)
#define MM_IN(src, mp) do { O[2 * (mp)] = MF16(src[0], Vb[0], O[2 * (mp)]); O[2 * (mp)] = MF16(src[1], Vb[1], O[2 * (mp)]); O[2 * (mp) + 1] = MF16(src[2], Vb[0], O[2 * (mp) + 1]); O[2 * (mp) + 1] = MF16(src[3], Vb[1], O[2 * (mp) + 1]); } while (0)
#define MM_KP(src, dp) do { S[2 * (dp)] = MF16(src[0], Vb[0], S[2 * (dp)]); S[2 * (dp)] = MF16(src[1], Vb[1], S[2 * (dp)]); S[2 * (dp) + 1] = MF16(src[2], Vb[0], S[2 * (dp) + 1]); S[2 * (dp) + 1] = MF16(src[3], Vb[1], S[2 * (dp) + 1]); } while (0)
            LD_WQ(fa, 0); FENCE(); LD_WQ(fb, 1); MM_WQ(fa, 0); FENCE(); LD_WQ(fa, 2); MM_WQ(fb, 1); FENCE(); LD_WQ(fb, 3); MM_WQ(fa, 2); FENCE(); LD_4(fa, SC_IN, 0); MM_WQ(fb, 3); FENCE();
#pragma unroll
            for (int dt = 0; dt < 8; ++dt) S[dt] = S[dt] * gl;
            s16x8 Vb[2];
#pragma unroll
            for (int k2 = 0; k2 < 2; ++k2) Vb[k2] = pack_b(Vn[2 * k2], Vn[2 * k2 + 1]);
            LD_4(fb, SC_IN, 1); MM_IN(fa, 0); FENCE(); LD_4(fa, SC_KPT, 0); MM_IN(fb, 1); FENCE(); LD_4(fb, SC_KPT, 1); MM_KP(fa, 0); FENCE(); LD_4(fa, SC_KPT, 2); MM_KP(fb, 1); FENCE(); LD_4(fb, SC_KPT, 3); MM_KP(fa, 2); FENCE(); MM_KP(fb, 3);
#undef FENCE
#undef LD_WQ
#undef MM_WQ
#undef LD_4
#undef MM_IN
#undef MM_KP
#pragma unroll
            for (int mt = 0; mt < 4; ++mt) { u32x2 w; w.x = pk2(O[mt].x, O[mt].y); w.y = pk2(O[mt].z, O[mt].w); if (!DRY) *(u32x2*)(op + 16 * mt) = w; else asm volatile("" :: "v"(w.x), "v"(w.y)); ucur[mt] = unext[mt]; }
            LDS_WAIT(); __builtin_amdgcn_s_barrier();
        }
        { unsigned so = (unsigned)((4 * g) * 128 + e0) * 4u; asm volatile("" : "+v"(so));
#pragma unroll
          for (int dt = 0; dt < 8; ++dt) { float* p = (float*)((char*)sout + (size_t)(so + dt * 8192u)); if (!DRY && write_s) { p[0] = S[dt].x; p[128] = S[dt].y; p[256] = S[dt].z; p[384] = S[dt].w; } else asm volatile("" :: "v"(S[dt].x), "v"(S[dt].y), "v"(S[dt].z), "v"(S[dt].w)); } }
#endif
    }
}

__device__ __forceinline__ void scanA_task(Frame& F, int cn0, int nchunk, int h, int hf, float* sout, bf16* mout) {
    const int lane = F.lane, wave = F.wave, e = lane & 15, g = lane >> 4;
    LAS unsigned char* ring = F.lds;
    if (wave >= 4) {
        const int lt = F.tid - 256; v4u rw[4], rk[4];
#define LD_A(cn) do { const size_t blk_ = (size_t)((cn) * 8 + h) * 8192; ld_tile<128, 4>(((bf16*)(F.ws + WS_U1)) + blk_, lt, rw); ld_tile<64, 4>(((bf16*)(F.ws + WS_U2)) + blk_, lt, rk); } while (0)
#define ST_A(st) do { LAS unsigned char* b_ = ring + (st) * SC_STAGE; st_tile<128, 4>(b_ + SC_WN, lt, rw); st_tile<64, 4>(b_ + SC_KPT, lt, rk); } while (0)
        LD_A(cn0); ST_A(0); if (nchunk > 1) LD_A(cn0 + 1);
        LDS_WAIT(); __builtin_amdgcn_s_barrier();
#pragma unroll 1
        for (int n = 0; n < nchunk; ++n) {
            if (n + 1 < nchunk) { ST_A((n + 1) & 1); if (n + 2 < nchunk) LD_A(cn0 + n + 2); }
            LDS_WAIT(); __builtin_amdgcn_s_barrier();
        }
#undef LD_A
#undef ST_A
    } else {
        const int e0 = 64 * hf + 16 * wave + e;
        f32x4 S[8], X[8];
#pragma unroll
        for (int dt = 0; dt < 8; ++dt) { S[dt] = (f32x4){0.f, 0.f, 0.f, 0.f}; const int d0 = 16 * dt + 4 * g;
            X[dt] = (f32x4){d0 == e0 ? 1.f : 0.f, d0 + 1 == e0 ? 1.f : 0.f, d0 + 2 == e0 ? 1.f : 0.f, d0 + 3 == e0 ? 1.f : 0.f}; }
        u32x2 ucur[4], unext[4];
        { const bf16* up = ((bf16*)(F.ws + WS_U3)) + ((size_t)(cn0 * 8 + h) * 128 + e0) * 64 + 4 * g;
#pragma unroll
          for (int mt = 0; mt < 4; ++mt) ucur[mt] = *(const u32x2*)(up + 16 * mt); }
        __builtin_amdgcn_s_barrier();
#pragma unroll 1
        for (int n = 0; n < nchunk; ++n) {
            const int cn = cn0 + n; const LAS unsigned char* st = ring + (n & 1) * SC_STAGE + lane * 16;
            const float gl = ((float*)(F.ws + WS_GL))[cn * 8 + h];
            const bf16* op = ((bf16*)(F.ws + WS_U3)) + ((size_t)(cn * 8 + h) * 128 + e0) * 64 + 4 * g;
            if (n + 1 < nchunk) {
#pragma unroll
                for (int mt = 0; mt < 4; ++mt) unext[mt] = *(const u32x2*)(op + 8 * 128 * 64 + 16 * mt); }
            s16x8 Sb[4], Xb[4];
#pragma unroll
            for (int ks = 0; ks < 4; ++ks) { Sb[ks] = pack_b(S[2 * ks], S[2 * ks + 1]); Xb[ks] = pack_b(X[2 * ks], X[2 * ks + 1]); }
            f32x4 Vn[4], Vx[4];
#pragma unroll
            for (int mt = 0; mt < 4; ++mt) { Vn[mt] = (f32x4){bflo(ucur[mt].x), bfhi(ucur[mt].x), bflo(ucur[mt].y), bfhi(ucur[mt].y)}; Vx[mt] = (f32x4){0.f, 0.f, 0.f, 0.f}; }
#pragma unroll
            for (int mt = 0; mt < 4; ++mt)
#pragma unroll
                for (int ks = 0; ks < 4; ++ks) { const s16x8 aw = *(const LAS s16x8*)(st + SC_WN + (mt * 4 + ks) * 1024);
                    Vn[mt] = MF16(aw, Sb[ks], Vn[mt]); Vx[mt] = MF16(aw, Xb[ks], Vx[mt]); if (ks == 3) asm volatile("" ::: "memory"); }
#pragma unroll
            for (int dt = 0; dt < 8; ++dt) { S[dt] = S[dt] * gl; X[dt] = X[dt] * gl; }
            s16x8 Vb[2], Wb[2];
#pragma unroll
            for (int k2 = 0; k2 < 2; ++k2) { Vb[k2] = pack_b(Vn[2 * k2], Vn[2 * k2 + 1]); Wb[k2] = pack_b(Vx[2 * k2], Vx[2 * k2 + 1]); }
#pragma unroll
            for (int dt = 0; dt < 8; ++dt)
#pragma unroll
                for (int k2 = 0; k2 < 2; ++k2) { const s16x8 ak = *(const LAS s16x8*)(st + SC_KPT + (dt * 2 + k2) * 1024); S[dt] = MF16(ak, Vb[k2], S[dt]); X[dt] = MF16(ak, Wb[k2], X[dt]); if (k2 == 1 && (dt & 1)) asm volatile("" ::: "memory"); }
#pragma unroll
            for (int mt = 0; mt < 4; ++mt) ucur[mt] = unext[mt];
            LDS_WAIT(); __builtin_amdgcn_s_barrier();
        }
        { unsigned so = (unsigned)((4 * g) * 128 + e0); asm volatile("" : "+v"(so));
#pragma unroll
          for (int dt = 0; dt < 8; ++dt) { float* p = sout + so + dt * 2048u; p[0] = S[dt].x; p[128] = S[dt].y; p[256] = S[dt].z; p[384] = S[dt].w;
              bf16* q = mout + so + dt * 2048u; q[0] = (bf16)f2bf(X[dt].x); q[128] = (bf16)f2bf(X[dt].y); q[256] = (bf16)f2bf(X[dt].z); q[384] = (bf16)f2bf(X[dt].w); } }
    }
}
template <int NGR, int N, int FL> __device__ __forceinline__ void scanB_step(Frame& F, int h, int cb, int rq, size_t roff, const bf16* MG, const float* SG, v4u (&rm)[3][4], f32x4 (&Bq)[3][2], f32x4 (&So)[FL][2]) {
    constexpr int J = N % 3, n = N;
    LAS unsigned char* ring = F.lds; LAS unsigned char* XB = ring + 2 * SC_STAGE; const int lane = F.lane;
    const LAS unsigned char* st = ring + (n & 1) * SC_STAGE + lane * 16;
    const LAS unsigned char* xr = XB + (((n & 1) * 2 + cb) * 4) * 1024 + lane * 16;
    s16x8 Sb[4];
#pragma unroll
    for (int ks = 0; ks < 4; ++ks) Sb[ks] = *(const LAS s16x8*)(xr + ks * 1024);
#pragma unroll
    for (int dt = 0; dt < 2; ++dt) { f32x4 acc = Bq[J][dt];
#pragma unroll
        for (int ks = 0; ks < 4; ++ks) { const s16x8 am = *(const LAS s16x8*)(st + ((2 * rq + dt) * 4 + ks) * 1024); acc = MF16(am, Sb[ks], acc); }
        So[N % FL][dt] = acc; }
    *(LAS s16x8*)(XB + (((((n + 1) & 1) * 2 + cb) * 4) + rq) * 1024 + lane * 16) = pack_b(So[N % FL][0], So[N % FL][1]);
    st_tile<128, 4>(ring + ((n + 1) & 1) * SC_STAGE, F.tid, rm[(J + 1) % 3]);
    { constexpr int nm = n + 4 < NGR ? n + 4 : NGR - 1; ld_tile<128, 4>(MG + (size_t)(nm * 8 + h) * 16384, F.tid, rm[(J + 1) % 3]); }
    { constexpr int nb = n + 3 < NGR ? n + 3 : NGR - 1; const float* bq = SG + (size_t)(nb * 8 + h) * 16384 + roff;
#pragma unroll
      for (int dt = 0; dt < 2; ++dt) { const float* p = bq + dt * 2048; Bq[J][dt] = (f32x4){p[0], p[128], p[256], p[384]}; } }
    LDS_WAIT(); __builtin_amdgcn_s_barrier();
}
template <int FL> __device__ __forceinline__ void scanB_flush(int n_first, int count, int h, size_t roff, float* SG, const f32x4 (&So)[FL][2]) {
#pragma unroll
    for (int i = 0; i < FL; ++i) if (i < count) { float* bp = SG + (size_t)((n_first + i) * 8 + h) * 16384 + roff;
#pragma unroll
        for (int dt = 0; dt < 2; ++dt) { float* p = bp + dt * 2048; p[0] = So[i][dt].x; p[128] = So[i][dt].y; p[256] = So[i][dt].z; p[384] = So[i][dt].w; } }
}
template <int NGR> __device__ __forceinline__ void scanB_task(Frame& F, int h, int cq, const bf16* MG, float* SG) {
    static_assert(NGR == 15, "pass B is written out for 15 steps");
    constexpr int FL = 8;
    const int lane = F.lane, e = lane & 15, g4 = lane >> 4, cb = F.wave & 1, rq = F.wave >> 1;
    LAS unsigned char* ring = F.lds; LAS unsigned char* XB = ring + 2 * SC_STAGE;
    const int e0 = 32 * cq + 16 * cb + e; const size_t roff = (size_t)(32 * rq + 4 * g4) * 128 + e0;
    v4u rm[3][4]; f32x4 Bq[3][2], So[FL][2];
    ld_tile<128, 4>(MG + (size_t)h * 16384, F.tid, rm[0]); st_tile<128, 4>(ring, F.tid, rm[0]);
    ld_tile<128, 4>(MG + (size_t)(1 * 8 + h) * 16384, F.tid, rm[1]);
    ld_tile<128, 4>(MG + (size_t)(2 * 8 + h) * 16384, F.tid, rm[2]);
    ld_tile<128, 4>(MG + (size_t)(3 * 8 + h) * 16384, F.tid, rm[0]);
#pragma unroll
    for (int q = 0; q < 3; ++q) { const float* bp0 = SG + (size_t)(q * 8 + h) * 16384 + roff;
#pragma unroll
        for (int dt = 0; dt < 2; ++dt) { const float* p = bp0 + dt * 2048; Bq[q][dt] = (f32x4){p[0], p[128], p[256], p[384]}; } }
    *(LAS v4u*)(XB + (cb * 4 + rq) * 1024 + lane * 16) = (v4u){0u, 0u, 0u, 0u};
    LDS_WAIT(); __builtin_amdgcn_s_barrier();
#define SB_STEP(N) scanB_step<NGR, N, FL>(F, h, cb, rq, roff, MG, SG, rm, Bq, So)
#if defined(PROBE_SB)
    const unsigned long long tq0 = __builtin_amdgcn_s_memrealtime();
#endif
    SB_STEP(0); SB_STEP(1); SB_STEP(2); SB_STEP(3); SB_STEP(4); SB_STEP(5); SB_STEP(6); SB_STEP(7);
#if defined(PROBE_SB)
    if (blockIdx.x == 0 && F.tid == 0) ((volatile LAS unsigned long long*)(F.lds + LDSCTL_OFF + 768))[13] = __builtin_amdgcn_s_memrealtime() - tq0;
#endif
    scanB_flush<FL>(0, 8, h, roff, SG, So);
    SB_STEP(8); SB_STEP(9); SB_STEP(10); SB_STEP(11); SB_STEP(12); SB_STEP(13); SB_STEP(14);
    scanB_flush<FL>(8, 7, h, roff, SG, So);
#undef SB_STEP
}
#undef MF16
constexpr int SCAN_NG = 16, SCAN_GC = 16;
constexpr size_t WS_MG = 242 * MiB, WS_SG = 246 * MiB;
__device__ __forceinline__ void scanA_phase(Frame& F) {
    const int bx = blockIdx.x; bf16* MG = (bf16*)(F.ws + WS_MG); float* SG = (float*)(F.ws + WS_SG);
    if (bx < (SCAN_NG - 1) * 16) { const int gq = bx >> 4, h = bx & 7, hf = (bx >> 3) & 1;
        scanA_task(F, gq * SCAN_GC, SCAN_GC, h, hf, SG + (size_t)(gq * 8 + h) * 16384, MG + (size_t)(gq * 8 + h) * 16384); }
    for (int t = (bx + 16) % F.G; t < 512; t += F.G) { const int b = t >> 4, h = t & 7, hf = (t >> 3) & 1;
        scan_task<false>(F, 256 + b, 1, h, hf, ((const float*)(F.in[3])) + (size_t)(b * 8 + h) * 16384, F.out + OFF_SS + (size_t)(b * 8 + h) * 16384, true); }
}
constexpr int SCANB_WGS = 32;
__device__ __forceinline__ void scanB_phase(Frame& F) { const int bx = blockIdx.x;
#if defined(PROBE_SB)
    const unsigned long long tsb0 = __builtin_amdgcn_s_memrealtime();
#endif
    for (int t = bx; t < SCANB_WGS; t += F.G) { scanB_task<SCAN_NG - 1>(F, t & 7, t >> 3, (const bf16*)(F.ws + WS_MG), (float*)(F.ws + WS_SG)); __syncthreads(); }
#if defined(PROBE_SB)
    if (bx == 0 && F.tid == 0) ((volatile LAS unsigned long long*)(F.lds + LDSCTL_OFF + 768))[PROBE_SB] = __builtin_amdgcn_s_memrealtime() - tsb0;
#endif
}
template <bool DRY, int SKIP = 0> __device__ __forceinline__ void scanC_phase(Frame& F) {
    const int bx = blockIdx.x;
    for (int t = bx; t < SCAN_NG * 16; t += F.G) { const int gq = t >> 4, h = t & 7, hf = (t >> 3) & 1;
        const float* s0 = gq == 0 ? (const float*)(F.ws + WS_CTL + 512 * 1024) : (const float*)(F.ws + WS_SG) + (size_t)((gq - 1) * 8 + h) * 16384;
        scan_task<DRY, SKIP>(F, gq * SCAN_GC, SCAN_GC, h, hf, s0, F.out + OFF_PS + (size_t)h * 16384, gq == SCAN_NG - 1); }
}
struct NgRegs { unsigned short o[16]; v4u z0, z1; };
__device__ __forceinline__ void ng_load(Frame& F, int it, int c, int eg, NgRegs& r) {
    const int cn = it >> 3, h = it & 7;
    const bf16* op = ((bf16*)(F.ws + WS_U3)) + ((size_t)(cn * 8 + h) * 128 + 16 * eg) * 64 + c;
#pragma unroll
    for (int i = 0; i < 16; ++i) r.o[i] = op[i * 64];
    const size_t ro = (size_t)(cn * 64 + c) * D + h * 128 + 16 * eg;
    r.z0 = *(const v4u*)(((bf16*)(F.ws + WS_U2)) + ro); r.z1 = *(const v4u*)(((bf16*)(F.ws + WS_U2)) + ro + 8);
}
__device__ __forceinline__ void normgate_phase(Frame& F) {
    const int tid = F.tid, c = tid & 63, eg = F.wave; LAS float* red = (LAS float*)F.lds;
    int it = F.vcu; if (it >= NCH * 8) return;
    NgRegs cur, nxt; ng_load(F, it, c, eg, cur); int par = 0;
    const float* nw = (F.in[16]) + 16 * eg;
#pragma unroll 1
    for (; it < NCH * 8; it += F.G) {
        const bool has_next = it + F.G < NCH * 8;
        if (has_next) ng_load(F, it + F.G, c, eg, nxt);
        float o[16]; float ss = 0.f;
#pragma unroll
        for (int i = 0; i < 16; ++i) { o[i] = bf2f(cur.o[i]); ss += o[i] * o[i]; }
        LAS float* rd = red + par * 512; rd[eg * 64 + c] = ss;
        __syncthreads();
        float tot = 0.f;
#pragma unroll
        for (int w = 0; w < 8; ++w) tot += rd[w * 64 + c];
        const float ri = __builtin_amdgcn_rsqf(tot * (1.f / 128.f) + EPS);
        const unsigned zz[8] = {cur.z0.x, cur.z0.y, cur.z0.z, cur.z0.w, cur.z1.x, cur.z1.y, cur.z1.z, cur.z1.w}; unsigned w[8];
#pragma unroll
        for (int i = 0; i < 8; ++i) w[i] = pk2(o[2 * i] * ri * nw[2 * i] * siluf(bflo(zz[i])), o[2 * i + 1] * ri * nw[2 * i + 1] * siluf(bfhi(zz[i])));
        const int cn = it >> 3, h = it & 7;
        bf16* dst = ((bf16*)(F.ws + WS_U1)) + (size_t)(cn * 64 + c) * D + h * 128 + 16 * eg;
        *(v4u*)dst = (v4u){w[0], w[1], w[2], w[3]}; *(v4u*)(dst + 8) = (v4u){w[4], w[5], w[6], w[7]};
        cur = nxt; par ^= 1;
    }
}
#ifndef PREP_STAGGER
#define PREP_STAGGER 3
#endif
#ifndef PREP_DROP
#define PREP_DROP 2
#endif
__device__ __forceinline__ int prep_unit_id(const Frame& F, int i) {
    if (F.G != 256) { const long it = (long)F.vcu + (long)i * F.G; return it < NCH * 8 ? (int)it : -1; }
    const int v = F.vcu;
    if (v < 64) return i < 9 - PREP_DROP ? v + 256 * i : -1;
    if (i < 9) return v + 256 * i;
    const int e = (v - 64) >> 3;
    return (i == 9 && e < 8 * PREP_DROP) ? 8 * (e & 7) + (v & 7) + 256 * (9 - PREP_DROP + (e >> 3)) : -1;
}
#ifndef CONV1_H2
#define CONV1_H2 0
#endif
#ifndef PROBE_AMP
#define PROBE_AMP 1
#endif
#ifndef ADA_NA
#define ADA_NA 5
#endif
enum Phase { PH_P0 = 0, PH_H1, PH_G1, PH_G2, PH_H2, PH_F1, PH_PREP, PH_SCAN, PH_SCANB, PH_SCANC, PH_F2, PH_NG, PH_G4A, PH_G4B, PH_G5, PH_H3, PH_G6, PH_G7, PH_FIN, PH_COUNT };
struct Args { const float* in[28]; float* out; unsigned char* ws; int ph_lo, ph_hi; };
static_assert(sizeof(Args) == 28 * 8 + 8 + 8 + 8, "Args has no padding");

#ifdef ONLY_PH
#define PHON(x) ((x) == ONLY_PH)
#else
#define PHON(x) true
#endif
template <class Epi> __device__ __forceinline__ void run_gemm(Frame& F, const bf16* A, const bf16* Bt, int N, int K, const Epi& E, int lda = 0) {
    pg8::Gemm g{A, Bt, M, N, K, lda}; pg8::StaticOrder S; S.init(M, N, F.G, (int)blockIdx.x); S.ntf = K / 64;
    pg8::gemm_phase<Epi, pg8::StaticOrder, PG8_ALIGN, PG8_SP2>(F.lds, g, S, E);
}

struct SplitOrder : pg8::StaticOrder {
    bool split; int probe2 = 0; bool only_first = false;
    __device__ __forceinline__ bool next(int i, pg8::Unit& u) const {
        if (!split) return pg8::StaticOrder::next(i, u);
        if (only_first && i > 0) return false;
        if (probe2) { if (i > 0) return false; i = 1; }
        if (i > 1) return false;
        const int x = c & 7, j = c >> 3;
        if (i == 0) { u.pm = 8 * x + (j & 7); u.pn = j >> 3; u.k0 = 0; u.nt = ntf; u.piece = 0; u.lidx = 0; return true; }
        const int P = 8, pc = x, pairs = ntf / 2, base = pairs / P, extra = pairs - base * P;
        u.pm = 64 + (j & 7); u.pn = j >> 3; u.lidx = (j & 7) * 4 + (j >> 3);
        u.k0 = 2 * (pc * base + (pc < extra ? pc : extra)); u.nt = 2 * (base + (pc < extra ? 1 : 0)); u.piece = pc + 1; if (probe2 == 2) u.nt = 2; return true;
    }
};
struct PiecesAB : pg8::StaticOrder {
    __device__ __forceinline__ bool next(int i, pg8::Unit& u) const {
        if (i > 0) return false;
        const int x = c & 7, j = c >> 3;
        u.pm = 64 + (j & 7); u.pn = j >> 3; u.lidx = (j & 7) * 4 + (j >> 3); u.k0 = 4 * (x & 3); u.nt = 4; u.piece = x + 1; return true;
    }
};
__device__ __forceinline__ void branch_fixup_rows(Frame& F, const bf16* part) {
    const int gw = F.vcu * NWAVES + F.wave, NGW = F.G * NWAVES;
    for (int m = MP + gw; m < M; m += NGW) {
        GAS u32x2* ga = (GAS u32x2*)(((bf16*)(F.ws + WS_U5)) + (size_t)m * D) + F.lane; const GAS u32x2* gb = (const GAS u32x2*)(((bf16*)(F.ws + WS_U6)) + (size_t)m * D) + F.lane;
#pragma unroll
        for (int j = 0; j < 4; ++j) { const int li = ((m >> 8) - 64) * 4 + j;
            const GAS u32x2* pp = (const GAS u32x2*)(part + (size_t)li * 8 * 65536 + (size_t)(m & 255) * 256) + F.lane; f32x4 sa = (f32x4){0.f, 0.f, 0.f, 0.f}, sb = sa;
#pragma unroll
            for (int p = 0; p < 4; ++p) { const u32x2 w = pp[(size_t)p * 16384]; sa += (f32x4){bflo(w.x), bfhi(w.x), bflo(w.y), bfhi(w.y)}; }
#pragma unroll
            for (int p = 4; p < 8; ++p) { const u32x2 w = pp[(size_t)p * 16384]; sb += (f32x4){bflo(w.x), bfhi(w.x), bflo(w.y), bfhi(w.y)}; }
            const u32x2 a = ga[64 * j], b = gb[64 * j];
            const f32x4 o = (f32x4){sigm(bflo(a.x)) * sa.x + sigm(bflo(b.x)) * sb.x, sigm(bfhi(a.x)) * sa.y + sigm(bfhi(b.x)) * sb.y, sigm(bflo(a.y)) * sa.z + sigm(bflo(b.y)) * sb.z, sigm(bfhi(a.y)) * sa.w + sigm(bfhi(b.y)) * sb.w};
            ga[64 * j] = (u32x2){pk2(o.x, o.y), pk2(o.z, o.w)}; }
    }
}
template <class Epi> __device__ __forceinline__ void run_gemm_split(Frame& F, const bf16* A, const bf16* Bt, int N, int K, const Epi& E, int probe = 0) {
    pg8::Gemm g{A, Bt, M, N, K, 0}; SplitOrder S; S.init(M, N, F.G, (int)blockIdx.x); S.ntf = K / 64; S.split = (F.G == 256); S.only_first = (probe == 2); S.probe2 = probe >= 3 ? probe - 2 : 0;
    pg8::gemm_phase<Epi, SplitOrder, PG8_ALIGN, PG8_SP2>(F.lds, g, S, E);
}
__global__ void __launch_bounds__(NWAVES * 64, 2) mega_fwd(Args args) {
    extern __shared__ __attribute__((aligned(16))) unsigned char lds[];
    Frame F;
    F.lds = (LAS unsigned char*)lds; F.MISC = (volatile LAS unsigned*)(F.lds + MISC_OFF);
    F.tid = threadIdx.x; F.lane = F.tid & 63; F.wave = __builtin_amdgcn_readfirstlane(F.tid >> 6);
    F.G = gridDim.x; { const int bx = blockIdx.x; F.vcu = (F.G % 8 == 0) ? (bx % 8) * (F.G / 8) + bx / 8 : bx; }
    unsigned char* ws = args.ws; F.ctl = (gu32*)(ws + WS_CTL);
    F.in = args.in; F.out = args.out; F.ws = ws;
    for (int u = F.tid; u < (LDS_BYTES - LDSCTL_OFF) / 4; u += NWAVES * 64) ((LAS unsigned*)(F.lds + LDSCTL_OFF))[u] = 0u;
    __syncthreads();
    XcdBarrier bar; bar.bar = (unsigned*)(F.ctl + CW_BAR); bar.x = 0; bar.st = nullptr;
    const bool multi = args.ph_hi - args.ph_lo > 1;
    if (multi) bar = xcd_barrier_post((unsigned*)(F.ctl + CW_BAR), F.MISC + 8);

    const int lo = args.ph_lo, hi = args.ph_hi;
#if defined(PROBE_TS)
    if (blockIdx.x == 0 && F.tid == 0) ((volatile LAS unsigned long long*)(F.lds + LDSCTL_OFF + 512))[0] = __builtin_amdgcn_s_memrealtime();
#endif
#define IN(k) (PHON(k) && lo <= (k) && (k) < hi)
#define SEAM(k) do { if (lo <= (k) && (k) + 1 < hi) xcd_barrier(bar); } while (0)
#if defined(PROBE_TS)
#undef SEAM
#define SEAM(k) do { if (lo <= (k) && (k) + 1 < hi) xcd_barrier(bar); if (blockIdx.x == 0 && F.tid == 0) ((volatile LAS unsigned long long*)(F.lds + LDSCTL_OFF + 512))[(k) + 1] = __builtin_amdgcn_s_memrealtime(); } while (0)
#endif
#if defined(PROBE_P0)
    if (IN(PH_P0)) { { { const bool sp = F.G >= 160; const int nB = sp ? (4224 - 144 * ADA_NA + F.G - 145) / (F.G - 144) : (4224 + F.G - 1) / F.G; const int tlo = !sp ? F.vcu * nB : F.vcu < 144 ? F.vcu * ADA_NA : 144 * ADA_NA + (F.vcu - 144) * nB; const int thi = tlo + ((sp && F.vcu < 144) ? ADA_NA : nB);
        for (int it = F.vcu; it < 144; it += F.G) ada_item(F, it); convert_ffn_range(F, (F.in[9]), (F.in[10]), ((bf16*)(F.ws + WS_W)) + W_FIN, ((bf16*)(F.ws + WS_W)) + W_FOUT, tlo, thi); } }  xcd_barrier(bar); }
#endif
    if (IN(PH_P0)) { { { const bool sp = F.G >= 160; const int nB = sp ? (4224 - 144 * ADA_NA + F.G - 145) / (F.G - 144) : (4224 + F.G - 1) / F.G; const int tlo = !sp ? F.vcu * nB : F.vcu < 144 ? F.vcu * ADA_NA : 144 * ADA_NA + (F.vcu - 144) * nB; const int thi = tlo + ((sp && F.vcu < 144) ? ADA_NA : nB);
        for (int it = F.vcu; it < 144; it += F.G) ada_item(F, it); convert_ffn_range(F, (F.in[9]), (F.in[10]), ((bf16*)(F.ws + WS_W)) + W_FIN, ((bf16*)(F.ws + WS_W)) + W_FOUT, tlo, thi); } } }
    SEAM(PH_P0);
#if defined(PROBE_H1)
#if defined(PROBE_BAR)
    if (IN(PH_H1)) { for (int i_ = 0; i_ < 10; ++i_) xcd_barrier(bar); }
#endif
    if (IN(PH_H1)) { rmsmod_rows<false>(F, true, (F.in[8]), 0, ((bf16*)(F.ws + WS_U1)));  xcd_barrier(bar); }
#endif
    if (IN(PH_H1)) { if (F.G == 256) rmsmod_rows_256<false, true, false, false, 4>(F, (F.in[8]), 0, ((bf16*)(F.ws + WS_U1)), Leftover{nullptr, false, 0, 0.f}, D); else rmsmod_rows<false>(F, true, (F.in[8]), 0, ((bf16*)(F.ws + WS_U1))); }
    SEAM(PH_H1);
#if defined(PROBE_G1)
    if (IN(PH_G1)) { run_gemm(F, ((bf16*)(F.ws + WS_U1)), ((bf16*)(F.ws + WS_W)) + W_FIN, 2 * DFF, D, EpiSwiglu{((bf16*)(F.ws + WS_U2))});  xcd_barrier(bar); }
#endif
    if (IN(PH_G1)) { run_gemm(F, ((bf16*)(F.ws + WS_U1)), ((bf16*)(F.ws + WS_W)) + W_FIN, 2 * DFF, D, EpiSwiglu{((bf16*)(F.ws + WS_U2))}); }
    SEAM(PH_G1);
#if defined(PROBE_G2)
    if (IN(PH_G2)) { run_gemm_split(F, ((bf16*)(F.ws + WS_U2)), ((bf16*)(F.ws + WS_W)) + W_FOUT, D, DFF, EpiResid<true>{(F.in[0]), (F.in[1]), (bf16*)F.out, ((float*)(F.ws + WS_ADA)), 2, 0.5f, (bf16*)(F.ws + WS_U5)}, PROBE_G2);  xcd_barrier(bar); }
#endif
    if (IN(PH_G2)) { run_gemm_split(F, ((bf16*)(F.ws + WS_U2)), ((bf16*)(F.ws + WS_W)) + W_FOUT, D, DFF, EpiResid<true>{(F.in[0]), (F.in[1]), (bf16*)F.out, ((float*)(F.ws + WS_ADA)), 2, 0.5f, (bf16*)(F.ws + WS_U5)}); }
    SEAM(PH_G2);
#if defined(PROBE_H2)
    if (IN(PH_H2)) { { if (PROBE_H2 & 1) convert_mixer(F, 0, F.vcu * NWAVES + F.wave, F.G * NWAVES); __syncthreads(); if (PROBE_H2 & 2) rmsmod_rows<true>(F, false, (F.in[11]), 1, (bf16*)F.out + 1024, Leftover{F.G == 256 ? (const bf16*)(F.ws + WS_U5) : nullptr, true, 2, 0.5f}, 2048); if (PROBE_H2 & 4) rmsmod_rows<false>(F, false, (F.in[11]), 1, (bf16*)F.out + 1024, Leftover{F.G == 256 ? (const bf16*)(F.ws + WS_U5) : nullptr, true, 2, 0.5f}, 2048); }  xcd_barrier(bar); }
#endif
    if (IN(PH_H2)) { { convert_conv_state(F); convert_mixer(F, 0, F.vcu * NWAVES + F.wave, F.G * NWAVES); if (F.G != 256 || CONV1_H2) convert_mixer(F, 1, F.vcu * NWAVES + F.wave, F.G * NWAVES); __syncthreads(); if (F.G == 256) rmsmod_rows_256<true, false, true, true, 4>(F, (F.in[11]), 1, (bf16*)F.out + 1024, Leftover{(const bf16*)(F.ws + WS_U5), true, 2, 0.5f}, 2048); else rmsmod_rows<true>(F, false, (F.in[11]), 1, (bf16*)F.out + 1024, Leftover{nullptr, true, 2, 0.5f}, 2048); } }
    SEAM(PH_H2);
#if defined(PROBE_F1)
    if (IN(PH_F1)) { run_gemm(F, (bf16*)F.out + 1024, ((bf16*)(F.ws + WS_W)) + W_IN, 4352, D, EpiF1{((bf16*)(F.ws + WS_U1)), ((bf16*)(F.ws + WS_U2)), ((bf16*)(F.ws + WS_U3)), ((bf16*)(F.ws + WS_U4)), ((bf16*)(F.ws + WS_KV)), ((bf16*)(F.ws + WS_TAIL)), F.out}, 2048);  xcd_barrier(bar); }
#endif
    if (IN(PH_F1)) { run_gemm(F, (bf16*)F.out + 1024, ((bf16*)(F.ws + WS_W)) + W_IN, 4352, D, EpiF1{((bf16*)(F.ws + WS_U1)), ((bf16*)(F.ws + WS_U2)), ((bf16*)(F.ws + WS_U3)), ((bf16*)(F.ws + WS_U4)), ((bf16*)(F.ws + WS_KV)), ((bf16*)(F.ws + WS_TAIL)), F.out}, 2048); }
    SEAM(PH_F1);
#if defined(PROBE_PREP)
    if (IN(PH_PREP)) { PrepRegs PR; int it = F.vcu; if (it < NCH * 8) prep_fetch(F, it, F.tid & 15, F.tid >> 4, PR); for (int par = 0; it < NCH * 8; it += F.G, par ^= 1) gdn_prep_unit<true, PROBE_PREP>(F, it >> 3, it & 7, PR, it + F.G < NCH * 8 ? it + F.G : -1, par); xcd_barrier(bar); }
#endif
#if defined(PROBE_SWA)
    if (IN(PH_PREP)) { for (int it = F.vcu; it < NCH * 2; it += F.G) swa_unit<true>(F, it >> 1, it & 1); xcd_barrier(bar); }
#endif
    if (IN(PH_PREP)) {
                        const int nsw0 = (F.G == 256) ? ((F.vcu >> 3) % PREP_STAGGER) : 0;
#ifndef NO_SWA
                        for (int k = 0; k < nsw0; ++k) { const int it = F.vcu + k * F.G; if (it < NCH * 2) swa_unit<false>(F, it >> 1, it & 1); }
#endif
#ifndef NO_PREP
                        for (int k = F.wave; prep_unit_id(F, k) >= 0; k += NWAVES) prep_gates(F, prep_unit_id(F, k), F.lane);
                        for (int i = F.tid; i < 12 * 128; i += NWAVES * 64) { const int tj = i >> 7, cc = i & 127; ((LAS float*)(F.lds + PR_CW))[i] = (F.in[13])[(tj & 3) * 3072 + (tj >> 2) * 1024 + (F.vcu & 7) * 128 + cc]; }
                        asm volatile("s_waitcnt vmcnt(0)" ::: "memory"); __syncthreads();
#if defined(PROBE_PS)
                        if (blockIdx.x == 0 && F.tid == 0) ((volatile LAS unsigned long long*)(F.lds + LDSCTL_OFF + 768))[15] = __builtin_amdgcn_s_memrealtime();
#endif
                        { PrepRegs PR; int it = prep_unit_id(F, 0); prep_fetch(F, it >= 0 ? it : 0, F.tid & 15, F.tid >> 4, PR);
                          { v4u* dm = (v4u*)(F.ws + WS_END) + (size_t)F.tid * 9;
#pragma unroll
                            for (int q = 0; q < 9; ++q) dm[q] = (v4u){0u, 0u, 0u, 0u}; }
                          for (int i = 0; it >= 0; ++i) { const int itn = prep_unit_id(F, i + 1); gdn_prep_unit<false>(F, it >> 3, it & 7, PR, itn, i & 1); it = itn; } }
#endif
#ifndef NO_SWA
                        for (int it = F.vcu + nsw0 * F.G; it < NCH * 2; it += F.G) swa_unit<false>(F, it >> 1, it & 1);
#endif
                      }
    SEAM(PH_PREP);
#if defined(PROBE_SCANA)
    if (IN(PH_SCAN)) { scanA_phase(F); xcd_barrier(bar); }
#endif
    if (IN(PH_SCAN)) { scanA_phase(F); }
    SEAM(PH_SCAN);
    if (IN(PH_SCANB)) { scanB_phase(F); if (F.G == 256 && !CONV1_H2 && blockIdx.x >= SCANB_WGS) convert_mixer(F, 1, ((int)blockIdx.x - SCANB_WGS) * NWAVES + F.wave, (256 - SCANB_WGS) * NWAVES); }
    SEAM(PH_SCANB);
#if defined(PROBE_SCANC)
    if (IN(PH_SCANC)) { scanC_phase<true, PROBE_SCANC>(F); xcd_barrier(bar); }
#endif
    if (IN(PH_SCANC)) { scanC_phase<false>(F); }
    SEAM(PH_SCANC);
#if defined(PROBE_F2)
    if (IN(PH_F2)) { run_gemm(F, (bf16*)F.out + 1024, ((bf16*)(F.ws + WS_W)) + W_IN + (size_t)4352 * D, 3072, D, EpiF2{((bf16*)(F.ws + WS_U2)), ((bf16*)(F.ws + WS_U5)), ((bf16*)(F.ws + WS_U6))}, 2048);  xcd_barrier(bar); }
#endif
    if (IN(PH_F2)) { run_gemm(F, (bf16*)F.out + 1024, ((bf16*)(F.ws + WS_W)) + W_IN + (size_t)4352 * D, 3072, D, EpiF2{((bf16*)(F.ws + WS_U2)), ((bf16*)(F.ws + WS_U5)), ((bf16*)(F.ws + WS_U6))}, 2048);  if (F.G == 256 && blockIdx.x >= 96) { __syncthreads(); convert_ffn(F, (F.in[23]), (F.in[24]), (bf16*)(F.ws + WS_MG), nullptr, ((int)blockIdx.x - 96) * NWAVES + F.wave, 160 * NWAVES); } }
    SEAM(PH_F2);
#if defined(PROBE_NG)
    if (IN(PH_NG)) { normgate_phase(F);  xcd_barrier(bar); }
#endif
    if (IN(PH_NG)) { normgate_phase(F); }
    SEAM(PH_NG);
    if (IN(PH_G4A)) { if (F.G == 256) run_gemm_split(F, ((bf16*)(F.ws + WS_U1)), ((bf16*)(F.ws + WS_W)) + W_A, D, D, EpiGate<0>{((bf16*)(F.ws + WS_U5)), nullptr}, 2);
                      else run_gemm(F, ((bf16*)(F.ws + WS_U1)), ((bf16*)(F.ws + WS_W)) + W_A, D, D, EpiGate<0>{((bf16*)(F.ws + WS_U5)), nullptr}); }
    SEAM(PH_G4A);
    if (IN(PH_G4B)) { if (F.G == 256) { run_gemm_split(F, ((bf16*)(F.ws + WS_U4)), ((bf16*)(F.ws + WS_W)) + W_B, D, D, EpiGate<1>{((bf16*)(F.ws + WS_U5)), ((bf16*)(F.ws + WS_U6))}, 2);
                          const bool sb_ = ((blockIdx.x & 7) >> 2) != 0;
                          pg8::Gemm g{sb_ ? ((const bf16*)(F.ws + WS_U4)) : ((const bf16*)(F.ws + WS_U1)), ((const bf16*)(F.ws + WS_W)) + (sb_ ? W_B : W_A), M, D, D, 0}; PiecesAB S; S.init(M, D, F.G, (int)blockIdx.x); S.ntf = 16;
                          pg8::gemm_phase<EpiPart, PiecesAB, PG8_ALIGN, PG8_SP2>(F.lds, g, S, EpiPart{(bf16*)(F.ws + WS_U2)}); }
                      else run_gemm(F, ((bf16*)(F.ws + WS_U4)), ((bf16*)(F.ws + WS_W)) + W_B, D, D, EpiGate<1>{((bf16*)(F.ws + WS_U5)), ((bf16*)(F.ws + WS_U6))}); }
    SEAM(PH_G4B);
    if (IN(PH_G5) && F.G == 256) { branch_fixup_rows(F, (const bf16*)(F.ws + WS_U2)); xcd_barrier(bar); }
    if (IN(PH_G5)) { run_gemm_split(F, ((bf16*)(F.ws + WS_U5)), ((bf16*)(F.ws + WS_W)) + W_O, D, D, EpiResid<false>{nullptr, nullptr, (bf16*)F.out, ((float*)(F.ws + WS_ADA)), 5, 1.0f, (bf16*)(F.ws + WS_U2)}); }
    SEAM(PH_G5);
#if defined(PROBE_H3)
    if (IN(PH_H3)) { { convert_ffn(F, (F.in[23]), (F.in[24]), F.G == 256 ? nullptr : (bf16*)(F.ws + WS_MG), ((bf16*)(F.ws + WS_W)) + W_FOUT, F.vcu * NWAVES + F.wave, F.G * NWAVES); rmsmod_rows<false>(F, false, (F.in[22]), 2, ((bf16*)(F.ws + WS_U1)), Leftover{F.G == 256 ? (const bf16*)(F.ws + WS_U2) : nullptr, false, 5, 1.0f}); }  xcd_barrier(bar); }
#endif
    if (IN(PH_H3)) { { convert_ffn(F, (F.in[23]), (F.in[24]), F.G == 256 ? nullptr : (bf16*)(F.ws + WS_MG), ((bf16*)(F.ws + WS_W)) + W_FOUT, F.vcu * NWAVES + F.wave, F.G * NWAVES); if (F.G == 256) rmsmod_rows_256<false, false, true, false, 8>(F, (F.in[22]), 2, ((bf16*)(F.ws + WS_U1)), Leftover{(const bf16*)(F.ws + WS_U2), false, 5, 1.0f}, D); else rmsmod_rows<false>(F, false, (F.in[22]), 2, ((bf16*)(F.ws + WS_U1)), Leftover{nullptr, false, 5, 1.0f}); } }
    SEAM(PH_H3);
#if defined(PROBE_G6)
    if (IN(PH_G6)) { run_gemm(F, ((bf16*)(F.ws + WS_U1)), ((bf16*)(F.ws + WS_W)) + W_FIN, 2 * DFF, D, EpiSwiglu{((bf16*)(F.ws + WS_U2))});  xcd_barrier(bar); }
#endif
    if (IN(PH_G6)) { run_gemm(F, ((bf16*)(F.ws + WS_U1)), (const bf16*)(F.ws + WS_MG), 2 * DFF, D, EpiSwiglu{((bf16*)(F.ws + WS_U2))}); }
    SEAM(PH_G6);
    if (IN(PH_G7)) { run_gemm_split(F, ((bf16*)(F.ws + WS_U2)), ((bf16*)(F.ws + WS_W)) + W_FOUT, D, DFF, EpiResid<false>{nullptr, nullptr, (bf16*)F.out, ((float*)(F.ws + WS_ADA)), 8, 0.5f, (bf16*)(F.ws + WS_U5)}); }
    SEAM(PH_G7);
    if (IN(PH_FIN)) { if (F.G == 256) final_norm_rows_256<8>(F, Leftover{(const bf16*)(F.ws + WS_U5), false, 8, 0.5f}); else final_norm_rows(F, Leftover{nullptr, false, 8, 0.5f}); }
    SEAM(PH_FIN);
#if defined(PROBE_TS)
    if (blockIdx.x == 0 && F.tid == 0) { volatile LAS unsigned long long* ts = (volatile LAS unsigned long long*)(F.lds + LDSCTL_OFF + 512); unsigned long long tot = 0;
        for (int k = 0; k < PH_COUNT; ++k) if ((PROBE_TS >> k) & 1) tot += ts[k + 1] - ts[k];
#if defined(PROBE_PS)
        tot += ((volatile LAS unsigned long long*)(F.lds + LDSCTL_OFF + 768))[PROBE_PS];
#endif
        tot *= PROBE_AMP;
        const unsigned long long t0 = __builtin_amdgcn_s_memrealtime(); while (__builtin_amdgcn_s_memrealtime() - t0 < tot) __builtin_amdgcn_s_sleep(8); }
#endif
#undef IN
#undef SEAM
}

extern "C" void kernel_launch(void* const* d_in, const int* in_sizes, int n_in, void* d_out, int out_size, void* d_ws, size_t ws_size, hipStream_t stream) {
    static int grid = 0;
    if (grid == 0) {
        if (n_in != 28 || in_sizes[0] != MP * D || (size_t)out_size != OUT_TOTAL || ws_size < WS_END) { fprintf(stderr, "kernel_launch: unexpected shapes (n_in %d, in0 %d, out %d, ws %zu); nothing launched\n", n_in, n_in > 0 ? in_sizes[0] : -1, out_size, ws_size); grid = -1; return; }
        int dev = 0, cus = 0, per_cu = 0;
        if (hipGetDevice(&dev) != hipSuccess || hipDeviceGetAttribute(&cus, hipDeviceAttributeMultiprocessorCount, dev) != hipSuccess) { grid = -1; return; }
        if (hipFuncSetAttribute((const void*)mega_fwd, hipFuncAttributeMaxDynamicSharedMemorySize, LDS_BYTES) != hipSuccess) { fprintf(stderr, "kernel_launch: hipFuncSetAttribute failed\n"); grid = -1; return; }
        if (hipOccupancyMaxActiveBlocksPerMultiprocessor(&per_cu, (const void*)mega_fwd, NWAVES * 64, LDS_BYTES) != hipSuccess || per_cu < 1) fprintf(stderr, "kernel_launch: occupancy query reports %d\n", per_cu);
        (void)hipGetLastError();
        grid = cus;
    }
    if (grid < 0) return;
    if (hipMemsetAsync((char*)d_ws + WS_CTL, 0, CTL_ZERO_BYTES, stream) != hipSuccess) return;
    Args a{};
    for (int i = 0; i < 28; ++i) a.in[i] = (const float*)d_in[i];
    a.out = (float*)d_out; a.ws = (unsigned char*)d_ws;
#if MK_PER_PHASE
    for (int ph = 0; ph < PH_COUNT; ++ph) { a.ph_lo = ph; a.ph_hi = ph + 1; hipLaunchKernelGGL(mega_fwd, dim3(grid), dim3(NWAVES * 64), LDS_BYTES, stream, a); }
#else
    a.ph_lo = 0; a.ph_hi = PH_COUNT; hipLaunchKernelGGL(mega_fwd, dim3(grid), dim3(NWAVES * 64), LDS_BYTES, stream, a);
#endif
    const hipError_t le = hipPeekAtLastError();
    if (le != hipSuccess) fprintf(stderr, "kernel_launch: launch failed: %s\n", hipGetErrorName(le));
}
```

```cpp
#define PG8_WGM 4
#define PREP_STAGGER 2
#include <hip/hip_runtime.h>
#include <cstdio>
#include <cstdint>
#ifndef PG8_PFIRST
#define PG8_PFIRST 0
#endif
#ifndef PG8_SERP
#define PG8_SERP 0
#endif
#ifndef PG8_PMOD
#define PG8_PMOD 0
#endif
#ifndef PG8_WGM
#define PG8_WGM 8
#endif
namespace pg8 {
#define PG8_LAS __attribute__((address_space(3)))
typedef unsigned short bf16_t;
typedef short bf16x8 __attribute__((ext_vector_type(8)));
typedef float f32x4 __attribute__((ext_vector_type(4)));
typedef unsigned u32x4 __attribute__((ext_vector_type(4)));
constexpr int BM = 256, BK = 64, HALF = 128, HTB = HALF * BK * 2  , STAGE_BYTES = 8 * HTB, NXCD = 8, WGM = PG8_WGM;

__host__ __device__ __forceinline__ int lds_byte(int r, int c) { const int st = (r >> 4) * 2 + (c >> 5), rr = r & 15, cc = c & 31, ob = rr * 64 + cc * 2; return st * 1024 + (ob ^ (((ob >> 9) & 1) << 5)); }
__host__ __device__ __forceinline__ void stage_rc(int b, int& R, int& C) { const int st = b / 1024, sb = b % 1024, swz = sb ^ (((sb >> 9) & 1) << 5); R = (st >> 1) * 16 + swz / 64; C = (st & 1) * 32 + (swz % 64) / 2; }
__host__ __device__ __forceinline__ int perm32(int rho) { const int n = rho >> 4, i = rho & 15; return 8 * (i >> 2) + 4 * n + (i & 3); }

struct Unit { int pm, pn, k0, nt, piece, lidx; };
struct Gemm { const bf16_t* A; const bf16_t* Bt; int M, N, K; int lda; };

struct StaticOrder {
    int nM, nN, nwg, G, c, ntf;
    __host__ __device__ void init(int M, int N, int G_, int c_) { nM = M / BM; nN = N / BM; nwg = nM * nN; G = G_; c = c_; }
    __host__ __device__ bool next(int i, Unit& u) const {
        const long L = (long)i * G + c; if (L >= nwg) return false;
#if PG8_PFIRST
        if (nM == 72 && G % NXCD == 0) {
            const int np = 64 * nN;
            if (L < np) { const int wg0 = (int)(L & 7) * (np / NXCD) + (int)(L >> 3), nig0 = WGM * nN; u.pm = (wg0 / nig0) * WGM + ((wg0 % nig0) % WGM); u.pn = (wg0 % nig0) / WGM; }
            else { const int s = (int)L - np, x = s & 7, q = (x & 3) * (np / 64) + (s >> 3); u.pm = 64 + 4 * (x >> 2) + (q & 3); u.pn = q >> 2; }
            u.k0 = 0; u.nt = ntf; u.piece = 0; u.lidx = 0; return true; }
#endif
        int wgid = (int)L; { const int q = nwg / NXCD, r = nwg % NXCD, xcd = wgid % NXCD, off = wgid / NXCD; wgid = (xcd < r ? xcd * (q + 1) : r * (q + 1) + (xcd - r) * q) + off; }
        const int nig = WGM * nN, gid = wgid / nig, fm = gid * WGM, gsz = (nM - fm) < WGM ? (nM - fm) : WGM;
        u.pm = fm + ((wgid % nig) % gsz); u.pn = (wgid % nig) / gsz; u.k0 = 0; u.nt = ntf; u.piece = 0; u.lidx = 0;
#if PG8_SERP
        if (gid & 1) u.pn = nN - 1 - u.pn;
#endif
#if PG8_PMOD
        if (nM == 72) u.pm = 8 * (u.pm % 9) + u.pm / 9;
#endif
        return true;
    }
    __device__ __forceinline__ void a_ready(const Unit&) const {}
    __device__ __forceinline__ void done(const Unit&) const {}
};

__device__ __forceinline__ unsigned cvt_pk_bf16(float lo, float hi) { unsigned r; asm volatile("v_cvt_pk_bf16_f32 %0, %1, %2" : "=v"(r) : "v"(lo), "v"(hi)); return r; }

template <class Epi, class Sched, bool ALIGN_EPI = false, bool SP2 = false>
__device__ __forceinline__ void gemm_phase(PG8_LAS unsigned char* lds, const Gemm g, const Sched& S, const Epi& E) {
    const int tid = threadIdx.x, wid = __builtin_amdgcn_readfirstlane(tid >> 6), lane = tid & 63, wr = wid >> 2, wc = wid & 3, fr = lane & 15, fq = lane >> 4;
    const int K = g.K, lda = g.lda ? g.lda : g.K;
    unsigned voffA[2], voffB[2];
#pragma unroll
    for (int i = 0; i < 2; ++i) { int R, C; stage_rc(tid * 16 + i * 8192, R, C); const int Rb = Epi::PERM ? ((R & ~31) + perm32(R & 31)) : R;
        voffA[i] = (unsigned)(R * lda + C) * 2u; voffB[i] = (unsigned)(Rb * K + C) * 2u; }
    const size_t kstep = (size_t)(BK * 2);
    const size_t hstep = (size_t)HALF * K * 2;
    const size_t tstep = 2 * hstep;
    const size_t hstepA = (size_t)HALF * lda * 2, tstepA = 2 * hstepA;
    const unsigned ldsw = (unsigned)wid * 1024u;
    const int aoff = lds_byte(wr * 64 + fr, fq * 8), boff = lds_byte(wc * 32 + fr, fq * 8);
#define PG8_SA(b, h) (((b) * 2 + (h)) * HTB)
#define PG8_SB(b, h) ((4 + (b) * 2 + (h)) * HTB)
#define PG8_STAGE(bufoff, gbase, voff) do { _Pragma("unroll") for (int _i = 0; _i < 2; ++_i) \
        __builtin_amdgcn_global_load_lds((const unsigned*)((const char*)(gbase) + (voff)[_i]), (PG8_LAS unsigned*)(lds + (bufoff) + ldsw + _i * 8192), 16, 0, 0); } while (0)
#define PG8_LDA(dst, b, h) do { _Pragma("unroll") for (int m = 0; m < 4; ++m) _Pragma("unroll") for (int k = 0; k < 2; ++k) dst[m][k] = *(const PG8_LAS bf16x8*)(lds + PG8_SA(b, h) + aoff + m * 2048 + k * 1024); } while (0)
#define PG8_LDB(dst, b, h) do { _Pragma("unroll") for (int n = 0; n < 2; ++n) _Pragma("unroll") for (int k = 0; k < 2; ++k) dst[n][k] = *(const PG8_LAS bf16x8*)(lds + PG8_SB(b, h) + boff + n * 2048 + k * 1024); } while (0)
#define PG8_MMA(ai, bj, At, Bt) do { __builtin_amdgcn_s_setprio(1); _Pragma("unroll") for (int m = 0; m < 4; ++m) _Pragma("unroll") for (int n = 0; n < 2; ++n) _Pragma("unroll") for (int k = 0; k < 2; ++k) \
        acc[ai][bj][m][n] = __builtin_amdgcn_mfma_f32_16x16x32_bf16(Bt[n][k], At[m][k], acc[ai][bj][m][n], 0, 0, 0); __builtin_amdgcn_s_setprio(0); } while (0)
#define PG8_WAIT_V(n) asm volatile("s_waitcnt vmcnt(" #n ")" ::: "memory")
#define PG8_WAIT_L(n) asm volatile("s_waitcnt lgkmcnt(" #n ")" ::: "memory")
#define PG8_BAR __builtin_amdgcn_s_barrier()
#define PG8_SCHED __builtin_amdgcn_sched_barrier(0)
    Unit cur, nxt; int ui = 0;
    if (!S.next(0, cur)) return;
    f32x4 acc[2][2][4][2];
#pragma unroll
    for (int a = 0; a < 2; ++a)
#pragma unroll
        for (int b = 0; b < 2; ++b)
#pragma unroll
            for (int m = 0; m < 4; ++m)
#pragma unroll
                for (int n = 0; n < 2; ++n) acc[a][b][m][n] = (f32x4){0.f, 0.f, 0.f, 0.f};
    bf16x8 At[4][2], B0[2][2], B1[2][2];
    const char* cA = (const char*)g.A + (size_t)cur.pm * tstepA + (size_t)cur.k0 * kstep; const char* cB = (const char*)g.Bt + (size_t)cur.pn * tstep + (size_t)cur.k0 * kstep;
    S.a_ready(cur);
    if constexpr (SP2) {
        PG8_STAGE(PG8_SB(0, 0), cB, voffB); PG8_STAGE(PG8_SB(0, 1), cB + hstep, voffB); PG8_STAGE(PG8_SA(0, 0), cA, voffA); PG8_STAGE(PG8_SA(0, 1), cA + hstepA, voffA);
        if (wr == 1) PG8_BAR;
        PG8_WAIT_V(2); PG8_BAR;
        PG8_STAGE(PG8_SB(1, 0), cB + kstep, voffB); PG8_STAGE(PG8_SA(1, 0), cA + kstep, voffA); PG8_STAGE(PG8_SB(1, 1), cB + hstep + kstep, voffB);
        PG8_WAIT_V(6); PG8_BAR;
    } else {
        PG8_STAGE(PG8_SB(0, 0), cB, voffB); PG8_STAGE(PG8_SA(0, 0), cA, voffA); PG8_STAGE(PG8_SB(0, 1), cB + hstep, voffB); PG8_STAGE(PG8_SA(0, 1), cA + hstepA, voffA);
        if (wr == 1) PG8_BAR;
        PG8_WAIT_V(4); PG8_BAR;
        PG8_STAGE(PG8_SB(1, 0), cB + kstep, voffB); PG8_STAGE(PG8_SA(1, 0), cA + kstep, voffA); PG8_STAGE(PG8_SB(1, 1), cB + hstep + kstep, voffB);
        PG8_WAIT_V(6); PG8_BAR;
    }
    for (;;) {
        const bool has_next = S.next(ui + 1, nxt);
        const char* nA = has_next ? (const char*)g.A + (size_t)nxt.pm * tstepA + (size_t)nxt.k0 * kstep : cA; const char* nB = has_next ? (const char*)g.Bt + (size_t)nxt.pn * tstep + (size_t)nxt.k0 * kstep : cB;
        const int cnt = cur.nt;
        for (int t = 0; t < cnt; t += 2) {
            const bool last = (t == cnt - 2);
            const char* a1 = cA + (size_t)(t + 1) * kstep;
            const char* a2 = last ? nA : cA + (size_t)(t + 2) * kstep; const char* b2 = last ? nB : cB + (size_t)(t + 2) * kstep;
            const char* a3 = a2 + kstep; const char* b3 = b2 + kstep;
            if (last && has_next) S.a_ready(nxt);
            if constexpr (SP2) {
            PG8_LDB(B0, 0, 0); PG8_LDB(B1, 0, 1); PG8_SCHED; PG8_LDA(At, 0, 0); PG8_STAGE(PG8_SA(1, 1), a1 + hstepA, voffA);
            PG8_WAIT_V(8); PG8_WAIT_L(0); PG8_BAR; PG8_MMA(0, 0, At, B0); PG8_MMA(0, 1, At, B1); PG8_BAR; PG8_SCHED;
            PG8_LDA(At, 0, 1); PG8_STAGE(PG8_SB(0, 0), b2, voffB); PG8_STAGE(PG8_SB(0, 1), b2 + hstep, voffB); PG8_STAGE(PG8_SA(0, 0), a2, voffA);
            PG8_WAIT_V(8); PG8_WAIT_L(0); PG8_BAR; PG8_MMA(1, 0, At, B0); PG8_MMA(1, 1, At, B1); PG8_BAR; PG8_SCHED;
            PG8_LDB(B0, 1, 0); PG8_LDB(B1, 1, 1); PG8_SCHED; PG8_LDA(At, 1, 0); PG8_STAGE(PG8_SA(0, 1), a2 + hstepA, voffA);
            PG8_WAIT_V(8); PG8_WAIT_L(0); PG8_BAR; PG8_MMA(0, 0, At, B0); PG8_MMA(0, 1, At, B1); PG8_BAR; PG8_SCHED;
            PG8_LDA(At, 1, 1); PG8_STAGE(PG8_SB(1, 0), b3, voffB); PG8_STAGE(PG8_SB(1, 1), b3 + hstep, voffB); PG8_STAGE(PG8_SA(1, 0), a3, voffA);
            PG8_WAIT_V(8); PG8_WAIT_L(0); PG8_BAR; PG8_MMA(1, 0, At, B0); PG8_MMA(1, 1, At, B1); PG8_BAR; PG8_SCHED;
            } else {
            PG8_LDB(B0, 0, 0); PG8_SCHED; PG8_LDA(At, 0, 0); PG8_STAGE(PG8_SA(1, 1), a1 + hstepA, voffA);
            PG8_WAIT_L(8); PG8_BAR; PG8_WAIT_L(0); PG8_MMA(0, 0, At, B0); PG8_BAR; PG8_SCHED;
            PG8_LDB(B1, 0, 1); PG8_STAGE(PG8_SB(0, 0), b2, voffB);
            PG8_BAR; PG8_WAIT_L(0); PG8_MMA(0, 1, At, B1); PG8_BAR;
            PG8_LDA(At, 0, 1); PG8_STAGE(PG8_SA(0, 0), a2, voffA);
            PG8_BAR; PG8_WAIT_L(0); PG8_MMA(1, 0, At, B0); PG8_BAR; PG8_SCHED;
            PG8_STAGE(PG8_SB(0, 1), b2 + hstep, voffB);
            PG8_WAIT_V(6); PG8_BAR; PG8_MMA(1, 1, At, B1); PG8_BAR;
            PG8_LDB(B0, 1, 0); PG8_SCHED; PG8_LDA(At, 1, 0); PG8_STAGE(PG8_SA(0, 1), a2 + hstepA, voffA);
            PG8_WAIT_L(8); PG8_BAR; PG8_WAIT_L(0); PG8_MMA(0, 0, At, B0); PG8_BAR; PG8_SCHED;
            PG8_LDB(B1, 1, 1); PG8_STAGE(PG8_SB(1, 0), b3, voffB);
            PG8_BAR; PG8_WAIT_L(0); PG8_MMA(0, 1, At, B1); PG8_BAR;
            PG8_LDA(At, 1, 1); PG8_STAGE(PG8_SA(1, 0), a3, voffA);
            PG8_BAR; PG8_WAIT_L(0); PG8_MMA(1, 0, At, B0); PG8_BAR; PG8_SCHED;
            PG8_STAGE(PG8_SB(1, 1), b3 + hstep, voffB);
            PG8_WAIT_V(6); PG8_BAR; PG8_MMA(1, 1, At, B1); PG8_BAR;
            }
        }
        if constexpr (ALIGN_EPI) { if (wr == 0) PG8_BAR; }
        if constexpr (!Epi::AFTER_DRAIN) { E(acc, cur, wr, wc, fr, fq); S.done(cur); }
        if (!has_next) break;
#pragma unroll
        for (int a = 0; a < 2; ++a)
#pragma unroll
            for (int b = 0; b < 2; ++b)
#pragma unroll
                for (int m = 0; m < 4; ++m)
#pragma unroll
                    for (int n = 0; n < 2; ++n) acc[a][b][m][n] = (f32x4){0.f, 0.f, 0.f, 0.f};
        cur = nxt; cA = nA; cB = nB; ++ui;
        if constexpr (ALIGN_EPI) { if (wr == 1) PG8_BAR; }
    }
    PG8_WAIT_V(0);
    if constexpr (!ALIGN_EPI) { if (wr == 0) PG8_BAR; }
    PG8_BAR;
    if constexpr (Epi::AFTER_DRAIN) { E.fused(acc, cur, wr, wc, fr, fq, lds, wid, lane); S.done(cur); }
#undef PG8_SA
#undef PG8_SB
#undef PG8_STAGE
#undef PG8_LDA
#undef PG8_LDB
#undef PG8_MMA
#undef PG8_WAIT_V
#undef PG8_WAIT_L
#undef PG8_BAR
#undef PG8_SCHED
}
}

#ifndef PG8_SP2
#define PG8_SP2 true
#endif
#define GAS __attribute__((address_space(1)))
#define LAS __attribute__((address_space(3)))
typedef unsigned short bf16;
typedef unsigned v4u __attribute__((ext_vector_type(4)));
typedef float f32x4 __attribute__((ext_vector_type(4)));
typedef short bf16x8 __attribute__((ext_vector_type(8)));
typedef GAS unsigned gu32;
typedef GAS unsigned long long gu64;
#define RLX_AGENT __ATOMIC_RELAXED, __HIP_MEMORY_SCOPE_AGENT
#define LDS_WAIT() asm volatile("s_waitcnt lgkmcnt(0)" ::: "memory")
#define VM_WAIT() asm volatile("s_waitcnt vmcnt(0)" ::: "memory")
__device__ __forceinline__ unsigned long long rt() { return __builtin_amdgcn_s_memrealtime(); }
typedef float pkf2_t __attribute__((ext_vector_type(2))); typedef __bf16 pkb2_t __attribute__((ext_vector_type(2)));
__device__ __forceinline__ unsigned pk2(float lo, float hi) { pkf2_t v = {lo, hi}; pkb2_t b = __builtin_convertvector(v, pkb2_t); return __builtin_bit_cast(unsigned, b); }
__device__ __forceinline__ unsigned f2bf(float f) { return pk2(f, 0.f) & 0xffffu; }

#define XB_TMO      128
#define XB_XCNT(j)  (256  + 64 * (j))
#define XB_XSUB(j)  (1280 + 64 * (j))
#define XB_XGEN(j)  (2304 + 64 * (j))
#define XB_TOP      3328
#define XB_TOPGEN   3392
#define XCD_BAR_WORDS 3456
#define XB_SPIN_CAP (1u << 18)

__device__ __forceinline__ unsigned xb_ld(unsigned* p)              { return __hip_atomic_load(p, __ATOMIC_RELAXED, __HIP_MEMORY_SCOPE_AGENT); }
__device__ __forceinline__ unsigned xb_add(unsigned* p, unsigned v) { return __hip_atomic_fetch_add(p, v, __ATOMIC_RELAXED, __HIP_MEMORY_SCOPE_AGENT); }
__device__ __forceinline__ unsigned xb_xcc_id() { return (unsigned)__builtin_amdgcn_s_getreg((3 << 11) | 20) & 0xFu; }
#define XB_SPIN(cond, bar) do { unsigned _sp = 0; while (cond) { __builtin_amdgcn_s_sleep(1); \
    if ((++_sp & 255u) == 0u) { if (xb_ld(&(bar)[XB_TMO])) break; if (_sp > XB_SPIN_CAP) { atomicAdd(&(bar)[XB_TMO], 1u); break; } } } } while (0)

struct XcdBarrier {
    unsigned* bar; unsigned x;
    volatile LAS unsigned* st;
};

__device__ __forceinline__ XcdBarrier xcd_barrier_post(unsigned* bar, volatile LAS unsigned* st) {
    XcdBarrier b; b.bar = bar; b.x = xb_xcc_id(); b.st = st;
    if (threadIdx.x == 0) (void)xb_add(&bar[XB_XCNT(b.x)], 1u);
    return b;
}
__device__ __forceinline__ void xcd_barrier_complete(unsigned* bar, unsigned x, unsigned& nloc, unsigned& nx) {
    const unsigned G = gridDim.x * gridDim.y * gridDim.z;
    unsigned sum, cnt, mine, sp = 0u;
    for (;;) {
        sum = 0u; cnt = 0u; mine = 0u;
#pragma unroll
        for (unsigned j = 0; j < 16; ++j) { const unsigned c = xb_ld(&bar[XB_XCNT(j)]); sum += c; cnt += (c > 0u) ? 1u : 0u; mine = (j == x) ? c : mine; }
        if (sum == G) break;
        __builtin_amdgcn_s_sleep(1);
        if ((++sp & 255u) == 0u) { if (xb_ld(&bar[XB_TMO])) break; if (sp > XB_SPIN_CAP) { atomicAdd(&bar[XB_TMO], 1u); break; } }
    }
    nloc = mine > 0u ? mine : 1u; nx = cnt > 0u ? cnt : 1u;
}

__device__ __forceinline__ void xcd_barrier(const XcdBarrier& b) {
    asm volatile("s_waitcnt vmcnt(0)" ::: "memory");
    __syncthreads();
    if (threadIdx.x == 0) {
        unsigned* bar = b.bar;
        __builtin_amdgcn_s_waitcnt(0);
        unsigned nloc = b.st[0], nx = b.st[1];
        if (nloc == 0u) { xcd_barrier_complete(bar, b.x, nloc, nx); b.st[0] = nloc; b.st[1] = nx; }
        const unsigned old = xb_add(&bar[XB_XSUB(b.x)], 1u);
        const unsigned gen = old / nloc;
        if (old + 1u == (gen + 1u) * nloc) {
            __builtin_amdgcn_fence(__ATOMIC_RELEASE, "agent");
            asm volatile("s_waitcnt vmcnt(0)" ::: "memory");
            const unsigned og = xb_add(&bar[XB_TOP], 1u);
            const unsigned tg = og / nx;
            if (og + 1u == (tg + 1u) * nx) xb_add(&bar[XB_TOPGEN], 1u);
            else XB_SPIN(xb_ld(&bar[XB_TOPGEN]) == tg, bar);
            __builtin_amdgcn_fence(__ATOMIC_ACQUIRE, "agent");
            xb_add(&bar[XB_XGEN(b.x)], 1u);
            asm volatile("s_waitcnt vmcnt(0)" ::: "memory");
        } else {
            XB_SPIN(xb_ld(&bar[XB_XGEN(b.x)]) == gen, bar);
            __builtin_amdgcn_fence(__ATOMIC_ACQUIRE, "agent");
            asm volatile("s_waitcnt vmcnt(0)" ::: "memory");
        }
    }
    __syncthreads();
}
#ifndef PG8_ALIGN
#define PG8_ALIGN true
#endif
constexpr int NWAVES = 8;
#ifndef MK_PER_PHASE
#define MK_PER_PHASE 0
#endif
constexpr int D = 1024, MP = 16384, MSMP = 2048, M = MP + MSMP, NCH = M / 64, DFF = 2816, INCOLS = 7440, NB = 33, ADAW = 9 * D;
constexpr float EPS = 1e-6f;
constexpr size_t OFF_Y = 0, OFF_PCONV = (size_t)M * D, OFF_PS = OFF_PCONV + 3 * 3072, OFF_PK = OFF_PS + 8 * 128 * 128, OFF_PV = OFF_PK + 128 * 128,
                 OFF_SCONV = OFF_PV + 128 * 128, OFF_SS = OFF_SCONV + 32 * 3 * 3072, OFF_SK = OFF_SS + (size_t)32 * 8 * 128 * 128, OFF_SV = OFF_SK + 32 * 128 * 128, OUT_TOTAL = OFF_SV + 32 * 128 * 128;
constexpr size_t MiB = 1u << 20;
constexpr size_t WS_CTL = 0, CTL_ZERO_BYTES = 1 * MiB, WS_ADA = 1 * MiB, WS_BA = 5 * MiB / 2, WS_GL = 4 * MiB, WS_W = 5 * MiB;
constexpr size_t WS_U1 = 26 * MiB, WS_U2 = 62 * MiB, WS_U3 = 98 * MiB, WS_U4 = 134 * MiB, WS_U5 = 170 * MiB, WS_U6 = 206 * MiB;
constexpr size_t WS_INTRA = 206 * MiB, WS_KV = 224 * MiB, WS_TAIL = 233 * MiB, WS_END = 254 * MiB;
static_assert((size_t)M * D * 2 == 36 * MiB && (size_t)NB * ADAW * 4 <= 3 * MiB / 2 && (size_t)M * 16 * 4 <= 3 * MiB / 2, "ws map");
static_assert((size_t)NCH * 8 * 64 * 64 * 2 == 18 * MiB && (size_t)M * 256 * 2 == 9 * MiB && WS_TAIL + (size_t)NCH * 3 * 3072 * 2 <= WS_END && (size_t)M * DFF * 2 <= 108 * MiB, "ws map 2");
constexpr size_t W_FIN = 0, W_FOUT = (size_t)2 * DFF * D;
constexpr size_t W_IN = 0, W_A = (size_t)7424 * D, W_B = W_A + (size_t)D * D, W_O = W_B + (size_t)D * D;
static_assert((W_O + (size_t)D * D) * 2 <= 21 * MiB, "w slot");
constexpr int CW_TMO = 0, CW_BAR = 4096;
constexpr int RING_BYTES = 131072, LDSCTL_OFF = RING_BYTES, MISC_OFF = LDSCTL_OFF + 320, LDS_BYTES = 147456;

struct Frame {
    LAS unsigned char* lds; volatile LAS unsigned* MISC; gu32* ctl;
    int tid, lane, wave, vcu, G;
    const float* const* in; float* out; unsigned char* ws;
};
typedef float f32x2 __attribute__((ext_vector_type(2)));
typedef unsigned u32x2 __attribute__((ext_vector_type(2)));
__device__ __forceinline__ float bflo(unsigned u) { return __builtin_bit_cast(float, u << 16); }
__device__ __forceinline__ float bfhi(unsigned u) { return __builtin_bit_cast(float, u & 0xffff0000u); }
__device__ __forceinline__ float bf2f(bf16 h) { return __builtin_bit_cast(float, (unsigned)h << 16); }
__device__ __forceinline__ float fexp(float x) { return __builtin_amdgcn_exp2f(x * 1.4426950408889634f); }
__device__ __forceinline__ float sigm(float x) { return __builtin_amdgcn_rcpf(1.f + fexp(-x)); }
__device__ __forceinline__ float siluf(float x) { return x * sigm(x); }
__device__ __forceinline__ float wave_sum(float v) {
#pragma unroll
    for (int o = 1; o < 64; o <<= 1) v += __shfl_xor(v, o);
    return v;
}
__device__ __forceinline__ int mod_row(int m) { return m < MP ? 0 : 1 + ((m - MP) >> 6); }

__device__ __forceinline__ void transpose_item(const float* W, int ldw, int c0, int K, bf16* WT, int drow0, LAS float* scr, int k0, int lane) {
    f32x4 wv[8];
#pragma unroll
    for (int i = 0; i < 8; ++i) wv[i] = *(const f32x4*)(W + (size_t)(k0 + 8 * i + (lane >> 3)) * ldw + c0 + 4 * (lane & 7));
#pragma unroll
    for (int i = 0; i < 8; ++i) { LAS float* d = scr + (8 * i + (lane >> 3)) * 33 + 4 * (lane & 7); d[0] = wv[i].x; d[1] = wv[i].y; d[2] = wv[i].z; d[3] = wv[i].w; }
    LDS_WAIT(); asm volatile("" ::: "memory");
    const int c = lane & 7;
#pragma unroll
    for (int j = 0; j < 4; ++j) { const int n = (lane >> 3) + 8 * j; const LAS float* s = scr + (8 * c) * 33 + n;
        v4u o; o.x = pk2(s[0 * 33], s[1 * 33]); o.y = pk2(s[2 * 33], s[3 * 33]); o.z = pk2(s[4 * 33], s[5 * 33]); o.w = pk2(s[6 * 33], s[7 * 33]);
        *(GAS v4u*)(WT + (size_t)(drow0 + n) * K + k0 + 8 * c) = o; }
    LDS_WAIT(); asm volatile("" ::: "memory");
}
struct TrItem { const float* W; int ldw, c0, K; bf16* WT; int drow0, k0; };
__device__ __forceinline__ void tr_load(const TrItem& t, int lane, f32x4 (&wv)[8]) {
#pragma unroll
    for (int i = 0; i < 8; ++i) wv[i] = *(const f32x4*)(t.W + (size_t)(t.k0 + 8 * i + (lane >> 3)) * t.ldw + t.c0 + 4 * (lane & 7));
}
__device__ __forceinline__ void tr_store(const TrItem& t, LAS float* scr, int lane, const f32x4 (&wv)[8]) {
#pragma unroll
    for (int i = 0; i < 8; ++i) { LAS float* d = scr + (8 * i + (lane >> 3)) * 33 + 4 * (lane & 7); d[0] = wv[i].x; d[1] = wv[i].y; d[2] = wv[i].z; d[3] = wv[i].w; }
    LDS_WAIT(); asm volatile("" ::: "memory");
    const int c = lane & 7;
#pragma unroll
    for (int j = 0; j < 4; ++j) { const int n = (lane >> 3) + 8 * j; const LAS float* s = scr + (8 * c) * 33 + n;
        v4u o; o.x = pk2(s[0 * 33], s[1 * 33]); o.y = pk2(s[2 * 33], s[3 * 33]); o.z = pk2(s[4 * 33], s[5 * 33]); o.w = pk2(s[6 * 33], s[7 * 33]);
        *(GAS v4u*)(t.WT + (size_t)(t.drow0 + n) * t.K + t.k0 + 8 * c) = o; }
    LDS_WAIT(); asm volatile("" ::: "memory");
}
__device__ __forceinline__ TrItem ffn_item(int it, const float* w_in, const float* w_out, bf16* dst_in, bf16* dst_out) {
    constexpr int I_IN = 16 * 176;
    if (it < I_IN) { const int kb = it / 176, nb = it % 176, c0 = 32 * nb; const int j0 = c0 < DFF ? c0 : c0 - DFF;
        return TrItem{w_in, 2 * DFF, c0, D, dst_in, (j0 >> 7) * 256 + (c0 < DFF ? 0 : 128) + (j0 & 127), 64 * kb}; }
    const int r = it - I_IN; const int kb = r / 32, nb = r % 32; return TrItem{w_out, D, 32 * nb, DFF, dst_out, 32 * nb, 64 * kb};
}
__device__ __forceinline__ void convert_ffn(Frame& F, const float* w_in, const float* w_out, bf16* dst_in, bf16* dst_out, int gw, int NGW) {
    LAS float* scr = (LAS float*)(F.lds + F.wave * 16384);
    constexpr int I_IN = 16 * 176, I_OUT = 44 * 32;
    if (dst_in) for (int it = gw; it < I_IN; it += NGW) { const int kb = it / 176, nb = it % 176, c0 = 32 * nb; const int j0 = c0 < DFF ? c0 : c0 - DFF;
        const int drow0 = (j0 >> 7) * 256 + (c0 < DFF ? 0 : 128) + (j0 & 127);
        transpose_item(w_in, 2 * DFF, c0, D, dst_in, drow0, scr, 64 * kb, F.lane); }
    if (dst_out) for (int r = gw; r < I_OUT; r += NGW) { const int kb = r / 32, nb = r % 32; transpose_item(w_out, D, 32 * nb, DFF, dst_out, 32 * nb, scr, 64 * kb, F.lane); }
}
__device__ __forceinline__ TrItem mixer_item(Frame& F, int part, int it) {
    constexpr int NB0 = 4352 / 32, NB1 = (7424 - 4352) / 32, I_SQ = 16 * 32;
    const int nb_n = part == 0 ? NB0 : NB1, i_in = 16 * nb_n;
    if (it < i_in) { const int kb = it / nb_n, nb = it % nb_n, dr = 32 * nb + (part == 0 ? 0 : 4352);
        const int c0 = dr < 3072 ? dr : dr < 4352 ? 4112 + (dr - 3072) : dr < 5376 ? 3072 + (dr - 4352) : 5392 + (dr - 5376);
        return TrItem{(F.in[12]), INCOLS, c0, D, ((bf16*)(F.ws + WS_W)) + W_IN, dr, 64 * kb}; }
    int r = it - i_in; const int which = r / I_SQ; r %= I_SQ; const int kb = r / 32, nb = r % 32;
    const float* src = which == 0 ? (F.in[19]) : which == 1 ? (F.in[20]) : (F.in[21]); bf16* dst = ((bf16*)(F.ws + WS_W)) + (which == 0 ? W_A : which == 1 ? W_B : W_O);
    return TrItem{src, D, 32 * nb, D, dst, 32 * nb, 64 * kb};
}
__device__ __forceinline__ void convert_mixer(Frame& F, int part, int gw, int NGW) {
    LAS float* scr = (LAS float*)(F.lds + F.wave * 16384);
    constexpr int NB0 = 4352 / 32, NB1 = (7424 - 4352) / 32, I_SQ = 16 * 32;
    const int i_tot = part == 0 ? 16 * NB0 : 16 * NB1 + 3 * I_SQ;
    for (int it = gw; it < i_tot; it += 2 * NGW) {
        const int itb = it + NGW; const bool hb = itb < i_tot;
        const TrItem ta = mixer_item(F, part, it), tb = mixer_item(F, part, hb ? itb : it);
        f32x4 wa[8], wb[8]; tr_load(ta, F.lane, wa); tr_load(tb, F.lane, wb);
        tr_store(ta, scr, F.lane, wa); if (hb) tr_store(tb, scr, F.lane, wb); }
}
template <int N> __device__ __forceinline__ void convert_mixer_n(Frame& F, int part, int gw, int NGW) {
    LAS float* scr = (LAS float*)(F.lds + F.wave * 16384);
    constexpr int NB0 = 4352 / 32, NB1 = (7424 - 4352) / 32, I_SQ = 16 * 32;
    const int i_tot = part == 0 ? 16 * NB0 : 16 * NB1 + 3 * I_SQ;
    for (int it = gw; it < i_tot; it += N * NGW) {
        TrItem t[N]; f32x4 w[N][8];
#pragma unroll
        for (int k = 0; k < N; ++k) { const int ik = it + k * NGW; t[k] = mixer_item(F, part, ik < i_tot ? ik : it); tr_load(t[k], F.lane, w[k]); }
#pragma unroll
        for (int k = 0; k < N; ++k) if (it + k * NGW < i_tot) tr_store(t[k], scr, F.lane, w[k]); }
}
__device__ __forceinline__ int ada_row_off(int s) { return s < 31 ? s * 4112 : 131584 + (s - 31) * 4112; }
__device__ __forceinline__ void split_bf(float a, float b, unsigned& hi, unsigned& lo) {
    hi = pk2(a, b); lo = pk2(a - __builtin_bit_cast(float, hi << 16), b - __builtin_bit_cast(float, hi & 0xffff0000u)); }
__device__ __forceinline__ void ada_item(Frame& F, int item) {
    { f32x4 cv[17];
#pragma unroll
      for (int i = 0; i < 17; ++i) { int q = F.tid + 512 * i; q = q < 8448 ? q : 8447; const int b = q >> 8;
          const float* src = b == 0 ? (F.in[6]) : (F.in[7]) + (size_t)(b - 1) * 1024; cv[i] = *(const f32x4*)(src + 4 * (q & 255)); }
#pragma unroll
      for (int i = 0; i < 17; ++i) { const int q = F.tid + 512 * i; const int b = q >> 8; const f32x4 c = cv[i];
          const f32x4 s = (f32x4){c.x / (1.f + __expf(-c.x)), c.y / (1.f + __expf(-c.y)), c.z / (1.f + __expf(-c.z)), c.w / (1.f + __expf(-c.w))};
          if (q < 8448) *(LAS f32x4*)(F.lds + ada_row_off(b == 0 ? 32 : b - 1) + 16 * (q & 255)) = s; } }
    __syncthreads();
    const int i16 = F.lane & 15, kg = F.lane >> 4, k0 = F.wave * 128;
    const float* wp = (F.in[25]) + (size_t)(k0 + 8 * kg) * ADAW + item * 64 + 4 * i16;
    f32x4 acc[3][4], ld[2][8];
#pragma unroll
    for (int mt = 0; mt < 3; ++mt)
#pragma unroll
        for (int t = 0; t < 4; ++t) acc[mt][t] = (f32x4){0.f, 0.f, 0.f, 0.f};
#pragma unroll
    for (int j = 0; j < 8; ++j) ld[0][j] = *(const f32x4*)(wp + (size_t)j * ADAW);
#pragma unroll
    for (int j = 0; j < 8; ++j) ld[1][j] = *(const f32x4*)(wp + (size_t)(32 + j) * ADAW);
#pragma unroll
    for (int ks = 0; ks < 4; ++ks) {
        bf16x8 bh[4], bl[4];
#pragma unroll
        for (int t = 0; t < 4; ++t) { unsigned h0, h1, h2, h3, l0, l1, l2, l3; split_bf(ld[ks & 1][0][t], ld[ks & 1][1][t], h0, l0); split_bf(ld[ks & 1][2][t], ld[ks & 1][3][t], h1, l1);
            split_bf(ld[ks & 1][4][t], ld[ks & 1][5][t], h2, l2); split_bf(ld[ks & 1][6][t], ld[ks & 1][7][t], h3, l3); bh[t] = __builtin_bit_cast(bf16x8, (v4u){h0, h1, h2, h3}); bl[t] = __builtin_bit_cast(bf16x8, (v4u){l0, l1, l2, l3}); }
        if (ks + 2 < 4) {
#pragma unroll
            for (int j = 0; j < 8; ++j) ld[ks & 1][j] = *(const f32x4*)(wp + (size_t)(32 * (ks + 2) + j) * ADAW); }
#pragma unroll
        for (int mt = 0; mt < 3; ++mt) { const LAS float* ap = (const LAS float*)(F.lds + ada_row_off(mt < 2 ? 16 * mt + i16 : 32)) + k0 + 32 * ks + 8 * kg;
            const f32x4 a0 = *(const LAS f32x4*)ap, a1 = *(const LAS f32x4*)(ap + 4); unsigned h0, h1, h2, h3, l0, l1, l2, l3;
            split_bf(a0.x, a0.y, h0, l0); split_bf(a0.z, a0.w, h1, l1); split_bf(a1.x, a1.y, h2, l2); split_bf(a1.z, a1.w, h3, l3);
            const bf16x8 ah = __builtin_bit_cast(bf16x8, (v4u){h0, h1, h2, h3}), al = __builtin_bit_cast(bf16x8, (v4u){l0, l1, l2, l3});
#pragma unroll
            for (int t = 0; t < 4; ++t) { acc[mt][t] = __builtin_amdgcn_mfma_f32_16x16x32_bf16(ah, bh[t], acc[mt][t], 0, 0, 0);
                acc[mt][t] = __builtin_amdgcn_mfma_f32_16x16x32_bf16(ah, bl[t], acc[mt][t], 0, 0, 0); acc[mt][t] = __builtin_amdgcn_mfma_f32_16x16x32_bf16(al, bh[t], acc[mt][t], 0, 0, 0); } }
    }
    __syncthreads();
    LAS float* red = (LAS float*)F.lds;
#pragma unroll
    for (int mt = 0; mt < 2; ++mt)
#pragma unroll
        for (int i = 0; i < 4; ++i) *(LAS f32x4*)(red + (F.wave * 33 + 16 * mt + 4 * kg + i + 1) * 64 + 4 * i16) = (f32x4){acc[mt][0][i], acc[mt][1][i], acc[mt][2][i], acc[mt][3][i]};
    if (kg == 0) *(LAS f32x4*)(red + (F.wave * 33) * 64 + 4 * i16) = (f32x4){acc[2][0][0], acc[2][1][0], acc[2][2][0], acc[2][3][0]};
    __syncthreads();
    const float bias = (F.in[26])[item * 64 + (F.tid & 63)];
    for (int idx = F.tid; idx < 33 * 64; idx += 512) { const int b = idx >> 6, l = idx & 63; float s = 0.f;
#pragma unroll
        for (int w = 0; w < 8; ++w) s += red[(w * 33 + b) * 64 + l];
        ((float*)(F.ws + WS_ADA))[(size_t)b * ADAW + item * 64 + l] = s + bias; }
    __syncthreads();
}
__device__ __forceinline__ void convert_ffn_range(Frame& F, const float* w_in, const float* w_out, bf16* dst_in, bf16* dst_out, int lo, int hi) {
    LAS float* scr = (LAS float*)(F.lds + F.wave * 16384);
    constexpr int I_ALL = 16 * 176 + 44 * 32;
    if (hi > I_ALL) hi = I_ALL;
    for (int it = lo + F.wave; it < hi; it += 2 * NWAVES) {
        const int itb = it + NWAVES; const bool hb = itb < hi;
        const TrItem ta = ffn_item(it, w_in, w_out, dst_in, dst_out), tb = ffn_item(hb ? itb : it, w_in, w_out, dst_in, dst_out);
        f32x4 wa[8], wb[8]; tr_load(ta, F.lane, wa); tr_load(tb, F.lane, wb);
        tr_store(ta, scr, F.lane, wa); if (hb) tr_store(tb, scr, F.lane, wb); }
}
__device__ __forceinline__ int left_index(int pm, int pn) { return pm >= 64 ? (pm - 64) * 4 + pn : -1; }
struct Leftover { const bf16* part; bool base_in; int gi; float scale; };
__device__ __forceinline__ void load_row(Frame& F, int m, bool from_in, const Leftover& LO, f32x4 (&v)[4]) {
    const float* irow = m < MP ? (F.in[0]) + (size_t)m * D : (F.in[1]) + (size_t)(m - MP) * D;
    GAS u32x2* xb = (GAS u32x2*)((bf16*)F.out + (size_t)m * 2048) + F.lane;
#pragma unroll
    for (int j = 0; j < 4; ++j) { const int li = LO.part ? left_index(m >> 8, j) : -1;
        if (li < 0) { if (from_in) v[j] = *((const GAS f32x4*)irow + 64 * j + F.lane); else { const u32x2 w = xb[64 * j]; v[j] = (f32x4){bflo(w.x), bfhi(w.x), bflo(w.y), bfhi(w.y)}; } }
        else { f32x4 bs; if (LO.base_in) bs = *((const GAS f32x4*)irow + 64 * j + F.lane); else { const u32x2 w = xb[64 * j]; bs = (f32x4){bflo(w.x), bfhi(w.x), bflo(w.y), bfhi(w.y)}; }
            const f32x4 gv = *((const GAS f32x4*)(((float*)(F.ws + WS_ADA)) + (size_t)mod_row(m) * ADAW + LO.gi * D) + 64 * j + F.lane);
            const GAS u32x2* pp = (const GAS u32x2*)(LO.part + (size_t)li * 8 * 65536 + (size_t)(m & 255) * 256) + F.lane; f32x4 s = (f32x4){0.f, 0.f, 0.f, 0.f};
#pragma unroll
            for (int p = 0; p < 8; ++p) { const u32x2 w = pp[(size_t)p * 16384]; s += (f32x4){bflo(w.x), bfhi(w.x), bflo(w.y), bfhi(w.y)}; }
            v[j] = bs + gv * s * LO.scale; xb[64 * j] = (u32x2){pk2(v[j].x, v[j].y), pk2(v[j].z, v[j].w)}; } }
}
struct RowBuf { f32x4 x[4], sc[4], sh[4]; };
__device__ __forceinline__ void rmsmod_row(const RowBuf& rb, const f32x4 (&gq)[4], bf16* orow, int lane, f32x4 (&hv)[4]) {
    float s = 0.f;
#pragma unroll
    for (int j = 0; j < 4; ++j) s += (rb.x[j].x * rb.x[j].x + rb.x[j].y * rb.x[j].y) + (rb.x[j].z * rb.x[j].z + rb.x[j].w * rb.x[j].w);
    const float r = __builtin_amdgcn_rsqf(wave_sum(s) * (1.f / D) + EPS);
    GAS u32x2* o8 = (GAS u32x2*)orow + lane;
#pragma unroll
    for (int j = 0; j < 4; ++j) { const f32x4 h = (rb.x[j] * r) * gq[j] * (rb.sc[j] + 1.f) + rb.sh[j]; hv[j] = h;
        u32x2 w; w.x = pk2(h.x, h.y); w.y = pk2(h.z, h.w); o8[64 * j] = w; }
}
template <bool WITH_BA>
__device__ __forceinline__ void rmsmod_rows(Frame& F, bool from_in, const float* g, int li, bf16* dst, const Leftover LO = Leftover{nullptr, false, 0, 0.f}, int dld = D) {
    const int gw = F.vcu * NWAVES + F.wave, NGW = F.G * NWAVES;
    LAS float* wba = (LAS float*)F.lds;
    if (WITH_BA) { for (int idx = F.tid; idx < 16 * 1024; idx += 512) { const int k = idx >> 4, j = idx & 15; wba[j * 1024 + k] = (F.in[12])[(size_t)k * INCOLS + 4096 + j]; } __syncthreads(); }
    f32x4 gq[4];
#pragma unroll
    for (int j = 0; j < 4; ++j) gq[j] = ((const GAS f32x4*)g)[64 * j + F.lane];
    RowBuf cur, nxt;
#define ROW_FETCH(mm, B) do { const float* ad_ = ((float*)(F.ws + WS_ADA)) + (size_t)mod_row(mm) * ADAW + (3 * li) * D; load_row(F, mm, from_in, LO, B.x); \
        _Pragma("unroll") for (int j = 0; j < 4; ++j) { B.sh[j] = ((const GAS f32x4*)ad_)[64 * j + F.lane]; B.sc[j] = ((const GAS f32x4*)(ad_ + D))[64 * j + F.lane]; } } while (0)
    if (gw < M) ROW_FETCH(gw, cur);
    for (int m = gw; m < M; m += NGW) {
        if (m + NGW < M) ROW_FETCH(m + NGW, nxt);
        f32x4 hv[4]; rmsmod_row(cur, gq, dst + (size_t)m * dld, F.lane, hv);
        if (WITH_BA) { float p[16];
#pragma unroll
            for (int j = 0; j < 16; ++j) { float s = 0.f;
#pragma unroll
                for (int jj = 0; jj < 4; ++jj) { const f32x4 w = *(const LAS f32x4*)(wba + j * 1024 + 256 * jj + 4 * F.lane); s += (hv[jj].x * w.x + hv[jj].y * w.y) + (hv[jj].z * w.z + hv[jj].w * w.w); }
                p[j] = s; if ((j & 3) == 3) asm volatile("" ::: "memory"); }
            { const bool up = F.lane & 32;
#pragma unroll
              for (int i = 0; i < 8; ++i) { const float snd = up ? p[i] : p[8 + i]; const float rcv = __shfl_xor(snd, 32); p[i] = (up ? p[8 + i] : p[i]) + rcv; } }
            { const bool up = F.lane & 16;
#pragma unroll
              for (int i = 0; i < 4; ++i) { const float snd = up ? p[i] : p[4 + i]; const float rcv = __shfl_xor(snd, 16); p[i] = (up ? p[4 + i] : p[i]) + rcv; } }
            { const bool up = F.lane & 8;
#pragma unroll
              for (int i = 0; i < 2; ++i) { const float snd = up ? p[i] : p[2 + i]; const float rcv = __shfl_xor(snd, 8); p[i] = (up ? p[2 + i] : p[i]) + rcv; } }
            { const bool up = F.lane & 4; const float snd = up ? p[0] : p[1]; const float rcv = __shfl_xor(snd, 4); p[0] = (up ? p[1] : p[0]) + rcv; }
            p[0] += __shfl_xor(p[0], 2); p[0] += __shfl_xor(p[0], 1);
            if ((F.lane & 3) == 0) ((float*)(F.ws + WS_BA))[(size_t)m * 16 + (((F.lane >> 5) & 1) * 8 + ((F.lane >> 4) & 1) * 4 + ((F.lane >> 3) & 1) * 2 + ((F.lane >> 2) & 1))] = p[0]; }
        cur = nxt;
    }
#undef ROW_FETCH
    if (WITH_BA) __syncthreads();
}
__device__ __forceinline__ void rmsmod_apply(const f32x4 (&x)[4], const f32x4 (&gs)[4], const f32x4 (&sh)[4], bf16* orow, int lane, f32x4 (&hv)[4]) {
    float s = 0.f;
#pragma unroll
    for (int j = 0; j < 4; ++j) s += (x[j].x * x[j].x + x[j].y * x[j].y) + (x[j].z * x[j].z + x[j].w * x[j].w);
    const float r = __builtin_amdgcn_rsqf(wave_sum(s) * (1.f / D) + EPS);
    GAS u32x2* o8 = (GAS u32x2*)orow + lane;
#pragma unroll
    for (int j = 0; j < 4; ++j) { const f32x4 h = (x[j] * r) * gs[j] + sh[j]; hv[j] = h;
        u32x2 w; w.x = pk2(h.x, h.y); w.y = pk2(h.z, h.w); o8[64 * j] = w; }
}
__device__ __forceinline__ void ba_reduce_store(Frame& F, float (&p)[16], int m) {
    { const bool up = F.lane & 32;
#pragma unroll
      for (int i = 0; i < 8; ++i) { const float snd = up ? p[i] : p[8 + i]; const float rcv = __shfl_xor(snd, 32); p[i] = (up ? p[8 + i] : p[i]) + rcv; } }
    { const bool up = F.lane & 16;
#pragma unroll
      for (int i = 0; i < 4; ++i) { const float snd = up ? p[i] : p[4 + i]; const float rcv = __shfl_xor(snd, 16); p[i] = (up ? p[4 + i] : p[i]) + rcv; } }
    { const bool up = F.lane & 8;
#pragma unroll
      for (int i = 0; i < 2; ++i) { const float snd = up ? p[i] : p[2 + i]; const float rcv = __shfl_xor(snd, 8); p[i] = (up ? p[2 + i] : p[i]) + rcv; } }
    { const bool up = F.lane & 4; const float snd = up ? p[0] : p[1]; const float rcv = __shfl_xor(snd, 4); p[0] = (up ? p[1] : p[0]) + rcv; }
    p[0] += __shfl_xor(p[0], 2); p[0] += __shfl_xor(p[0], 1);
    if ((F.lane & 3) == 0) ((float*)(F.ws + WS_BA))[(size_t)m * 16 + (((F.lane >> 5) & 1) * 8 + ((F.lane >> 4) & 1) * 4 + ((F.lane >> 3) & 1) * 2 + ((F.lane >> 2) & 1))] = p[0];
}
__device__ __forceinline__ void ba_project(Frame& F, const f32x4 (&hv)[4], int m, const LAS float* wba) {
    float p[16];
#pragma unroll
    for (int j = 0; j < 16; ++j) { float s = 0.f;
#pragma unroll
        for (int jj = 0; jj < 4; ++jj) { const f32x4 w = *(const LAS f32x4*)(wba + j * 1024 + 256 * jj + 4 * F.lane); s += (hv[jj].x * w.x + hv[jj].y * w.y) + (hv[jj].z * w.z + hv[jj].w * w.w); }
        p[j] = s; if ((j & 3) == 3) asm volatile("" ::: "memory"); }
    ba_reduce_store(F, p, m);
}
#ifndef BA_PAIR
#define BA_PAIR 1
#endif
__device__ __forceinline__ void ba_reduce8_store(Frame& F, float (&p)[8], int m, int jbase) {
    { const bool up = F.lane & 32;
#pragma unroll
      for (int i = 0; i < 4; ++i) { const float snd = up ? p[i] : p[4 + i]; const float rcv = __shfl_xor(snd, 32); p[i] = (up ? p[4 + i] : p[i]) + rcv; } }
    { const bool up = F.lane & 16;
#pragma unroll
      for (int i = 0; i < 2; ++i) { const float snd = up ? p[i] : p[2 + i]; const float rcv = __shfl_xor(snd, 16); p[i] = (up ? p[2 + i] : p[i]) + rcv; } }
    { const bool up = F.lane & 8; const float snd = up ? p[0] : p[1]; const float rcv = __shfl_xor(snd, 8); p[0] = (up ? p[1] : p[0]) + rcv; }
    p[0] += __shfl_xor(p[0], 4); p[0] += __shfl_xor(p[0], 2); p[0] += __shfl_xor(p[0], 1);
    if ((F.lane & 7) == 0) ((float*)(F.ws + WS_BA))[(size_t)m * 16 + jbase + (((F.lane >> 5) & 1) * 4 + ((F.lane >> 4) & 1) * 2 + ((F.lane >> 3) & 1))] = p[0];
}
__device__ __forceinline__ void ba_project2(Frame& F, const f32x4 (&ha)[4], int ma, const f32x4 (&hb)[4], int mb, const LAS float* wba) {
#pragma unroll 1
    for (int jb = 0; jb < 16; jb += 8) { float pa[8], pb[8];
#pragma unroll
        for (int j = 0; j < 8; ++j) { float sa = 0.f, sb = 0.f;
#pragma unroll
            for (int jj = 0; jj < 4; ++jj) { const f32x4 w = *(const LAS f32x4*)(wba + (jb + j) * 1024 + 256 * jj + 4 * F.lane);
                sa += (ha[jj].x * w.x + ha[jj].y * w.y) + (ha[jj].z * w.z + ha[jj].w * w.w); sb += (hb[jj].x * w.x + hb[jj].y * w.y) + (hb[jj].z * w.z + hb[jj].w * w.w); }
            pa[j] = sa; pb[j] = sb; if (j & 1) asm volatile("" ::: "memory"); }
        ba_reduce8_store(F, pa, ma, jb); ba_reduce8_store(F, pb, mb, jb); }
}
template <bool BASE_IN, bool WRITE_XB> __device__ __forceinline__ void sample_row_complete(Frame& F, int m, const Leftover& LO, f32x4 (&v)[4]) {
    const float* irow = (F.in[1]) + (size_t)(m - MP) * D;
    GAS u32x2* xb = (GAS u32x2*)((bf16*)F.out + (size_t)m * 2048) + F.lane;
    f32x4 bsf[4]; u32x2 bsb[4]; f32x4 gv[4]; u32x2 pw[4][8];
#pragma unroll
    for (int j = 0; j < 4; ++j) { if (BASE_IN) bsf[j] = *((const GAS f32x4*)irow + 64 * j + F.lane); else bsb[j] = xb[64 * j];
        gv[j] = *((const GAS f32x4*)(((float*)(F.ws + WS_ADA)) + (size_t)mod_row(m) * ADAW + LO.gi * D) + 64 * j + F.lane); }
#pragma unroll
    for (int j = 0; j < 4; ++j) { const int li = ((m >> 8) - 64) * 4 + j; const GAS u32x2* pp = (const GAS u32x2*)(LO.part + (size_t)li * 8 * 65536 + (size_t)(m & 255) * 256) + F.lane;
#pragma unroll
        for (int p = 0; p < 8; ++p) pw[j][p] = pp[(size_t)p * 16384]; }
#pragma unroll
    for (int j = 0; j < 4; ++j) { f32x4 s = (f32x4){0.f, 0.f, 0.f, 0.f};
#pragma unroll
        for (int p = 0; p < 8; ++p) { const u32x2 w = pw[j][p]; s += (f32x4){bflo(w.x), bfhi(w.x), bflo(w.y), bfhi(w.y)}; }
        const f32x4 bs = BASE_IN ? bsf[j] : (f32x4){bflo(bsb[j].x), bfhi(bsb[j].x), bflo(bsb[j].y), bfhi(bsb[j].y)};
        v[j] = bs + gv[j] * s * LO.scale; if (WRITE_XB) xb[64 * j] = (u32x2){pk2(v[j].x, v[j].y), pk2(v[j].z, v[j].w)}; }
}
struct NoPre { __device__ __forceinline__ void operator()() const {} };
template <bool WITH_BA, bool FROM_IN, bool HAS_LO, bool BASE_IN, int NB, class Pre = NoPre>
__device__ __forceinline__ void rmsmod_rows_256(Frame& F, const float* g, int li, bf16* dst, const Leftover LO, int dld, const Pre& pre = Pre()) {
    static_assert(8 % NB == 0, "prompt rows per wave come in batches");
    const int gw = F.vcu * NWAVES + F.wave;
    LAS float* wba = (LAS float*)F.lds;
    if (WITH_BA) { float wv[32];
#pragma unroll
        for (int i = 0; i < 32; ++i) { const int idx = F.tid + 512 * i; wv[i] = (F.in[12])[(size_t)(idx >> 4) * INCOLS + 4096 + (idx & 15)]; }
#pragma unroll
        for (int i = 0; i < 32; ++i) { const int idx = F.tid + 512 * i; wba[(idx & 15) * 1024 + (idx >> 4)] = wv[i]; }
        __syncthreads(); }
    f32x4 gs0[4], sh0[4];
    { const float* ad = ((float*)(F.ws + WS_ADA)) + (3 * li) * D;
#pragma unroll
      for (int j = 0; j < 4; ++j) { const f32x4 gq = ((const GAS f32x4*)g)[64 * j + F.lane]; sh0[j] = ((const GAS f32x4*)ad)[64 * j + F.lane]; gs0[j] = gq * (((const GAS f32x4*)(ad + D))[64 * j + F.lane] + 1.f); } }
#pragma unroll 1
    for (int it = 0; it < 8 / NB; ++it) {
        f32x4 rf[FROM_IN ? NB : 1][4]; u32x2 rb[FROM_IN ? 1 : NB][4];
#pragma unroll
        for (int r = 0; r < NB; ++r) { const int m = gw + 2048 * (NB * it + r);
#pragma unroll
            for (int j = 0; j < 4; ++j) { if (FROM_IN) rf[r][j] = *((const GAS f32x4*)((F.in[0]) + (size_t)m * D) + 64 * j + F.lane); else rb[r][j] = ((const GAS u32x2*)((bf16*)F.out + (size_t)m * 2048) + F.lane)[64 * j]; } }
        if (it == 0) pre();
        if (WITH_BA) {
#pragma unroll
            for (int r = 0; r < NB; r += 2) { const int ma = gw + 2048 * (NB * it + r), mb = ma + 2048; f32x4 xa[4], xb2[4], ha[4], hb[4];
#pragma unroll
                for (int j = 0; j < 4; ++j) { if (FROM_IN) { xa[j] = rf[r][j]; xb2[j] = rf[r + 1][j]; } else { const u32x2 w = rb[r][j], w2 = rb[r + 1][j];
                    xa[j] = (f32x4){bflo(w.x), bfhi(w.x), bflo(w.y), bfhi(w.y)}; xb2[j] = (f32x4){bflo(w2.x), bfhi(w2.x), bflo(w2.y), bfhi(w2.y)}; } }
                rmsmod_apply(xa, gs0, sh0, dst + (size_t)ma * dld, F.lane, ha); rmsmod_apply(xb2, gs0, sh0, dst + (size_t)mb * dld, F.lane, hb);
                if (BA_PAIR) ba_project2(F, ha, ma, hb, mb, wba); else { ba_project(F, ha, ma, wba); ba_project(F, hb, mb, wba); } }
        } else {
#pragma unroll
        for (int r = 0; r < NB; ++r) { const int m = gw + 2048 * (NB * it + r); f32x4 x[4], hv[4];
#pragma unroll
            for (int j = 0; j < 4; ++j) { if (FROM_IN) x[j] = rf[r][j]; else { const u32x2 w = rb[r][j]; x[j] = (f32x4){bflo(w.x), bfhi(w.x), bflo(w.y), bfhi(w.y)}; } }
            rmsmod_apply(x, gs0, sh0, dst + (size_t)m * dld, F.lane, hv); }
        }
    }
    { const int m = MP + gw; f32x4 x[4], hv[4], scs[4], shs[4];
      const float* ad = ((float*)(F.ws + WS_ADA)) + (size_t)mod_row(m) * ADAW + (3 * li) * D;
#pragma unroll
      for (int j = 0; j < 4; ++j) { shs[j] = ((const GAS f32x4*)ad)[64 * j + F.lane]; scs[j] = ((const GAS f32x4*)g)[64 * j + F.lane] * (((const GAS f32x4*)(ad + D))[64 * j + F.lane] + 1.f); }
      if (HAS_LO) sample_row_complete<BASE_IN, true>(F, m, LO, x);
      else {
#pragma unroll
          for (int j = 0; j < 4; ++j) x[j] = *((const GAS f32x4*)((F.in[1]) + (size_t)(m - MP) * D) + 64 * j + F.lane); }
      rmsmod_apply(x, scs, shs, dst + (size_t)m * dld, F.lane, hv);
      if (WITH_BA) ba_project(F, hv, m, wba); }
    if (WITH_BA) __syncthreads();
}
template <int NB> __device__ __forceinline__ void final_norm_rows_256(Frame& F, const Leftover LO) {
    const int gw = F.vcu * NWAVES + F.wave;
    f32x4 gq[4];
#pragma unroll
    for (int j = 0; j < 4; ++j) gq[j] = ((const GAS f32x4*)(F.in[27]))[64 * j + F.lane];
#pragma unroll 1
    for (int it = 0; it < 8 / NB; ++it) {
        u32x2 rb[NB][4];
#pragma unroll
        for (int r = 0; r < NB; ++r) { const int m = gw + 2048 * (NB * it + r);
#pragma unroll
            for (int j = 0; j < 4; ++j) rb[r][j] = ((const GAS u32x2*)((bf16*)F.out + (size_t)m * 2048) + F.lane)[64 * j]; }
#pragma unroll
        for (int r = 0; r < NB; ++r) { const int m = gw + 2048 * (NB * it + r); f32x4 x[4]; float s = 0.f;
#pragma unroll
            for (int j = 0; j < 4; ++j) { const u32x2 w = rb[r][j]; x[j] = (f32x4){bflo(w.x), bfhi(w.x), bflo(w.y), bfhi(w.y)}; s += (x[j].x * x[j].x + x[j].y * x[j].y) + (x[j].z * x[j].z + x[j].w * x[j].w); }
            const float rr = __builtin_amdgcn_rsqf(wave_sum(s) * (1.f / D) + EPS); GAS f32x4* xr = (GAS f32x4*)(F.out + (size_t)m * D) + F.lane;
#pragma unroll
            for (int j = 0; j < 4; ++j) xr[64 * j] = (x[j] * rr) * gq[j]; }
    }
    { const int m = MP + gw; f32x4 x[4]; float s = 0.f;
      sample_row_complete<false, false>(F, m, LO, x);
#pragma unroll
      for (int j = 0; j < 4; ++j) s += (x[j].x * x[j].x + x[j].y * x[j].y) + (x[j].z * x[j].z + x[j].w * x[j].w);
      const float rr = __builtin_amdgcn_rsqf(wave_sum(s) * (1.f / D) + EPS); GAS f32x4* xr = (GAS f32x4*)(F.out + (size_t)m * D) + F.lane;
#pragma unroll
      for (int j = 0; j < 4; ++j) xr[64 * j] = (x[j] * rr) * gq[j]; }
}
__device__ __forceinline__ void final_norm_rows(Frame& F, const Leftover LO) {
    const int gw = F.vcu * NWAVES + F.wave, NGW = F.G * NWAVES;
    f32x4 gq[4], cur[4], nxt[4];
#pragma unroll
    for (int j = 0; j < 4; ++j) gq[j] = ((const GAS f32x4*)(F.in[27]))[64 * j + F.lane];
    if (gw < M) load_row(F, gw, false, LO, cur);
    for (int m = gw; m < M; m += NGW) {
        if (m + NGW < M) load_row(F, m + NGW, false, LO, nxt);
        GAS f32x4* xr = (GAS f32x4*)(F.out + (size_t)m * D) + F.lane; float s = 0.f;
#pragma unroll
        for (int j = 0; j < 4; ++j) s += (cur[j].x * cur[j].x + cur[j].y * cur[j].y) + (cur[j].z * cur[j].z + cur[j].w * cur[j].w);
        const float r = __builtin_amdgcn_rsqf(wave_sum(s) * (1.f / D) + EPS);
#pragma unroll
        for (int j = 0; j < 4; ++j) { xr[64 * j] = (cur[j] * r) * gq[j]; cur[j] = nxt[j]; }
    }
}
typedef pg8::f32x4 pf4; typedef pg8::u32x4 pu4;
#ifndef WT_STORES
#define WT_STORES 0
#endif
__device__ __forceinline__ void st16(void* p, pu4 v) {
#if WT_STORES
    asm volatile("global_store_dwordx4 %0, %1, off sc1\n\ts_nop 1" :: "v"(p), "v"(v) : "memory");
#else
    *(pu4*)p = v;
#endif
}
__device__ __forceinline__ void st16f(void* p, pf4 v) { st16(p, __builtin_bit_cast(pu4, v)); }
typedef float pf2 __attribute__((ext_vector_type(2)));
__device__ __forceinline__ pf2 silu_mul2(pf2 g, pf2 u) { const pf2 s = g * (-1.4426950408889634f); pf2 e; e.x = __builtin_amdgcn_exp2f(s.x); e.y = __builtin_amdgcn_exp2f(s.y);
    const pf2 d = e + 1.0f; pf2 r; r.x = __builtin_amdgcn_rcpf(d.x); r.y = __builtin_amdgcn_rcpf(d.y); return (g * r) * u; }
__device__ __forceinline__ pf4 silu_mul4(pf4 g, pf4 u) { const pf2 a = silu_mul2((pf2){g.x, g.y}, (pf2){u.x, u.y}), b = silu_mul2((pf2){g.z, g.w}, (pf2){u.z, u.w}); return (pf4){a.x, a.y, b.x, b.y}; }
__device__ __forceinline__ pu4 pack8(pf4 a, pf4 b) { pu4 w; w.x = pg8::cvt_pk_bf16(a.x, a.y); w.y = pg8::cvt_pk_bf16(a.z, a.w); w.z = pg8::cvt_pk_bf16(b.x, b.y); w.w = pg8::cvt_pk_bf16(b.z, b.w); return w; }
struct EpiSwiglu {
    static constexpr bool PERM = true, AFTER_DRAIN = false; bf16* O;
    __device__ __forceinline__ void operator()(const pf4 (&acc)[2][2][4][2], const pg8::Unit& u, int wr, int wc, int fr, int fq) const {
        const int row0 = u.pm * 256 + wr * 64 + fr, col0 = u.pn * 128 + wc * 32 + 8 * fq;
#pragma unroll
        for (int ai = 0; ai < 2; ++ai)
#pragma unroll
            for (int m = 0; m < 4; ++m) { bf16* p = O + (size_t)(row0 + ai * 128 + m * 16) * DFF + col0;
                const pf4 h0 = silu_mul4(acc[ai][0][m][0], acc[ai][1][m][0]), h1 = silu_mul4(acc[ai][0][m][1], acc[ai][1][m][1]);
                st16(p, pack8(h0, h1)); }
    }
};
template <bool BASE_IN> struct EpiResid {
    static constexpr bool PERM = true, AFTER_DRAIN = false; const float* in0; const float* in1; bf16* xb; const float* ada; int gi; float scale; bf16* part;
    __device__ __forceinline__ void operator()(const pf4 (&acc)[2][2][4][2], const pg8::Unit& u, int wr, int wc, int fr, int fq) const {
        if (u.piece) {
            char* pb = (char*)(part + ((size_t)u.lidx * 8 + (u.piece - 1)) * 65536);
#pragma unroll
            for (int ai = 0; ai < 2; ++ai)
#pragma unroll
                for (int bj = 0; bj < 2; ++bj) { unsigned off = (unsigned)((ai * 128 + wr * 64 + fr) * 256 + wc * 32 + 8 * fq + bj * 128) * 2u; asm volatile("" : "+v"(off));
#pragma unroll
                    for (int m = 0; m < 4; ++m) { *(pu4*)(pb + (size_t)off) = pack8(acc[ai][bj][m][0], acc[ai][bj][m][1]); off += 16u * 256u * 2u; }
                    asm volatile("" ::: "memory"); }
            return; }
        const int rowt = u.pm * 256, col0 = u.pn * 256 + wc * 32 + 8 * fq;
        const char* ib = (const char*)(rowt < MP ? in0 + (size_t)rowt * D : in1 + (size_t)(rowt - MP) * D); char* xo = (char*)(xb + (size_t)rowt * 2048);
#pragma unroll
        for (int ai = 0; ai < 2; ++ai) {
            const int b = rowt < MP ? 0 : 1 + ((rowt - MP) >> 6) + ai * 2 + wr; const char* ga = (const char*)(ada + (size_t)b * ADAW + gi * D);
#pragma unroll
            for (int bj = 0; bj < 2; ++bj) { unsigned co = (unsigned)(col0 + bj * 128); asm volatile("" : "+v"(co));
                const pf4 g0r = *(const pf4*)(ga + (size_t)co * 4u), g1r = *(const pf4*)(ga + (size_t)co * 4u + 16);
                const unsigned r0 = (unsigned)(ai * 128 + wr * 64 + fr);
                pf4 bf[BASE_IN ? 4 : 1][2]; pu4 bw[BASE_IN ? 1 : 4];
#pragma unroll
                for (int m = 0; m < 4; ++m) { const unsigned r = r0 + 16u * m;
                    if (BASE_IN) { const char* p = ib + ((size_t)r * D + co) * 4u; bf[m][0] = *(const pf4*)p; bf[m][1] = *(const pf4*)(p + 16); }
                    else bw[m] = *(const pu4*)(xo + ((size_t)r * 2048 + co) * 2u); }
                const pf4 g0 = g0r * scale, g1 = g1r * scale;
#pragma unroll
                for (int m = 0; m < 4; ++m) { const unsigned r = r0 + 16u * m; pf4 b0, b1;
                    if (BASE_IN) { b0 = bf[m][0]; b1 = bf[m][1]; }
                    else { const pu4 w = bw[m]; b0 = (pf4){bflo(w.x), bfhi(w.x), bflo(w.y), bfhi(w.y)}; b1 = (pf4){bflo(w.z), bfhi(w.z), bflo(w.w), bfhi(w.w)}; }
                    *(pu4*)(xo + ((size_t)r * 2048 + co) * 2u) = pack8(b0 + g0 * acc[ai][bj][m][0], b1 + g1 * acc[ai][bj][m][1]); }
                asm volatile("" ::: "memory"); }
        }
    }
};
struct EpiPart {
    static constexpr bool PERM = true, AFTER_DRAIN = false; bf16* part;
    __device__ __forceinline__ void operator()(const pf4 (&acc)[2][2][4][2], const pg8::Unit& u, int wr, int wc, int fr, int fq) const {
        char* pb = (char*)(part + ((size_t)u.lidx * 8 + (u.piece - 1)) * 65536);
#pragma unroll
        for (int ai = 0; ai < 2; ++ai)
#pragma unroll
            for (int bj = 0; bj < 2; ++bj) { unsigned off = (unsigned)((ai * 128 + wr * 64 + fr) * 256 + wc * 32 + 8 * fq + bj * 128) * 2u; asm volatile("" : "+v"(off));
#pragma unroll
                for (int m = 0; m < 4; ++m) { *(pu4*)(pb + (size_t)off) = pack8(acc[ai][bj][m][0], acc[ai][bj][m][1]); off += 16u * 256u * 2u; }
                asm volatile("" ::: "memory"); }
    }
};
struct EpiF1 {
    static constexpr bool PERM = true, AFTER_DRAIN = false; bf16 *U1, *U2, *U3, *U4, *KV, *TAIL; float* out;
    __device__ __forceinline__ void operator()(const pf4 (&acc)[2][2][4][2], const pg8::Unit& u, int wr, int wc, int fr, int fq) const {
        const int pn = u.pn, dcol = wc * 32 + 8 * fq;
        if (pn < 12) {
            char* Ub = (char*)U1 + (size_t)((pn >> 2) == 0 ? 4 : (pn >> 2)) * (36u << 20);
#pragma unroll
            for (int ai = 0; ai < 2; ++ai) { const int cn = u.pm * 4 + ai * 2 + wr;
#pragma unroll
                for (int bj = 0; bj < 2; ++bj) { unsigned off = (unsigned)(((cn * 8 + (pn & 3) * 2 + bj) * 64 + fr) * 128 + dcol) * 2u; asm volatile("" : "+v"(off));
#pragma unroll
                    for (int m = 0; m < 4; ++m) { st16(Ub + (size_t)off, pack8(acc[ai][bj][m][0], acc[ai][bj][m][1])); off += 16u * 128u * 2u; }
                    asm volatile("" ::: "memory"); } }
            if (fr >= 13) {
#pragma unroll
                for (int ai = 0; ai < 2; ++ai) { const int cn = u.pm * 4 + ai * 2 + wr;
#pragma unroll
                    for (int bj = 0; bj < 2; ++bj) { const int j = fr - 13, qc = pn * 256 + bj * 128 + dcol; const pf4 v0 = acc[ai][bj][3][0], v1 = acc[ai][bj][3][1];
                        *(pu4*)(TAIL + ((size_t)cn * 3 + j) * 3072 + qc) = pack8(v0, v1);
                        if (cn >= 255) { float* o = out + (cn == 255 ? OFF_PCONV + (size_t)j * 3072 : OFF_SCONV + ((size_t)(cn - 256) * 3 + j) * 3072) + qc; *(pf4*)o = v0; *(pf4*)(o + 4) = v1; } } } }
        } else if (pn < 16) {
#pragma unroll
            for (int ai = 0; ai < 2; ++ai)
#pragma unroll
                for (int bj = 0; bj < 2; ++bj) { unsigned off = (unsigned)((u.pm * 256 + ai * 128 + wr * 64 + fr) * D + (pn - 12) * 256 + bj * 128 + dcol) * 2u; asm volatile("" : "+v"(off));
#pragma unroll
                    for (int m = 0; m < 4; ++m) { st16((char*)U4 + (size_t)off, pack8(acc[ai][bj][m][0], acc[ai][bj][m][1])); off += 16u * D * 2u; }
                    asm volatile("" ::: "memory"); }
        } else {
#pragma unroll
            for (int ai = 0; ai < 2; ++ai) { const int cn = u.pm * 4 + ai * 2 + wr;
#pragma unroll
                for (int bj = 0; bj < 2; ++bj) { unsigned off = (unsigned)((cn * 64 + fr) * 256 + bj * 128 + dcol) * 2u; asm volatile("" : "+v"(off));
#pragma unroll
                    for (int m = 0; m < 4; ++m) { st16((char*)KV + (size_t)off, pack8(acc[ai][bj][m][0], acc[ai][bj][m][1])); off += 16u * 256u * 2u; }
                    asm volatile("" ::: "memory");
                    if (cn >= 254) {
                        float* ob = cn < 256 ? out + (bj == 0 ? OFF_PK : OFF_PV) + (size_t)((cn - 254) * 64 + fr) * 128 + dcol
                                             : out + (bj == 0 ? OFF_SK : OFF_SV) + (size_t)(cn - 256) * 16384 + (size_t)(64 + fr) * 128 + dcol;
#pragma unroll
                        for (int m = 0; m < 4; ++m) { *(pf4*)(ob + m * 16 * 128) = acc[ai][bj][m][0]; *(pf4*)(ob + m * 16 * 128 + 4) = acc[ai][bj][m][1]; }
                        asm volatile("" ::: "memory"); } } }
        }
    }
};
struct EpiF2 {
    static constexpr bool PERM = true, AFTER_DRAIN = false; bf16 *Z, *GA, *GB;
    __device__ __forceinline__ void operator()(const pf4 (&acc)[2][2][4][2], const pg8::Unit& u, int wr, int wc, int fr, int fq) const {
        const int t_ = u.pn >> 2; bf16* Ob = (bf16*)((char*)Z + (size_t)(108 * t_ - 72 * (t_ >> 1)) * (1u << 20)); const int col0 = (u.pn & 3) * 256 + wc * 32 + 8 * fq, row0 = u.pm * 256 + wr * 64 + fr;
#pragma unroll
        for (int ai = 0; ai < 2; ++ai)
#pragma unroll
            for (int m = 0; m < 4; ++m)
#pragma unroll
                for (int bj = 0; bj < 2; ++bj) st16(Ob + (size_t)(row0 + ai * 128 + m * 16) * D + col0 + bj * 128, pack8(acc[ai][bj][m][0], acc[ai][bj][m][1]));
    }
};
template <int MODE> struct EpiGate {
    static constexpr bool PERM = true, AFTER_DRAIN = false; bf16* T; const bf16* G2;
    __device__ __forceinline__ void operator()(const pf4 (&acc)[2][2][4][2], const pg8::Unit& u, int wr, int wc, int fr, int fq) const {
        const int col0 = u.pn * 256 + wc * 32 + 8 * fq, row0 = u.pm * 256 + wr * 64 + fr;
#pragma unroll
        for (int ai = 0; ai < 2; ++ai)
#pragma unroll
            for (int mq = 0; mq < 2; ++mq) { pu4 gv[4], tv[4];
#pragma unroll
                for (int f = 0; f < 4; ++f) { const size_t off = (size_t)(row0 + ai * 128 + (2 * mq + (f >> 1)) * 16) * D + col0 + (f & 1) * 128;
                    gv[f] = *(const pu4*)((MODE == 0 ? (const bf16*)T : G2) + off); tv[f] = (pu4){0u, 0u, 0u, 0u}; if (MODE == 1) tv[f] = *(const pu4*)(T + off); }
#pragma unroll
                for (int f = 0; f < 4; ++f) { const int m = 2 * mq + (f >> 1), bj = f & 1; const size_t off = (size_t)(row0 + ai * 128 + m * 16) * D + col0 + bj * 128;
                    const pf4 a0 = acc[ai][bj][m][0], a1 = acc[ai][bj][m][1]; pf4 o0, o1; const pu4 g = gv[f], t = tv[f];
                    o0.x = bflo(t.x) + sigm(bflo(g.x)) * a0.x; o0.y = bfhi(t.x) + sigm(bfhi(g.x)) * a0.y; o0.z = bflo(t.y) + sigm(bflo(g.y)) * a0.z; o0.w = bfhi(t.y) + sigm(bfhi(g.y)) * a0.w;
                    o1.x = bflo(t.z) + sigm(bflo(g.z)) * a1.x; o1.y = bfhi(t.z) + sigm(bfhi(g.z)) * a1.y; o1.z = bflo(t.w) + sigm(bflo(g.w)) * a1.z; o1.w = bfhi(t.w) + sigm(bfhi(g.w)) * a1.w;
                    st16(T + off, pack8(o0, o1)); }
                asm volatile("" ::: "memory"); }
    }
};
typedef short s16x8 __attribute__((ext_vector_type(8)));
constexpr int PR_RHST = 0, PR_QB = 69632, PR_KB = 87040, PR_AM = 104448, PR_TB = 121856, PR_SC = 126976, PR_IL = 132096, PR_CW = 141312;
static_assert(PR_IL + 64 * 72 * 2 <= PR_CW && PR_CW + 12 * 128 * 4 <= LDS_BYTES, "prep LDS map (IL, CW)");
static_assert(PR_SC + 2 * 1536 <= RING_BYTES, "prep LDS map");
constexpr size_t WS_GATES = 242 * MiB;
struct PrepRegs { v4u raw[3][5]; float gate; };
__device__ __forceinline__ void prep_fetch(Frame& F, int it, int ch8, int rg, PrepRegs& P) {
    const int cn = it >> 3, h = it & 7; const size_t blk = (size_t)(cn * 8 + h) * 64 * 128;
    P.gate = ((const float*)(F.ws + WS_GATES))[(size_t)it * 256 + ((rg * 16 + ch8) & 255)];
    const bf16* hist = cn == 0 ? (const bf16*)(F.ws + WS_CTL + 512 * 1024) : ((const bf16*)(F.ws + WS_TAIL)) + (size_t)(cn < 256 ? cn - 1 : cn + 32) * 3 * 3072;
#pragma unroll
    for (int t = 0; t < 3; ++t) { const int ch = t * 1024 + h * 128 + 8 * ch8; const bf16* Ub = (t == 0 ? ((bf16*)(F.ws + WS_U5)) : t == 1 ? ((bf16*)(F.ws + WS_U2)) : ((bf16*)(F.ws + WS_U3))) + blk + 8 * ch8;
#pragma unroll
        for (int j = 0; j < 5; ++j) { const int rr = 2 * rg - 3 + j;
            const bf16* p = (j >= 3 || rr >= 0) ? Ub + rr * 128 : hist + (size_t)(3 + rr) * 3072 + ch;
            P.raw[t][j] = *(const v4u*)p; } }
}
__device__ __forceinline__ void convert_conv_state(Frame& F) {
    for (int i = (F.vcu * (NWAVES * 64) + F.tid) * 8; i < 32 * 3 * 3072; i += F.G * NWAVES * 64 * 8) { const float* p = (F.in[2]) + i; const f32x4 a = *(const f32x4*)p, b = *(const f32x4*)(p + 4);
        *(v4u*)(((bf16*)(F.ws + WS_TAIL)) + (size_t)288 * 3 * 3072 + i) = (v4u){pk2(a.x, a.y), pk2(a.z, a.w), pk2(b.x, b.y), pk2(b.z, b.w)}; }
}
__device__ __forceinline__ void prep_gates(Frame& F, int it, int lane) {
    const int cn = it >> 3, h = it & 7, row = cn * 64 + lane; const float braw = ((float*)(F.ws + WS_BA))[(size_t)row * 16 + h], araw = ((float*)(F.ws + WS_BA))[(size_t)row * 16 + 8 + h];
    const float beta = 1.f / (1.f + expf(-braw)); const float xx = araw + (F.in[15])[h]; const float sp = xx > 20.f ? xx : log1pf(expf(xx)); const float g = -expf((F.in[14])[h]) * sp;
    float gcs = g;
#pragma unroll
    for (int o = 1; o < 64; o <<= 1) { const float t = __shfl_up(gcs, o); if (lane >= o) gcs += t; }
    const float glast = __shfl(gcs, 63);
    float* G = (float*)(F.ws + WS_GATES) + (size_t)it * 256;
    G[lane] = beta; G[64 + lane] = gcs; G[128 + lane] = expf(gcs); G[192 + lane] = expf(glast - gcs);
    if (lane == 63) ((float*)(F.ws + WS_GL))[it] = expf(glast);
}
#if defined(PROBE_PS)
#define PS_MARK(k) do { if (blockIdx.x == 0 && F.tid == 0) { const unsigned long long t_ = __builtin_amdgcn_s_memrealtime(); volatile LAS unsigned long long* a_ = (volatile LAS unsigned long long*)(F.lds + LDSCTL_OFF + 768); a_[(k)] += t_ - a_[15]; a_[15] = t_; } } while (0)
#else
#define PS_MARK(k) do {} while (0)
#endif
template <bool DRY, int SKIP = 0> __device__ __forceinline__ void gdn_prep_unit(Frame& F, int cn, int h, PrepRegs& P, int it_next, int par) {
    const int tid = F.tid, lane = F.lane, wave = F.wave, ch8 = tid & 15, rg = tid >> 4;
    LAS float* RHST = (LAS float*)(F.lds + PR_RHST); LAS bf16* QB = (LAS bf16*)(F.lds + PR_QB); LAS bf16* KB = (LAS bf16*)(F.lds + PR_KB);
    LAS float* AM = (LAS float*)(F.lds + PR_AM); LAS bf16* TB = (LAS bf16*)(F.lds + PR_TB);
    LAS float* SC = (LAS float*)(F.lds + PR_SC + (par ? 1536 : 0)); LAS float *S_BETA = SC, *S_GC = SC + 64, *S_EG = SC + 128, *S_EK = SC + 192;
    const size_t blk = (size_t)(cn * 8 + h) * 64 * 128;
    PS_MARK(0);
    const float gate_rec = P.gate;
    float y[3][2][8]; int ch8v = ch8, rgv = rg; asm volatile("" : "+v"(ch8v), "+v"(rgv));
#pragma unroll
    for (int t = 0; t < 3; ++t) { const int ch = t * 1024 + h * 128 + 8 * ch8v;
        float x[5][8];
#pragma unroll
        for (int j = 0; j < 5; ++j) { const v4u w = P.raw[t][j]; x[j][0] = bflo(w.x); x[j][1] = bfhi(w.x); x[j][2] = bflo(w.y); x[j][3] = bfhi(w.y); x[j][4] = bflo(w.z); x[j][5] = bfhi(w.z); x[j][6] = bflo(w.w); x[j][7] = bfhi(w.w); }
        const LAS float* cw = (const LAS float*)(F.lds + PR_CW) + t * 512 + 8 * ch8v;
#pragma unroll
        for (int hh = 0; hh < 2; ++hh) { const f32x4 w0 = *(const LAS f32x4*)(cw + 4 * hh), w1 = *(const LAS f32x4*)(cw + 128 + 4 * hh), w2 = *(const LAS f32x4*)(cw + 256 + 4 * hh), w3 = *(const LAS f32x4*)(cw + 384 + 4 * hh);
#pragma unroll
            for (int i = 0; i < 4; ++i)
#pragma unroll
                for (int r2 = 0; r2 < 2; ++r2) { const int ii = 4 * hh + i; if (SKIP & 8) y[t][r2][ii] = x[r2 + 3][ii] + w0[i]; else y[t][r2][ii] = siluf((w0[i] * x[r2][ii] + w1[i] * x[r2 + 1][ii]) + (w2[i] * x[r2 + 2][ii] + w3[i] * x[r2 + 3][ii])); } }
        asm volatile("" ::: "memory"); }
    float rn[2][2];
#pragma unroll
    for (int t = 0; t < 2; ++t)
#pragma unroll
        for (int r2 = 0; r2 < 2; ++r2) { float s = 0.f;
#pragma unroll
            for (int i = 0; i < 8; ++i) s += y[t][r2][i] * y[t][r2][i];
            s += __shfl_xor(s, 1); s += __shfl_xor(s, 2); s += __shfl_xor(s, 4); s += __shfl_xor(s, 8);
            rn[t][r2] = __builtin_amdgcn_rsqf(s + EPS) * (t == 0 ? 0.08838834764831845f : 1.f); }
    if (tid < 256) SC[tid] = gate_rec;
    LDS_WAIT(); __builtin_amdgcn_s_barrier();
    PS_MARK(1);
    if (SKIP & 16) { asm volatile("" :: "v"(y[0][0][0]), "v"(y[1][1][7]), "v"(y[2][0][3]), "v"(rn[0][0]), "v"(rn[1][1])); } else
    { int c8 = 8 * ch8, r0 = 2 * rg; asm volatile("" : "+v"(c8), "+v"(r0));
      float be[2], eg[2], ek[2];
#pragma unroll
      for (int r2 = 0; r2 < 2; ++r2) { be[r2] = S_BETA[r0 + r2]; eg[r2] = S_EG[r0 + r2]; ek[r2] = S_EK[r0 + r2]; }
#pragma unroll
      for (int r2 = 0; r2 < 2; ++r2) { float q[8], k[8];
#pragma unroll
          for (int i = 0; i < 8; ++i) { q[i] = y[0][r2][i] * rn[0][r2]; k[i] = y[1][r2][i] * rn[1][r2]; }
          const int row = r0 + r2;
          *(LAS v4u*)(QB + row * 136 + c8) = (v4u){pk2(q[0], q[1]), pk2(q[2], q[3]), pk2(q[4], q[5]), pk2(q[6], q[7])};
          *(LAS v4u*)(KB + row * 136 + c8) = (v4u){pk2(k[0], k[1]), pk2(k[2], k[3]), pk2(k[4], k[5]), pk2(k[6], k[7])};
          if (!DRY) *(v4u*)(((bf16*)(F.ws + WS_U5)) + blk + row * 128 + c8) = (v4u){pk2(q[0] * eg[r2], q[1] * eg[r2]), pk2(q[2] * eg[r2], q[3] * eg[r2]), pk2(q[4] * eg[r2], q[5] * eg[r2]), pk2(q[6] * eg[r2], q[7] * eg[r2])};
#pragma unroll
          for (int i = 0; i < 8; ++i) {
              y[1][r2][i] = k[i] * be[r2] * eg[r2]; y[2][r2][i] = y[2][r2][i] * be[r2]; } }
#pragma unroll
      for (int i = 0; i < 8; ++i) {
          const int rs = (r0 + (c8 >> 1)) & 63;
          *(LAS f32x2*)(RHST + (c8 + i) * 68 + rs) = (f32x2){y[2][0][i], y[2][1][i]};
          *(LAS f32x2*)(RHST + (128 + c8 + i) * 68 + rs) = (f32x2){y[1][0][i], y[1][1][i]}; } }
    LDS_WAIT(); __builtin_amdgcn_s_barrier();
    PS_MARK(2);
    if (!(SKIP & 2)) { int l4 = lane; asm volatile("" : "+v"(l4)); const int ti = wave & 3, fr = l4 & 15, fq = l4 >> 4; const LAS bf16* Ab = (wave < 4 ? KB : QB) + (16 * ti + fr) * 136 + 8 * fq;
      s16x8 a[4];
#pragma unroll
      for (int s = 0; s < 4; ++s) a[s] = *(const LAS s16x8*)(Ab + 32 * s);
      LAS bf16* IL = (LAS bf16*)(F.lds + PR_IL);
#pragma unroll
      for (int tj = 0; tj < 4; ++tj) { if (wave < 4 && tj > ti) continue;
          f32x4 acc = (f32x4){0.f, 0.f, 0.f, 0.f}; const LAS bf16* Bb = KB + (16 * tj + fr) * 136 + 8 * fq;
#pragma unroll
          for (int s = 0; s < 4; ++s) { const s16x8 b = *(const LAS s16x8*)(Bb + 32 * s); acc = __builtin_amdgcn_mfma_f32_16x16x32_bf16(a[s], b, acc, 0, 0, 0); }
          const int j = 16 * tj + fr; const float gj = S_GC[j];
#pragma unroll
          for (int r = 0; r < 4; ++r) { const int i = 16 * ti + 4 * fq + r; const float dec = fexp(fminf(S_GC[i] - gj, 0.f));
              if (wave < 4) AM[i * 68 + j] = (i > j) ? -(S_BETA[i] * acc[r] * dec) : 0.f;
              else { const unsigned iv = f2bf((i >= j) ? acc[r] * dec : 0.f); IL[i * 72 + j] = (bf16)iv; } } }
      if (wave < 4) {
          LDS_WAIT(); asm volatile("" ::: "memory");
          const int j = l4 & 15; int zv = 0; asm volatile("" : "+v"(zv)); const LAS float* Ad = AM + zv + (16 * ti) * 68 + 16 * ti; float t[16];
          f32x4 ar[16][4];
#pragma unroll
          for (int i = 1; i < 16; ++i)
#pragma unroll
              for (int k4 = 0; k4 < (i + 3) / 4; ++k4) ar[i][k4] = *(const LAS f32x4*)(Ad + i * 68 + 4 * k4);
#pragma unroll
          for (int i = 0; i < 16; ++i) { float acc = (i == j) ? 1.f : 0.f;
#pragma unroll
              for (int k = 0; k < i; ++k) acc += ar[i][k >> 2][k & 3] * t[k];
              t[i] = acc; }
          if (l4 < 16) {
#pragma unroll
              for (int i = 0; i < 16; ++i) TB[(16 * ti + i) * 16 + j] = (bf16)f2bf(t[i]); } } }
    LDS_WAIT(); __builtin_amdgcn_s_barrier();
    PS_MARK(3);
    if (!(SKIP & 4)) { int l6 = lane; asm volatile("" : "+v"(l6)); const int n = l6 & 15, g = l6 >> 4; f32x4 R[4][2];
#pragma unroll
      for (int b = 0; b < 4; ++b)
#pragma unroll
          for (int nt = 0; nt < 2; ++nt) { const int col = 32 * wave + 16 * nt + n; R[b][nt] = *(const LAS f32x4*)(RHST + col * 68 + ((16 * b + 4 * g + 4 * ((col >> 3) & 15)) & 63)); }
      LDS_WAIT(); __builtin_amdgcn_s_barrier();
      const LAS bf16* tb = TB + n * 16 + 4 * g; const LAS float* am = AM + n * 68 + 4 * g;
#pragma unroll
      for (int b = 0; b < 4; ++b) {
          const u32x2 tw = *(const LAS u32x2*)(tb + (16 * b) * 16); const s16x8 ta = __builtin_bit_cast(s16x8, (v4u){tw.x, tw.y, 0u, 0u});
          s16x8 xb[2];
#pragma unroll
          for (int nt = 0; nt < 2; ++nt) { const s16x8 rb = __builtin_bit_cast(s16x8, (v4u){pk2(R[b][nt].x, R[b][nt].y), pk2(R[b][nt].z, R[b][nt].w), 0u, 0u});
              R[b][nt] = __builtin_amdgcn_mfma_f32_16x16x32_bf16(ta, rb, (f32x4){0.f, 0.f, 0.f, 0.f}, 0, 0, 0);
              xb[nt] = __builtin_bit_cast(s16x8, (v4u){pk2(R[b][nt].x, R[b][nt].y), pk2(R[b][nt].z, R[b][nt].w), 0u, 0u}); }
#pragma unroll
          for (int b2 = b + 1; b2 < 4; ++b2) { const f32x4 av = *(const LAS f32x4*)(am + (16 * b2) * 68 + 16 * b); const s16x8 aa = __builtin_bit_cast(s16x8, (v4u){pk2(av.x, av.y), pk2(av.z, av.w), 0u, 0u});
              R[b2][0] = __builtin_amdgcn_mfma_f32_16x16x32_bf16(aa, xb[0], R[b2][0], 0, 0, 0); R[b2][1] = __builtin_amdgcn_mfma_f32_16x16x32_bf16(aa, xb[1], R[b2][1], 0, 0, 0); } }
      if (wave < 4) { LAS bf16* UL = (LAS bf16*)(F.lds + PR_RHST) + (32 * wave + n) * 72 + 4 * g;
#pragma unroll
          for (int b = 0; b < 4; ++b)
#pragma unroll
              for (int nt = 0; nt < 2; ++nt) *(LAS u32x2*)(UL + nt * 16 * 72 + 16 * b) = (u32x2){pk2(R[b][nt].x, R[b][nt].y), pk2(R[b][nt].z, R[b][nt].w)}; }
      else { LAS bf16* WL = QB + (4 * g) * 136 + 32 * (wave - 4) + n;
#pragma unroll
          for (int b = 0; b < 4; ++b)
#pragma unroll
              for (int nt = 0; nt < 2; ++nt)
#pragma unroll
                  for (int r = 0; r < 4; ++r) WL[(16 * b + r) * 136 + 16 * nt] = (bf16)f2bf(-R[b][nt][r]); } }
    LDS_WAIT(); __builtin_amdgcn_s_barrier();
    PS_MARK(5);
    { int c9 = ch8, r9 = rg; asm volatile("" : "+v"(c9), "+v"(r9)); prep_fetch(F, it_next >= 0 ? it_next : cn * 8 + h, c9, r9, P); }
    if (!DRY) { int t5 = tid; asm volatile("" : "+v"(t5));
#pragma unroll
        for (int i = 0; i < 2; ++i) { const int id = t5 + 512 * i, row = id >> 4, q = id & 15; *(v4u*)(((bf16*)(F.ws + WS_U1)) + blk + row * 128 + 8 * q) = *(const LAS v4u*)(QB + row * 136 + 8 * q); }
        { const int row = t5 >> 3, q = t5 & 7; *(v4u*)(((bf16*)(F.ws + WS_INTRA)) + (size_t)(cn * 8 + h) * 4096 + row * 64 + 8 * q) = *(const LAS v4u*)((LAS bf16*)(F.lds + PR_IL) + row * 72 + 8 * q); }
#pragma unroll
        for (int i = 0; i < 2; ++i) { const int id = t5 + 512 * i, row = id >> 3, q = id & 7;
            *(v4u*)(((bf16*)(F.ws + WS_U3)) + blk + row * 64 + 8 * q) = *(const LAS v4u*)((LAS bf16*)(F.lds + PR_RHST) + row * 72 + 8 * q);
            float kv[8];
#pragma unroll
            for (int j = 0; j < 8; ++j) kv[j] = bf2f(KB[(8 * q + j) * 136 + row]) * S_EK[8 * q + j];
            *(v4u*)(((bf16*)(F.ws + WS_U2)) + blk + row * 64 + 8 * q) = (v4u){pk2(kv[0], kv[1]), pk2(kv[2], kv[3]), pk2(kv[4], kv[5]), pk2(kv[6], kv[7])}; } }
    PS_MARK(6);
    LDS_WAIT();
}
typedef float f32x16 __attribute__((ext_vector_type(16)));
constexpr int SW_KS = 0, SW_VT = 27648, SW_TB = 53248;
__device__ __forceinline__ int t5_bucket(int rel) { const int n = rel < 0 ? -rel : rel;
    const int b = n < 8 ? n : n < 12 ? 8 : n < 16 ? 9 : n < 23 ? 10 : n < 32 ? 11 : n < 46 ? 12 : n < 64 ? 13 : n < 91 ? 14 : 15; return (rel > 0 ? 16 : 0) + b; }
template <bool DRY> __device__ __forceinline__ void swa_unit(Frame& F, int cn, int kh) {
    const int tid = F.tid, lane = F.lane, wave = F.wave, r32 = lane & 31, hi = lane >> 5;
    LAS bf16* KS = (LAS bf16*)(F.lds + SW_KS); LAS bf16* VT = (LAS bf16*)(F.lds + SW_VT); LAS float* TB = (LAS float*)(F.lds + SW_TB);
    const bool smp = cn >= 256; const int b = cn - 256;
    const int head = kh * 8 + wave;
    bf16* Qg = ((bf16*)(F.ws + WS_U4)) + (size_t)(cn * 64) * D + head * 64;
    v4u kw[3], vw[3];
    if (smp) {
        f32x4 kf[2][2], vf[2][2];
#pragma unroll
        for (int it = 0; it < 2; ++it) { const int id = tid + 512 * it, row = id >> 3, dq = id & 7; const size_t so = ((size_t)(b * 128 + row) * 2 + kh) * 64 + dq * 8;
            kf[it][0] = *(const f32x4*)((F.in[4]) + so); kf[it][1] = *(const f32x4*)((F.in[4]) + so + 4); vf[it][0] = *(const f32x4*)((F.in[5]) + so); vf[it][1] = *(const f32x4*)((F.in[5]) + so + 4); }
        { const int id = tid + 1024, row = id >> 3, dq = id & 7; const bf16* src = ((bf16*)(F.ws + WS_KV)) + (size_t)(MP + b * 64 + row - 128) * 256 + kh * 64 + dq * 8; kw[2] = *(const v4u*)src; vw[2] = *(const v4u*)(src + 128); }
#pragma unroll
        for (int it = 0; it < 2; ++it) { const f32x4 k0 = kf[it][0], k1 = kf[it][1], v0 = vf[it][0], v1 = vf[it][1];
            kw[it] = (v4u){pk2(k0.x, k0.y), pk2(k0.z, k0.w), pk2(k1.x, k1.y), pk2(k1.z, k1.w)}; vw[it] = (v4u){pk2(v0.x, v0.y), pk2(v0.z, v0.w), pk2(v1.x, v1.y), pk2(v1.z, v1.w)}; }
        if (!DRY) { const int id = tid + 512, row = id >> 3, dq = id & 7;
            float* ok = F.out + OFF_SK + (size_t)b * 16384 + (size_t)(row - 64) * 128 + kh * 64 + dq * 8; float* ov = F.out + OFF_SV + (size_t)b * 16384 + (size_t)(row - 64) * 128 + kh * 64 + dq * 8;
            *(f32x4*)ok = kf[1][0]; *(f32x4*)(ok + 4) = kf[1][1]; *(f32x4*)ov = vf[1][0]; *(f32x4*)(ov + 4) = vf[1][1]; }
    } else {
#pragma unroll
        for (int it = 0; it < 3; ++it) { const int id = tid + 512 * it, row = id >> 3, dq = id & 7; const int kp = cn * 64 - 128 + row;
            const bf16* src = ((bf16*)(F.ws + WS_KV)) + (size_t)(kp >= 0 ? kp : 0) * 256 + kh * 64 + dq * 8; kw[it] = *(const v4u*)src; vw[it] = *(const v4u*)(src + 128); }
#pragma unroll
        for (int it = 0; it < 3; ++it) { const int row = (tid + 512 * it) >> 3; if (cn * 64 - 128 + row < 0) { kw[it] = (v4u){0u, 0u, 0u, 0u}; vw[it] = kw[it]; } }
    }
    float tbv[4];
#pragma unroll
    for (int i = 0; i < 4; ++i) { const int id = tid + 512 * i, hl = id >> 8, ix = id & 255; tbv[i] = (F.in[18])[t5_bucket(ix < 255 ? ix - 191 : 0) * 16 + kh * 8 + hl]; }
#pragma unroll
    for (int it = 0; it < 3; ++it) { const int id = tid + 512 * it, row = id >> 3, dq = id & 7;
        *(LAS v4u*)(KS + row * 72 + dq * 8) = kw[it];
        LAS bf16* vt = VT + (dq * 8) * 200 + (row ^ (dq << 2));
        vt[0] = (bf16)(vw[it].x & 0xffffu); vt[200] = (bf16)(vw[it].x >> 16); vt[400] = (bf16)(vw[it].y & 0xffffu); vt[600] = (bf16)(vw[it].y >> 16);
        vt[800] = (bf16)(vw[it].z & 0xffffu); vt[1000] = (bf16)(vw[it].z >> 16); vt[1200] = (bf16)(vw[it].w & 0xffffu); vt[1400] = (bf16)(vw[it].w >> 16); }
#pragma unroll
    for (int i = 0; i < 4; ++i) { const int id = tid + 512 * i; TB[id] = (id & 255) < 255 ? tbv[i] : 0.f; }
    __syncthreads();
    const float sink = (F.in[17])[head];
    const LAS float* tb = TB + wave * 256;
#pragma unroll 1
    for (int qt = 0; qt < 2; ++qt) {
        s16x8 qf[4];
#pragma unroll
        for (int s = 0; s < 4; ++s) qf[s] = *(const s16x8*)(Qg + (size_t)(32 * qt + r32) * D + 16 * s + 8 * hi);
        f32x16 P[6]; const int qi = 32 * qt + r32; float mx = -INFINITY;
#pragma unroll
        for (int kt = 0; kt < 6; ++kt) { f32x16 acc = {};
#pragma unroll
            for (int s = 0; s < 4; ++s) { const s16x8 a = *(const LAS s16x8*)(KS + (32 * kt + r32) * 72 + 16 * s + 8 * hi); acc = __builtin_amdgcn_mfma_f32_32x32x16_bf16(a, qf[s], acc, 0, 0, 0); }
#pragma unroll
            for (int r = 0; r < 16; ++r) { const int j = 32 * kt + (r & 3) + 8 * (r >> 2) + 4 * hi; float l = acc[r] * 0.125f + tb[j - qi + 63];
                if (!smp && cn * 64 + j < 128) l = -INFINITY; acc[r] = l; mx = fmaxf(mx, l); }
            P[kt] = acc; asm volatile("" ::: "memory"); }
        mx = fmaxf(mx, __shfl_xor(mx, 32)); mx = fmaxf(mx, sink);
        float sum = 0.f;
#pragma unroll
        for (int kt = 0; kt < 6; ++kt)
#pragma unroll
            for (int r = 0; r < 16; ++r) { const float p = fexp(P[kt][r] - mx); P[kt][r] = p; sum += p; }
        sum += __shfl_xor(sum, 32);
        const float inv = 1.f / (sum + fexp(sink - mx));
        f32x16 O[2]; O[0] = (f32x16){}; O[1] = (f32x16){};
        const LAS bf16* vsw[2][2][2];
#pragma unroll
        for (int dt = 0; dt < 2; ++dt)
#pragma unroll
            for (int s2 = 0; s2 < 2; ++s2)
#pragma unroll
                for (int h8 = 0; h8 < 2; ++h8) vsw[dt][s2][h8] = VT + (32 * dt + r32) * 200 + ((16 * s2 + 8 * h8 + 4 * hi) ^ ((4 * dt + (r32 >> 3)) << 2));
#pragma unroll
        for (int kt = 0; kt < 6; ++kt) {
#pragma unroll
            for (int s2 = 0; s2 < 2; ++s2) { v4u pw; pw.x = pk2(P[kt][8 * s2] * inv, P[kt][8 * s2 + 1] * inv); pw.y = pk2(P[kt][8 * s2 + 2] * inv, P[kt][8 * s2 + 3] * inv);
                pw.z = pk2(P[kt][8 * s2 + 4] * inv, P[kt][8 * s2 + 5] * inv); pw.w = pk2(P[kt][8 * s2 + 6] * inv, P[kt][8 * s2 + 7] * inv);
                const s16x8 pa = __builtin_bit_cast(s16x8, pw);
#pragma unroll
                for (int dt = 0; dt < 2; ++dt) {
                    const u32x2 lo = *(const LAS u32x2*)(vsw[dt][s2][0] + 32 * kt), hh = *(const LAS u32x2*)(vsw[dt][s2][1] + 32 * kt);
                    const s16x8 vb = __builtin_bit_cast(s16x8, (v4u){lo.x, lo.y, hh.x, hh.y});
                    O[dt] = __builtin_amdgcn_mfma_f32_32x32x16_bf16(pa, vb, O[dt], 0, 0, 0); } }
            asm volatile("" ::: "memory"); }
        { LAS bf16* OT = (LAS bf16*)(F.lds + 65536 + wave * 4608);
#pragma unroll
          for (int dt = 0; dt < 2; ++dt)
#pragma unroll
              for (int r = 0; r < 16; ++r) { const unsigned ov = f2bf(O[dt][r]); if (!DRY) OT[((r & 3) + 8 * (r >> 2) + 4 * hi) * 72 + 32 * dt + r32] = (bf16)ov; else asm volatile("" :: "v"(ov)); }
          asm volatile("s_waitcnt lgkmcnt(0)" ::: "memory");
          if (!DRY) {
#pragma unroll
              for (int i = 0; i < 4; ++i) { const int row = 8 * i + (lane >> 3), c8 = lane & 7; const v4u v = *(const LAS v4u*)(OT + row * 72 + 8 * c8); *(v4u*)(Qg + (size_t)(32 * qt + row) * D + 8 * c8) = v; } }
          asm volatile("s_waitcnt lgkmcnt(0)" ::: "memory"); }
    }
    __syncthreads();
}
constexpr int SC_WN = 0, SC_QP = 16384, SC_KPT = 32768, SC_IN = 49152, SC_STAGE = 57344;
template <int C, int NCHUNK> __device__ __forceinline__ void tile_rq(int lt, int i, int& row, int& q) {
    const int l = lt & 63, lw = lt >> 6, grp = l >> 4, s = NCHUNK * lw + i;
    const int rb = (C == 128) ? (s >> 1) : s, qb = (C == 128) ? 8 * (s & 1) : 0;
    row = 8 * rb + (l & 7); q = qb + 4 * (grp >> 1) + (grp & 1) + 2 * ((l >> 3) & 1);
}
template <int C, int NCHUNK> __device__ __forceinline__ void ld_tile(const bf16* src, int lt, v4u (&reg)[NCHUNK]) {
#pragma unroll
    for (int i = 0; i < NCHUNK; ++i) { int row, q; tile_rq<C, NCHUNK>(lt, i, row, q); reg[i] = *(const v4u*)(src + (size_t)row * C + 8 * q); }
}
template <int C, int NCHUNK> __device__ __forceinline__ void st_tile(LAS unsigned char* base, int lt, const v4u (&reg)[NCHUNK]) {
#pragma unroll
    for (int i = 0; i < NCHUNK; ++i) { int row, q; tile_rq<C, NCHUNK>(lt, i, row, q); const int ks = q >> 2, qq = q & 3;
        LAS unsigned char* d0 = base + ((row >> 4) * (C / 32) + ks) * 1024 + ((2 * (qq & 1)) * 16 + (row & 15)) * 16 + (qq >> 1) * 8;
        *(LAS u32x2*)d0 = (u32x2){reg[i].x, reg[i].y}; *(LAS u32x2*)(d0 + 256) = (u32x2){reg[i].z, reg[i].w}; }
}
__device__ __forceinline__ s16x8 pack_b(f32x4 a, f32x4 b) { v4u w; w.x = pk2(a.x, a.y); w.y = pk2(a.z, a.w); w.z = pk2(b.x, b.y); w.w = pk2(b.z, b.w); return __builtin_bit_cast(s16x8, w); }
#define MF16(a, b, c) __builtin_amdgcn_mfma_f32_16x16x32_bf16(a, b, c, 0, 0, 0)
template <bool DRY, int SKIP = 0> __device__ __forceinline__ void scan_task(Frame& F, int cn0, int nchunk, int h, int hf, const float* s0, float* sout, bool write_s) {
    const int lane = F.lane, wave = F.wave, e = lane & 15, g = lane >> 4;
    LAS unsigned char* ring = F.lds;
    if (wave >= 4) {
#ifndef SCAN_NO_LOADER
        const int lt = F.tid - 256; v4u rw[4], rq[4], rk[4], ri[2], sw[4], sq[4], sk[4], si[2];
#define LD_SET(cn, W, Q, K, I) do { const size_t blk_ = (size_t)((cn) * 8 + h) * 8192; ld_tile<128, 4>(((bf16*)(F.ws + WS_U1)) + blk_, lt, W); ld_tile<128, 4>(((bf16*)(F.ws + WS_U5)) + blk_, lt, Q); ld_tile<64, 4>(((bf16*)(F.ws + WS_U2)) + blk_, lt, K); ld_tile<64, 2>(((bf16*)(F.ws + WS_INTRA)) + (size_t)((cn) * 8 + h) * 4096, lt, I); } while (0)
#define ST_SET(st, W, Q, K, I) do { LAS unsigned char* b_ = ring + (st) * SC_STAGE; st_tile<128, 4>(b_ + SC_WN, lt, W); st_tile<128, 4>(b_ + SC_QP, lt, Q); st_tile<64, 4>(b_ + SC_KPT, lt, K); st_tile<64, 2>(b_ + SC_IN, lt, I); } while (0)
        if (!(SKIP & 1)) { LD_SET(cn0, rw, rq, rk, ri); ST_SET(0, rw, rq, rk, ri); if (nchunk > 1) LD_SET(cn0 + 1, sw, sq, sk, si); if (nchunk > 2) LD_SET(cn0 + 2, rw, rq, rk, ri); }
        LDS_WAIT(); __builtin_amdgcn_s_barrier();
#pragma unroll 1
        for (int n = 0; n < nchunk; ++n) {
            if (n + 1 < nchunk && !(SKIP & 1)) {
                if (n & 1) { ST_SET(0, rw, rq, rk, ri); if (n + 3 < nchunk) LD_SET(cn0 + n + 3, rw, rq, rk, ri); }
                else { ST_SET(1, sw, sq, sk, si); if (n + 3 < nchunk) LD_SET(cn0 + n + 3, sw, sq, sk, si); } }
            LDS_WAIT(); __builtin_amdgcn_s_barrier();
        }
#undef LD_SET
#undef ST_SET
#endif
    } else {
#ifndef SCAN_NO_SCAN
        const int e0 = 64 * hf + 16 * wave + e;
        f32x4 S[8];
#pragma unroll
        for (int dt = 0; dt < 8; ++dt) { const float* p = (const float*)((const char*)s0 + (size_t)((unsigned)((16 * dt + 4 * g) * 128 + e0) * 4u)); S[dt] = (f32x4){p[0], p[128], p[256], p[384]}; }
        u32x2 ucur[4], unext[4];
        { const bf16* up = ((bf16*)(F.ws + WS_U3)) + ((size_t)(cn0 * 8 + h) * 128 + e0) * 64 + 4 * g;
#pragma unroll
          for (int mt = 0; mt < 4; ++mt) ucur[mt] = *(const u32x2*)(up + 16 * mt); }
        __builtin_amdgcn_s_barrier();
#pragma unroll 1
        for (int n = 0; n < nchunk; ++n) {
            const int cn = cn0 + n; const LAS unsigned char* st = ring + (n & 1) * SC_STAGE + lane * 16;
            const float gl = ((float*)(F.ws + WS_GL))[cn * 8 + h];
            bf16* op = ((bf16*)(F.ws + WS_U3)) + ((size_t)(cn * 8 + h) * 128 + e0) * 64 + 4 * g;
            if (n + 1 < nchunk) {
#pragma unroll
                for (int mt = 0; mt < 4; ++mt) unext[mt] = *(const u32x2*)(op + 8 * 128 * 64 + 16 * mt); }
            if (SKIP & 2) { LDS_WAIT(); __builtin_amdgcn_s_barrier(); continue; }
            s16x8 Sb[4];
#pragma unroll
            for (int ks = 0; ks < 4; ++ks) Sb[ks] = pack_b(S[2 * ks], S[2 * ks + 1]);
            f32x4 Vn[4], O[4];
#pragma unroll
            for (int mt = 0; mt < 4; ++mt) { Vn[mt] = (f32x4){bflo(ucur[mt].x), bfhi(ucur[mt].x), bflo(ucur[mt].y), bfhi(ucur[mt].y)}; O[mt] = (f32x4){0.f, 0.f, 0.f, 0.f}; }
            s16x8 fa[8], fb[8];
#define FENCE() asm volatile("" ::: "memory")
#define LD_WQ(dst, mt) do { _Pragma("unroll") for (int ks = 0; ks < 4; ++ks) { dst[ks] = *(const LAS s16x8*)(st + SC_WN + ((mt) * 4 + ks) * 1024); dst[4 + ks] = *(const LAS s16x8*)(st + SC_QP + ((mt) * 4 + ks) * 1024); } } while (0)
#define MM_WQ(src, mt) do { _Pragma("unroll") for (int ks = 0; ks < 4; ++ks) { Vn[mt] = MF16(src[ks], Sb[ks], Vn[mt]); O[mt] = MF16(src[4 + ks], Sb[ks], O[mt]); } } while (0)
#define LD_4(dst, off, a) do { _Pragma("unroll") for (int i_ = 0; i_ < 4; ++i_) dst[i_] = *(const LAS s16x8*)(st + (off) + ((a) * 4 + i_) * 1024); } while (0)
#define MM_IN(src, mp) do { O[2 * (mp)] = MF16(src[0], Vb[0], O[2 * (mp)]); O[2 * (mp)] = MF16(src[1], Vb[1], O[2 * (mp)]); O[2 * (mp) + 1] = MF16(src[2], Vb[0], O[2 * (mp) + 1]); O[2 * (mp) + 1] = MF16(src[3], Vb[1], O[2 * (mp) + 1]); } while (0)
#define MM_KP(src, dp) do { S[2 * (dp)] = MF16(src[0], Vb[0], S[2 * (dp)]); S[2 * (dp)] = MF16(src[1], Vb[1], S[2 * (dp)]); S[2 * (dp) + 1] = MF16(src[2], Vb[0], S[2 * (dp) + 1]); S[2 * (dp) + 1] = MF16(src[3], Vb[1], S[2 * (dp) + 1]); } while (0)
            LD_WQ(fa, 0); FENCE(); LD_WQ(fb, 1); MM_WQ(fa, 0); FENCE(); LD_WQ(fa, 2); MM_WQ(fb, 1); FENCE(); LD_WQ(fb, 3); MM_WQ(fa, 2); FENCE(); LD_4(fa, SC_IN, 0); MM_WQ(fb, 3); FENCE();
#pragma unroll
            for (int dt = 0; dt < 8; ++dt) S[dt] = S[dt] * gl;
            s16x8 Vb[2];
#pragma unroll
            for (int k2 = 0; k2 < 2; ++k2) Vb[k2] = pack_b(Vn[2 * k2], Vn[2 * k2 + 1]);
            LD_4(fb, SC_IN, 1); MM_IN(fa, 0); FENCE(); LD_4(fa, SC_KPT, 0); MM_IN(fb, 1); FENCE(); LD_4(fb, SC_KPT, 1); MM_KP(fa, 0); FENCE(); LD_4(fa, SC_KPT, 2); MM_KP(fb, 1); FENCE(); LD_4(fb, SC_KPT, 3); MM_KP(fa, 2); FENCE(); MM_KP(fb, 3);
#undef FENCE
#undef LD_WQ
#undef MM_WQ
#undef LD_4
#undef MM_IN
#undef MM_KP
#pragma unroll
            for (int mt = 0; mt < 4; ++mt) { u32x2 w; w.x = pk2(O[mt].x, O[mt].y); w.y = pk2(O[mt].z, O[mt].w); if (!DRY) *(u32x2*)(op + 16 * mt) = w; else asm volatile("" :: "v"(w.x), "v"(w.y)); ucur[mt] = unext[mt]; }
            LDS_WAIT(); __builtin_amdgcn_s_barrier();
        }
        { unsigned so = (unsigned)((4 * g) * 128 + e0) * 4u; asm volatile("" : "+v"(so));
#pragma unroll
          for (int dt = 0; dt < 8; ++dt) { float* p = (float*)((char*)sout + (size_t)(so + dt * 8192u)); if (!DRY && write_s) { p[0] = S[dt].x; p[128] = S[dt].y; p[256] = S[dt].z; p[384] = S[dt].w; } else asm volatile("" :: "v"(S[dt].x), "v"(S[dt].y), "v"(S[dt].z), "v"(S[dt].w)); } }
#endif
    }
}

__device__ __forceinline__ void scan_chunk(const LAS unsigned char* st, float gl, f32x4 (&S)[8], const u32x2 (&U)[4], bf16* op) {
    s16x8 Sb[4];
#pragma unroll
    for (int ks = 0; ks < 4; ++ks) Sb[ks] = pack_b(S[2 * ks], S[2 * ks + 1]);
    f32x4 Vn[4], O[4];
#pragma unroll
    for (int mt = 0; mt < 4; ++mt) { Vn[mt] = (f32x4){bflo(U[mt].x), bfhi(U[mt].x), bflo(U[mt].y), bfhi(U[mt].y)}; O[mt] = (f32x4){0.f, 0.f, 0.f, 0.f}; }
    s16x8 fa[8], fb[8];
#define FENCE() asm volatile("" ::: "memory")
#define LD_WQ(dst, mt) do { _Pragma("unroll") for (int ks = 0; ks < 4; ++ks) { dst[ks] = *(const LAS s16x8*)(st + SC_WN + ((mt) * 4 + ks) * 1024); dst[4 + ks] = *(const LAS s16x8*)(st + SC_QP + ((mt) * 4 + ks) * 1024); } } while (0)
#define MM_WQ(src, mt) do { _Pragma("unroll") for (int ks = 0; ks < 4; ++ks) { Vn[mt] = MF16(src[ks], Sb[ks], Vn[mt]); O[mt] = MF16(src[4 + ks], Sb[ks], O[mt]); } } while (0)
#define LD_4(dst, off, a) do { _Pragma("unroll") for (int i_ = 0; i_ < 4; ++i_) dst[i_] = *(const LAS s16x8*)(st + (off) + ((a) * 4 + i_) * 1024); } while (0)
#define MM_IN(src, mp) do { O[2 * (mp)] = MF16(src[0], Vb[0], O[2 * (mp)]); O[2 * (mp)] = MF16(src[1], Vb[1], O[2 * (mp)]); O[2 * (mp) + 1] = MF16(src[2], Vb[0], O[2 * (mp) + 1]); O[2 * (mp) + 1] = MF16(src[3], Vb[1], O[2 * (mp) + 1]); } while (0)
#define MM_KP(src, dp) do { S[2 * (dp)] = MF16(src[0], Vb[0], S[2 * (dp)]); S[2 * (dp)] = MF16(src[1], Vb[1], S[2 * (dp)]); S[2 * (dp) + 1] = MF16(src[2], Vb[0], S[2 * (dp) + 1]); S[2 * (dp) + 1] = MF16(src[3], Vb[1], S[2 * (dp) + 1]); } while (0)
    LD_WQ(fa, 0); FENCE(); LD_WQ(fb, 1); MM_WQ(fa, 0); FENCE(); LD_WQ(fa, 2); MM_WQ(fb, 1); FENCE(); LD_WQ(fb, 3); MM_WQ(fa, 2); FENCE(); LD_4(fa, SC_IN, 0); MM_WQ(fb, 3); FENCE();
#pragma unroll
    for (int dt = 0; dt < 8; ++dt) S[dt] = S[dt] * gl;
    s16x8 Vb[2];
#pragma unroll
    for (int k2 = 0; k2 < 2; ++k2) Vb[k2] = pack_b(Vn[2 * k2], Vn[2 * k2 + 1]);
    LD_4(fb, SC_IN, 1); MM_IN(fa, 0); FENCE(); LD_4(fa, SC_KPT, 0); MM_IN(fb, 1); FENCE(); LD_4(fb, SC_KPT, 1); MM_KP(fa, 0); FENCE(); LD_4(fa, SC_KPT, 2); MM_KP(fb, 1); FENCE(); LD_4(fb, SC_KPT, 3); MM_KP(fa, 2); FENCE(); MM_KP(fb, 3);
#undef FENCE
#undef LD_WQ
#undef MM_WQ
#undef LD_4
#undef MM_IN
#undef MM_KP
#pragma unroll
    for (int mt = 0; mt < 4; ++mt) { u32x2 w; w.x = pk2(O[mt].x, O[mt].y); w.y = pk2(O[mt].z, O[mt].w); *(u32x2*)(op + 16 * mt) = w; }
}
__device__ __forceinline__ void scan_sample_pair(Frame& F, int tA, int tB) {
    const int lane = F.lane, wave = F.wave, e = lane & 15, g = lane >> 4;
    LAS unsigned char* ring = F.lds;
    const int bA = tA >> 4, hA = tA & 7, fA = (tA >> 3) & 1, cnA = 256 + bA, bB = tB >> 4, hB = tB & 7, fB = (tB >> 3) & 1, cnB = 256 + bB;
    if (wave >= 4) {
        const int lt = F.tid - 256; v4u rw[4], rq[4], rk[4], ri[2], sw[4], sq[4], sk[4], si[2];
#define LD_P(cn, h, W, Q, K, I) do { const size_t blk_ = (size_t)((cn) * 8 + (h)) * 8192; ld_tile<128, 4>(((bf16*)(F.ws + WS_U1)) + blk_, lt, W); ld_tile<128, 4>(((bf16*)(F.ws + WS_U5)) + blk_, lt, Q); ld_tile<64, 4>(((bf16*)(F.ws + WS_U2)) + blk_, lt, K); ld_tile<64, 2>(((bf16*)(F.ws + WS_INTRA)) + (size_t)((cn) * 8 + (h)) * 4096, lt, I); } while (0)
#define ST_P(st, W, Q, K, I) do { LAS unsigned char* b_ = ring + (st) * SC_STAGE; st_tile<128, 4>(b_ + SC_WN, lt, W); st_tile<128, 4>(b_ + SC_QP, lt, Q); st_tile<64, 4>(b_ + SC_KPT, lt, K); st_tile<64, 2>(b_ + SC_IN, lt, I); } while (0)
        LD_P(cnA, hA, rw, rq, rk, ri); LD_P(cnB, hB, sw, sq, sk, si);
        ST_P(0, rw, rq, rk, ri); ST_P(1, sw, sq, sk, si);
        LDS_WAIT(); __builtin_amdgcn_s_barrier();
        __builtin_amdgcn_s_barrier();
#undef LD_P
#undef ST_P
    } else {
        const int eA = 64 * fA + 16 * wave + e, eB = 64 * fB + 16 * wave + e;
        const float* sA = ((const float*)(F.in[3])) + (size_t)(bA * 8 + hA) * 16384 + (4 * g) * 128 + eA; const float* sB = ((const float*)(F.in[3])) + (size_t)(bB * 8 + hB) * 16384 + (4 * g) * 128 + eB;
        bf16* opA = ((bf16*)(F.ws + WS_U3)) + ((size_t)(cnA * 8 + hA) * 128 + eA) * 64 + 4 * g; bf16* opB = ((bf16*)(F.ws + WS_U3)) + ((size_t)(cnB * 8 + hB) * 128 + eB) * 64 + 4 * g;
        f32x4 SA[8], SB[8]; u32x2 uA[4], uB[4];
#pragma unroll
        for (int dt = 0; dt < 8; ++dt) { const float* p = sA + dt * 2048; SA[dt] = (f32x4){p[0], p[128], p[256], p[384]}; }
#pragma unroll
        for (int mt = 0; mt < 4; ++mt) uA[mt] = *(const u32x2*)(opA + 16 * mt);
#pragma unroll
        for (int dt = 0; dt < 8; ++dt) { const float* p = sB + dt * 2048; SB[dt] = (f32x4){p[0], p[128], p[256], p[384]}; }
#pragma unroll
        for (int mt = 0; mt < 4; ++mt) uB[mt] = *(const u32x2*)(opB + 16 * mt);
        const float glA = ((float*)(F.ws + WS_GL))[cnA * 8 + hA], glB = ((float*)(F.ws + WS_GL))[cnB * 8 + hB];
        __builtin_amdgcn_s_barrier();
        scan_chunk(ring + lane * 16, glA, SA, uA, opA);
        { float* q = F.out + OFF_SS + (size_t)(bA * 8 + hA) * 16384 + (4 * g) * 128 + eA;
#pragma unroll
          for (int dt = 0; dt < 8; ++dt) { float* p = q + dt * 2048; p[0] = SA[dt].x; p[128] = SA[dt].y; p[256] = SA[dt].z; p[384] = SA[dt].w; } }
        scan_chunk(ring + SC_STAGE + lane * 16, glB, SB, uB, opB);
        { float* q = F.out + OFF_SS + (size_t)(bB * 8 + hB) * 16384 + (4 * g) * 128 + eB;
#pragma unroll
          for (int dt = 0; dt < 8; ++dt) { float* p = q + dt * 2048; p[0] = SB[dt].x; p[128] = SB[dt].y; p[256] = SB[dt].z; p[384] = SB[dt].w; } }
        LDS_WAIT(); __builtin_amdgcn_s_barrier();
    }
}
__device__ __forceinline__ void scanA_step(Frame& F, int n, int cn, int last, int h, int e0, int g, f32x4 (&S)[8], f32x4 (&X)[8], u32x2 (&U)[4]) {
    const LAS unsigned char* st = F.lds + (n & 1) * SC_STAGE + F.lane * 16;
    const float gl = ((float*)(F.ws + WS_GL))[cn * 8 + h];
    f32x4 Vn[4], Vx[4];
#pragma unroll
    for (int mt = 0; mt < 4; ++mt) { Vn[mt] = (f32x4){bflo(U[mt].x), bfhi(U[mt].x), bflo(U[mt].y), bfhi(U[mt].y)}; Vx[mt] = (f32x4){0.f, 0.f, 0.f, 0.f}; }
    { const int cf = cn + 2 < last ? cn + 2 : last; const bf16* up = ((bf16*)(F.ws + WS_U3)) + ((size_t)(cf * 8 + h) * 128 + e0) * 64 + 4 * g;
#pragma unroll
      for (int mt = 0; mt < 4; ++mt) U[mt] = *(const u32x2*)(up + 16 * mt); }
    s16x8 Sb[4], Xb[4];
#pragma unroll
    for (int ks = 0; ks < 4; ++ks) { Sb[ks] = pack_b(S[2 * ks], S[2 * ks + 1]); Xb[ks] = pack_b(X[2 * ks], X[2 * ks + 1]); }
#pragma unroll
    for (int mt = 0; mt < 4; ++mt)
#pragma unroll
        for (int ks = 0; ks < 4; ++ks) { const s16x8 aw = *(const LAS s16x8*)(st + SC_WN + (mt * 4 + ks) * 1024);
            Vn[mt] = MF16(aw, Sb[ks], Vn[mt]); Vx[mt] = MF16(aw, Xb[ks], Vx[mt]); if (ks == 3) asm volatile("" ::: "memory"); }
#pragma unroll
    for (int dt = 0; dt < 8; ++dt) { S[dt] = S[dt] * gl; X[dt] = X[dt] * gl; }
    s16x8 Vb[2], Wb[2];
#pragma unroll
    for (int k2 = 0; k2 < 2; ++k2) { Vb[k2] = pack_b(Vn[2 * k2], Vn[2 * k2 + 1]); Wb[k2] = pack_b(Vx[2 * k2], Vx[2 * k2 + 1]); }
#pragma unroll
    for (int dt = 0; dt < 8; ++dt)
#pragma unroll
        for (int k2 = 0; k2 < 2; ++k2) { const s16x8 ak = *(const LAS s16x8*)(st + SC_KPT + (dt * 2 + k2) * 1024); S[dt] = MF16(ak, Vb[k2], S[dt]); X[dt] = MF16(ak, Wb[k2], X[dt]); if (k2 == 1 && (dt & 1)) asm volatile("" ::: "memory"); }
    LDS_WAIT(); __builtin_amdgcn_s_barrier();
}
__device__ __forceinline__ void scanA_task(Frame& F, int cn0, int nchunk, int h, int hf, float* sout, bf16* mout) {
    const int lane = F.lane, wave = F.wave, e = lane & 15, g = lane >> 4;
    LAS unsigned char* ring = F.lds; const int last = cn0 + nchunk - 1;
    if (wave >= 4) {
        const int lt = F.tid - 256; v4u rw[4], rk[4], sw[4], sk[4];
#define LD_A(cn, W, K) do { const int c_ = (cn) < last ? (cn) : last; const size_t blk_ = (size_t)(c_ * 8 + h) * 8192; ld_tile<128, 4>(((bf16*)(F.ws + WS_U1)) + blk_, lt, W); ld_tile<64, 4>(((bf16*)(F.ws + WS_U2)) + blk_, lt, K); } while (0)
#define ST_A(st, W, K) do { LAS unsigned char* b_ = ring + (st) * SC_STAGE; st_tile<128, 4>(b_ + SC_WN, lt, W); st_tile<64, 4>(b_ + SC_KPT, lt, K); } while (0)
        LD_A(cn0, rw, rk); ST_A(0, rw, rk); LD_A(cn0 + 1, sw, sk); LD_A(cn0 + 2, rw, rk);
        LDS_WAIT(); __builtin_amdgcn_s_barrier();
#pragma unroll 1
        for (int n = 0; n < nchunk; n += 2) {
            ST_A(1, sw, sk); LD_A(cn0 + n + 3, sw, sk); LDS_WAIT(); __builtin_amdgcn_s_barrier();
            ST_A(0, rw, rk); LD_A(cn0 + n + 4, rw, rk); LDS_WAIT(); __builtin_amdgcn_s_barrier();
        }
#undef LD_A
#undef ST_A
    } else {
        const int e0 = 64 * hf + 16 * wave + e;
        f32x4 S[8], X[8];
#pragma unroll
        for (int dt = 0; dt < 8; ++dt) { S[dt] = (f32x4){0.f, 0.f, 0.f, 0.f}; const int d0 = 16 * dt + 4 * g;
            X[dt] = (f32x4){d0 == e0 ? 1.f : 0.f, d0 + 1 == e0 ? 1.f : 0.f, d0 + 2 == e0 ? 1.f : 0.f, d0 + 3 == e0 ? 1.f : 0.f}; }
        u32x2 ua[4], ub[4];
        { const bf16* up = ((bf16*)(F.ws + WS_U3)) + ((size_t)(cn0 * 8 + h) * 128 + e0) * 64 + 4 * g;
#pragma unroll
          for (int mt = 0; mt < 4; ++mt) ua[mt] = *(const u32x2*)(up + 16 * mt);
#pragma unroll
          for (int mt = 0; mt < 4; ++mt) ub[mt] = *(const u32x2*)(up + 8 * 128 * 64 + 16 * mt); }
        __builtin_amdgcn_s_barrier();
#pragma unroll 1
        for (int n = 0; n < nchunk; n += 2) { scanA_step(F, n, cn0 + n, last, h, e0, g, S, X, ua); scanA_step(F, n + 1, cn0 + n + 1, last, h, e0, g, S, X, ub); }
        { unsigned so = (unsigned)((4 * g) * 128 + e0); asm volatile("" : "+v"(so));
#pragma unroll
          for (int dt = 0; dt < 8; ++dt) { float* p = sout + so + dt * 2048u; p[0] = S[dt].x; p[128] = S[dt].y; p[256] = S[dt].z; p[384] = S[dt].w;
              bf16* q = mout + so + dt * 2048u; q[0] = (bf16)f2bf(X[dt].x); q[128] = (bf16)f2bf(X[dt].y); q[256] = (bf16)f2bf(X[dt].z); q[384] = (bf16)f2bf(X[dt].w); } }
    }
}
template <int NGR, int N, int FL> __device__ __forceinline__ void scanB_step(Frame& F, int h, int cb, int rq, size_t roff, const bf16* MG, const float* SG, v4u (&rm)[3][4], f32x4 (&Bq)[3][2], f32x4 (&So)[FL][2]) {
    constexpr int J = N % 3, n = N;
    LAS unsigned char* ring = F.lds; LAS unsigned char* XB = ring + 2 * SC_STAGE; const int lane = F.lane;
    const LAS unsigned char* st = ring + (n & 1) * SC_STAGE + lane * 16;
    const LAS unsigned char* xr = XB + (((n & 1) * 2 + cb) * 4) * 1024 + lane * 16;
    s16x8 Sb[4];
#pragma unroll
    for (int ks = 0; ks < 4; ++ks) Sb[ks] = *(const LAS s16x8*)(xr + ks * 1024);
#pragma unroll
    for (int dt = 0; dt < 2; ++dt) { f32x4 acc = Bq[J][dt];
#pragma unroll
        for (int ks = 0; ks < 4; ++ks) { const s16x8 am = *(const LAS s16x8*)(st + ((2 * rq + dt) * 4 + ks) * 1024); acc = MF16(am, Sb[ks], acc); }
        So[N % FL][dt] = acc; }
    *(LAS s16x8*)(XB + (((((n + 1) & 1) * 2 + cb) * 4) + rq) * 1024 + lane * 16) = pack_b(So[N % FL][0], So[N % FL][1]);
    st_tile<128, 4>(ring + ((n + 1) & 1) * SC_STAGE, F.tid, rm[(J + 1) % 3]);
    { constexpr int nm = n + 4 < NGR ? n + 4 : NGR - 1; ld_tile<128, 4>(MG + (size_t)(nm * 8 + h) * 16384, F.tid, rm[(J + 1) % 3]); }
    { constexpr int nb = n + 3 < NGR ? n + 3 : NGR - 1; const float* bq = SG + (size_t)(nb * 8 + h) * 16384 + roff;
#pragma unroll
      for (int dt = 0; dt < 2; ++dt) { const float* p = bq + dt * 2048; Bq[J][dt] = (f32x4){p[0], p[128], p[256], p[384]}; } }
    LDS_WAIT(); __builtin_amdgcn_s_barrier();
}
template <int FL> __device__ __forceinline__ void scanB_flush(int n_first, int count, int h, size_t roff, float* SG, const f32x4 (&So)[FL][2]) {
#pragma unroll
    for (int i = 0; i < FL; ++i) if (i < count) { float* bp = SG + (size_t)((n_first + i) * 8 + h) * 16384 + roff;
#pragma unroll
        for (int dt = 0; dt < 2; ++dt) { float* p = bp + dt * 2048; p[0] = So[i][dt].x; p[128] = So[i][dt].y; p[256] = So[i][dt].z; p[384] = So[i][dt].w; } }
}
template <int NGR> __device__ __forceinline__ void scanB_task(Frame& F, int h, int cq, const bf16* MG, float* SG) {
    static_assert(NGR == 15, "pass B is written out for 15 steps");
    constexpr int FL = 8;
    const int lane = F.lane, e = lane & 15, g4 = lane >> 4, cb = F.wave & 1, rq = F.wave >> 1;
    LAS unsigned char* ring = F.lds; LAS unsigned char* XB = ring + 2 * SC_STAGE;
    const int e0 = 32 * cq + 16 * cb + e; const size_t roff = (size_t)(32 * rq + 4 * g4) * 128 + e0;
    v4u rm[3][4]; f32x4 Bq[3][2], So[FL][2];
    ld_tile<128, 4>(MG + (size_t)h * 16384, F.tid, rm[0]); st_tile<128, 4>(ring, F.tid, rm[0]);
    ld_tile<128, 4>(MG + (size_t)(1 * 8 + h) * 16384, F.tid, rm[1]);
    ld_tile<128, 4>(MG + (size_t)(2 * 8 + h) * 16384, F.tid, rm[2]);
    ld_tile<128, 4>(MG + (size_t)(3 * 8 + h) * 16384, F.tid, rm[0]);
#pragma unroll
    for (int q = 0; q < 3; ++q) { const float* bp0 = SG + (size_t)(q * 8 + h) * 16384 + roff;
#pragma unroll
        for (int dt = 0; dt < 2; ++dt) { const float* p = bp0 + dt * 2048; Bq[q][dt] = (f32x4){p[0], p[128], p[256], p[384]}; } }
    *(LAS v4u*)(XB + (cb * 4 + rq) * 1024 + lane * 16) = (v4u){0u, 0u, 0u, 0u};
    LDS_WAIT(); __builtin_amdgcn_s_barrier();
#define SB_STEP(N) scanB_step<NGR, N, FL>(F, h, cb, rq, roff, MG, SG, rm, Bq, So)
#if defined(PROBE_SB)
    const unsigned long long tq0 = __builtin_amdgcn_s_memrealtime();
#endif
    SB_STEP(0); SB_STEP(1); SB_STEP(2); SB_STEP(3); SB_STEP(4); SB_STEP(5); SB_STEP(6); SB_STEP(7);
#if defined(PROBE_SB)
    if (blockIdx.x == 0 && F.tid == 0) ((volatile LAS unsigned long long*)(F.lds + LDSCTL_OFF + 768))[13] = __builtin_amdgcn_s_memrealtime() - tq0;
#endif
    scanB_flush<FL>(0, 8, h, roff, SG, So);
    SB_STEP(8); SB_STEP(9); SB_STEP(10); SB_STEP(11); SB_STEP(12); SB_STEP(13); SB_STEP(14);
    scanB_flush<FL>(8, 7, h, roff, SG, So);
#undef SB_STEP
}
#undef MF16
constexpr int SCAN_NG = 16, SCAN_GC = 16;
constexpr size_t WS_MG = 242 * MiB, WS_SG = 246 * MiB;
__device__ __forceinline__ void scanA_phase(Frame& F) {
    const int bx = blockIdx.x; bf16* MG = (bf16*)(F.ws + WS_MG); float* SG = (float*)(F.ws + WS_SG);
    if (bx < (SCAN_NG - 1) * 16) { const int gq = bx >> 4, h = bx & 7, hf = (bx >> 3) & 1;
#if defined(PROBE_PQ)
        const unsigned long long ta0 = __builtin_amdgcn_s_memrealtime();
#endif
        scanA_task(F, gq * SCAN_GC, SCAN_GC, h, hf, SG + (size_t)(gq * 8 + h) * 16384, MG + (size_t)(gq * 8 + h) * 16384);
#if defined(PROBE_PQ)
        if (bx == 0 && F.tid == 0) ((volatile LAS unsigned long long*)(F.lds + LDSCTL_OFF + 768))[10] = __builtin_amdgcn_s_memrealtime() - ta0;
#endif
    }
    if (F.G == 256) { const int t = (bx + 16) % 256; scan_sample_pair(F, t, t + 256); }
    else for (int t = (bx + 16) % F.G; t < 512; t += F.G) { const int b = t >> 4, h = t & 7, hf = (t >> 3) & 1;
        scan_task<false>(F, 256 + b, 1, h, hf, ((const float*)(F.in[3])) + (size_t)(b * 8 + h) * 16384, F.out + OFF_SS + (size_t)(b * 8 + h) * 16384, true); }
}
constexpr int SCANB_WGS = 32;
__device__ __forceinline__ void scanB_phase(Frame& F) { const int bx = blockIdx.x;
#if defined(PROBE_SB)
    const unsigned long long tsb0 = __builtin_amdgcn_s_memrealtime();
#endif
    for (int t = bx; t < SCANB_WGS; t += F.G) { scanB_task<SCAN_NG - 1>(F, t & 7, t >> 3, (const bf16*)(F.ws + WS_MG), (float*)(F.ws + WS_SG)); __syncthreads(); }
#if defined(PROBE_SB)
    if (bx == 0 && F.tid == 0) ((volatile LAS unsigned long long*)(F.lds + LDSCTL_OFF + 768))[PROBE_SB] = __builtin_amdgcn_s_memrealtime() - tsb0;
#endif
}
template <bool DRY, int SKIP = 0> __device__ __forceinline__ void scanC_phase(Frame& F) {
    const int bx = blockIdx.x;
    for (int t = bx; t < SCAN_NG * 16; t += F.G) { const int gq = t >> 4, h = t & 7, hf = (t >> 3) & 1;
        const float* s0 = gq == 0 ? (const float*)(F.ws + WS_CTL + 512 * 1024) : (const float*)(F.ws + WS_SG) + (size_t)((gq - 1) * 8 + h) * 16384;
        scan_task<DRY, SKIP>(F, gq * SCAN_GC, SCAN_GC, h, hf, s0, F.out + OFF_PS + (size_t)h * 16384, gq == SCAN_NG - 1); }
}
struct NgRegs { unsigned short o[16]; v4u z0, z1; };
__device__ __forceinline__ void ng_load(Frame& F, int it, int c, int eg, NgRegs& r) {
    const int cn = it >> 3, h = it & 7;
    const bf16* op = ((bf16*)(F.ws + WS_U3)) + ((size_t)(cn * 8 + h) * 128 + 16 * eg) * 64 + c;
#pragma unroll
    for (int i = 0; i < 16; ++i) r.o[i] = op[i * 64];
    const size_t ro = (size_t)(cn * 64 + c) * D + h * 128 + 16 * eg;
    r.z0 = *(const v4u*)(((bf16*)(F.ws + WS_U2)) + ro); r.z1 = *(const v4u*)(((bf16*)(F.ws + WS_U2)) + ro + 8);
}
__device__ __forceinline__ void ng_item(Frame& F, int it, int c, int eg, const NgRegs& cur, int par) {
    LAS float* red = (LAS float*)F.lds; const float* nw = (F.in[16]) + 16 * eg;
    float o[16]; float ss = 0.f;
#pragma unroll
    for (int i = 0; i < 16; ++i) { o[i] = bf2f(cur.o[i]); ss += o[i] * o[i]; }
    LAS float* rd = red + par * 512; rd[eg * 64 + c] = ss;
    __syncthreads();
    float tot = 0.f;
#pragma unroll
    for (int w = 0; w < 8; ++w) tot += rd[w * 64 + c];
    const float ri = __builtin_amdgcn_rsqf(tot * (1.f / 128.f) + EPS);
    const unsigned zz[8] = {cur.z0.x, cur.z0.y, cur.z0.z, cur.z0.w, cur.z1.x, cur.z1.y, cur.z1.z, cur.z1.w}; unsigned w[8];
#pragma unroll
    for (int i = 0; i < 8; ++i) w[i] = pk2(o[2 * i] * ri * nw[2 * i] * siluf(bflo(zz[i])), o[2 * i + 1] * ri * nw[2 * i + 1] * siluf(bfhi(zz[i])));
    const int cn = it >> 3, h = it & 7;
    bf16* dst = ((bf16*)(F.ws + WS_U1)) + (size_t)(cn * 64 + c) * D + h * 128 + 16 * eg;
    *(v4u*)dst = (v4u){w[0], w[1], w[2], w[3]}; *(v4u*)(dst + 8) = (v4u){w[4], w[5], w[6], w[7]};
}
template <int N> __device__ __forceinline__ void ng_batch(Frame& F, int k0) {
    const int c = F.tid & 63, eg = F.wave;
    NgRegs R[N];
#pragma unroll
    for (int r = 0; r < N; ++r) ng_load(F, F.vcu + 256 * (k0 + r), c, eg, R[r]);
#pragma unroll
    for (int r = 0; r < N; ++r) ng_item(F, F.vcu + 256 * (k0 + r), c, eg, R[r], (k0 + r) & 1);
}
__device__ __forceinline__ void normgate_phase_256(Frame& F) { ng_batch<5>(F, 0); ng_batch<4>(F, 5); }
__device__ __forceinline__ void normgate_phase(Frame& F) {
    const int tid = F.tid, c = tid & 63, eg = F.wave; LAS float* red = (LAS float*)F.lds;
    int it = F.vcu; if (it >= NCH * 8) return;
    NgRegs cur, nxt; ng_load(F, it, c, eg, cur); int par = 0;
    const float* nw = (F.in[16]) + 16 * eg;
#pragma unroll 1
    for (; it < NCH * 8; it += F.G) {
        const bool has_next = it + F.G < NCH * 8;
        if (has_next) ng_load(F, it + F.G, c, eg, nxt);
        float o[16]; float ss = 0.f;
#pragma unroll
        for (int i = 0; i < 16; ++i) { o[i] = bf2f(cur.o[i]); ss += o[i] * o[i]; }
        LAS float* rd = red + par * 512; rd[eg * 64 + c] = ss;
        __syncthreads();
        float tot = 0.f;
#pragma unroll
        for (int w = 0; w < 8; ++w) tot += rd[w * 64 + c];
        const float ri = __builtin_amdgcn_rsqf(tot * (1.f / 128.f) + EPS);
        const unsigned zz[8] = {cur.z0.x, cur.z0.y, cur.z0.z, cur.z0.w, cur.z1.x, cur.z1.y, cur.z1.z, cur.z1.w}; unsigned w[8];
#pragma unroll
        for (int i = 0; i < 8; ++i) w[i] = pk2(o[2 * i] * ri * nw[2 * i] * siluf(bflo(zz[i])), o[2 * i + 1] * ri * nw[2 * i + 1] * siluf(bfhi(zz[i])));
        const int cn = it >> 3, h = it & 7;
        bf16* dst = ((bf16*)(F.ws + WS_U1)) + (size_t)(cn * 64 + c) * D + h * 128 + 16 * eg;
        *(v4u*)dst = (v4u){w[0], w[1], w[2], w[3]}; *(v4u*)(dst + 8) = (v4u){w[4], w[5], w[6], w[7]};
        cur = nxt; par ^= 1;
    }
}
#ifndef PREP_STAGGER
#define PREP_STAGGER 3
#endif
constexpr int SWA_PREP = 576 - (256 - 32);
__device__ __forceinline__ int prep_unit_id(const Frame& F, int i) {
    if (F.G != 256) { const long it = (long)F.vcu + (long)i * F.G; return it < NCH * 8 ? (int)it : -1; }
    const int v = F.vcu;
    if (v < 96) return i < 8 ? v + 256 * i : -1;
    if (i < 9) return v + 256 * i;
    const int e = (v - 96) >> 3;
    return (i == 9 && e < 12) ? 8 * e + (v & 7) + 2048 : -1;
}
#ifndef CONV1_SLACK
#define CONV1_SLACK 1
#endif
#ifndef CONV1_H2
#define CONV1_H2 0
#endif
#ifndef PROBE_AMP
#define PROBE_AMP 1
#endif
#ifndef H2_NB
#define H2_NB 4
#endif
struct H3Pre { Frame* F; __device__ __forceinline__ void operator()() const { convert_ffn(*F, (F->in[23]), (F->in[24]), nullptr, ((bf16*)(F->ws + WS_W)) + W_FOUT, F->vcu * NWAVES + F->wave, F->G * NWAVES); } };
#ifndef ADA_NA
#define ADA_NA 5
#endif
enum Phase { PH_P0 = 0, PH_H1, PH_G1, PH_G2, PH_H2, PH_F1, PH_PREP, PH_SCAN, PH_SCANB, PH_SCANC, PH_F2, PH_NG, PH_G4A, PH_G4B, PH_G5, PH_H3, PH_G6, PH_G7, PH_FIN, PH_COUNT };
struct Args { const float* in[28]; float* out; unsigned char* ws; int ph_lo, ph_hi; };
static_assert(sizeof(Args) == 28 * 8 + 8 + 8 + 8, "Args has no padding");

#ifdef ONLY_PH
#define PHON(x) ((x) == ONLY_PH)
#else
#define PHON(x) true
#endif
template <class Epi> __device__ __forceinline__ void run_gemm(Frame& F, const bf16* A, const bf16* Bt, int N, int K, const Epi& E, int lda = 0) {
    pg8::Gemm g{A, Bt, M, N, K, lda}; pg8::StaticOrder S; S.init(M, N, F.G, (int)blockIdx.x); S.ntf = K / 64;
    pg8::gemm_phase<Epi, pg8::StaticOrder, PG8_ALIGN, PG8_SP2>(F.lds, g, S, E);
}

struct SplitOrder : pg8::StaticOrder {
    bool split; int probe2 = 0; bool only_first = false;
    __device__ __forceinline__ bool next(int i, pg8::Unit& u) const {
        if (!split) return pg8::StaticOrder::next(i, u);
        if (only_first && i > 0) return false;
        if (probe2) { if (i > 0) return false; i = 1; }
        if (i > 1) return false;
        const int x = c & 7, j = c >> 3;
        if (i == 0) { u.pm = PG8_PMOD ? 8 * (j & 7) + x : 8 * x + (j & 7); u.pn = j >> 3; u.k0 = 0; u.nt = ntf; u.piece = 0; u.lidx = 0; return true; }
        const int P = 8, pc = x, pairs = ntf / 2, base = pairs / P, extra = pairs - base * P;
        u.pm = 64 + (j & 7); u.pn = j >> 3; u.lidx = (j & 7) * 4 + (j >> 3);
        u.k0 = 2 * (pc * base + (pc < extra ? pc : extra)); u.nt = 2 * (base + (pc < extra ? 1 : 0)); u.piece = pc + 1; if (probe2 == 2) u.nt = 2; return true;
    }
};
struct PiecesAB : pg8::StaticOrder {
    __device__ __forceinline__ bool next(int i, pg8::Unit& u) const {
        if (i > 0) return false;
        const int x = c & 7, j = c >> 3;
        u.pm = 64 + (j & 7); u.pn = j >> 3; u.lidx = (j & 7) * 4 + (j >> 3); u.k0 = 4 * (x & 3); u.nt = 4; u.piece = x + 1; return true;
    }
};
__device__ __forceinline__ void branch_fixup_rows(Frame& F, const bf16* part) {
    const int gw = F.vcu * NWAVES + F.wave, NGW = F.G * NWAVES;
    for (int m = MP + gw; m < M; m += NGW) {
        GAS u32x2* ga = (GAS u32x2*)(((bf16*)(F.ws + WS_U5)) + (size_t)m * D) + F.lane; const GAS u32x2* gb = (const GAS u32x2*)(((bf16*)(F.ws + WS_U6)) + (size_t)m * D) + F.lane;
        u32x2 pw[4][8], av[4], bv[4];
#pragma unroll
        for (int j = 0; j < 4; ++j) { const int li = ((m >> 8) - 64) * 4 + j; const GAS u32x2* pp = (const GAS u32x2*)(part + (size_t)li * 8 * 65536 + (size_t)(m & 255) * 256) + F.lane;
#pragma unroll
            for (int p = 0; p < 8; ++p) pw[j][p] = pp[(size_t)p * 16384];
            av[j] = ga[64 * j]; bv[j] = gb[64 * j]; }
#pragma unroll
        for (int j = 0; j < 4; ++j) { f32x4 sa = (f32x4){0.f, 0.f, 0.f, 0.f}, sb = sa;
#pragma unroll
            for (int p = 0; p < 4; ++p) { const u32x2 w = pw[j][p]; sa += (f32x4){bflo(w.x), bfhi(w.x), bflo(w.y), bfhi(w.y)}; }
#pragma unroll
            for (int p = 4; p < 8; ++p) { const u32x2 w = pw[j][p]; sb += (f32x4){bflo(w.x), bfhi(w.x), bflo(w.y), bfhi(w.y)}; }
            const u32x2 a = av[j], b = bv[j];
            const f32x4 o = (f32x4){sigm(bflo(a.x)) * sa.x + sigm(bflo(b.x)) * sb.x, sigm(bfhi(a.x)) * sa.y + sigm(bfhi(b.x)) * sb.y, sigm(bflo(a.y)) * sa.z + sigm(bflo(b.y)) * sb.z, sigm(bfhi(a.y)) * sa.w + sigm(bfhi(b.y)) * sb.w};
            ga[64 * j] = (u32x2){pk2(o.x, o.y), pk2(o.z, o.w)}; }
    }
}
template <class Epi> __device__ __forceinline__ void run_gemm_split(Frame& F, const bf16* A, const bf16* Bt, int N, int K, const Epi& E, int probe = 0) {
    pg8::Gemm g{A, Bt, M, N, K, 0}; SplitOrder S; S.init(M, N, F.G, (int)blockIdx.x); S.ntf = K / 64; S.split = (F.G == 256); S.only_first = (probe == 2); S.probe2 = probe >= 3 ? probe - 2 : 0;
    pg8::gemm_phase<Epi, SplitOrder, PG8_ALIGN, PG8_SP2>(F.lds, g, S, E);
}
__global__ void __launch_bounds__(NWAVES * 64, 2) mega_fwd(Args args) {
    extern __shared__ __attribute__((aligned(16))) unsigned char lds[];
    Frame F;
    F.lds = (LAS unsigned char*)lds; F.MISC = (volatile LAS unsigned*)(F.lds + MISC_OFF);
    F.tid = threadIdx.x; F.lane = F.tid & 63; F.wave = __builtin_amdgcn_readfirstlane(F.tid >> 6);
    F.G = gridDim.x; { const int bx = blockIdx.x; F.vcu = (F.G % 8 == 0) ? (bx % 8) * (F.G / 8) + bx / 8 : bx; }
    unsigned char* ws = args.ws; F.ctl = (gu32*)(ws + WS_CTL);
    F.in = args.in; F.out = args.out; F.ws = ws;
    for (int u = F.tid; u < (LDS_BYTES - LDSCTL_OFF) / 4; u += NWAVES * 64) ((LAS unsigned*)(F.lds + LDSCTL_OFF))[u] = 0u;
    __syncthreads();
    XcdBarrier bar; bar.bar = (unsigned*)(F.ctl + CW_BAR); bar.x = 0; bar.st = nullptr;
    const bool multi = args.ph_hi - args.ph_lo > 1;
    if (multi) bar = xcd_barrier_post((unsigned*)(F.ctl + CW_BAR), F.MISC + 8);

    const int lo = args.ph_lo, hi = args.ph_hi;
#if defined(PROBE_TS)
    if (blockIdx.x == 0 && F.tid == 0) ((volatile LAS unsigned long long*)(F.lds + LDSCTL_OFF + 512))[0] = __builtin_amdgcn_s_memrealtime();
#endif
#define IN(k) (PHON(k) && lo <= (k) && (k) < hi)
#define SEAM(k) do { if (lo <= (k) && (k) + 1 < hi) xcd_barrier(bar); } while (0)
#if defined(PROBE_TS)
#undef SEAM
#define SEAM(k) do { if (lo <= (k) && (k) + 1 < hi) xcd_barrier(bar); if (blockIdx.x == 0 && F.tid == 0) ((volatile LAS unsigned long long*)(F.lds + LDSCTL_OFF + 512))[(k) + 1] = __builtin_amdgcn_s_memrealtime(); } while (0)
#endif
#if defined(PROBE_P0)
    if (IN(PH_P0)) { { { const bool sp = F.G >= 160; const int nB = sp ? (4224 - 144 * ADA_NA + F.G - 145) / (F.G - 144) : (4224 + F.G - 1) / F.G; const int tlo = !sp ? F.vcu * nB : F.vcu < 144 ? F.vcu * ADA_NA : 144 * ADA_NA + (F.vcu - 144) * nB; const int thi = tlo + ((sp && F.vcu < 144) ? ADA_NA : nB);
        for (int it = F.vcu; it < 144; it += F.G) ada_item(F, it); convert_ffn_range(F, (F.in[9]), (F.in[10]), ((bf16*)(F.ws + WS_W)) + W_FIN, ((bf16*)(F.ws + WS_W)) + W_FOUT, tlo, thi); } }  xcd_barrier(bar); }
#endif
    if (IN(PH_P0)) { { { const bool sp = F.G >= 160; const int nB = sp ? (4224 - 144 * ADA_NA + F.G - 145) / (F.G - 144) : (4224 + F.G - 1) / F.G; const int tlo = !sp ? F.vcu * nB : F.vcu < 144 ? F.vcu * ADA_NA : 144 * ADA_NA + (F.vcu - 144) * nB; const int thi = tlo + ((sp && F.vcu < 144) ? ADA_NA : nB);
        for (int it = F.vcu; it < 144; it += F.G) ada_item(F, it); convert_ffn_range(F, (F.in[9]), (F.in[10]), ((bf16*)(F.ws + WS_W)) + W_FIN, ((bf16*)(F.ws + WS_W)) + W_FOUT, tlo, thi); } } }
    SEAM(PH_P0);
#if defined(PROBE_H1)
#if defined(PROBE_BAR)
    if (IN(PH_H1)) { for (int i_ = 0; i_ < 10; ++i_) xcd_barrier(bar); }
#endif
    if (IN(PH_H1)) { rmsmod_rows<false>(F, true, (F.in[8]), 0, ((bf16*)(F.ws + WS_U1)));  xcd_barrier(bar); }
#endif
    if (IN(PH_H1)) { if (F.G == 256) rmsmod_rows_256<false, true, false, false, 8>(F, (F.in[8]), 0, ((bf16*)(F.ws + WS_U1)), Leftover{nullptr, false, 0, 0.f}, D); else rmsmod_rows<false>(F, true, (F.in[8]), 0, ((bf16*)(F.ws + WS_U1))); }
    SEAM(PH_H1);
#if defined(PROBE_G1)
    if (IN(PH_G1)) { run_gemm(F, ((bf16*)(F.ws + WS_U1)), ((bf16*)(F.ws + WS_W)) + W_FIN, 2 * DFF, D, EpiSwiglu{((bf16*)(F.ws + WS_U2))});  xcd_barrier(bar); }
#endif
    if (IN(PH_G1)) { run_gemm(F, ((bf16*)(F.ws + WS_U1)), ((bf16*)(F.ws + WS_W)) + W_FIN, 2 * DFF, D, EpiSwiglu{((bf16*)(F.ws + WS_U2))}); }
    SEAM(PH_G1);
#if defined(PROBE_G2)
    if (IN(PH_G2)) { run_gemm_split(F, ((bf16*)(F.ws + WS_U2)), ((bf16*)(F.ws + WS_W)) + W_FOUT, D, DFF, EpiResid<true>{(F.in[0]), (F.in[1]), (bf16*)F.out, ((float*)(F.ws + WS_ADA)), 2, 0.5f, (bf16*)(F.ws + WS_U5)}, PROBE_G2);  xcd_barrier(bar); }
#endif
    if (IN(PH_G2)) { run_gemm_split(F, ((bf16*)(F.ws + WS_U2)), ((bf16*)(F.ws + WS_W)) + W_FOUT, D, DFF, EpiResid<true>{(F.in[0]), (F.in[1]), (bf16*)F.out, ((float*)(F.ws + WS_ADA)), 2, 0.5f, (bf16*)(F.ws + WS_U5)}); }
    SEAM(PH_G2);
#if defined(PROBE_H2)
    if (IN(PH_H2)) { { if (PROBE_H2 & 1) convert_mixer(F, 0, F.vcu * NWAVES + F.wave, F.G * NWAVES); __syncthreads(); if (PROBE_H2 & 2) rmsmod_rows<true>(F, false, (F.in[11]), 1, (bf16*)F.out + 1024, Leftover{F.G == 256 ? (const bf16*)(F.ws + WS_U5) : nullptr, true, 2, 0.5f}, 2048); if (PROBE_H2 & 4) rmsmod_rows<false>(F, false, (F.in[11]), 1, (bf16*)F.out + 1024, Leftover{F.G == 256 ? (const bf16*)(F.ws + WS_U5) : nullptr, true, 2, 0.5f}, 2048); }  xcd_barrier(bar); }
#endif
    if (IN(PH_H2)) { { convert_conv_state(F); convert_mixer(F, 0, F.vcu * NWAVES + F.wave, F.G * NWAVES); if (F.G != 256 || CONV1_H2) convert_mixer(F, 1, F.vcu * NWAVES + F.wave, F.G * NWAVES); __syncthreads(); if (F.G == 256) rmsmod_rows_256<true, false, true, true, H2_NB>(F, (F.in[11]), 1, (bf16*)F.out + 1024, Leftover{(const bf16*)(F.ws + WS_U5), true, 2, 0.5f}, 2048); else rmsmod_rows<true>(F, false, (F.in[11]), 1, (bf16*)F.out + 1024, Leftover{nullptr, true, 2, 0.5f}, 2048); } }
    SEAM(PH_H2);
#if defined(PROBE_F1)
    if (IN(PH_F1)) { run_gemm(F, (bf16*)F.out + 1024, ((bf16*)(F.ws + WS_W)) + W_IN, 4352, D, EpiF1{((bf16*)(F.ws + WS_U1)), ((bf16*)(F.ws + WS_U2)), ((bf16*)(F.ws + WS_U3)), ((bf16*)(F.ws + WS_U4)), ((bf16*)(F.ws + WS_KV)), ((bf16*)(F.ws + WS_TAIL)), F.out}, 2048);  xcd_barrier(bar); }
#endif
    if (IN(PH_F1)) { run_gemm(F, (bf16*)F.out + 1024, ((bf16*)(F.ws + WS_W)) + W_IN, 4352, D, EpiF1{((bf16*)(F.ws + WS_U1)), ((bf16*)(F.ws + WS_U2)), ((bf16*)(F.ws + WS_U3)), ((bf16*)(F.ws + WS_U4)), ((bf16*)(F.ws + WS_KV)), ((bf16*)(F.ws + WS_TAIL)), F.out}, 2048);
        if (F.G == 256 && blockIdx.x >= 200) for (int k = ((int)blockIdx.x - 200) * NWAVES + F.wave; k < NCH * 8; k += 56 * NWAVES) prep_gates(F, k, F.lane); }
    SEAM(PH_F1);
#if defined(PROBE_PREP)
    if (IN(PH_PREP)) { PrepRegs PR; int it = F.vcu; if (it < NCH * 8) prep_fetch(F, it, F.tid & 15, F.tid >> 4, PR); for (int par = 0; it < NCH * 8; it += F.G, par ^= 1) gdn_prep_unit<true, PROBE_PREP>(F, it >> 3, it & 7, PR, it + F.G < NCH * 8 ? it + F.G : -1, par); xcd_barrier(bar); }
#endif
#if defined(PROBE_SWA)
    if (IN(PH_PREP)) { for (int it = F.vcu; it < NCH * 2; it += F.G) swa_unit<true>(F, it >> 1, it & 1); xcd_barrier(bar); }
#endif
    if (IN(PH_PREP)) {
                        const int nsw0 = (F.G == 256) ? ((F.vcu >> 3) % PREP_STAGGER) : 0;
                        const int nswa = (F.G == 256) ? SWA_PREP : NCH * 2;
#ifndef NO_SWA
                        for (int k = 0; k < nsw0; ++k) { const int it = F.vcu + k * F.G; if (it < nswa) swa_unit<false>(F, it >> 1, it & 1); }
#endif
#ifndef NO_PREP
                        if (F.G != 256) for (int k = F.wave; prep_unit_id(F, k) >= 0; k += NWAVES) prep_gates(F, prep_unit_id(F, k), F.lane);
                        for (int i = F.tid; i < 12 * 128; i += NWAVES * 64) { const int tj = i >> 7, cc = i & 127; ((LAS float*)(F.lds + PR_CW))[i] = (F.in[13])[(tj & 3) * 3072 + (tj >> 2) * 1024 + (F.vcu & 7) * 128 + cc]; }
                        asm volatile("s_waitcnt vmcnt(0)" ::: "memory"); __syncthreads();
#if defined(PROBE_PS)
                        if (blockIdx.x == 0 && F.tid == 0) ((volatile LAS unsigned long long*)(F.lds + LDSCTL_OFF + 768))[15] = __builtin_amdgcn_s_memrealtime();
#endif
                        { PrepRegs PR; int it = prep_unit_id(F, 0); prep_fetch(F, it >= 0 ? it : 0, F.tid & 15, F.tid >> 4, PR);
                          { v4u* dm = (v4u*)(F.ws + WS_END) + (size_t)F.tid * 9;
#pragma unroll
                            for (int q = 0; q < 9; ++q) dm[q] = (v4u){0u, 0u, 0u, 0u}; }
#if defined(PROBE_PQ)
                          const unsigned long long tp0 = __builtin_amdgcn_s_memrealtime();
#endif
                          for (int i = 0; it >= 0; ++i) { const int itn = prep_unit_id(F, i + 1); gdn_prep_unit<false>(F, it >> 3, it & 7, PR, itn, i & 1); it = itn; }
#if defined(PROBE_PQ)
                          if (blockIdx.x == 0 && F.tid == 0) ((volatile LAS unsigned long long*)(F.lds + LDSCTL_OFF + 768))[12] = __builtin_amdgcn_s_memrealtime() - tp0;
#endif
                        }
#endif
#ifndef NO_SWA
#if defined(PROBE_PQ)
                        const unsigned long long tp1 = __builtin_amdgcn_s_memrealtime();
#endif
                        for (int it = F.vcu + nsw0 * F.G; it < nswa; it += F.G) swa_unit<false>(F, it >> 1, it & 1);
                        if (F.G == 256 && CONV1_SLACK && !CONV1_H2 && F.vcu >= 192) { __syncthreads(); convert_mixer_n<3>(F, 1, (F.vcu - 192) * NWAVES + F.wave, 64 * NWAVES); }
#if defined(PROBE_PQ)
                        if (blockIdx.x == 0 && F.tid == 0) ((volatile LAS unsigned long long*)(F.lds + LDSCTL_OFF + 768))[11] = __builtin_amdgcn_s_memrealtime() - tp1;
#endif
#endif
                      }
    SEAM(PH_PREP);
#if defined(PROBE_SCANA)
    if (IN(PH_SCAN)) { scanA_phase(F); xcd_barrier(bar); }
#endif
    if (IN(PH_SCAN)) { scanA_phase(F); }
    SEAM(PH_SCAN);
    if (IN(PH_SCANB)) { scanB_phase(F); if (F.G == 256 && blockIdx.x >= SCANB_WGS) { if (!CONV1_H2 && !CONV1_SLACK) convert_mixer(F, 1, ((int)blockIdx.x - SCANB_WGS) * NWAVES + F.wave, (256 - SCANB_WGS) * NWAVES);
        __syncthreads(); { const int it = SWA_PREP + (int)blockIdx.x - SCANB_WGS; swa_unit<false>(F, it >> 1, it & 1); } } }
    SEAM(PH_SCANB);
#if defined(PROBE_SCANC)
    if (IN(PH_SCANC)) { scanC_phase<true, PROBE_SCANC>(F); xcd_barrier(bar); }
#endif
    if (IN(PH_SCANC)) { scanC_phase<false>(F); }
    SEAM(PH_SCANC);
#if defined(PROBE_F2)
    if (IN(PH_F2)) { run_gemm(F, (bf16*)F.out + 1024, ((bf16*)(F.ws + WS_W)) + W_IN + (size_t)4352 * D, 3072, D, EpiF2{((bf16*)(F.ws + WS_U2)), ((bf16*)(F.ws + WS_U5)), ((bf16*)(F.ws + WS_U6))}, 2048);  xcd_barrier(bar); }
#endif
    if (IN(PH_F2)) { run_gemm(F, (bf16*)F.out + 1024, ((bf16*)(F.ws + WS_W)) + W_IN + (size_t)4352 * D, 3072, D, EpiF2{((bf16*)(F.ws + WS_U2)), ((bf16*)(F.ws + WS_U5)), ((bf16*)(F.ws + WS_U6))}, 2048);  if (F.G == 256 && blockIdx.x >= 96) { __syncthreads(); convert_ffn(F, (F.in[23]), (F.in[24]), (bf16*)(F.ws + WS_MG), nullptr, ((int)blockIdx.x - 96) * NWAVES + F.wave, 160 * NWAVES); } }
    SEAM(PH_F2);
#if defined(PROBE_NG)
    if (IN(PH_NG)) { normgate_phase(F);  xcd_barrier(bar); }
#endif
    if (IN(PH_NG)) { if (F.G == 256) normgate_phase_256(F); else normgate_phase(F); }
    SEAM(PH_NG);
    if (IN(PH_G4A)) { if (F.G == 256) run_gemm_split(F, ((bf16*)(F.ws + WS_U1)), ((bf16*)(F.ws + WS_W)) + W_A, D, D, EpiGate<0>{((bf16*)(F.ws + WS_U5)), nullptr}, 2);
                      else run_gemm(F, ((bf16*)(F.ws + WS_U1)), ((bf16*)(F.ws + WS_W)) + W_A, D, D, EpiGate<0>{((bf16*)(F.ws + WS_U5)), nullptr}); }
    __syncthreads();
    if (IN(PH_G4B)) { if (F.G == 256) { run_gemm_split(F, ((bf16*)(F.ws + WS_U4)), ((bf16*)(F.ws + WS_W)) + W_B, D, D, EpiGate<1>{((bf16*)(F.ws + WS_U5)), ((bf16*)(F.ws + WS_U6))}, 2);
                          const bool sb_ = ((blockIdx.x & 7) >> 2) != 0;
                          pg8::Gemm g{sb_ ? ((const bf16*)(F.ws + WS_U4)) : ((const bf16*)(F.ws + WS_U1)), ((const bf16*)(F.ws + WS_W)) + (sb_ ? W_B : W_A), M, D, D, 0}; PiecesAB S; S.init(M, D, F.G, (int)blockIdx.x); S.ntf = 16;
                          pg8::gemm_phase<EpiPart, PiecesAB, PG8_ALIGN, PG8_SP2>(F.lds, g, S, EpiPart{(bf16*)(F.ws + WS_U2)}); }
                      else run_gemm(F, ((bf16*)(F.ws + WS_U4)), ((bf16*)(F.ws + WS_W)) + W_B, D, D, EpiGate<1>{((bf16*)(F.ws + WS_U5)), ((bf16*)(F.ws + WS_U6))}); }
    SEAM(PH_G4B);
    if (IN(PH_G5) && F.G == 256) { branch_fixup_rows(F, (const bf16*)(F.ws + WS_U2)); xcd_barrier(bar); }
    if (IN(PH_G5)) { run_gemm_split(F, ((bf16*)(F.ws + WS_U5)), ((bf16*)(F.ws + WS_W)) + W_O, D, D, EpiResid<false>{nullptr, nullptr, (bf16*)F.out, ((float*)(F.ws + WS_ADA)), 5, 1.0f, (bf16*)(F.ws + WS_U2)}); }
    SEAM(PH_G5);
#if defined(PROBE_H3)
    if (IN(PH_H3)) { { convert_ffn(F, (F.in[23]), (F.in[24]), F.G == 256 ? nullptr : (bf16*)(F.ws + WS_MG), ((bf16*)(F.ws + WS_W)) + W_FOUT, F.vcu * NWAVES + F.wave, F.G * NWAVES); rmsmod_rows<false>(F, false, (F.in[22]), 2, ((bf16*)(F.ws + WS_U1)), Leftover{F.G == 256 ? (const bf16*)(F.ws + WS_U2) : nullptr, false, 5, 1.0f}); }  xcd_barrier(bar); }
#endif
    if (IN(PH_H3)) { { if (F.G != 256) convert_ffn(F, (F.in[23]), (F.in[24]), (bf16*)(F.ws + WS_MG), ((bf16*)(F.ws + WS_W)) + W_FOUT, F.vcu * NWAVES + F.wave, F.G * NWAVES);
        if (F.G == 256) rmsmod_rows_256<false, false, true, false, 8, H3Pre>(F, (F.in[22]), 2, ((bf16*)(F.ws + WS_U1)), Leftover{(const bf16*)(F.ws + WS_U2), false, 5, 1.0f}, D, H3Pre{&F}); else rmsmod_rows<false>(F, false, (F.in[22]), 2, ((bf16*)(F.ws + WS_U1)), Leftover{nullptr, false, 5, 1.0f}); } }
    SEAM(PH_H3);
#if defined(PROBE_G6)
    if (IN(PH_G6)) { run_gemm(F, ((bf16*)(F.ws + WS_U1)), ((bf16*)(F.ws + WS_W)) + W_FIN, 2 * DFF, D, EpiSwiglu{((bf16*)(F.ws + WS_U2))});  xcd_barrier(bar); }
#endif
    if (IN(PH_G6)) { run_gemm(F, ((bf16*)(F.ws + WS_U1)), (const bf16*)(F.ws + WS_MG), 2 * DFF, D, EpiSwiglu{((bf16*)(F.ws + WS_U2))}); }
    SEAM(PH_G6);
    if (IN(PH_G7)) { run_gemm_split(F, ((bf16*)(F.ws + WS_U2)), ((bf16*)(F.ws + WS_W)) + W_FOUT, D, DFF, EpiResid<false>{nullptr, nullptr, (bf16*)F.out, ((float*)(F.ws + WS_ADA)), 8, 0.5f, (bf16*)(F.ws + WS_U5)}); }
    SEAM(PH_G7);
    if (IN(PH_FIN)) { if (F.G == 256) final_norm_rows_256<8>(F, Leftover{(const bf16*)(F.ws + WS_U5), false, 8, 0.5f}); else final_norm_rows(F, Leftover{nullptr, false, 8, 0.5f}); }
    SEAM(PH_FIN);
#if defined(PROBE_TS)
    if (blockIdx.x == 0 && F.tid == 0) { volatile LAS unsigned long long* ts = (volatile LAS unsigned long long*)(F.lds + LDSCTL_OFF + 512); unsigned long long tot = 0;
        for (int k = 0; k < PH_COUNT; ++k) if ((PROBE_TS >> k) & 1) tot += ts[k + 1] - ts[k];
#if defined(PROBE_PS)
        tot += ((volatile LAS unsigned long long*)(F.lds + LDSCTL_OFF + 768))[PROBE_PS];
#endif
#if defined(PROBE_PQ)
        tot += ((volatile LAS unsigned long long*)(F.lds + LDSCTL_OFF + 768))[PROBE_PQ];
#endif
        tot *= PROBE_AMP;
        const unsigned long long t0 = __builtin_amdgcn_s_memrealtime(); while (__builtin_amdgcn_s_memrealtime() - t0 < tot) __builtin_amdgcn_s_sleep(8); }
#endif
#undef IN
#undef SEAM
}

extern "C" void kernel_launch(void* const* d_in, const int* in_sizes, int n_in, void* d_out, int out_size, void* d_ws, size_t ws_size, hipStream_t stream) {
    static int grid = 0;
    if (grid == 0) {
        if (n_in != 28 || in_sizes[0] != MP * D || (size_t)out_size != OUT_TOTAL || ws_size < WS_END) { fprintf(stderr, "kernel_launch: unexpected shapes (n_in %d, in0 %d, out %d, ws %zu); nothing launched\n", n_in, n_in > 0 ? in_sizes[0] : -1, out_size, ws_size); grid = -1; return; }
        int dev = 0, cus = 0, per_cu = 0;
        if (hipGetDevice(&dev) != hipSuccess || hipDeviceGetAttribute(&cus, hipDeviceAttributeMultiprocessorCount, dev) != hipSuccess) { grid = -1; return; }
        if (hipFuncSetAttribute((const void*)mega_fwd, hipFuncAttributeMaxDynamicSharedMemorySize, LDS_BYTES) != hipSuccess) { fprintf(stderr, "kernel_launch: hipFuncSetAttribute failed\n"); grid = -1; return; }
        if (hipOccupancyMaxActiveBlocksPerMultiprocessor(&per_cu, (const void*)mega_fwd, NWAVES * 64, LDS_BYTES) != hipSuccess || per_cu < 1) fprintf(stderr, "kernel_launch: occupancy query reports %d\n", per_cu);
        (void)hipGetLastError();
        grid = cus;
    }
    if (grid < 0) return;
    if (hipMemsetAsync((char*)d_ws + WS_CTL, 0, CTL_ZERO_BYTES, stream) != hipSuccess) return;
    Args a{};
    for (int i = 0; i < 28; ++i) a.in[i] = (const float*)d_in[i];
    a.out = (float*)d_out; a.ws = (unsigned char*)d_ws;
#if MK_PER_PHASE
    for (int ph = 0; ph < PH_COUNT; ++ph) { a.ph_lo = ph; a.ph_hi = ph + 1; hipLaunchKernelGGL(mega_fwd, dim3(grid), dim3(NWAVES * 64), LDS_BYTES, stream, a); }
#else
    a.ph_lo = 0; a.ph_hi = PH_COUNT; hipLaunchKernelGGL(mega_fwd, dim3(grid), dim3(NWAVES * 64), LDS_BYTES, stream, a);
#endif
    const hipError_t le = hipPeekAtLastError();
    if (le != hipSuccess) fprintf(stderr, "kernel_launch: launch failed: %s\n", hipGetErrorName(le));
}
```
